# Optimizing an MI355X kernel written in HIP

```python
import jax, jax.numpy as jnp
from jax import lax
import numpy as np

D_MODEL = 2048
BATCH = 1
SEQ = 8192
DEPTH = 1

CHUNK = 64
N_MEM = 256
EPS = 1e-6

DSA_HEADS = 8
DSA_HEAD_DIM = 128
DSA_LATENT = 256
IDX_HEADS = 8
IDX_DIM = 64
TOPK_MAX = 256
Q_BLOCK = 128

ML_HEADS = 4
ML_QK_DIM = 128
ML_V_DIM = 256
CONV_W = 4

D_MIX = DSA_HEADS * DSA_HEAD_DIM + ML_HEADS * ML_V_DIM

IN_SIZES = (
    DSA_HEADS * DSA_HEAD_DIM,
    DSA_LATENT,
    IDX_HEADS * IDX_DIM,
    IDX_DIM,
    IDX_HEADS,
    ML_HEADS * ML_QK_DIM,
    ML_HEADS * ML_QK_DIM,
    ML_HEADS * ML_V_DIM,
    ML_HEADS,
    ML_HEADS,
    ML_HEADS * ML_V_DIM,
)
D_IN = sum(IN_SIZES)

X_HEADS = 4
X_HEAD_DIM = D_MODEL // X_HEADS

N_GROUPS = 4
EXP_PER_GROUP = 8
N_EXPERTS = N_GROUPS * EXP_PER_GROUP
TOPK_IN_GROUP = 2
D_EXPERT = 512
MOE_BLOCK = 128

kernel_name = "hybrid_dsa_mlstm_hiermoe_layer"


def rmsnorm(x, g):
    xf = x.astype(jnp.float32)
    y = xf * lax.rsqrt(jnp.mean(xf * xf, axis=-1, keepdims=True) + EPS)
    return (y * g.astype(jnp.float32)).astype(x.dtype)


def dsa_mixer(q, c_kv, q_idx, k_idx, w_idx, w_uk, w_uv, kv_norm_g, k_idx_norm_g):
    B, T = q.shape[:2]
    topk = min(TOPK_MAX, T // 4)
    c_kv = rmsnorm(c_kv, kv_norm_g)
    k_idx = rmsnorm(k_idx, k_idx_norm_g).astype(jnp.float32)
    q_abs = jnp.einsum('bthd,chd->bthc', q, w_uk)
    key_chunk = jnp.arange(T) // CHUNK
    nb = T // Q_BLOCK
    bidx = jnp.arange(B)[:, None, None]

    def to_blocks(a):
        return jnp.moveaxis(a.reshape((B, nb, Q_BLOCK) + a.shape[2:]), 1, 0)

    def block_fn(args):
        qi, wi, qa, start = args
        q_chunk = (start + jnp.arange(Q_BLOCK)) // CHUNK
        admissible = key_chunk[None, :] <= q_chunk[:, None]
        dots = jnp.einsum('bqhd,bsd->bqhs', qi.astype(jnp.float32), k_idx) * IDX_DIM ** -0.5
        score = jnp.einsum('bqh,bqhs->bqs', wi.astype(jnp.float32) * IDX_HEADS ** -0.5,
                           jax.nn.relu(dots))
        score = jnp.where(admissible[None], score, -jnp.inf)
        _, sel = lax.top_k(score, topk)
        valid = key_chunk[sel] <= q_chunk[None, :, None]
        c_sel = c_kv[bidx, sel]
        logits = jnp.einsum('bqhc,bqkc->bqhk', qa.astype(jnp.float32),
                            c_sel.astype(jnp.float32)) * DSA_HEAD_DIM ** -0.5
        logits = jnp.where(valid[:, :, None, :], logits, -jnp.inf)
        p = jax.nn.softmax(logits, axis=-1)
        return jnp.einsum('bqhk,bqkc->bqhc', p.astype(c_sel.dtype), c_sel)

    o_lat = lax.map(block_fn, (to_blocks(q_idx), to_blocks(w_idx), to_blocks(q_abs),
                               jnp.arange(nb) * Q_BLOCK))
    o_lat = jnp.moveaxis(o_lat, 0, 1).reshape(B, T, DSA_HEADS, DSA_LATENT)
    o = jnp.einsum('bthc,chd->bthd', o_lat, w_uv)
    return o.reshape(B, T, DSA_HEADS * DSA_HEAD_DIM)


def causal_conv(x, w, b):
    T = x.shape[1]
    xp = jnp.pad(x, ((0, 0), (CONV_W - 1, 0), (0, 0)))
    y = b
    for j in range(CONV_W):
        y = y + xp[:, j:j + T] * w[j]
    return y


def mlstm_mixer(q, k, v, i_pre, f_pre, o_pre, head_norm_g):
    B, T, H, DK = q.shape
    DV = v.shape[-1]
    nc = T // CHUNK
    f32 = jnp.float32

    def chunks(a):
        a = a.reshape((B, nc, CHUNK) + a.shape[2:])
        return jnp.moveaxis(jnp.moveaxis(a, 3, 2), 1, 0)

    qc = chunks(q.astype(f32) * DK ** -0.5)
    kc = chunks(k.astype(f32))
    vc = chunks(v.astype(f32))
    li = chunks(i_pre.astype(f32))
    lf = chunks(jax.nn.log_sigmoid(f_pre.astype(f32)))
    causal = jnp.tril(jnp.ones((CHUNK, CHUNK), bool))

    def step(carry, inp):
        C, n, m = carry
        qh, kh, vh, li_c, lf_c = inp
        b = jnp.cumsum(lf_c, axis=-1)
        g = b[..., -1]
        dmat = b[..., :, None] - b[..., None, :] + li_c[..., None, :]
        dmat = jnp.where(causal, dmat, -jnp.inf)
        inter = b + m[..., None]
        m_t = jnp.maximum(inter, jnp.max(dmat, axis=-1))
        w_intra = jnp.exp(dmat - m_t[..., None])
        a_inter = jnp.exp(inter - m_t)
        qk = jnp.einsum('bhtd,bhsd->bhts', qh, kh) * w_intra
        num = (a_inter[..., None] * jnp.einsum('bhtd,bhdv->bhtv', qh, C)
               + jnp.einsum('bhts,bhsv->bhtv', qk, vh))
        den = a_inter * jnp.einsum('bhtd,bhd->bht', qh, n) + qk.sum(-1)
        h = num / jnp.maximum(jnp.abs(den), jnp.exp(-m_t))[..., None]
        decay_s = g[..., None] - b + li_c
        m_new = jnp.maximum(g + m, decay_s.max(-1))
        ws = jnp.exp(decay_s - m_new[..., None])
        a_state = jnp.exp(g + m - m_new)
        wk = ws[..., None] * kh
        C_new = a_state[..., None, None] * C + jnp.einsum('bhsd,bhsv->bhdv', wk, vh)
        n_new = a_state[..., None] * n + wk.sum(-2)
        return (C_new, n_new, m_new), h

    init = (jnp.zeros((B, H, DK, DV), f32), jnp.zeros((B, H, DK), f32), jnp.zeros((B, H), f32))
    _, hs = lax.scan(step, init, (qc, kc, vc, li, lf))
    hs = jnp.moveaxis(jnp.moveaxis(hs, 0, 1), 2, 3).reshape(B, T, H, DV).astype(v.dtype)
    hs = rmsnorm(hs, head_norm_g.reshape(H, DV)).reshape(B, T, H * DV)
    return hs * jax.nn.sigmoid(o_pre)


def memory_cross_attn(h, mem_n, w_cq, w_ckv, w_co):
    B, T, D = h.shape
    M = mem_n.shape[1]
    q = (h @ w_cq).reshape(B, T, X_HEADS, X_HEAD_DIM)
    kv = (mem_n @ w_ckv).reshape(B, M, 2, X_HEADS, X_HEAD_DIM)
    k, v = kv[:, :, 0], kv[:, :, 1]
    logits = jnp.einsum('bthd,bmhd->bhtm', q.astype(jnp.float32),
                        k.astype(jnp.float32)) * X_HEAD_DIM ** -0.5
    p = jax.nn.softmax(logits, axis=-1).astype(v.dtype)
    o = jnp.einsum('bhtm,bmhd->bthd', p, v).reshape(B, T, D)
    return o @ w_co


def hier_moe(h, w_group, b_group, w_router, b_router, w_gate, w_up, w_down):
    B, T, D = h.shape
    N = B * T
    xt = h.reshape(N, D)
    g_logits = (xt @ w_group).astype(jnp.float32) + b_group
    g_prob = jax.nn.softmax(g_logits, axis=-1)
    g_sel = jnp.argmax(g_logits, axis=-1)
    p_g = jnp.take_along_axis(g_prob, g_sel[:, None], axis=-1)
    e_logits = ((xt @ w_router).astype(jnp.float32) + b_router).reshape(N, N_GROUPS, EXP_PER_GROUP)
    e_logits = jnp.take_along_axis(e_logits, g_sel[:, None, None], axis=1)[:, 0]
    top_p, top_local = lax.top_k(jax.nn.softmax(e_logits, axis=-1), TOPK_IN_GROUP)
    gates = p_g * top_p / top_p.sum(-1, keepdims=True)
    expert_id = g_sel[:, None] * EXP_PER_GROUP + top_local

    A = N * TOPK_IN_GROUP
    flat_e = expert_id.reshape(A).astype(jnp.int32)
    flat_tok = jnp.repeat(jnp.arange(N, dtype=jnp.int32), TOPK_IN_GROUP)
    flat_w = gates.reshape(A)
    order = jnp.argsort(flat_e)
    se, stok, sw = flat_e[order], flat_tok[order], flat_w[order]
    counts = jnp.zeros((N_EXPERTS,), jnp.int32).at[flat_e].add(1)
    starts = jnp.cumsum(counts) - counts
    padded = (counts + MOE_BLOCK - 1) // MOE_BLOCK * MOE_BLOCK
    pad_ends = jnp.cumsum(padded)
    pad_starts = pad_ends - padded
    row = pad_starts[se] + (jnp.arange(A, dtype=jnp.int32) - starts[se])
    nblk = -(-A // MOE_BLOCK) + N_EXPERTS
    n_rows = nblk * MOE_BLOCK
    row_tok = jnp.full((n_rows,), N, jnp.int32).at[row].set(stok)
    row_w = jnp.zeros((n_rows,), jnp.float32).at[row].set(sw)
    blk_expert = jnp.minimum(
        jnp.searchsorted(pad_ends, jnp.arange(nblk, dtype=jnp.int32) * MOE_BLOCK, side='right'),
        N_EXPERTS - 1)
    x_pad = jnp.concatenate([xt, jnp.zeros((1, D), xt.dtype)], axis=0)

    def expert_block(args):
        tok, e = args
        xb = x_pad[tok]
        a = jax.nn.silu(xb @ w_gate[e]) * (xb @ w_up[e])
        return a @ w_down[e]

    y_rows = lax.map(expert_block, (row_tok.reshape(nblk, MOE_BLOCK), blk_expert))
    y_rows = y_rows.reshape(n_rows, D) * row_w[:, None].astype(y_rows.dtype)
    y = jax.ops.segment_sum(y_rows, row_tok, num_segments=N + 1)[:N]
    return y.reshape(B, T, D)


def setup_inputs(seed: int = 0) -> dict:
    key = jax.random.key(seed)
    ks = jax.random.split(key, 32)
    f32 = jnp.float32
    L = DEPTH

    def nrm(k, shape, scale):
        return jax.random.normal(k, shape, f32) * scale

    def gain(k, shape):
        return 1.0 + 0.02 * jax.random.normal(k, shape, f32)

    return {
        "x": nrm(ks[0], (BATCH, SEQ, D_MODEL), 1.0),
        "mem": nrm(ks[1], (BATCH, N_MEM, D_MODEL), 1.0),
        "norm_mix_g": gain(ks[2], (L, D_MODEL)),
        "w_in": nrm(ks[3], (L, D_MODEL, D_IN), D_MODEL ** -0.5),
        "kv_norm_g": gain(ks[4], (L, DSA_LATENT)),
        "k_idx_norm_g": gain(ks[5], (L, IDX_DIM)),
        "w_uk": nrm(ks[6], (L, DSA_LATENT, DSA_HEADS, DSA_HEAD_DIM), DSA_LATENT ** -0.5),
        "w_uv": nrm(ks[7], (L, DSA_LATENT, DSA_HEADS, DSA_HEAD_DIM), DSA_LATENT ** -0.5),
        "conv_w": nrm(ks[8], (L, CONV_W, 2 * ML_HEADS * ML_QK_DIM), CONV_W ** -0.5),
        "conv_b": nrm(ks[9], (L, 2 * ML_HEADS * ML_QK_DIM), 0.01),
        "gate_b": jnp.concatenate([nrm(ks[10], (L, ML_HEADS), 0.1),
                                   3.0 + nrm(ks[11], (L, ML_HEADS), 0.1)], axis=-1),
        "ml_norm_g": gain(ks[12], (L, ML_HEADS * ML_V_DIM)),
        "w_out": nrm(ks[13], (L, D_MIX, D_MODEL), D_MIX ** -0.5),
        "norm_x_g": gain(ks[14], (L, D_MODEL)),
        "mem_norm_g": gain(ks[15], (L, D_MODEL)),
        "w_cq": nrm(ks[16], (L, D_MODEL, D_MODEL), D_MODEL ** -0.5),
        "w_ckv": nrm(ks[17], (L, D_MODEL, 2 * D_MODEL), D_MODEL ** -0.5),
        "w_co": nrm(ks[18], (L, D_MODEL, D_MODEL), D_MODEL ** -0.5),
        "norm_ffn_g": gain(ks[19], (L, D_MODEL)),
        "w_group": nrm(ks[20], (L, D_MODEL, N_GROUPS), D_MODEL ** -0.5),
        "b_group": nrm(ks[21], (L, N_GROUPS), 0.01),
        "w_router": nrm(ks[22], (L, D_MODEL, N_EXPERTS), D_MODEL ** -0.5),
        "b_router": nrm(ks[23], (L, N_EXPERTS), 0.01),
        "w_gate": nrm(ks[24], (L, N_EXPERTS, D_MODEL, D_EXPERT), D_MODEL ** -0.5),
        "w_up": nrm(ks[25], (L, N_EXPERTS, D_MODEL, D_EXPERT), D_MODEL ** -0.5),
        "w_down": nrm(ks[26], (L, N_EXPERTS, D_EXPERT, D_MODEL), D_EXPERT ** -0.5),
        "final_norm_g": gain(ks[27], (D_MODEL,)),
    }


def reference(x, mem, norm_mix_g, w_in, kv_norm_g, k_idx_norm_g, w_uk, w_uv, conv_w, conv_b,
              gate_b, ml_norm_g, w_out, norm_x_g, mem_norm_g, w_cq, w_ckv, w_co, norm_ffn_g,
              w_group, b_group, w_router, b_router, w_gate, w_up, w_down, final_norm_g):
    B, T, _ = x.shape
    split_points = np.cumsum(IN_SIZES)[:-1].tolist()
    for layer in range(DEPTH):
        h = rmsnorm(x, norm_mix_g[layer])
        proj = h @ w_in[layer]
        dq, ckv, qi, ki, wi, mq, mk, mv, mi, mf, mo = jnp.split(proj, split_points, axis=-1)
        dsa_out = dsa_mixer(dq.reshape(B, T, DSA_HEADS, DSA_HEAD_DIM), ckv,
                            qi.reshape(B, T, IDX_HEADS, IDX_DIM), ki, wi,
                            w_uk[layer], w_uv[layer], kv_norm_g[layer], k_idx_norm_g[layer])
        qk = jax.nn.silu(causal_conv(jnp.concatenate([mq, mk], axis=-1), conv_w[layer], conv_b[layer]))
        mq, mk = jnp.split(qk, 2, axis=-1)
        gb = gate_b[layer]
        ml_out = mlstm_mixer(mq.reshape(B, T, ML_HEADS, ML_QK_DIM),
                             mk.reshape(B, T, ML_HEADS, ML_QK_DIM),
                             mv.reshape(B, T, ML_HEADS, ML_V_DIM),
                             mi + gb[:ML_HEADS], mf + gb[ML_HEADS:], mo, ml_norm_g[layer])
        x = x + jnp.concatenate([dsa_out, ml_out], axis=-1) @ w_out[layer]
        mem_n = rmsnorm(mem, mem_norm_g[layer])
        x = x + memory_cross_attn(rmsnorm(x, norm_x_g[layer]), mem_n,
                                  w_cq[layer], w_ckv[layer], w_co[layer])
        x = x + hier_moe(rmsnorm(x, norm_ffn_g[layer]), w_group[layer], b_group[layer],
                         w_router[layer], b_router[layer], w_gate[layer], w_up[layer], w_down[layer])
    return rmsnorm(x, final_norm_g)
```

```cpp
#include <hip/hip_runtime.h>
#include <cstdio>
#include <cstdint>

#ifndef MK_N_LAUNCHES
#define MK_N_LAUNCHES 13
#endif

#define GAS __attribute__((address_space(1)))
#define LAS __attribute__((address_space(3)))
typedef unsigned short bf16;
typedef short bf16x8 __attribute__((ext_vector_type(8)));
typedef float f32x4 __attribute__((ext_vector_type(4)));
typedef float f32x2 __attribute__((ext_vector_type(2)));
typedef unsigned u32x4 __attribute__((ext_vector_type(4)));
typedef unsigned u32x2 __attribute__((ext_vector_type(2)));

constexpr int T = 8192, D = 2048, NMEM = 256;
constexpr int D_IN = 4944;
constexpr int NPROJ = 6144;
constexpr int KMIX = 3072;
constexpr int NCH = 128, CH = 64;
constexpr int NEXP = 32, DEXP = 512;
constexpr float EPS = 1e-6f;
constexpr int NPHASE = 13;

constexpr size_t MiB = 1u << 20;
constexpr size_t WS_CTL = 0, CTL_ZERO_BYTES = 256 * 1024;
constexpr size_t WS_WOUT_T = 1 * MiB;
constexpr size_t WS_WCQ_T = 13 * MiB;
constexpr size_t WS_WCKV_T = 21 * MiB;
constexpr size_t WS_WCO_T = 37 * MiB;
constexpr size_t WS_WGU_T = 45 * MiB;
constexpr size_t WS_WDN_T = 173 * MiB;
constexpr size_t WS_WIN_T = 237 * MiB;
constexpr size_t WS_H1 = 261 * MiB;
constexpr size_t WS_MIXIN = 237 * MiB;
constexpr size_t WS_MEMN = 293 * MiB;
constexpr size_t WS_KC = 294 * MiB;
constexpr size_t WS_VT = 295 * MiB;
constexpr size_t WS_GATES = 296 * MiB;
constexpr size_t WS_QABS = 298 * MiB;
constexpr size_t WS_CKVRAW = 330 * MiB;
constexpr size_t WS_QI = 338 * MiB;
constexpr size_t WS_SMALL = 346 * MiB;
constexpr size_t WS_MQKRAW = 354 * MiB;
constexpr size_t WS_MV = 386 * MiB;
constexpr size_t WS_MO = 402 * MiB;
constexpr size_t WS_CKVN = 418 * MiB;
constexpr size_t WS_KIDXN = 422 * MiB;
constexpr size_t WS_QCM = 423 * MiB;
constexpr size_t WS_KCM = 431 * MiB;
constexpr size_t WS_LST = 439 * MiB;
constexpr size_t WS_NL = 503 * MiB;
constexpr size_t WS_CST = 504 * MiB;
constexpr size_t WS_X1B = 298 * MiB;
constexpr size_t WS_QC = 330 * MiB;
constexpr size_t WS_OC = 362 * MiB;
constexpr size_t WS_X2B = 394 * MiB;
constexpr size_t WS_LIST = 426 * MiB;
constexpr size_t WS_TOK = 427 * MiB;
constexpr size_t WS_ACT = 428 * MiB;
constexpr size_t WS_Y = 452 * MiB;
constexpr size_t WS_END = 548 * MiB;
constexpr int GT_B = 0;
constexpr int GT_LI = T * 4;
constexpr int GT_G = 2 * T * 4;
constexpr int GT_MLOC = GT_G + 512;
constexpr int GT_MPREV = GT_MLOC + 512;
constexpr int CW_BAR = 4096;
constexpr int CW_CNT = 8192;
constexpr int CW_SS2 = 16384;
static_assert((CW_SS2 + T) * 4 <= (int)CTL_ZERO_BYTES, "ctl");

constexpr int RING_BYTES = 131072;
constexpr int MISC_OFF = RING_BYTES;
constexpr int LDS_BYTES = 147456;

__device__ __forceinline__ float bf2f(unsigned b) { return __uint_as_float(b << 16); }
__device__ __forceinline__ unsigned f2bf(float f) { unsigned u = __float_as_uint(f); return (u + 0x7fffu + ((u >> 16) & 1u)) >> 16; }
__device__ __forceinline__ unsigned pk2(float lo, float hi) { return f2bf(lo) | (f2bf(hi) << 16); }
__device__ __forceinline__ float wave_sum(float v) {
#pragma unroll
    for (int o = 1; o < 64; o <<= 1) v += __shfl_xor(v, o);
    return v;
}
__device__ __forceinline__ float wave_max(float v) {
#pragma unroll
    for (int o = 1; o < 64; o <<= 1) v = fmaxf(v, __shfl_xor(v, o));
    return v;
}
#define LDS_WAIT() asm volatile("s_waitcnt lgkmcnt(0)" ::: "memory")

#define XB_TMO      128
#define XB_XCNT(j)  (256  + 64 * (j))
#define XB_XSUB(j)  (1280 + 64 * (j))
#define XB_XGEN(j)  (2304 + 64 * (j))
#define XB_TOP      3328
#define XB_TOPGEN   3392
#define XCD_BAR_WORDS 3456
#define XB_SPIN_CAP (1u << 18)
__device__ __forceinline__ unsigned xb_ld(unsigned* p)              { return __hip_atomic_load(p, __ATOMIC_RELAXED, __HIP_MEMORY_SCOPE_AGENT); }
__device__ __forceinline__ unsigned xb_add(unsigned* p, unsigned v) { return __hip_atomic_fetch_add(p, v, __ATOMIC_RELAXED, __HIP_MEMORY_SCOPE_AGENT); }
__device__ __forceinline__ unsigned xb_xcc_id() { return (unsigned)__builtin_amdgcn_s_getreg((3 << 11) | 20) & 0xFu; }
#define XB_SPIN(cond, bar) do { unsigned _sp = 0; while (cond) { __builtin_amdgcn_s_sleep(1); \
    if ((++_sp & 255u) == 0u) { if (xb_ld(&(bar)[XB_TMO])) break; if (_sp > XB_SPIN_CAP) { atomicAdd(&(bar)[XB_TMO], 1u); break; } } } } while (0)
struct XcdBarrier { unsigned* bar; unsigned x; volatile LAS unsigned* st; };
__device__ __forceinline__ XcdBarrier xcd_barrier_post(unsigned* bar, volatile LAS unsigned* st) {
    XcdBarrier b; b.bar = bar; b.x = xb_xcc_id(); b.st = st;
    if (threadIdx.x == 0) (void)xb_add(&bar[XB_XCNT(b.x)], 1u);
    return b;
}
__device__ __forceinline__ void xcd_barrier_complete(unsigned* bar, unsigned x, unsigned& nloc, unsigned& nx) {
    const unsigned G = gridDim.x * gridDim.y * gridDim.z;
    unsigned sum, cnt, mine, sp = 0u;
    for (;;) {
        sum = 0u; cnt = 0u; mine = 0u;
#pragma unroll
        for (unsigned j = 0; j < 16; ++j) { const unsigned c = xb_ld(&bar[XB_XCNT(j)]); sum += c; cnt += (c > 0u) ? 1u : 0u; mine = (j == x) ? c : mine; }
        if (sum == G) break;
        __builtin_amdgcn_s_sleep(1);
        if ((++sp & 255u) == 0u) { if (xb_ld(&bar[XB_TMO])) break; if (sp > XB_SPIN_CAP) { atomicAdd(&bar[XB_TMO], 1u); break; } }
    }
    nloc = mine > 0u ? mine : 1u; nx = cnt > 0u ? cnt : 1u;
}
__device__ __forceinline__ void xcd_barrier(const XcdBarrier& b) {
    asm volatile("s_waitcnt vmcnt(0)" ::: "memory");
    __syncthreads();
    if (threadIdx.x == 0) {
        unsigned* bar = b.bar;
        __builtin_amdgcn_s_waitcnt(0);
        unsigned nloc = b.st[0], nx = b.st[1];
        if (nloc == 0u) { xcd_barrier_complete(bar, b.x, nloc, nx); b.st[0] = nloc; b.st[1] = nx; }
        const unsigned old = xb_add(&bar[XB_XSUB(b.x)], 1u);
        const unsigned gen = old / nloc;
        if (old + 1u == (gen + 1u) * nloc) {
            __builtin_amdgcn_fence(__ATOMIC_RELEASE, "agent");
            asm volatile("s_waitcnt vmcnt(0)" ::: "memory");
            const unsigned og = xb_add(&bar[XB_TOP], 1u);
            const unsigned tg = og / nx;
            if (og + 1u == (tg + 1u) * nx) xb_add(&bar[XB_TOPGEN], 1u);
            else XB_SPIN(xb_ld(&bar[XB_TOPGEN]) == tg, bar);
            __builtin_amdgcn_fence(__ATOMIC_ACQUIRE, "agent");
            xb_add(&bar[XB_XGEN(b.x)], 1u);
            asm volatile("s_waitcnt vmcnt(0)" ::: "memory");
        } else {
            XB_SPIN(xb_ld(&bar[XB_XGEN(b.x)]) == gen, bar);
            __builtin_amdgcn_fence(__ATOMIC_ACQUIRE, "agent");
            asm volatile("s_waitcnt vmcnt(0)" ::: "memory");
        }
    }
    __syncthreads();
}

namespace pg8 {
constexpr int BM = 256, BK = 64, HALF = 128, HTB = HALF * BK * 2, STAGE_BYTES = 8 * HTB, NXCD = 8, WGM = 8;
__host__ __device__ __forceinline__ int lds_byte(int r, int c) { const int st = (r >> 4) * 2 + (c >> 5), rr = r & 15, cc = c & 31, ob = rr * 64 + cc * 2; return st * 1024 + (ob ^ (((ob >> 9) & 1) << 5)); }
__host__ __device__ __forceinline__ void stage_rc(int b, int& R, int& C) { const int st = b / 1024, sb = b % 1024, swz = sb ^ (((sb >> 9) & 1) << 5); R = (st >> 1) * 16 + swz / 64; C = (st & 1) * 32 + (swz % 64) / 2; }

struct Unit { int pm, pn, e, rt; };

struct DenseOrder {
    int nM, nN, nwg, G, c; unsigned lda_bytes; unsigned kb;
    __device__ void init(int M, int N, int K, int lda, int G_, int c_) { nM = M / BM; nN = N / BM; nwg = nM * nN; G = G_; c = c_; lda_bytes = (unsigned)lda * 2u; kb = (unsigned)K * 2u; }
    __device__ bool next(int i, Unit& u) const {
        if (c < 0) return false;
        const long L = (long)i * G + c; if (L >= nwg) return false;
        int wgid = (int)L; { const int q = nwg / NXCD, r = nwg % NXCD, xcd = wgid % NXCD, off = wgid / NXCD; wgid = (xcd < r ? xcd * (q + 1) : r * (q + 1) + (xcd - r) * q) + off; }
        const int nig = WGM * nN, gid = wgid / nig, fm = gid * WGM, gsz = (nM - fm) < WGM ? (nM - fm) : WGM;
        u.pm = fm + ((wgid % nig) % gsz); u.pn = (wgid % nig) / gsz; u.e = 0; u.rt = 0; return true;
    }
    __device__ __forceinline__ unsigned a_row(const Unit& u, int r) const { return (unsigned)(u.pm * BM + r) * lda_bytes; }
    __device__ __forceinline__ size_t b_off(const Unit& u) const { return (size_t)u.pn * BM * kb; }
};

#define PG8_SA(b, h) (((b) * 2 + (h)) * HTB)
#define PG8_SB(b, h) ((4 + (b) * 2 + (h)) * HTB)
#define PG8_STAGEB(bufoff, gbase) do { _Pragma("unroll") for (int _i = 0; _i < 2; ++_i) \
        __builtin_amdgcn_global_load_lds((const unsigned*)((const char*)(gbase) + voffB[_i]), (LAS unsigned*)(lds + (bufoff) + ldsw + _i * 8192), 16, 0, 0); } while (0)
#define PG8_STAGEA(bufoff, kbyte, ao0, ao1) do { \
        __builtin_amdgcn_global_load_lds((const unsigned*)(Ab + (kbyte) + (ao0)), (LAS unsigned*)(lds + (bufoff) + ldsw), 16, 0, 0); \
        __builtin_amdgcn_global_load_lds((const unsigned*)(Ab + (kbyte) + (ao1)), (LAS unsigned*)(lds + (bufoff) + ldsw + 8192), 16, 0, 0); } while (0)
#define PG8_LDA(dst, b, h) do { _Pragma("unroll") for (int m = 0; m < 4; ++m) _Pragma("unroll") for (int k = 0; k < 2; ++k) dst[m][k] = *(const LAS bf16x8*)(lds + PG8_SA(b, h) + aoff + m * 2048 + k * 1024); } while (0)
#define PG8_LDB(dst, b, h) do { _Pragma("unroll") for (int n = 0; n < 2; ++n) _Pragma("unroll") for (int k = 0; k < 2; ++k) dst[n][k] = *(const LAS bf16x8*)(lds + PG8_SB(b, h) + boff + n * 2048 + k * 1024); } while (0)
#define PG8_MMA(ai, bj, At, Bt) do { __builtin_amdgcn_s_setprio(1); _Pragma("unroll") for (int m = 0; m < 4; ++m) _Pragma("unroll") for (int n = 0; n < 2; ++n) _Pragma("unroll") for (int k = 0; k < 2; ++k) \
        acc[ai][bj][m][n] = __builtin_amdgcn_mfma_f32_16x16x32_bf16(Bt[n][k], At[m][k], acc[ai][bj][m][n], 0, 0, 0); __builtin_amdgcn_s_setprio(0); } while (0)
#define PG8_WAIT_V(n) asm volatile("s_waitcnt vmcnt(" #n ")" ::: "memory")
#define PG8_WAIT_L(n) asm volatile("s_waitcnt lgkmcnt(" #n ")" ::: "memory")
#define PG8_BAR __builtin_amdgcn_s_barrier()
#define PG8_SCHED __builtin_amdgcn_sched_barrier(0)

template <class Epi, class Sched>
__device__ __forceinline__ void gemm_phase(LAS unsigned char* lds, const bf16* A, const bf16* Bt, const int K, const Sched& S, const Epi& E) {
    const int tid = threadIdx.x, wid = __builtin_amdgcn_readfirstlane(tid >> 6), lane = tid & 63, wr = wid >> 2, wc = wid & 3, fr = lane & 15, fq = lane >> 4;
    const int nt = K / BK;
    int sR[2], sC2[2]; unsigned voffB[2];
#pragma unroll
    for (int i = 0; i < 2; ++i) { int R, C; stage_rc(tid * 16 + i * 8192, R, C); sR[i] = R; sC2[i] = C * 2; voffB[i] = (unsigned)(R * K + C) * 2u; }
    const unsigned kstep = (unsigned)(BK * 2);
    const size_t hstepB = (size_t)HALF * K * 2;
    const unsigned ldsw = (unsigned)wid * 1024u;
    const int aoff = lds_byte(wr * 64 + fr, fq * 8), boff = lds_byte(wc * 32 + fr, fq * 8);
    Unit cur, nxt; int ui = 0;
    if (!S.next(0, cur)) return;
    f32x4 acc[2][2][4][2];
#pragma unroll
    for (int a = 0; a < 2; ++a)
#pragma unroll
        for (int b = 0; b < 2; ++b)
#pragma unroll
            for (int m = 0; m < 4; ++m)
#pragma unroll
                for (int n = 0; n < 2; ++n) acc[a][b][m][n] = (f32x4){0.f, 0.f, 0.f, 0.f};
    bf16x8 At[4][2], B0[2][2], B1[2][2];
    const char* Ab = (const char*)A;
    unsigned c00 = S.a_row(cur, sR[0]) + sC2[0], c01 = S.a_row(cur, sR[1]) + sC2[1], c10 = S.a_row(cur, 128 + sR[0]) + sC2[0], c11 = S.a_row(cur, 128 + sR[1]) + sC2[1];
    const char* cB = (const char*)Bt + S.b_off(cur);
    PG8_STAGEB(PG8_SB(0, 0), cB); PG8_STAGEA(PG8_SA(0, 0), 0u, c00, c01); PG8_STAGEB(PG8_SB(0, 1), cB + hstepB); PG8_STAGEA(PG8_SA(0, 1), 0u, c10, c11);
    if (wr == 1) PG8_BAR;
    PG8_WAIT_V(4); PG8_BAR;
    PG8_STAGEB(PG8_SB(1, 0), cB + kstep); PG8_STAGEA(PG8_SA(1, 0), kstep, c00, c01); PG8_STAGEB(PG8_SB(1, 1), cB + hstepB + kstep);
    PG8_WAIT_V(6); PG8_BAR;
    for (;;) {
        const bool has_next = S.next(ui + 1, nxt);
        unsigned n00 = c00, n01 = c01, n10 = c10, n11 = c11; const char* nB = cB;
        if (has_next) { n00 = S.a_row(nxt, sR[0]) + sC2[0]; n01 = S.a_row(nxt, sR[1]) + sC2[1]; n10 = S.a_row(nxt, 128 + sR[0]) + sC2[0]; n11 = S.a_row(nxt, 128 + sR[1]) + sC2[1]; nB = (const char*)Bt + S.b_off(nxt); }
        for (int t = 0; t < nt; t += 2) {
            const bool last = (t == nt - 2);
            const unsigned k1 = (unsigned)(t + 1) * kstep;
            const unsigned k2 = last ? 0u : (unsigned)(t + 2) * kstep, k3 = k2 + kstep;
            const unsigned o00 = last ? n00 : c00, o01 = last ? n01 : c01, o10 = last ? n10 : c10, o11 = last ? n11 : c11;
            const char* b2 = last ? nB : cB + (size_t)(t + 2) * kstep; const char* b3 = b2 + kstep;
            PG8_LDB(B0, 0, 0); PG8_SCHED; PG8_LDA(At, 0, 0); PG8_STAGEA(PG8_SA(1, 1), k1, c10, c11);
            PG8_WAIT_L(8); PG8_BAR; PG8_WAIT_L(0); PG8_MMA(0, 0, At, B0); PG8_BAR; PG8_SCHED;
            PG8_LDB(B1, 0, 1); PG8_STAGEB(PG8_SB(0, 0), b2);
            PG8_BAR; PG8_WAIT_L(0); PG8_MMA(0, 1, At, B1); PG8_BAR;
            PG8_LDA(At, 0, 1); PG8_STAGEA(PG8_SA(0, 0), k2, o00, o01);
            PG8_BAR; PG8_WAIT_L(0); PG8_MMA(1, 0, At, B0); PG8_BAR; PG8_SCHED;
            PG8_STAGEB(PG8_SB(0, 1), b2 + hstepB);
            PG8_WAIT_V(6); PG8_BAR; PG8_MMA(1, 1, At, B1); PG8_BAR;
            PG8_LDB(B0, 1, 0); PG8_SCHED; PG8_LDA(At, 1, 0); PG8_STAGEA(PG8_SA(0, 1), k2, o10, o11);
            PG8_WAIT_L(8); PG8_BAR; PG8_WAIT_L(0); PG8_MMA(0, 0, At, B0); PG8_BAR; PG8_SCHED;
            PG8_LDB(B1, 1, 1); PG8_STAGEB(PG8_SB(1, 0), b3);
            PG8_BAR; PG8_WAIT_L(0); PG8_MMA(0, 1, At, B1); PG8_BAR;
            PG8_LDA(At, 1, 1); PG8_STAGEA(PG8_SA(1, 0), k3, o00, o01);
            PG8_BAR; PG8_WAIT_L(0); PG8_MMA(1, 0, At, B0); PG8_BAR; PG8_SCHED;
            PG8_STAGEB(PG8_SB(1, 1), b3 + hstepB);
            PG8_WAIT_V(6); PG8_BAR; PG8_MMA(1, 1, At, B1); PG8_BAR;
        }
        E(acc, cur, wr, wc, fr, fq);
        if (!has_next) break;
#pragma unroll
        for (int a = 0; a < 2; ++a)
#pragma unroll
            for (int b = 0; b < 2; ++b)
#pragma unroll
                for (int m = 0; m < 4; ++m)
#pragma unroll
                    for (int n = 0; n < 2; ++n) acc[a][b][m][n] = (f32x4){0.f, 0.f, 0.f, 0.f};
        cur = nxt; c00 = n00; c01 = n01; c10 = n10; c11 = n11; cB = nB; ++ui;
    }
    PG8_WAIT_V(0);
    if (wr == 0) PG8_BAR;
    PG8_BAR;
}

__device__ __forceinline__ void store_tile_f32(const f32x4 (&acc)[2][2][4][2], float* dst, int ld, int row0, int col0) {
#pragma unroll
    for (int ai = 0; ai < 2; ++ai)
#pragma unroll
        for (int m = 0; m < 4; ++m) { float* rowp = dst + (size_t)(row0 + ai * HALF + m * 16) * ld + col0;
#pragma unroll
            for (int bj = 0; bj < 2; ++bj)
#pragma unroll
                for (int n = 0; n < 2; ++n) *(f32x4*)(rowp + bj * HALF + n * 16) = acc[ai][bj][m][n]; }
}
__device__ __forceinline__ void store_tile_bf16(const f32x4 (&acc)[2][2][4][2], bf16* dst, int ld, int row0, int col0) {
#pragma unroll
    for (int ai = 0; ai < 2; ++ai)
#pragma unroll
        for (int m = 0; m < 4; ++m) { bf16* rowp = dst + (size_t)(row0 + ai * HALF + m * 16) * ld + col0;
#pragma unroll
            for (int bj = 0; bj < 2; ++bj)
#pragma unroll
                for (int n = 0; n < 2; ++n) { const f32x4 v = acc[ai][bj][m][n]; u32x2 w; w.x = pk2(v[0], v[1]); w.y = pk2(v[2], v[3]); *(u32x2*)(rowp + bj * HALF + n * 16) = w; } }
}
struct EpiBf16 {
    bf16* dst; int ld;
    __device__ __forceinline__ void operator()(const f32x4 (&acc)[2][2][4][2], const Unit& u, int wr, int wc, int fr, int fq) const {
        store_tile_bf16(acc, dst, ld, u.pm * BM + wr * 64 + fr, u.pn * BM + wc * 32 + 4 * fq);
    }
};
struct EpiProj {
    bf16* qabs; float* ckvraw; bf16* qi; float* small; float* mqkraw; bf16* mv; bf16* mo;
    __device__ __forceinline__ void operator()(const f32x4 (&acc)[2][2][4][2], const Unit& u, int wr, int wc, int fr, int fq) const {
        const int row0 = u.pm * BM + wr * 64 + fr, cl = wc * 32 + 4 * fq, pn = u.pn;
        if (pn < 8) store_tile_bf16(acc, qabs, 2048, row0, pn * 256 + cl);
        else if (pn == 8) store_tile_f32(acc, ckvraw, 256, row0, cl);
        else if (pn < 11) store_tile_bf16(acc, qi, 512, row0, (pn - 9) * 256 + cl);
        else if (pn == 11) store_tile_f32(acc, small, 256, row0, cl);
        else if (pn < 16) store_tile_f32(acc, mqkraw, 1024, row0, (pn - 12) * 256 + cl);
        else if (pn < 20) store_tile_bf16(acc, mv, 1024, row0, (pn - 16) * 256 + cl);
        else store_tile_bf16(acc, mo, 1024, row0, (pn - 20) * 256 + cl);
    }
};
struct EpiResid {
    const float* base; float* out; bf16* xb; float* ss;
    __device__ __forceinline__ void operator()(const f32x4 (&acc)[2][2][4][2], const Unit& u, int wr, int wc, int fr, int fq) const {
        const int row0 = u.pm * BM + wr * 64 + fr, col0 = u.pn * BM + wc * 32 + 4 * fq;
#pragma unroll
        for (int ai = 0; ai < 2; ++ai)
#pragma unroll
            for (int m = 0; m < 4; ++m) { const int row = row0 + ai * HALF + m * 16; const size_t off = (size_t)row * D + col0; float s = 0.f;
#pragma unroll
                for (int bj = 0; bj < 2; ++bj)
#pragma unroll
                    for (int n = 0; n < 2; ++n) { const f32x4 b = *(const f32x4*)(base + off + bj * HALF + n * 16); const f32x4 v = b + acc[ai][bj][m][n];
                        *(f32x4*)(out + off + bj * HALF + n * 16) = v; u32x2 w; w.x = pk2(v[0], v[1]); w.y = pk2(v[2], v[3]); *(u32x2*)(xb + off + bj * HALF + n * 16) = w;
                        s += (v[0] * v[0] + v[1] * v[1]) + (v[2] * v[2] + v[3] * v[3]); }
                if (ss) { s += __shfl_xor(s, 16); s += __shfl_xor(s, 32); if (fq == 0) atomicAdd(ss + row, s); } }
    }
};
struct EpiCq {
    bf16* dst; const float* ss; float scale;
    __device__ __forceinline__ void operator()(const f32x4 (&acc)[2][2][4][2], const Unit& u, int wr, int wc, int fr, int fq) const {
        const int row0 = u.pm * BM + wr * 64 + fr, col0 = u.pn * BM + wc * 32 + 4 * fq;
#pragma unroll
        for (int ai = 0; ai < 2; ++ai)
#pragma unroll
            for (int m = 0; m < 4; ++m) { const int row = row0 + ai * HALF + m * 16; const float r = rsqrtf(ss[row] * (1.0f / D) + EPS) * scale; bf16* rowp = dst + (size_t)row * D + col0;
#pragma unroll
                for (int bj = 0; bj < 2; ++bj)
#pragma unroll
                    for (int n = 0; n < 2; ++n) { const f32x4 v = acc[ai][bj][m][n] * r; u32x2 w; w.x = pk2(v[0], v[1]); w.y = pk2(v[2], v[3]); *(u32x2*)(rowp + bj * HALF + n * 16) = w; } }
    }
};
struct MoeOrder {
    const volatile LAS int* pre; const volatile LAS int* tb; const volatile LAS int* cn; const int* list; int ncol; int G, c; unsigned a_ld_bytes; size_t b_exp_bytes; unsigned kb; int gather;
    __device__ bool next(int i, Unit& u) const {
        const int L = i * G + c; if (L >= pre[32]) return false;
        int e = 0;
#pragma unroll 1
        for (int j = 1; j < 32; ++j) if (L >= pre[j]) e = j;
        const int loc = L - pre[e]; u.e = e; u.rt = loc / ncol; u.pn = loc % ncol; u.pm = tb[e] + u.rt; return true;
    }
    __device__ __forceinline__ unsigned a_row(const Unit& u, int r) const {
        if (gather) { int idx = u.rt * 256 + r; const int cnt = cn[u.e]; idx = idx < cnt ? idx : cnt - 1; const int tok = list[u.e * T + idx]; return (unsigned)tok * a_ld_bytes; }
        return (unsigned)(u.pm * 256 + r) * a_ld_bytes;
    }
    __device__ __forceinline__ size_t b_off(const Unit& u) const { return (size_t)u.e * b_exp_bytes + (size_t)u.pn * BM * kb; }
};
struct EpiSwiGLU {
    bf16* act; const int* list; const float* rstd; const volatile LAS int* cn;
    __device__ __forceinline__ void operator()(const f32x4 (&acc)[2][2][4][2], const Unit& u, int wr, int wc, int fr, int fq) const {
        const int cnt = cn[u.e];
#pragma unroll
        for (int ai = 0; ai < 2; ++ai)
#pragma unroll
            for (int m = 0; m < 4; ++m) { const int rl = ai * HALF + wr * 64 + m * 16 + fr; int idx = u.rt * 256 + rl; idx = idx < cnt ? idx : cnt - 1; const float r = rstd[list[u.e * T + idx]];
                bf16* rowp = act + (size_t)(u.pm * 256 + rl) * DEXP + u.pn * 128 + wc * 32 + 4 * fq;
#pragma unroll
                for (int n = 0; n < 2; ++n) { const f32x4 g = acc[ai][0][m][n] * r, uu = acc[ai][1][m][n] * r; f32x4 a;
#pragma unroll
                    for (int j = 0; j < 4; ++j) a[j] = g[j] / (1.0f + __expf(-g[j])) * uu[j];
                    u32x2 w; w.x = pk2(a[0], a[1]); w.y = pk2(a[2], a[3]); *(u32x2*)(rowp + n * 16) = w; } }
    }
};
}

struct Args { const float* in[27]; float* out; unsigned char* ws; int ph_lo, ph_hi; };
enum { I_X = 0, I_MEM, I_NORM_MIX_G, I_W_IN, I_KV_NORM_G, I_KIDX_NORM_G, I_W_UK, I_W_UV, I_CONV_W, I_CONV_B, I_GATE_B, I_ML_NORM_G, I_W_OUT, I_NORM_X_G, I_MEM_NORM_G,
       I_W_CQ, I_W_CKV, I_W_CO, I_NORM_FFN_G, I_W_GROUP, I_B_GROUP, I_W_ROUTER, I_B_ROUTER, I_W_GATE, I_W_UP, I_W_DOWN, I_FINAL_G };

__device__ __forceinline__ void tr_item(const float* W, size_t ldw, int k0, int n0, const float* kscale, bf16* WT, size_t ldt, int drow0, int dcol0, LAS float* scr, int lane) {
#pragma unroll 8
    for (int i = 0; i < 32; ++i) { const int kk = 2 * i + (lane >> 5); float v = W[(size_t)(k0 + kk) * ldw + n0 + (lane & 31)]; if (kscale) v *= kscale[k0 + kk]; scr[kk * 33 + (lane & 31)] = v; }
    LDS_WAIT(); asm volatile("" ::: "memory");
    const int c = lane & 7;
#pragma unroll
    for (int j = 0; j < 4; ++j) { const int n = (lane >> 3) + 8 * j; const LAS float* s = scr + (8 * c) * 33 + n;
        u32x4 o; o.x = pk2(s[0 * 33], s[1 * 33]); o.y = pk2(s[2 * 33], s[3 * 33]); o.z = pk2(s[4 * 33], s[5 * 33]); o.w = pk2(s[6 * 33], s[7 * 33]);
        *(u32x4*)(WT + (size_t)(drow0 + n0 + n) * ldt + dcol0 + k0 + 8 * c) = o; }
    LDS_WAIT(); asm volatile("" ::: "memory");
}
__device__ __forceinline__ void rms_row_to_bf16(const float* xrow, const float* g, bf16* orow, int lane) {
    const f32x4* xr = (const f32x4*)xrow + lane; const f32x4* gr = (const f32x4*)g + lane;
    f32x4 v[8]; float s = 0.f;
#pragma unroll
    for (int j = 0; j < 8; ++j) { v[j] = xr[64 * j]; s += (v[j][0] * v[j][0] + v[j][1] * v[j][1]) + (v[j][2] * v[j][2] + v[j][3] * v[j][3]); }
    const float r = rsqrtf(wave_sum(s) * (1.f / D) + EPS);
    u32x2* o8 = (u32x2*)orow + lane;
#pragma unroll
    for (int j = 0; j < 8; ++j) { const f32x4 gg = gr[64 * j]; u32x2 w; w.x = pk2(v[j][0] * r * gg[0], v[j][1] * r * gg[1]); w.y = pk2(v[j][2] * r * gg[2], v[j][3] * r * gg[3]); o8[64 * j] = w; }
}

__global__ void __launch_bounds__(512, 2) mega(Args args) {
    extern __shared__ __attribute__((aligned(16))) unsigned char lds_raw[];
    LAS unsigned char* lds = (LAS unsigned char*)lds_raw;
    volatile LAS unsigned* MISC = (volatile LAS unsigned*)(lds + MISC_OFF);
    const int tid = threadIdx.x, lane = tid & 63, wave = __builtin_amdgcn_readfirstlane(tid >> 6);
    const int G = gridDim.x, bx = blockIdx.x;
    unsigned char* ws = args.ws;
    unsigned* ctl = (unsigned*)(ws + WS_CTL);
    const int lo = args.ph_lo, hi = args.ph_hi;
    for (int u = tid; u < 1024; u += 512) MISC[u] = 0u;
    __syncthreads();
    XcdBarrier bar; bar.bar = ctl + CW_BAR; bar.x = 0; bar.st = MISC;
    if (hi - lo > 1) bar = xcd_barrier_post(ctl + CW_BAR, MISC);
#ifndef PH_MASK
#define PH_MASK 0x1fff
#endif
#define IN(k) ((((PH_MASK) >> (k)) & 1) && lo <= (k) && (k) < hi)
#define BOTH(k) (IN(k) && IN((k) + 1))
#define GRID_BAR(k) do { if (BOTH(k)) xcd_barrier(bar); } while (0)

#define WOUT_T ((bf16*)(ws + WS_WOUT_T))
#define WCQ_T ((bf16*)(ws + WS_WCQ_T))
#define WCKV_T ((bf16*)(ws + WS_WCKV_T))
#define WCO_T ((bf16*)(ws + WS_WCO_T))
#define WGU_T ((bf16*)(ws + WS_WGU_T))
#define WDN_T ((bf16*)(ws + WS_WDN_T))
#define WIN_T ((bf16*)(ws + WS_WIN_T))
#define H1 ((bf16*)(ws + WS_H1))
#define MIXIN ((bf16*)(ws + WS_MIXIN))
#define MEMN ((bf16*)(ws + WS_MEMN))
#define KC ((bf16*)(ws + WS_KC))
#define VT ((bf16*)(ws + WS_VT))
#define GATES ((float*)(ws + WS_GATES))
#define QABS ((bf16*)(ws + WS_QABS))
#define CKVRAW ((float*)(ws + WS_CKVRAW))
#define QI ((bf16*)(ws + WS_QI))
#define SMALL ((float*)(ws + WS_SMALL))
#define MQKRAW ((float*)(ws + WS_MQKRAW))
#define MV ((bf16*)(ws + WS_MV))
#define MO ((bf16*)(ws + WS_MO))
#define CKVN ((bf16*)(ws + WS_CKVN))
#define KIDXN ((bf16*)(ws + WS_KIDXN))
#define QCM ((bf16*)(ws + WS_QCM))
#define KCM ((bf16*)(ws + WS_KCM))
#define LST ((float*)(ws + WS_LST))
#define NL ((float*)(ws + WS_NL))
#define NST (NL + NCH * 4 * 128)
#define CST ((bf16*)(ws + WS_CST))
#define X1B ((bf16*)(ws + WS_X1B))
#define QC ((bf16*)(ws + WS_QC))
#define OC ((bf16*)(ws + WS_OC))
#define X2B ((bf16*)(ws + WS_X2B))
#define LIST ((int*)(ws + WS_LIST))
#define TOKE ((int*)(ws + WS_TOK))
#define TOKW ((float*)(ws + WS_TOK) + 2 * T)
#define RSTD3 ((float*)(ws + WS_TOK) + 4 * T)
#define ACT ((bf16*)(ws + WS_ACT))
#define Y ((bf16*)(ws + WS_Y))
#define SS2 ((float*)(ctl + CW_SS2))
#define CNT ((int*)(ctl + CW_CNT))
    const int gw = bx * 8 + wave, NGW = G * 8;

    if (IN(0)) {
        LAS float* scr = (LAS float*)(lds + wave * 16384);
        const float* w_in = args.in[I_W_IN]; const float* w_out = args.in[I_W_OUT];
        constexpr int J_CKV = 32 * 8, J_QI = 32 * 16, J_KI = 32 * 2, J_MQK = 32 * 32, J_MV = 32 * 32, J_MO = 32 * 32, J_WO = 16 * 64, J_CQ = 32 * 64, J_CKVW = 32 * 128, J_CO = 32 * 64,
                      J_G = 32 * 512, J_U = 32 * 512, J_D = 32 * 512;
        constexpr int NITEMS = J_CKV + J_QI + J_KI + J_MQK + J_MV + J_MO + J_WO + J_CQ + J_CKVW + J_CO + J_G + J_U + J_D;
        for (int it = gw; it < NITEMS; it += NGW) {
            int r = it;
            if (r < J_CKV) { tr_item(w_in + 1024, D_IN, 64 * (r / 8), 32 * (r % 8), nullptr, WIN_T, D, 2048, 0, scr, lane); continue; } r -= J_CKV;
            if (r < J_QI) { tr_item(w_in + 1280, D_IN, 64 * (r / 16), 32 * (r % 16), nullptr, WIN_T, D, 2304, 0, scr, lane); continue; } r -= J_QI;
            if (r < J_KI) { tr_item(w_in + 1792, D_IN, 64 * (r / 2), 32 * (r % 2), nullptr, WIN_T, D, 2816, 0, scr, lane); continue; } r -= J_KI;
            if (r < J_MQK) { tr_item(w_in + 1864, D_IN, 64 * (r / 32), 32 * (r % 32), nullptr, WIN_T, D, 3072, 0, scr, lane); continue; } r -= J_MQK;
            if (r < J_MV) { tr_item(w_in + 2888, D_IN, 64 * (r / 32), 32 * (r % 32), nullptr, WIN_T, D, 4096, 0, scr, lane); continue; } r -= J_MV;
            if (r < J_MO) { tr_item(w_in + 3920, D_IN, 64 * (r / 32), 32 * (r % 32), nullptr, WIN_T, D, 5120, 0, scr, lane); continue; } r -= J_MO;
            if (r < J_WO) { tr_item(w_out + (size_t)1024 * D, D, 64 * (r / 64), 32 * (r % 64), nullptr, WOUT_T, KMIX, 0, 2048, scr, lane); continue; } r -= J_WO;
            if (r < J_CQ) { tr_item(args.in[I_W_CQ], D, 64 * (r / 64), 32 * (r % 64), args.in[I_NORM_X_G], WCQ_T, D, 0, 0, scr, lane); continue; } r -= J_CQ;
            if (r < J_CKVW) { tr_item(args.in[I_W_CKV], 2 * D, 64 * (r / 128), 32 * (r % 128), nullptr, WCKV_T, D, 0, 0, scr, lane); continue; } r -= J_CKVW;
            if (r < J_CO) { tr_item(args.in[I_W_CO], D, 64 * (r / 64), 32 * (r % 64), nullptr, WCO_T, D, 0, 0, scr, lane); continue; } r -= J_CO;
            if (r < J_G) { const int e = r / 512, q = r % 512, kb = q / 16, nb = q % 16;
                tr_item(args.in[I_W_GATE] + (size_t)e * D * DEXP, DEXP, 64 * kb, 32 * nb, args.in[I_NORM_FFN_G], WGU_T + (size_t)e * 1024 * D, D, (nb / 4) * 128, 0, scr, lane); continue; } r -= J_G;
            if (r < J_U) { const int e = r / 512, q = r % 512, kb = q / 16, nb = q % 16;
                tr_item(args.in[I_W_UP] + (size_t)e * D * DEXP, DEXP, 64 * kb, 32 * nb, args.in[I_NORM_FFN_G], WGU_T + (size_t)e * 1024 * D, D, (nb / 4) * 128 + 128, 0, scr, lane); continue; } r -= J_U;
            { const int e = r / 512, q = r % 512, kb = q / 64, nb = q % 64;
                tr_item(args.in[I_W_DOWN] + (size_t)e * DEXP * D, D, 64 * kb, 32 * nb, nullptr, WDN_T + (size_t)e * D * DEXP, DEXP, 0, 0, scr, lane); }
        }
        for (int i = bx * 512 + tid; i < 192 * D; i += G * 512) { const int r = i / D, k = i % D; float v = 0.f;
            if (r < 8) v = w_in[(size_t)k * D_IN + 1856 + r]; else if (r < 16) v = w_in[(size_t)k * D_IN + 3912 + (r - 8)];
            WIN_T[(size_t)(2880 + r) * D + k] = (bf16)f2bf(v); }
        __syncthreads();
        {
            LAS float* tile = (LAS float*)lds;
            const int c = tid & 255, half = tid >> 8;
            for (int uu = bx; uu < 512; uu += G) {
                const bool isq = uu < 256; const int h = (uu & 255) >> 5, kt = uu & 31;
                __syncthreads();
                if (isq) { for (int i = tid; i < 64 * 128; i += 512) { const int kk = i >> 7, d = i & 127; tile[kk * 128 + d] = w_in[(size_t)(kt * 64 + kk) * D_IN + h * 128 + d]; } }
                else { for (int i = tid; i < 128 * 64; i += 512) { const int d = i >> 6, n = i & 63; tile[d * 64 + n] = w_out[(size_t)(h * 128 + d) * D + kt * 64 + n]; } }
                __syncthreads();
                const float* wrow = (isq ? args.in[I_W_UK] : args.in[I_W_UV]) + (size_t)(c * 8 + h) * 128;
                float acc[32];
#pragma unroll
                for (int j = 0; j < 32; ++j) acc[j] = 0.f;
                for (int d = 0; d < 128; ++d) { const float a = wrow[d];
                    if (isq) {
#pragma unroll
                        for (int j = 0; j < 32; ++j) acc[j] += a * tile[(half * 32 + j) * 128 + d];
                    } else {
#pragma unroll
                        for (int j = 0; j < 32; ++j) acc[j] += a * tile[d * 64 + half * 32 + j];
                    } }
                if (isq) { bf16* o = WIN_T + (size_t)(h * 256 + c) * D + kt * 64 + half * 32; const float sc = 0.08838834764831845f;
#pragma unroll
                    for (int j = 0; j < 32; j += 8) { u32x4 w; w.x = pk2(acc[j] * sc, acc[j + 1] * sc); w.y = pk2(acc[j + 2] * sc, acc[j + 3] * sc); w.z = pk2(acc[j + 4] * sc, acc[j + 5] * sc); w.w = pk2(acc[j + 6] * sc, acc[j + 7] * sc); *(u32x4*)(o + j) = w; } }
                else {
#pragma unroll
                    for (int j = 0; j < 32; ++j) WOUT_T[(size_t)(kt * 64 + half * 32 + j) * KMIX + h * 256 + c] = (bf16)f2bf(acc[j]); }
            }
        }
        for (int m = gw; m < T; m += NGW) rms_row_to_bf16(args.in[I_X] + (size_t)m * D, args.in[I_NORM_MIX_G], H1 + (size_t)m * D, lane);
        for (int m = gw; m < NMEM; m += NGW) rms_row_to_bf16(args.in[I_MEM] + (size_t)m * D, args.in[I_MEM_NORM_G], MEMN + (size_t)m * D, lane);
        GRID_BAR(0);
    }

    if (IN(1)) {
        pg8::DenseOrder S; S.init(T, NPROJ, D, D, G, bx);
        pg8::EpiProj E{QABS, CKVRAW, QI, SMALL, MQKRAW, MV, MO};
        pg8::gemm_phase(lds, H1, WIN_T, D, S, E);
        GRID_BAR(1);
    }

    if (IN(2)) {
#ifndef P2_SUB
#define P2_SUB 15
#endif
        if (P2_SUB & 1) {
            pg8::DenseOrder S; S.init(NMEM, D, D, D, G, bx); pg8::EpiBf16 E{KC, D};
            pg8::gemm_phase(lds, MEMN, WCKV_T, D, S, E);
        }
        if (P2_SUB & 2) {
            pg8::DenseOrder S; S.init(D, NMEM, D, D, G, bx >= 8 ? bx - 8 : -1); pg8::EpiBf16 E{VT, NMEM};
            pg8::gemm_phase(lds, WCKV_T + (size_t)D * D, MEMN, D, S, E);
        }
        __syncthreads();
        if (P2_SUB & 4) for (int t = gw; t < T; t += NGW) {
            const f32x4 v = ((const f32x4*)(CKVRAW + (size_t)t * 256))[lane];
            const float r = rsqrtf(wave_sum((v[0] * v[0] + v[1] * v[1]) + (v[2] * v[2] + v[3] * v[3])) * (1.f / 256.f) + EPS);
            const f32x4 g = ((const f32x4*)args.in[I_KV_NORM_G])[lane];
            u32x2 w; w.x = pk2(v[0] * r * g[0], v[1] * r * g[1]); w.y = pk2(v[2] * r * g[2], v[3] * r * g[3]);
            ((u32x2*)(CKVN + (size_t)t * 256))[lane] = w;
            const float kv = SMALL[(size_t)t * 256 + lane];
            const float rk = rsqrtf(wave_sum(kv * kv) * (1.f / 64.f) + EPS);
            KIDXN[(size_t)t * 64 + lane] = (bf16)f2bf(kv * rk * args.in[I_KIDX_NORM_G][lane]);
        }
        if (P2_SUB & 8) {
            LAS float* kq = (LAS float*)lds;
            LAS float* vv = (LAS float*)(lds + 32768);
            LAS float* sw = (LAS float*)(lds + 98304);
            const float* conv_w = args.in[I_CONV_W]; const float* conv_b = args.in[I_CONV_B]; const float* gate_b = args.in[I_GATE_B];
            for (int uu = bx; uu < NCH * 4; uu += G) {
                const int c = uu >> 2, h = uu & 3, t0 = c * CH;
                __syncthreads();
                if (tid < 64) { const int t = t0 + tid; const float mi = SMALL[(size_t)t * 256 + 72 + h] + gate_b[h]; const float mf = SMALL[(size_t)t * 256 + 76 + h] + gate_b[4 + h];
                    sw[128 + tid] = mi; sw[64 + tid] = fminf(mf, 0.f) - log1pf(__expf(-fabsf(mf))); }
                __syncthreads();
                if (tid == 0) { float b = 0.f;
#pragma unroll 1
                    for (int s = 0; s < 64; ++s) { b += sw[64 + s]; sw[192 + s] = b; }
                    const float g = b; float mx = -3.0e38f;
#pragma unroll 1
                    for (int s = 0; s < 64; ++s) mx = fmaxf(mx, g - sw[192 + s] + sw[128 + s]);
#pragma unroll 1
                    for (int s = 0; s < 64; ++s) sw[s] = __expf(g - sw[192 + s] + sw[128 + s] - mx);
                    GATES[GT_G + c * 4 + h] = g; GATES[GT_MLOC + c * 4 + h] = mx; }
                __syncthreads();
                if (tid < 64) { GATES[GT_B + (size_t)(t0 + tid) * 4 + h] = sw[192 + tid]; GATES[GT_LI + (size_t)(t0 + tid) * 4 + h] = sw[128 + tid]; }
                for (int e = tid; e < 64 * 256; e += 512) { const int s = e >> 8, ch = e & 255, t = t0 + s; const int src = ch < 128 ? h * 128 + ch : 512 + h * 128 + (ch - 128);
                    float y = conv_b[src];
#pragma unroll
                    for (int j = 0; j < 4; ++j) { const int tt = t - 3 + j; if (tt >= 0) y += conv_w[j * 1024 + src] * MQKRAW[(size_t)tt * 1024 + src]; }
                    y = y / (1.f + __expf(-y));
                    if (ch < 128) QCM[(size_t)t * 512 + h * 128 + ch] = (bf16)f2bf(y * 0.08838834764831845f);
                    else { const unsigned kb = f2bf(y); KCM[(size_t)t * 512 + h * 128 + (ch - 128)] = (bf16)kb; kq[s * 128 + (ch - 128)] = bf2f(kb); } }
                for (int e = tid; e < 64 * 256; e += 512) { const int s = e >> 8, dv = e & 255; vv[s * 256 + dv] = bf2f(MV[(size_t)(t0 + s) * 1024 + h * 256 + dv]); }
                __syncthreads();
                {
                    const int dv = tid >> 1, dkh = tid & 1; float acc[64];
#pragma unroll
                    for (int j = 0; j < 64; ++j) acc[j] = 0.f;
#pragma unroll 1
                    for (int s = 0; s < 64; ++s) { const float wv = sw[s] * vv[s * 256 + dv]; const LAS f32x4* kr = (const LAS f32x4*)(kq + s * 128 + dkh * 64);
#pragma unroll
                        for (int j = 0; j < 16; ++j) { const f32x4 kk = kr[j]; acc[4 * j] += wv * kk[0]; acc[4 * j + 1] += wv * kk[1]; acc[4 * j + 2] += wv * kk[2]; acc[4 * j + 3] += wv * kk[3]; } }
                    f32x4* o = (f32x4*)(LST + ((size_t)(c * 4 + h) * 256 + dv) * 128 + dkh * 64);
#pragma unroll
                    for (int j = 0; j < 16; ++j) o[j] = (f32x4){acc[4 * j], acc[4 * j + 1], acc[4 * j + 2], acc[4 * j + 3]};
                }
                if (tid < 128) { float a = 0.f;
#pragma unroll 4
                    for (int s = 0; s < 64; ++s) a += sw[s] * kq[s * 128 + tid]; NL[(size_t)(c * 4 + h) * 128 + tid] = a; }
            }
        }
        GRID_BAR(2);
    }

    if (IN(3)) {
        {
            LAS float* am = (LAS float*)lds;
            LAS float* sm = am + 512;
            __syncthreads();
            if (tid < 4) { float m = 0.f;
#pragma unroll 1
                for (int k = 0; k < NCH; ++k) { const float g = GATES[GT_G + k * 4 + tid], ml = GATES[GT_MLOC + k * 4 + tid]; const float mn = fmaxf(g + m, ml);
                    am[tid * 128 + k] = __expf(g + m - mn); sm[tid * 128 + k] = __expf(ml - mn); if (bx == 0) GATES[GT_MPREV + k * 4 + tid] = m; m = mn; } }
            __syncthreads();
            for (int e = bx * 512 + tid; e < 4 * 32768; e += G * 512) { const int h = e >> 15, rem = e & 32767; float C = 0.f;
#pragma unroll 8
                for (int k = 0; k < NCH; ++k) { const size_t o = (size_t)(k * 4 + h) * 32768 + rem; CST[o] = (bf16)f2bf(C); C = am[h * 128 + k] * C + sm[h * 128 + k] * LST[o]; } }
            if (bx == 0) { const int h = tid >> 7, dk = tid & 127; float n = 0.f;
#pragma unroll 4
                for (int k = 0; k < NCH; ++k) { const size_t o = (size_t)(k * 4 + h) * 128 + dk; NST[o] = n; n = am[h * 128 + k] * n + sm[h * 128 + k] * NL[o]; } }
            __syncthreads();
        }
        {
            LAS float* sc = (LAS float*)lds;
            LAS float* qil = (LAS float*)(lds + MISC_OFF + 4096);
            LAS int* cntl = (LAS int*)(lds + MISC_OFF + 2048);
            LAS float* qal = (LAS float*)lds;
            LAS float* pl = (LAS float*)(lds + 32768);
            LAS int* sel = (LAS int*)(lds + MISC_OFF + 12288);
            const int q = wave >> 1, half = wave & 1;
            for (int uu = bx; uu < T / 4; uu += G) {
                const int t = uu * 4 + q, N = ((t >> 6) + 1) * 64, ng = N >> 6;
                __syncthreads();
                for (int i = tid; i < 2048; i += 512) qil[i] = bf2f(QI[(size_t)(uu * 4) * 512 + i]);
                __syncthreads();
                float wsc[8];
#pragma unroll
                for (int h = 0; h < 8; ++h) wsc[h] = SMALL[(size_t)t * 256 + 64 + h] * 0.04419417382415922f;
#pragma unroll 1
                for (int j = half; j < ng; j += 2) { const int s = j * 64 + lane; float dot[8];
#pragma unroll
                    for (int h = 0; h < 8; ++h) dot[h] = 0.f;
#pragma unroll 1
                    for (int dc = 0; dc < 8; ++dc) { const u32x4 kk = *(const u32x4*)(KIDXN + (size_t)s * 64 + dc * 8); float kf[8];
                        kf[0] = bf2f(kk.x & 0xffffu); kf[1] = bf2f(kk.x >> 16); kf[2] = bf2f(kk.y & 0xffffu); kf[3] = bf2f(kk.y >> 16); kf[4] = bf2f(kk.z & 0xffffu); kf[5] = bf2f(kk.z >> 16); kf[6] = bf2f(kk.w & 0xffffu); kf[7] = bf2f(kk.w >> 16);
#pragma unroll
                        for (int h = 0; h < 8; ++h) { const LAS f32x4* qq = (const LAS f32x4*)(qil + q * 512 + h * 64 + dc * 8); const f32x4 a = qq[0], b = qq[1];
                            dot[h] += (kf[0] * a[0] + kf[1] * a[1]) + (kf[2] * a[2] + kf[3] * a[3]) + (kf[4] * b[0] + kf[5] * b[1]) + (kf[6] * b[2] + kf[7] * b[3]); } }
                    float score = 0.f;
#pragma unroll
                    for (int h = 0; h < 8; ++h) score += wsc[h] * fmaxf(dot[h], 0.f);
                    sc[q * 8192 + s] = score; }
                __syncthreads();
                int nsel = N;
                unsigned thr = 0u;
                if (N > 256) {
#pragma unroll 1
                    for (int bit = 31; bit >= 0; --bit) { const unsigned cand = thr | (1u << bit); int cnt = 0;
#pragma unroll 4
                        for (int j = half; j < ng; j += 2) { const unsigned u = __float_as_uint(sc[q * 8192 + j * 64 + lane]); const unsigned key = (u & 0x80000000u) ? ~u : (u | 0x80000000u);
                            cnt += __popcll(__ballot(key >= cand)); }
                        if (lane == 0) cntl[q * 2 + half] = cnt;
                        __syncthreads();
                        const int tot = cntl[q * 2] + cntl[q * 2 + 1];
                        __syncthreads();
                        if (tot >= 256) thr = cand; }
                    nsel = 256;
                }
                int ngt = 0;
                if (N > 256) { int cnt = 0;
                    for (int j = half; j < ng; j += 2) { const unsigned u = __float_as_uint(sc[q * 8192 + j * 64 + lane]); const unsigned key = (u & 0x80000000u) ? ~u : (u | 0x80000000u); cnt += __popcll(__ballot(key > thr)); }
                    if (lane == 0) cntl[q * 2 + half] = cnt;
                    __syncthreads();
                    ngt = cntl[q * 2] + cntl[q * 2 + 1]; }
                __syncthreads();
                if (half == 0) {
                    if (N <= 256) {
#pragma unroll
                        for (int r = 0; r < 4; ++r) sel[q * 256 + r * 64 + lane] = r * 64 + lane;
                    } else { int pos = 0, ties = 0; const int need = 256 - ngt; const unsigned long long lt = (1ull << lane) - 1ull;
#pragma unroll 1
                        for (int j = 0; j < ng; ++j) { const int s = j * 64 + lane; const unsigned u = __float_as_uint(sc[q * 8192 + s]); const unsigned key = (u & 0x80000000u) ? ~u : (u | 0x80000000u);
                            const bool gt = key > thr, eq = key == thr; const unsigned long long meq = __ballot(eq);
                            const bool take = gt || (eq && (ties + __popcll(meq & lt)) < need); const unsigned long long mt = __ballot(take);
                            const int p = pos + __popcll(mt & lt);
                            if (take && p < 256) sel[q * 256 + p] = s;
                            pos += __popcll(mt); ties += __popcll(meq); }
                    }
                }
                __syncthreads();
                for (int i = tid; i < 4 * 2048; i += 512) qal[i] = bf2f(QABS[(size_t)(uu * 4) * 2048 + i]);
                __syncthreads();
#pragma unroll 1
                for (int r = 0; r < 2; ++r) { const int jj = half * 128 + r * 64 + lane; const bool valid = jj < nsel; const int row = valid ? sel[q * 256 + jj] : 0; float dot[8];
#pragma unroll
                    for (int h = 0; h < 8; ++h) dot[h] = 0.f;
#pragma unroll 1
                    for (int dc = 0; dc < 32; ++dc) { const u32x4 kk = *(const u32x4*)(CKVN + (size_t)row * 256 + dc * 8); float kf[8];
                        kf[0] = bf2f(kk.x & 0xffffu); kf[1] = bf2f(kk.x >> 16); kf[2] = bf2f(kk.y & 0xffffu); kf[3] = bf2f(kk.y >> 16); kf[4] = bf2f(kk.z & 0xffffu); kf[5] = bf2f(kk.z >> 16); kf[6] = bf2f(kk.w & 0xffffu); kf[7] = bf2f(kk.w >> 16);
#pragma unroll
                        for (int h = 0; h < 8; ++h) { const LAS f32x4* qq = (const LAS f32x4*)(qal + q * 2048 + h * 256 + dc * 8); const f32x4 a = qq[0], b = qq[1];
                            dot[h] += (kf[0] * a[0] + kf[1] * a[1]) + (kf[2] * a[2] + kf[3] * a[3]) + (kf[4] * b[0] + kf[5] * b[1]) + (kf[6] * b[2] + kf[7] * b[3]); } }
#pragma unroll
                    for (int h = 0; h < 8; ++h) pl[(q * 8 + h) * 256 + jj] = valid ? dot[h] : -3.0e38f; }
                __syncthreads();
#pragma unroll 1
                for (int rr = 0; rr < 4; ++rr) { LAS float* pr = pl + (wave * 4 + rr) * 256; float v[4]; float mx = -3.0e38f;
#pragma unroll
                    for (int i = 0; i < 4; ++i) { v[i] = pr[i * 64 + lane]; mx = fmaxf(mx, v[i]); }
                    mx = wave_max(mx); float sum = 0.f;
#pragma unroll
                    for (int i = 0; i < 4; ++i) { v[i] = (v[i] > -1.0e38f) ? __expf(v[i] - mx) : 0.f; sum += v[i]; }
                    sum = wave_sum(sum); const float inv = 1.f / sum;
#pragma unroll
                    for (int i = 0; i < 4; ++i) pr[i * 64 + lane] = v[i] * inv; }
                __syncthreads();
                { float o0[8], o1[8];
#pragma unroll
                    for (int h = 0; h < 8; ++h) { o0[h] = 0.f; o1[h] = 0.f; }
#pragma unroll 2
                    for (int j = 0; j < nsel; ++j) { const int row = sel[q * 256 + j]; const unsigned kv = *(const unsigned*)(CKVN + (size_t)row * 256 + half * 128 + 2 * lane); const float k0 = bf2f(kv & 0xffffu), k1 = bf2f(kv >> 16);
#pragma unroll
                        for (int h = 0; h < 8; ++h) { const float p = pl[(q * 8 + h) * 256 + j]; o0[h] += p * k0; o1[h] += p * k1; } }
#pragma unroll
                    for (int h = 0; h < 8; ++h) *(unsigned*)(MIXIN + (size_t)t * KMIX + h * 256 + half * 128 + 2 * lane) = pk2(o0[h], o1[h]); }
            }
        }
        GRID_BAR(3);
    }

    if (IN(4)) {
        LAS float* qs = (LAS float*)lds;
        LAS float* ks = (LAS float*)(lds + 32768);
        LAS float* Sm = (LAS float*)(lds + 66048);
        LAS bf16* vs = (LAS bf16*)(lds + 82432);
        LAS float* ms = (LAS float*)(lds + 115200);
        LAS float* hb = (LAS float*)lds;
        const float* mlg = args.in[I_ML_NORM_G];
        for (int uu = bx; uu < NCH * 4; uu += G) {
            const int c = uu >> 2, h = uu & 3, t0 = c * CH;
            __syncthreads();
            for (int e = tid; e < 64 * 128; e += 512) { const int s = e >> 7, d = e & 127; qs[s * 128 + d] = bf2f(QCM[(size_t)(t0 + s) * 512 + h * 128 + d]); ks[s * 129 + d] = bf2f(KCM[(size_t)(t0 + s) * 512 + h * 128 + d]); }
            for (int e = tid; e < 64 * 256; e += 512) { const int s = e >> 8, dv = e & 255; vs[s * 256 + dv] = MV[(size_t)(t0 + s) * 1024 + h * 256 + dv]; }
            if (tid < 64) { ms[tid] = GATES[GT_B + (size_t)(t0 + tid) * 4 + h]; ms[64 + tid] = GATES[GT_LI + (size_t)(t0 + tid) * 4 + h]; }
            if (tid < 128) ms[320 + tid] = NST[(size_t)(c * 4 + h) * 128 + tid];
            __syncthreads();
            const float mprev = GATES[GT_MPREV + c * 4 + h];
            if (tid < 64) { const float bt = ms[tid]; const float inter = bt + mprev; float mx = inter; for (int s = 0; s <= tid; ++s) mx = fmaxf(mx, bt - ms[s] + ms[64 + s]);
                ms[128 + tid] = mx; ms[192 + tid] = __expf(inter - mx); }
            __syncthreads();
            for (int e = tid; e < 64 * 64; e += 512) { const int t = e >> 6, s = e & 63; float v = 0.f;
                if (s <= t) { float d = 0.f;
#pragma unroll 8
                    for (int k = 0; k < 128; ++k) d += qs[t * 128 + k] * ks[s * 129 + k];
                    v = d * __expf(ms[t] - ms[s] + ms[64 + s] - ms[128 + t]); }
                Sm[t * 64 + s] = v; }
            __syncthreads();
            if (tid < 64) { float dn = 0.f; for (int k = 0; k < 128; ++k) dn += qs[tid * 128 + k] * ms[320 + k]; dn *= ms[192 + tid]; for (int s = 0; s < 64; ++s) dn += Sm[tid * 64 + s];
                ms[256 + tid] = fmaxf(fabsf(dn), __expf(-ms[128 + tid])); }
            float acc[32];
            {
                const int dv = tid & 255, th = tid >> 8;
#pragma unroll
                for (int j = 0; j < 32; ++j) acc[j] = 0.f;
                const bf16* crow = CST + ((size_t)(c * 4 + h) * 256 + dv) * 128;
                for (int k8 = 0; k8 < 16; ++k8) { const u32x4 cc = *(const u32x4*)(crow + k8 * 8); float cf[8];
                    cf[0] = bf2f(cc.x & 0xffffu); cf[1] = bf2f(cc.x >> 16); cf[2] = bf2f(cc.y & 0xffffu); cf[3] = bf2f(cc.y >> 16); cf[4] = bf2f(cc.z & 0xffffu); cf[5] = bf2f(cc.z >> 16); cf[6] = bf2f(cc.w & 0xffffu); cf[7] = bf2f(cc.w >> 16);
#pragma unroll
                    for (int j = 0; j < 32; ++j) { const LAS f32x4* qq = (const LAS f32x4*)(qs + (th * 32 + j) * 128 + k8 * 8); const f32x4 a = qq[0], b = qq[1];
                        acc[j] += (cf[0] * a[0] + cf[1] * a[1]) + (cf[2] * a[2] + cf[3] * a[3]) + (cf[4] * b[0] + cf[5] * b[1]) + (cf[6] * b[2] + cf[7] * b[3]); } }
                __syncthreads();
#pragma unroll
                for (int j = 0; j < 32; ++j) acc[j] *= ms[192 + th * 32 + j];
                for (int s = 0; s < 64; ++s) { const float v = bf2f(vs[s * 256 + dv]);
#pragma unroll
                    for (int j = 0; j < 32; ++j) acc[j] += Sm[(th * 32 + j) * 64 + s] * v; }
#pragma unroll
                for (int j = 0; j < 32; ++j) acc[j] /= ms[256 + th * 32 + j];
                __syncthreads();
#pragma unroll
                for (int j = 0; j < 32; ++j) hb[(th * 32 + j) * 256 + dv] = acc[j];
            }
            __syncthreads();
#pragma unroll 1
            for (int i = 0; i < 8; ++i) { const int tt = wave * 8 + i; const f32x4 v = ((const LAS f32x4*)(hb + tt * 256))[lane];
                const float r = rsqrtf(wave_sum((v[0] * v[0] + v[1] * v[1]) + (v[2] * v[2] + v[3] * v[3])) * (1.f / 256.f) + EPS);
                const f32x4 g = ((const f32x4*)(mlg + h * 256))[lane]; const u32x2 ob = ((const u32x2*)(MO + (size_t)(t0 + tt) * 1024 + h * 256))[lane];
                const float o0 = bf2f(ob.x & 0xffffu), o1 = bf2f(ob.x >> 16), o2 = bf2f(ob.y & 0xffffu), o3 = bf2f(ob.y >> 16);
                u32x2 w; w.x = pk2(v[0] * r * g[0] / (1.f + __expf(-o0)), v[1] * r * g[1] / (1.f + __expf(-o1))); w.y = pk2(v[2] * r * g[2] / (1.f + __expf(-o2)), v[3] * r * g[3] / (1.f + __expf(-o3)));
                ((u32x2*)(MIXIN + (size_t)(t0 + tt) * KMIX + 2048 + h * 256))[lane] = w; }
        }
        GRID_BAR(4);
    }

    if (IN(5)) {
        pg8::DenseOrder S; S.init(T, D, KMIX, KMIX, G, bx);
        pg8::EpiResid E{args.in[I_X], args.out, X1B, SS2};
        pg8::gemm_phase(lds, MIXIN, WOUT_T, KMIX, S, E);
        GRID_BAR(5);
    }
    if (IN(6)) {
        pg8::DenseOrder S; S.init(T, D, D, D, G, bx);
        pg8::EpiCq E{QC, SS2, 0.04419417382415922f};
        pg8::gemm_phase(lds, X1B, WCQ_T, D, S, E);
        GRID_BAR(6);
    }
    if (IN(7)) {
        LAS float* Sx = (LAS float*)lds;
        LAS float* qx = (LAS float*)(lds + 65792);
        LAS float* kx = (LAS float*)(lds + 74240);
        for (int uu = bx; uu < 4 * (T / 64); uu += G) {
            const int h = uu & 3, t0 = (uu >> 2) * 64;
            const int tq = tid >> 3, mg = tid & 7;
            float acc[32];
#pragma unroll
            for (int i = 0; i < 32; ++i) acc[i] = 0.f;
            for (int ch = 0; ch < 16; ++ch) {
                __syncthreads();
                for (int e = tid; e < 64 * 32; e += 512) { const int r = e >> 5, d = e & 31; qx[r * 33 + d] = bf2f(QC[(size_t)(t0 + r) * D + h * 512 + ch * 32 + d]); }
                for (int e = tid; e < 256 * 32; e += 512) { const int r = e >> 5, d = e & 31; kx[r * 33 + d] = bf2f(KC[(size_t)r * D + h * 512 + ch * 32 + d]); }
                __syncthreads();
                for (int d = 0; d < 32; ++d) { const float qv = qx[tq * 33 + d];
#pragma unroll
                    for (int i = 0; i < 32; ++i) acc[i] += qv * kx[(mg + 8 * i) * 33 + d]; }
            }
            __syncthreads();
#pragma unroll
            for (int i = 0; i < 32; ++i) Sx[tq * 257 + mg + 8 * i] = acc[i];
            __syncthreads();
#pragma unroll 1
            for (int i = 0; i < 8; ++i) { LAS float* pr = Sx + (wave * 8 + i) * 257; float v[4]; float mx = -3.0e38f;
#pragma unroll
                for (int k = 0; k < 4; ++k) { v[k] = pr[k * 64 + lane]; mx = fmaxf(mx, v[k]); }
                mx = wave_max(mx); float sum = 0.f;
#pragma unroll
                for (int k = 0; k < 4; ++k) { v[k] = __expf(v[k] - mx); sum += v[k]; }
                const float inv = 1.f / wave_sum(sum);
#pragma unroll
                for (int k = 0; k < 4; ++k) pr[k * 64 + lane] = v[k] * inv; }
            __syncthreads();
#pragma unroll 1
            for (int tp = 0; tp < 2; ++tp) {
                float o[32];
#pragma unroll
                for (int i = 0; i < 32; ++i) o[i] = 0.f;
                const bf16* vrow = VT + (size_t)(h * 512 + tid) * NMEM;
                const LAS float* pb = Sx + tp * 32 * 257;
#pragma unroll 1
                for (int m8 = 0; m8 < 32; ++m8) { const u32x4 cc = *(const u32x4*)(vrow + m8 * 8); float vf[8];
                    vf[0] = bf2f(cc.x & 0xffffu); vf[1] = bf2f(cc.x >> 16); vf[2] = bf2f(cc.y & 0xffffu); vf[3] = bf2f(cc.y >> 16); vf[4] = bf2f(cc.z & 0xffffu); vf[5] = bf2f(cc.z >> 16); vf[6] = bf2f(cc.w & 0xffffu); vf[7] = bf2f(cc.w >> 16);
#pragma unroll
                    for (int i = 0; i < 32; ++i) { const LAS float* pr = pb + i * 257 + m8 * 8;
                        o[i] += (pr[0] * vf[0] + pr[1] * vf[1]) + (pr[2] * vf[2] + pr[3] * vf[3]) + (pr[4] * vf[4] + pr[5] * vf[5]) + (pr[6] * vf[6] + pr[7] * vf[7]); } }
#pragma unroll
                for (int i = 0; i < 32; ++i) OC[(size_t)(t0 + tp * 32 + i) * D + h * 512 + tid] = (bf16)f2bf(o[i]);
            }
        }
        GRID_BAR(7);
    }
    if (IN(8)) {
        pg8::DenseOrder S; S.init(T, D, D, D, G, bx);
        pg8::EpiResid E{args.out, args.out, X2B, nullptr};
        pg8::gemm_phase(lds, OC, WCO_T, D, S, E);
        GRID_BAR(8);
    }
    if (IN(9)) {
        LAS float* xt = (LAS float*)lds;
        LAS float* wt = (LAS float*)(lds + 32768);
        LAS float* lg = (LAS float*)(lds + MISC_OFF + 4096);
        const float* x2 = args.out; const float* gf = args.in[I_NORM_FFN_G];
        const float* w_group = args.in[I_W_GROUP]; const float* w_router = args.in[I_W_ROUTER];
        for (int uu = bx; uu < T / 32; uu += G) {
            const int t0 = uu * 32; const int tk = tid >> 4, og = tid & 15;
            float a0 = 0.f, a1 = 0.f, a2 = 0.f, ssq = 0.f;
            for (int ch = 0; ch < 8; ++ch) {
                __syncthreads();
                for (int e = tid; e < 32 * 256; e += 512) { const int r = e >> 8, k = e & 255; xt[r * 256 + k] = x2[(size_t)(t0 + r) * D + ch * 256 + k] * gf[ch * 256 + k]; }
                for (int e = tid; e < 256 * 36; e += 512) { const int k = e / 36, o = e % 36; wt[e] = o < 4 ? w_group[(size_t)(ch * 256 + k) * 4 + o] : w_router[(size_t)(ch * 256 + k) * 32 + (o - 4)]; }
                __syncthreads();
                for (int k = 0; k < 256; ++k) { const float xv = xt[tk * 256 + k]; a0 += xv * wt[k * 36 + og]; a1 += xv * wt[k * 36 + og + 16]; if (og < 4) a2 += xv * wt[k * 36 + og + 32]; }
                for (int k = og; k < 256; k += 16) { const float v = x2[(size_t)(t0 + tk) * D + ch * 256 + k]; ssq += v * v; }
            }
            ssq += __shfl_xor(ssq, 1); ssq += __shfl_xor(ssq, 2); ssq += __shfl_xor(ssq, 4); ssq += __shfl_xor(ssq, 8);
            const float rstd = rsqrtf(ssq * (1.f / D) + EPS);
            __syncthreads();
            lg[tk * 36 + og] = a0 * rstd; lg[tk * 36 + og + 16] = a1 * rstd; if (og < 4) lg[tk * 36 + og + 32] = a2 * rstd;
            if (og == 0) RSTD3[t0 + tk] = rstd;
            __syncthreads();
            if (tid < 32) { const int t = t0 + tid; const LAS float* l = lg + tid * 36; int gs = 0; float gmax = l[0] + args.in[I_B_GROUP][0];
                float gv[4]; gv[0] = gmax;
#pragma unroll
                for (int i = 1; i < 4; ++i) { gv[i] = l[i] + args.in[I_B_GROUP][i]; if (gv[i] > gmax) { gmax = gv[i]; gs = i; } }
                float gsum = 0.f;
#pragma unroll
                for (int i = 0; i < 4; ++i) gsum += __expf(gv[i] - gmax);
                const float pg = 1.f / gsum;
                int i1 = 0, i2 = 0; float v1 = -3.0e38f, v2 = -3.0e38f;
#pragma unroll 1
                for (int i = 0; i < 8; ++i) { const float ev = l[4 + gs * 8 + i] + args.in[I_B_ROUTER][gs * 8 + i];
                    if (ev > v1) { v2 = v1; i2 = i1; v1 = ev; i1 = i; } else if (ev > v2) { v2 = ev; i2 = i; } }
                const float p2 = __expf(v2 - v1); const float g1 = pg / (1.f + p2), g2 = pg * p2 / (1.f + p2);
                const int e1 = gs * 8 + i1, e2 = gs * 8 + i2;
                const int s1 = atomicAdd(CNT + e1, 1), s2 = atomicAdd(CNT + e2, 1);
                LIST[e1 * T + s1] = t; LIST[e2 * T + s2] = t;
                TOKE[2 * t] = e1 * T + s1; TOKE[2 * t + 1] = e2 * T + s2; TOKW[2 * t] = g1; TOKW[2 * t + 1] = g2; }
        }
        GRID_BAR(9);
    }
    volatile LAS int* cnl = (volatile LAS int*)(MISC + 64); volatile LAS int* prel = (volatile LAS int*)(MISC + 128); volatile LAS int* tbl = (volatile LAS int*)(MISC + 192);
#define MOE_TABLES(ncol) do { __syncthreads(); if (tid == 0) { int p = 0, tb = 0; for (int e = 0; e < 32; ++e) { const int c = __hip_atomic_load(CNT + e, __ATOMIC_RELAXED, __HIP_MEMORY_SCOPE_AGENT); const int rt = (c + 255) >> 8; cnl[e] = c; prel[e] = p; tbl[e] = tb; p += rt * (ncol); tb += rt; } prel[32] = p; tbl[32] = tb; } __syncthreads(); } while (0)
    if (IN(10)) {
        MOE_TABLES(4);
        pg8::MoeOrder S{prel, tbl, cnl, LIST, 4, G, bx, (unsigned)D * 2u, (size_t)1024 * D * 2, (unsigned)D * 2u, 1};
        pg8::EpiSwiGLU E{ACT, LIST, RSTD3, cnl};
        pg8::gemm_phase(lds, X2B, WGU_T, D, S, E);
        GRID_BAR(10);
    }
    if (IN(11)) {
        MOE_TABLES(8);
        pg8::MoeOrder S{prel, tbl, cnl, LIST, 8, G, bx, (unsigned)DEXP * 2u, (size_t)D * DEXP * 2, (unsigned)DEXP * 2u, 0};
        pg8::EpiBf16 E{Y, D};
        pg8::gemm_phase(lds, ACT, WDN_T, DEXP, S, E);
        GRID_BAR(11);
    }
    if (IN(12)) {
        MOE_TABLES(1);
        const float* fg = args.in[I_FINAL_G];
        for (int t = gw; t < T; t += NGW) {
            const int a0 = TOKE[2 * t], a1 = TOKE[2 * t + 1]; const float w0 = TOKW[2 * t], w1 = TOKW[2 * t + 1];
            const size_t r0 = (size_t)tbl[a0 / T] * 256 + (a0 % T), r1 = (size_t)tbl[a1 / T] * 256 + (a1 % T);
            f32x4* xr = (f32x4*)(args.out + (size_t)t * D) + lane; const u32x2* y0 = (const u32x2*)(Y + r0 * D) + lane; const u32x2* y1 = (const u32x2*)(Y + r1 * D) + lane;
            f32x4 v[8]; float s = 0.f;
#pragma unroll
            for (int j = 0; j < 8; ++j) { v[j] = xr[64 * j]; const u32x2 p = y0[64 * j], q = y1[64 * j];
                v[j][0] += w0 * bf2f(p.x & 0xffffu) + w1 * bf2f(q.x & 0xffffu); v[j][1] += w0 * bf2f(p.x >> 16) + w1 * bf2f(q.x >> 16);
                v[j][2] += w0 * bf2f(p.y & 0xffffu) + w1 * bf2f(q.y & 0xffffu); v[j][3] += w0 * bf2f(p.y >> 16) + w1 * bf2f(q.y >> 16);
                s += (v[j][0] * v[j][0] + v[j][1] * v[j][1]) + (v[j][2] * v[j][2] + v[j][3] * v[j][3]); }
            const float r = rsqrtf(wave_sum(s) * (1.f / D) + EPS);
#pragma unroll
            for (int j = 0; j < 8; ++j) { const f32x4 g = ((const f32x4*)fg)[lane + 64 * j]; xr[64 * j] = (f32x4){v[j][0] * r * g[0], v[j][1] * r * g[1], v[j][2] * r * g[2], v[j][3] * r * g[3]}; }
        }
    }
#undef IN
#undef BOTH
#undef GRID_BAR
}

extern "C" void kernel_launch(void* const* d_in, const int* in_sizes, int n_in, void* d_out, int out_size, void* d_ws, size_t ws_size, hipStream_t stream) {
    static int grid = 0;
    if (grid == 0) {
        if (n_in != 27 || out_size != T * D || ws_size < WS_END) { fprintf(stderr, "kernel_launch: unexpected problem (n_in %d out %d ws %zu)\n", n_in, out_size, ws_size); grid = -1; return; }
        int dev = 0, cus = 0, per_cu = 0;
        if (hipGetDevice(&dev) != hipSuccess || hipDeviceGetAttribute(&cus, hipDeviceAttributeMultiprocessorCount, dev) != hipSuccess) { grid = -1; return; }
        if (hipFuncSetAttribute((const void*)mega, hipFuncAttributeMaxDynamicSharedMemorySize, LDS_BYTES) != hipSuccess) { fprintf(stderr, "kernel_launch: hipFuncSetAttribute failed\n"); grid = -1; return; }
        if (hipOccupancyMaxActiveBlocksPerMultiprocessor(&per_cu, (const void*)mega, 512, LDS_BYTES) != hipSuccess || per_cu < 1) fprintf(stderr, "kernel_launch: occupancy query reports %d\n", per_cu);
        (void)hipGetLastError();
        grid = cus;
    }
    if (grid < 0) return;
    if (hipMemsetAsync((char*)d_ws + WS_CTL, 0, CTL_ZERO_BYTES, stream) != hipSuccess) return;
    Args a{};
    for (int i = 0; i < 27; ++i) a.in[i] = (const float*)d_in[i];
    a.out = (float*)d_out; a.ws = (unsigned char*)d_ws;
    if (MK_N_LAUNCHES == 1) { a.ph_lo = 0; a.ph_hi = NPHASE; hipLaunchKernelGGL(mega, dim3(grid), dim3(512), LDS_BYTES, stream, a); }
    else { for (int p = 0; p < NPHASE; ++p) { a.ph_lo = p; a.ph_hi = p + 1; hipLaunchKernelGGL(mega, dim3(grid), dim3(512), LDS_BYTES, stream, a); } }
}
```

```cpp
#include <hip/hip_runtime.h>
#include <cstdio>
#include <cstdint>

#ifndef MK_N_LAUNCHES
#define MK_N_LAUNCHES 1
#endif

#define GAS __attribute__((address_space(1)))
#define LAS __attribute__((address_space(3)))
typedef unsigned short bf16;
typedef short bf16x8 __attribute__((ext_vector_type(8)));
typedef float f32x4 __attribute__((ext_vector_type(4)));
typedef float f32x2 __attribute__((ext_vector_type(2)));
typedef float f32x16 __attribute__((ext_vector_type(16)));
typedef unsigned u32x4 __attribute__((ext_vector_type(4)));
typedef unsigned u32x2 __attribute__((ext_vector_type(2)));

constexpr int T = 8192, D = 2048, NMEM = 256;
constexpr int D_IN = 4944;
constexpr int NPROJ = 6144;
constexpr int KMIX = 3072;
constexpr int NCH = 128, CH = 64;
constexpr int NEXP = 32, DEXP = 512;
constexpr float EPS = 1e-6f;
constexpr int NPHASE = 17;

constexpr size_t MiB = 1u << 20;
constexpr size_t WS_CTL = 0, CTL_ZERO_BYTES = 256 * 1024;
constexpr size_t WS_WOUT_T = 1 * MiB;
constexpr size_t WS_WCQ_T = 13 * MiB;
constexpr size_t WS_WCKV_T = 21 * MiB;
constexpr size_t WS_WCO_T = 37 * MiB;
constexpr size_t WS_WGU_T = 45 * MiB;
constexpr size_t WS_WDN_T = 173 * MiB;
constexpr size_t WS_WIN_T = 237 * MiB;
constexpr size_t WS_H1 = 261 * MiB;
constexpr size_t WS_MIXIN = 237 * MiB;
constexpr size_t WS_SC127 = 285 * MiB;
constexpr size_t WS_MEMN = 293 * MiB;
constexpr size_t WS_KC = 294 * MiB;
constexpr size_t WS_VT = 295 * MiB;
constexpr size_t WS_GATES = 296 * MiB;
constexpr size_t WS_WR = 297 * MiB;
constexpr size_t WS_QABS = 298 * MiB;
constexpr size_t WS_CKVRAW = 330 * MiB;
constexpr size_t WS_QI = 338 * MiB;
constexpr size_t WS_SMALL = 346 * MiB;
constexpr size_t WS_MQKRAW = 354 * MiB;
constexpr size_t WS_MV = 386 * MiB;
constexpr size_t WS_MO = 402 * MiB;
constexpr size_t WS_CKVN = 418 * MiB;
constexpr size_t WS_KIDXN = 422 * MiB;
constexpr size_t WS_QCM = 423 * MiB;
constexpr size_t WS_KCM = 431 * MiB;
constexpr size_t WS_LST = 439 * MiB;
constexpr size_t WS_NL = 503 * MiB;
constexpr size_t WS_CST = 504 * MiB;
constexpr size_t WS_VTM = 536 * MiB;
constexpr size_t WS_X1B = 298 * MiB;
constexpr size_t WS_QC = 330 * MiB;
constexpr size_t WS_OC = 362 * MiB;
constexpr size_t WS_X2B = 394 * MiB;
constexpr size_t WS_LIST = 426 * MiB;
constexpr size_t WS_TOK = 427 * MiB;
constexpr size_t WS_ACT = 428 * MiB;
constexpr size_t WS_Y = 452 * MiB;
constexpr size_t WS_END = 552 * MiB;
constexpr int GT_B = 0;
constexpr int GT_LI = T * 4;
constexpr int GT_G = 2 * T * 4;
constexpr int GT_MLOC = GT_G + 512;
constexpr int GT_MPREV = GT_MLOC + 512;
constexpr int CW_BAR = 4096;
constexpr int CW_CNT = 8192;
constexpr int CW_SS2 = 16384;
static_assert((CW_SS2 + T) * 4 <= (int)CTL_ZERO_BYTES, "ctl");

constexpr int RING_BYTES = 131072;
constexpr int MISC_OFF = RING_BYTES;
constexpr int LDS_BYTES = 159744;

__device__ __forceinline__ float bf2f(unsigned b) { return __uint_as_float(b << 16); }
__device__ __forceinline__ unsigned f2bf(float f) { unsigned u = __float_as_uint(f); return (u + 0x7fffu + ((u >> 16) & 1u)) >> 16; }
__device__ __forceinline__ unsigned pk2(float lo, float hi) { return f2bf(lo) | (f2bf(hi) << 16); }
__device__ __forceinline__ float wave_sum(float v) {
#pragma unroll
    for (int o = 1; o < 64; o <<= 1) v += __shfl_xor(v, o);
    return v;
}
__device__ __forceinline__ float wave_max(float v) {
#pragma unroll
    for (int o = 1; o < 64; o <<= 1) v = fmaxf(v, __shfl_xor(v, o));
    return v;
}
#define LDS_WAIT() asm volatile("s_waitcnt lgkmcnt(0)" ::: "memory")

#define XB_TMO      128
#define XB_XCNT(j)  (256  + 64 * (j))
#define XB_XSUB(j)  (1280 + 64 * (j))
#define XB_XGEN(j)  (2304 + 64 * (j))
#define XB_TOP      3328
#define XB_TOPGEN   3392
#define XCD_BAR_WORDS 3456
#define XB_SPIN_CAP (1u << 18)
__device__ __forceinline__ unsigned xb_ld(unsigned* p)              { return __hip_atomic_load(p, __ATOMIC_RELAXED, __HIP_MEMORY_SCOPE_AGENT); }
__device__ __forceinline__ unsigned xb_add(unsigned* p, unsigned v) { return __hip_atomic_fetch_add(p, v, __ATOMIC_RELAXED, __HIP_MEMORY_SCOPE_AGENT); }
__device__ __forceinline__ unsigned xb_xcc_id() { return (unsigned)__builtin_amdgcn_s_getreg((3 << 11) | 20) & 0xFu; }
#define XB_SPIN(cond, bar) do { unsigned _sp = 0; while (cond) { __builtin_amdgcn_s_sleep(1); \
    if ((++_sp & 255u) == 0u) { if (xb_ld(&(bar)[XB_TMO])) break; if (_sp > XB_SPIN_CAP) { atomicAdd(&(bar)[XB_TMO], 1u); break; } } } } while (0)
struct XcdBarrier { unsigned* bar; unsigned x; volatile LAS unsigned* st; };
__device__ __forceinline__ XcdBarrier xcd_barrier_post(unsigned* bar, volatile LAS unsigned* st) {
    XcdBarrier b; b.bar = bar; b.x = xb_xcc_id(); b.st = st;
    if (threadIdx.x == 0) (void)xb_add(&bar[XB_XCNT(b.x)], 1u);
    return b;
}
__device__ __forceinline__ void xcd_barrier_complete(unsigned* bar, unsigned x, unsigned& nloc, unsigned& nx) {
    const unsigned G = gridDim.x * gridDim.y * gridDim.z;
    unsigned sum, cnt, mine, sp = 0u;
    for (;;) {
        sum = 0u; cnt = 0u; mine = 0u;
#pragma unroll
        for (unsigned j = 0; j < 16; ++j) { const unsigned c = xb_ld(&bar[XB_XCNT(j)]); sum += c; cnt += (c > 0u) ? 1u : 0u; mine = (j == x) ? c : mine; }
        if (sum == G) break;
        __builtin_amdgcn_s_sleep(1);
        if ((++sp & 255u) == 0u) { if (xb_ld(&bar[XB_TMO])) break; if (sp > XB_SPIN_CAP) { atomicAdd(&bar[XB_TMO], 1u); break; } }
    }
    nloc = mine > 0u ? mine : 1u; nx = cnt > 0u ? cnt : 1u;
}
__device__ __forceinline__ void xcd_barrier(const XcdBarrier& b) {
    asm volatile("s_waitcnt vmcnt(0)" ::: "memory");
    __syncthreads();
    if (threadIdx.x == 0) {
        unsigned* bar = b.bar;
        __builtin_amdgcn_s_waitcnt(0);
        unsigned nloc = b.st[0], nx = b.st[1];
        if (nloc == 0u) { xcd_barrier_complete(bar, b.x, nloc, nx); b.st[0] = nloc; b.st[1] = nx; }
        const unsigned old = xb_add(&bar[XB_XSUB(b.x)], 1u);
        const unsigned gen = old / nloc;
        if (old + 1u == (gen + 1u) * nloc) {
            __builtin_amdgcn_fence(__ATOMIC_RELEASE, "agent");
            asm volatile("s_waitcnt vmcnt(0)" ::: "memory");
            const unsigned og = xb_add(&bar[XB_TOP], 1u);
            const unsigned tg = og / nx;
            if (og + 1u == (tg + 1u) * nx) xb_add(&bar[XB_TOPGEN], 1u);
            else XB_SPIN(xb_ld(&bar[XB_TOPGEN]) == tg, bar);
            __builtin_amdgcn_fence(__ATOMIC_ACQUIRE, "agent");
            xb_add(&bar[XB_XGEN(b.x)], 1u);
            asm volatile("s_waitcnt vmcnt(0)" ::: "memory");
        } else {
            XB_SPIN(xb_ld(&bar[XB_XGEN(b.x)]) == gen, bar);
            __builtin_amdgcn_fence(__ATOMIC_ACQUIRE, "agent");
            asm volatile("s_waitcnt vmcnt(0)" ::: "memory");
        }
    }
    __syncthreads();
}

namespace pg8 {
constexpr int BM = 256, BK = 64, HALF = 128, HTB = HALF * BK * 2, STAGE_BYTES = 8 * HTB, NXCD = 8, WGM = 8;
__host__ __device__ __forceinline__ int lds_byte(int r, int c) { const int st = (r >> 4) * 2 + (c >> 5), rr = r & 15, cc = c & 31, ob = rr * 64 + cc * 2; return st * 1024 + (ob ^ (((ob >> 9) & 1) << 5)); }
__host__ __device__ __forceinline__ void stage_rc(int b, int& R, int& C) { const int st = b / 1024, sb = b % 1024, swz = sb ^ (((sb >> 9) & 1) << 5); R = (st >> 1) * 16 + swz / 64; C = (st & 1) * 32 + (swz % 64) / 2; }

struct Unit { int pm, pn, e, rt; };

struct DenseOrder {
    static constexpr bool GATHER = false;
    int nM, nN, nwg, G, c; unsigned lda_bytes; unsigned kb;
    __device__ void init(int M, int N, int K, int lda, int G_, int c_) { nM = M / BM; nN = N / BM; nwg = nM * nN; G = G_; c = c_; lda_bytes = (unsigned)lda * 2u; kb = (unsigned)K * 2u; }
    __device__ bool next(int i, Unit& u) const {
        if (c < 0) return false;
        const long L = (long)i * G + c; if (L >= nwg) return false;
        int wgid = (int)L; { const int q = nwg / NXCD, r = nwg % NXCD, xcd = wgid % NXCD, off = wgid / NXCD; wgid = (xcd < r ? xcd * (q + 1) : r * (q + 1) + (xcd - r) * q) + off; }
        const int nig = WGM * nN, gid = wgid / nig, fm = gid * WGM, gsz = (nM - fm) < WGM ? (nM - fm) : WGM;
        u.pm = fm + ((wgid % nig) % gsz); u.pn = (wgid % nig) / gsz; u.e = 0; u.rt = 0; return true;
    }
    __device__ __forceinline__ unsigned a_row(const Unit& u, int r) const { return (unsigned)(u.pm * BM + r) * lda_bytes; }
    __device__ __forceinline__ size_t b_off(const Unit& u) const { return (size_t)u.pn * BM * kb; }
};

#define PG8_SA(b, h) (((b) * 2 + (h)) * HTB)
#define PG8_SB(b, h) ((4 + (b) * 2 + (h)) * HTB)
#define PG8_STAGEB(bufoff, gbase) do { _Pragma("unroll") for (int _i = 0; _i < 2; ++_i) \
        __builtin_amdgcn_global_load_lds((const unsigned*)((const char*)(gbase) + voffB[_i]), (LAS unsigned*)(lds + (bufoff) + ldsw + _i * 8192), 16, 0, 0); } while (0)
#define PG8_GLDS(src, dstoff) __builtin_amdgcn_global_load_lds((const unsigned*)(src), (LAS unsigned*)(lds + (dstoff)), 16, 0, 0)
#define PG8_STAGEA(bufoff, kbyte, h, NXT) do { if constexpr (Sched::GATHER) { const unsigned _o0 = (NXT) ? ((h) ? n10 : n00) : ((h) ? c10 : c00), _o1 = (NXT) ? ((h) ? n11 : n01) : ((h) ? c11 : c01); \
            PG8_GLDS(Ab + (kbyte) + _o0, (bufoff) + ldsw); PG8_GLDS(Ab + (kbyte) + _o1, (bufoff) + ldsw + 8192); } \
        else { const char* _b = ((NXT) ? nA : cA) + (kbyte) + ((h) ? hstepA : (size_t)0); PG8_GLDS(_b + voffA[0], (bufoff) + ldsw); PG8_GLDS(_b + voffA[1], (bufoff) + ldsw + 8192); } } while (0)
#define PG8_LDA(dst, b, h) do { _Pragma("unroll") for (int m = 0; m < 4; ++m) _Pragma("unroll") for (int k = 0; k < 2; ++k) dst[m][k] = *(const LAS bf16x8*)(lds + PG8_SA(b, h) + aoff + m * 2048 + k * 1024); } while (0)
#define PG8_LDB(dst, b, h) do { _Pragma("unroll") for (int n = 0; n < 2; ++n) _Pragma("unroll") for (int k = 0; k < 2; ++k) dst[n][k] = *(const LAS bf16x8*)(lds + PG8_SB(b, h) + boff + n * 2048 + k * 1024); } while (0)
#define PG8_MMA(ai, bj, At, Bt) do { __builtin_amdgcn_s_setprio(1); _Pragma("unroll") for (int m = 0; m < 4; ++m) _Pragma("unroll") for (int n = 0; n < 2; ++n) _Pragma("unroll") for (int k = 0; k < 2; ++k) \
        acc[ai][bj][m][n] = __builtin_amdgcn_mfma_f32_16x16x32_bf16(Bt[n][k], At[m][k], acc[ai][bj][m][n], 0, 0, 0); __builtin_amdgcn_s_setprio(0); } while (0)
#define PG8_WAIT_V(n) asm volatile("s_waitcnt vmcnt(" #n ")" ::: "memory")
#define PG8_WAIT_L(n) asm volatile("s_waitcnt lgkmcnt(" #n ")" ::: "memory")
#define PG8_BAR __builtin_amdgcn_s_barrier()
#define PG8_SCHED __builtin_amdgcn_sched_barrier(0)

template <class Epi, class Sched>
__device__ __forceinline__ void gemm_phase(LAS unsigned char* lds, const bf16* A, const bf16* Bt, const int K, const Sched& S, const Epi& E) {
    int tid = threadIdx.x; asm volatile("" : "+v"(tid));
    const int wid = __builtin_amdgcn_readfirstlane(tid >> 6), lane = tid & 63, wr = wid >> 2, wc = wid & 3, fr = lane & 15, fq = lane >> 4;
    int Kop_ = K; asm volatile("" : "+s"(Kop_));
    const int nt = Kop_ / BK;
    int sR[2], sC2[2]; unsigned voffB[2];
#pragma unroll
    for (int i = 0; i < 2; ++i) { int R, C; stage_rc(tid * 16 + i * 8192, R, C); sR[i] = R; sC2[i] = C * 2; voffB[i] = (unsigned)R * S.kb + (unsigned)C * 2u; }
    const unsigned kstep = (unsigned)(BK * 2);
    const size_t hstepB = (size_t)HALF * S.kb;
    const unsigned ldsw = (unsigned)wid * 1024u;
    const int aoff = lds_byte(wr * 64 + fr, fq * 8), boff = lds_byte(wc * 32 + fr, fq * 8);
    Unit cur, nxt; int ui = 0;
    if (!S.next(0, cur)) return;
    f32x4 acc[2][2][4][2];
#pragma unroll
    for (int a = 0; a < 2; ++a)
#pragma unroll
        for (int b = 0; b < 2; ++b)
#pragma unroll
            for (int m = 0; m < 4; ++m)
#pragma unroll
                for (int n = 0; n < 2; ++n) acc[a][b][m][n] = (f32x4){0.f, 0.f, 0.f, 0.f};
    bf16x8 At[4][2], B0[2][2], B1[2][2];
    const char* Ab = (const char*)A;
    unsigned c00 = 0, c01 = 0, c10 = 0, c11 = 0, n00 = 0, n01 = 0, n10 = 0, n11 = 0; unsigned voffA[2] = {0u, 0u}; const char* cA = Ab; const char* nA = Ab; size_t hstepA = 0;
    if constexpr (Sched::GATHER) { c00 = S.a_row(cur, sR[0]) + sC2[0]; c01 = S.a_row(cur, sR[1]) + sC2[1]; c10 = S.a_row(cur, 128 + sR[0]) + sC2[0]; c11 = S.a_row(cur, 128 + sR[1]) + sC2[1]; }
    else { voffA[0] = (unsigned)sR[0] * S.lda_bytes + sC2[0]; voffA[1] = (unsigned)sR[1] * S.lda_bytes + sC2[1]; hstepA = (size_t)HALF * S.lda_bytes; cA = Ab + (size_t)S.a_row(cur, 0); }
    const char* cB = (const char*)Bt + S.b_off(cur);
    PG8_STAGEB(PG8_SB(0, 0), cB); PG8_STAGEA(PG8_SA(0, 0), 0u, 0, false); PG8_STAGEB(PG8_SB(0, 1), cB + hstepB); PG8_STAGEA(PG8_SA(0, 1), 0u, 1, false);
    if (wr == 1) PG8_BAR;
    PG8_WAIT_V(4); PG8_BAR;
    PG8_STAGEB(PG8_SB(1, 0), cB + kstep); PG8_STAGEA(PG8_SA(1, 0), kstep, 0, false); PG8_STAGEB(PG8_SB(1, 1), cB + hstepB + kstep);
    PG8_WAIT_V(6); PG8_BAR;
    for (;;) {
        const bool has_next = S.next(ui + 1, nxt);
        const char* nB = cB;
        if constexpr (Sched::GATHER) { n00 = c00; n01 = c01; n10 = c10; n11 = c11; } else nA = cA;
        if (has_next) { nB = (const char*)Bt + S.b_off(nxt);
            if constexpr (Sched::GATHER) { n00 = S.a_row(nxt, sR[0]) + sC2[0]; n01 = S.a_row(nxt, sR[1]) + sC2[1]; n10 = S.a_row(nxt, 128 + sR[0]) + sC2[0]; n11 = S.a_row(nxt, 128 + sR[1]) + sC2[1]; }
            else nA = Ab + (size_t)S.a_row(nxt, 0); }
        for (int t = 0; t < nt; t += 2) {
            const bool last = (t == nt - 2);
            const unsigned k1 = (unsigned)(t + 1) * kstep;
            const unsigned k2 = last ? 0u : (unsigned)(t + 2) * kstep, k3 = k2 + kstep;
            const char* b2 = last ? nB : cB + (size_t)(t + 2) * kstep; const char* b3 = b2 + kstep;
            PG8_LDB(B0, 0, 0); PG8_SCHED; PG8_LDA(At, 0, 0); PG8_STAGEA(PG8_SA(1, 1), k1, 1, false);
            PG8_WAIT_L(8); PG8_BAR; PG8_WAIT_L(0); PG8_MMA(0, 0, At, B0); PG8_BAR; PG8_SCHED;
            PG8_LDB(B1, 0, 1); PG8_STAGEB(PG8_SB(0, 0), b2);
            PG8_BAR; PG8_WAIT_L(0); PG8_MMA(0, 1, At, B1); PG8_BAR;
            PG8_LDA(At, 0, 1); PG8_STAGEA(PG8_SA(0, 0), k2, 0, last);
            PG8_BAR; PG8_WAIT_L(0); PG8_MMA(1, 0, At, B0); PG8_BAR; PG8_SCHED;
            PG8_STAGEB(PG8_SB(0, 1), b2 + hstepB);
            PG8_WAIT_V(6); PG8_BAR; PG8_MMA(1, 1, At, B1); PG8_BAR;
            PG8_LDB(B0, 1, 0); PG8_SCHED; PG8_LDA(At, 1, 0); PG8_STAGEA(PG8_SA(0, 1), k2, 1, last);
            PG8_WAIT_L(8); PG8_BAR; PG8_WAIT_L(0); PG8_MMA(0, 0, At, B0); PG8_BAR; PG8_SCHED;
            PG8_LDB(B1, 1, 1); PG8_STAGEB(PG8_SB(1, 0), b3);
            PG8_BAR; PG8_WAIT_L(0); PG8_MMA(0, 1, At, B1); PG8_BAR;
            PG8_LDA(At, 1, 1); PG8_STAGEA(PG8_SA(1, 0), k3, 0, last);
            PG8_BAR; PG8_WAIT_L(0); PG8_MMA(1, 0, At, B0); PG8_BAR; PG8_SCHED;
            PG8_STAGEB(PG8_SB(1, 1), b3 + hstepB);
            PG8_WAIT_V(6); PG8_BAR; PG8_MMA(1, 1, At, B1); PG8_BAR;
        }
        if constexpr (!Epi::AFTER_DRAIN) E(acc, cur, wr, wc, fr, fq);
        if (!has_next) break;
#pragma unroll
        for (int a = 0; a < 2; ++a)
#pragma unroll
            for (int b = 0; b < 2; ++b)
#pragma unroll
                for (int m = 0; m < 4; ++m)
#pragma unroll
                    for (int n = 0; n < 2; ++n) acc[a][b][m][n] = (f32x4){0.f, 0.f, 0.f, 0.f};
        cur = nxt; if constexpr (Sched::GATHER) { c00 = n00; c01 = n01; c10 = n10; c11 = n11; } else cA = nA; cB = nB; ++ui;
    }
    PG8_WAIT_V(0);
    if (wr == 0) PG8_BAR;
    PG8_BAR;
    if constexpr (Epi::AFTER_DRAIN) E.fused(acc, cur, wr, wc, fr, fq, lds, wid, lane);
}

__device__ __forceinline__ void store_tile_f32(const f32x4 (&acc)[2][2][4][2], float* dst, int ld, int row0, int col0) {
#pragma unroll
    for (int ai = 0; ai < 2; ++ai)
#pragma unroll
        for (int m = 0; m < 4; ++m) { float* rowp = dst + (size_t)(row0 + ai * HALF + m * 16) * ld + col0;
#pragma unroll
            for (int bj = 0; bj < 2; ++bj)
#pragma unroll
                for (int n = 0; n < 2; ++n) *(f32x4*)(rowp + bj * HALF + n * 16) = acc[ai][bj][m][n]; }
}
__device__ __forceinline__ void store_tile_bf16(const f32x4 (&acc)[2][2][4][2], bf16* dst, int ld, int row0, int col0) {
#pragma unroll
    for (int ai = 0; ai < 2; ++ai)
#pragma unroll
        for (int m = 0; m < 4; ++m) { bf16* rowp = dst + (size_t)(row0 + ai * HALF + m * 16) * ld + col0;
#pragma unroll
            for (int bj = 0; bj < 2; ++bj)
#pragma unroll
                for (int n = 0; n < 2; ++n) { const f32x4 v = acc[ai][bj][m][n]; u32x2 w; w.x = pk2(v[0], v[1]); w.y = pk2(v[2], v[3]); *(u32x2*)(rowp + bj * HALF + n * 16) = w; } }
}
struct EpiBf16 {
    static constexpr bool AFTER_DRAIN = false;
    bf16* dst; int ld;
    __device__ __forceinline__ void operator()(const f32x4 (&acc)[2][2][4][2], const Unit& u, int wr, int wc, int fr, int fq) const {
        store_tile_bf16(acc, dst, ld, u.pm * BM + wr * 64 + fr, u.pn * BM + wc * 32 + 4 * fq);
    }
};
struct EpiProj {
    static constexpr bool AFTER_DRAIN = false;
    bf16* qabs; float* ckvraw; bf16* qi; float* small; float* mqkraw; bf16* mv; bf16* mo;
    __device__ __forceinline__ void operator()(const f32x4 (&acc)[2][2][4][2], const Unit& u, int wr, int wc, int fr, int fq) const {
        const int row0 = u.pm * BM + wr * 64 + fr, cl = wc * 32 + 4 * fq, pn = u.pn;
        if (pn < 8) store_tile_bf16(acc, qabs, 2048, row0, pn * 256 + cl);
        else if (pn == 8) store_tile_f32(acc, ckvraw, 256, row0, cl);
        else if (pn < 11) store_tile_bf16(acc, qi, 512, row0, (pn - 9) * 256 + cl);
        else if (pn == 11) store_tile_f32(acc, small, 256, row0, cl);
        else if (pn < 16) store_tile_f32(acc, mqkraw, 1024, row0, (pn - 12) * 256 + cl);
        else if (pn < 20) store_tile_bf16(acc, mv, 1024, row0, (pn - 16) * 256 + cl);
        else store_tile_bf16(acc, mo, 1024, row0, (pn - 20) * 256 + cl);
    }
};
template <bool BASE_BF16>
struct EpiResidT {
    static constexpr bool AFTER_DRAIN = false;
    const void* base; bf16* xb; float* ss;
    __device__ __forceinline__ void operator()(const f32x4 (&acc)[2][2][4][2], const Unit& u, int wr, int wc, int fr, int fq) const {
        const int row0 = u.pm * BM + wr * 64 + fr, col0 = u.pn * BM + wc * 32 + 4 * fq;
#pragma unroll
        for (int ai = 0; ai < 2; ++ai)
#pragma unroll
            for (int m = 0; m < 4; ++m) { const int row = row0 + ai * HALF + m * 16; const size_t off = (size_t)row * D + col0; float s = 0.f;
#pragma unroll
                for (int bj = 0; bj < 2; ++bj)
#pragma unroll
                    for (int n = 0; n < 2; ++n) { f32x4 b;
                        if constexpr (BASE_BF16) { const u32x2 p = *(const u32x2*)((const bf16*)base + off + bj * HALF + n * 16); b = (f32x4){bf2f(p.x & 0xffffu), bf2f(p.x >> 16), bf2f(p.y & 0xffffu), bf2f(p.y >> 16)}; }
                        else b = *(const f32x4*)((const float*)base + off + bj * HALF + n * 16);
                        const f32x4 v = b + acc[ai][bj][m][n];
                        u32x2 w; w.x = pk2(v[0], v[1]); w.y = pk2(v[2], v[3]); *(u32x2*)(xb + off + bj * HALF + n * 16) = w;
                        s += (v[0] * v[0] + v[1] * v[1]) + (v[2] * v[2] + v[3] * v[3]); }
                if (ss) { s += __shfl_xor(s, 16); s += __shfl_xor(s, 32); if (fq == 0) atomicAdd(ss + row, s); } }
    }
};
struct EpiCq {
    static constexpr bool AFTER_DRAIN = false;
    bf16* dst; const float* ss; float scale;
    __device__ __forceinline__ void operator()(const f32x4 (&acc)[2][2][4][2], const Unit& u, int wr, int wc, int fr, int fq) const {
        const int row0 = u.pm * BM + wr * 64 + fr, col0 = u.pn * BM + wc * 32 + 4 * fq;
#pragma unroll
        for (int ai = 0; ai < 2; ++ai)
#pragma unroll
            for (int m = 0; m < 4; ++m) { const int row = row0 + ai * HALF + m * 16; const float r = rsqrtf(ss[row] * (1.0f / D) + EPS) * scale; bf16* rowp = dst + (size_t)row * D + col0;
#pragma unroll
                for (int bj = 0; bj < 2; ++bj)
#pragma unroll
                    for (int n = 0; n < 2; ++n) { const f32x4 v = acc[ai][bj][m][n] * r; u32x2 w; w.x = pk2(v[0], v[1]); w.y = pk2(v[2], v[3]); *(u32x2*)(rowp + bj * HALF + n * 16) = w; } }
    }
};
struct XsOrder {
    static constexpr bool GATHER = false;
    int G, c; unsigned lda_bytes, kb;
    __device__ bool next(int i, Unit& u) const { const int L = i * G + c; if (i > 0 || L >= 128) return false; u.pm = L >> 2; u.pn = L & 3; u.e = 0; u.rt = 0; return true; }
    __device__ __forceinline__ unsigned a_row(const Unit& u, int r) const { return (unsigned)(u.pm * BM + r) * lda_bytes + (unsigned)u.pn * 1024u; }
    __device__ __forceinline__ size_t b_off(const Unit& u) const { return (size_t)u.pn * 1024; }
};
struct XoOrder {
    static constexpr bool GATHER = false;
    int G, c; unsigned lda_bytes, kb;
    __device__ bool next(int i, Unit& u) const { const int L = i * G + c; if (L >= 256) return false; u.pm = L >> 3; u.pn = L & 7; u.e = 0; u.rt = 0; return true; }
    __device__ __forceinline__ unsigned a_row(const Unit& u, int r) const { return (unsigned)(u.pm * BM + r) * lda_bytes + (unsigned)(u.pn >> 1) * 512u; }
    __device__ __forceinline__ size_t b_off(const Unit& u) const { return (size_t)u.pn * BM * kb; }
};
struct EpiSoftmax {
    static constexpr bool AFTER_DRAIN = true;
    bf16* P; const float* ss;
    __device__ __forceinline__ void fused(f32x4 (&acc)[2][2][4][2], const Unit& u, int wr, int wc, int fr, int fq, LAS unsigned char* lds, int wid, int lane) const {
        LAS float* Pm = (LAS float*)lds; LAS float* Ps = (LAS float*)(lds + 4096);
#pragma unroll
        for (int ai = 0; ai < 2; ++ai)
#pragma unroll
            for (int m = 0; m < 4; ++m) { float mx = -3.0e38f; const float rs = rsqrtf(ss[u.pm * BM + ai * HALF + wr * 64 + m * 16 + fr] * (1.0f / D) + EPS);
#pragma unroll
                for (int bj = 0; bj < 2; ++bj)
#pragma unroll
                    for (int n = 0; n < 2; ++n) { const f32x4 v = acc[ai][bj][m][n] * rs; acc[ai][bj][m][n] = v; mx = fmaxf(mx, fmaxf(fmaxf(v[0], v[1]), fmaxf(v[2], v[3]))); }
                mx = fmaxf(mx, __shfl_xor(mx, 16)); mx = fmaxf(mx, __shfl_xor(mx, 32));
                if (fq == 0) Pm[(ai * HALF + wr * 64 + m * 16 + fr) * 4 + wc] = mx; }
        asm volatile("s_waitcnt lgkmcnt(0)" ::: "memory"); __builtin_amdgcn_s_barrier(); asm volatile("" ::: "memory");
#pragma unroll
        for (int ai = 0; ai < 2; ++ai)
#pragma unroll
            for (int m = 0; m < 4; ++m) { const int r = ai * HALF + wr * 64 + m * 16 + fr; const f32x4 pm4 = *(const LAS f32x4*)(Pm + r * 4); const float mx = fmaxf(fmaxf(pm4[0], pm4[1]), fmaxf(pm4[2], pm4[3])); float sm = 0.f;
#pragma unroll
                for (int bj = 0; bj < 2; ++bj)
#pragma unroll
                    for (int n = 0; n < 2; ++n) { f32x4 v = acc[ai][bj][m][n];
#pragma unroll
                        for (int j = 0; j < 4; ++j) { v[j] = __expf(v[j] - mx); sm += v[j]; }
                        acc[ai][bj][m][n] = v; }
                sm += __shfl_xor(sm, 16); sm += __shfl_xor(sm, 32);
                if (fq == 0) Ps[r * 4 + wc] = sm; }
        asm volatile("s_waitcnt lgkmcnt(0)" ::: "memory"); __builtin_amdgcn_s_barrier(); asm volatile("" ::: "memory");
#pragma unroll
        for (int ai = 0; ai < 2; ++ai)
#pragma unroll
            for (int m = 0; m < 4; ++m) { const int r = ai * HALF + wr * 64 + m * 16 + fr; const f32x4 ps4 = *(const LAS f32x4*)(Ps + r * 4); const float inv = 1.f / ((ps4[0] + ps4[1]) + (ps4[2] + ps4[3]));
                bf16* rowp = P + (size_t)(u.pm * BM + r) * 1024 + u.pn * 256 + wc * 32 + 4 * fq;
#pragma unroll
                for (int bj = 0; bj < 2; ++bj)
#pragma unroll
                    for (int n = 0; n < 2; ++n) { const f32x4 v = acc[ai][bj][m][n] * inv; u32x2 w; w.x = pk2(v[0], v[1]); w.y = pk2(v[2], v[3]); *(u32x2*)(rowp + bj * HALF + n * 16) = w; } }
    }
};
struct MoeOrder {
    static constexpr bool GATHER = true;
    const volatile LAS int* tb; const volatile LAS int* cn; const int* list; int ncol; int Lbeg, Lend, nb, c; unsigned a_ld_bytes; size_t b_exp_bytes; unsigned kb; int gather;
    __device__ bool next(int i, Unit& u) const {
        if (c < 0 || nb <= 0) return false;
        const int L = Lbeg + i * nb + c; if (L >= Lend) return false;
        const int g = L / ncol; int e = 0;
#pragma unroll 1
        for (int j = 1; j < 32; ++j) if (g >= tb[j]) e = j;
        u.e = e; u.rt = g - tb[e]; u.pn = L - g * ncol; u.pm = g; return true;
    }
    __device__ __forceinline__ unsigned a_row(const Unit& u, int r) const {
        if (gather) { int idx = u.rt * 256 + r; const int cnt = cn[u.e]; idx = idx < cnt ? idx : cnt - 1; const int tok = list[u.e * T + idx]; return (unsigned)tok * a_ld_bytes; }
        return (unsigned)(u.pm * 256 + r) * a_ld_bytes;
    }
    __device__ __forceinline__ size_t b_off(const Unit& u) const { return (size_t)u.e * b_exp_bytes + (size_t)u.pn * BM * kb; }
};
struct EpiSwiGLU {
    static constexpr bool AFTER_DRAIN = false;
    bf16* act; const int* list; const float* rstd; const volatile LAS int* cn;
    __device__ __forceinline__ void operator()(const f32x4 (&acc)[2][2][4][2], const Unit& u, int wr, int wc, int fr, int fq) const {
        const int cnt = cn[u.e];
#pragma unroll
        for (int ai = 0; ai < 2; ++ai)
#pragma unroll
            for (int m = 0; m < 4; ++m) { const int rl = ai * HALF + wr * 64 + m * 16 + fr; int idx = u.rt * 256 + rl; idx = idx < cnt ? idx : cnt - 1; const float r = rstd[list[u.e * T + idx]];
                bf16* rowp = act + (size_t)(u.pm * 256 + rl) * DEXP + u.pn * 128 + wc * 32 + 4 * fq;
#pragma unroll
                for (int n = 0; n < 2; ++n) { const f32x4 g = acc[ai][0][m][n] * r, uu = acc[ai][1][m][n] * r; f32x4 a;
#pragma unroll
                    for (int j = 0; j < 4; ++j) a[j] = g[j] / (1.0f + __expf(-g[j])) * uu[j];
                    u32x2 w; w.x = pk2(a[0], a[1]); w.y = pk2(a[2], a[3]); *(u32x2*)(rowp + n * 16) = w; } }
    }
};
}

struct Args { const float* in[27]; float* out; unsigned char* ws; int ph_lo, ph_hi; };
enum { I_X = 0, I_MEM, I_NORM_MIX_G, I_W_IN, I_KV_NORM_G, I_KIDX_NORM_G, I_W_UK, I_W_UV, I_CONV_W, I_CONV_B, I_GATE_B, I_ML_NORM_G, I_W_OUT, I_NORM_X_G, I_MEM_NORM_G,
       I_W_CQ, I_W_CKV, I_W_CO, I_NORM_FFN_G, I_W_GROUP, I_B_GROUP, I_W_ROUTER, I_B_ROUTER, I_W_GATE, I_W_UP, I_W_DOWN, I_FINAL_G };

__device__ __forceinline__ void tr_item(const float* W, size_t ldw, int k0, int n0, const float* kscale, bf16* WT, size_t ldt, int drow0, int dcol0, LAS float* scr, int lane) {
#pragma unroll 8
    for (int i = 0; i < 32; ++i) { const int kk = 2 * i + (lane >> 5); float v = W[(size_t)(k0 + kk) * ldw + n0 + (lane & 31)]; if (kscale) v *= kscale[k0 + kk]; scr[kk * 33 + (lane & 31)] = v; }
    LDS_WAIT(); asm volatile("" ::: "memory");
    const int c = lane & 7;
#pragma unroll
    for (int j = 0; j < 4; ++j) { const int n = (lane >> 3) + 8 * j; const LAS float* s = scr + (8 * c) * 33 + n;
        u32x4 o; o.x = pk2(s[0 * 33], s[1 * 33]); o.y = pk2(s[2 * 33], s[3 * 33]); o.z = pk2(s[4 * 33], s[5 * 33]); o.w = pk2(s[6 * 33], s[7 * 33]);
        *(u32x4*)(WT + (size_t)(drow0 + n0 + n) * ldt + dcol0 + k0 + 8 * c) = o; }
    LDS_WAIT(); asm volatile("" ::: "memory");
}
__device__ __forceinline__ void tr_item64(const float* W, size_t ldw, int k0, int n0, const float* kscale, bf16* WT, size_t ldt, int drow0, int dcol0, LAS unsigned char* scr, int lane) {
    const int nq = lane & 15, kq = lane >> 4;
    const float* src = W + (size_t)(k0 + 2 * kq) * ldw + n0 + 4 * nq;
    f32x4 a[8], b[8];
#pragma unroll
    for (int i = 0; i < 8; ++i) { a[i] = __builtin_nontemporal_load((const f32x4*)(src + (size_t)(8 * i) * ldw)); b[i] = __builtin_nontemporal_load((const f32x4*)(src + (size_t)(8 * i + 1) * ldw)); }
#pragma unroll
    for (int i = 0; i < 8; ++i) { float sa = 1.f, sb = 1.f; if (kscale) { sa = kscale[k0 + 8 * i + 2 * kq]; sb = kscale[k0 + 8 * i + 2 * kq + 1]; }
#pragma unroll
        for (int j = 0; j < 4; ++j) { const int n = 4 * nq + j; *(LAS unsigned*)(scr + n * 128 + 16 * (i ^ (nq & 7)) + 4 * kq) = pk2(a[i][j] * sa, b[i][j] * sb); } }
    LDS_WAIT(); asm volatile("" ::: "memory");
#pragma unroll
    for (int m = 0; m < 8; ++m) { const int n = (lane >> 3) + 8 * m, c = lane & 7; const u32x4 v = *(const LAS u32x4*)(scr + n * 128 + 16 * (c ^ ((n >> 2) & 7)));
        __builtin_nontemporal_store(v, (u32x4*)(WT + (size_t)(drow0 + n0 + n) * ldt + dcol0 + k0 + 8 * c)); }
    LDS_WAIT(); asm volatile("" ::: "memory");
}
__device__ __forceinline__ void cv_item64(const float* W, size_t ldw, int k0, int n0, const float* kscale, float scale, bf16* O, size_t ldo, int lane) {
    const int c4 = (lane & 15) * 4, rr = lane >> 4;
    f32x4 v[16];
#pragma unroll
    for (int i = 0; i < 16; ++i) v[i] = __builtin_nontemporal_load((const f32x4*)(W + (size_t)(k0 + i * 4 + rr) * ldw + n0 + c4));
#pragma unroll
    for (int i = 0; i < 16; ++i) { const float g = kscale[k0 + i * 4 + rr] * scale; u32x2 w; w.x = pk2(v[i][0] * g, v[i][1] * g); w.y = pk2(v[i][2] * g, v[i][3] * g);
        *(u32x2*)(O + (size_t)(k0 + i * 4 + rr) * ldo + n0 + c4) = w; }
}
__device__ __forceinline__ void rms_row_to_bf16(const float* xrow, const float* g, bf16* orow, int lane) {
    const f32x4* xr = (const f32x4*)xrow + lane; const f32x4* gr = (const f32x4*)g + lane;
    f32x4 v[8]; float s = 0.f;
#pragma unroll
    for (int j = 0; j < 8; ++j) { v[j] = xr[64 * j]; s += (v[j][0] * v[j][0] + v[j][1] * v[j][1]) + (v[j][2] * v[j][2] + v[j][3] * v[j][3]); }
    const float r = rsqrtf(wave_sum(s) * (1.f / D) + EPS);
    u32x2* o8 = (u32x2*)orow + lane;
#pragma unroll
    for (int j = 0; j < 8; ++j) { const f32x4 gg = gr[64 * j]; u32x2 w; w.x = pk2(v[j][0] * r * gg[0], v[j][1] * r * gg[1]); w.y = pk2(v[j][2] * r * gg[2], v[j][3] * r * gg[3]); o8[64 * j] = w; }
}

__device__ __forceinline__ void mini_gemm64(LAS unsigned char* lds, const bf16* Ap, const unsigned lda, const bf16* Bp, const unsigned ldb, const int nch, bf16* o, const unsigned ldo, const int wave, const int lane) {
    const int r32 = lane & 31, hh = lane >> 5; const int tm = wave & 1, tn = (wave >> 1) & 1, kh = wave >> 2;
#define KV_DMA(kc_) do { _Pragma("unroll") for (int i4 = 0; i4 < 4; ++i4) { const int ii = wave * 4 + i4; const int isb = ii >> 4, row_ = (ii & 15) * 4 + (lane >> 4); \
        const bf16* gsrc_ = (isb ? Bp + (size_t)row_ * ldb : Ap + (size_t)row_ * lda) + (kc_) * 128 + (((lane & 15) ^ (row_ & 15)) * 8); \
        const unsigned ldst_ = __builtin_amdgcn_readfirstlane((unsigned)(size_t)lds + (unsigned)(((kc_) & 1) * 32768 + isb * 16384 + (ii & 15) * 1024)); unsigned keep_; \
        asm volatile("s_mov_b32 %0, m0\n\ts_mov_b32 m0, %2\n\ts_nop 0\n\tglobal_load_lds_dwordx4 %1, off\n\ts_mov_b32 m0, %0" : "=&s"(keep_) : "v"(gsrc_), "s"(ldst_) : "memory"); } } while (0)
    f32x16 acc;
#pragma unroll
    for (int i = 0; i < 16; ++i) acc[i] = 0.f;
    asm volatile("s_waitcnt vmcnt(0)" ::: "memory");
    __syncthreads();
    KV_DMA(0);
#pragma unroll 1
    for (int kc = 0; kc < nch; ++kc) {
        asm volatile("s_waitcnt vmcnt(0)" ::: "memory");
        __syncthreads();
        if (kc + 1 < nch) KV_DMA(kc + 1);
        const LAS unsigned char* ba = lds + (kc & 1) * 32768 + (tm * 32 + r32) * 256; const LAS unsigned char* bb = lds + (kc & 1) * 32768 + 16384 + (tn * 32 + r32) * 256;
#pragma unroll
        for (int k4 = 0; k4 < 4; ++k4) { const int ch = (kh * 4 + k4) * 2 + hh;
            const bf16x8 af = *(const LAS bf16x8*)(ba + ((ch ^ (r32 & 15)) * 16)), bfr = *(const LAS bf16x8*)(bb + ((ch ^ (r32 & 15)) * 16));
            acc = __builtin_amdgcn_mfma_f32_32x32x16_bf16(af, bfr, acc, 0, 0, 0); }
    }
#undef KV_DMA
    __syncthreads();
    LAS float* xb = (LAS float*)(lds + 65536) + (wave & 3) * 1024;
    if (kh == 1) {
#pragma unroll
        for (int i = 0; i < 16; ++i) xb[i * 64 + lane] = acc[i]; }
    __syncthreads();
    if (kh == 0) { bf16* op = o + (size_t)(tm * 32 + 4 * hh) * ldo + tn * 32 + r32;
#pragma unroll
        for (int i = 0; i < 16; ++i) op[(size_t)((i & 3) + 8 * (i >> 2)) * ldo] = (bf16)f2bf(acc[i] + xb[i * 64 + lane]); }
}


__global__ void __launch_bounds__(512, 2) mega(Args args) {
    extern __shared__ __attribute__((aligned(16))) unsigned char lds_raw[];
    LAS unsigned char* lds = (LAS unsigned char*)lds_raw;
    volatile LAS unsigned* MISC = (volatile LAS unsigned*)(lds + MISC_OFF);
    const int tid0 = threadIdx.x;
    const int G = gridDim.x, bx = blockIdx.x;
#define PHASE_IDS const Args* A_ = (const Args*)__builtin_amdgcn_kernarg_segment_ptr(); asm volatile("" : "+s"(A_)); int tid = threadIdx.x; asm volatile("" : "+v"(tid)); const int lane = tid & 63, wave = __builtin_amdgcn_readfirstlane(tid >> 6); const int gw = bx * 8 + wave, NGW = G * 8; (void)lane; (void)gw; (void)NGW;
    const Args* A_ = (const Args*)__builtin_amdgcn_kernarg_segment_ptr();
    unsigned char* ws = args.ws;
    unsigned* ctl = (unsigned*)(ws + WS_CTL);
    const int lo = args.ph_lo, hi = args.ph_hi;
    for (int u = tid0; u < 1024; u += 512) MISC[u] = 0u;
    __syncthreads();
    XcdBarrier bar; bar.bar = ctl + CW_BAR; bar.x = 0; bar.st = MISC;
    if (hi - lo > 1) bar = xcd_barrier_post(ctl + CW_BAR, MISC);
#ifndef PH_MASK
#define PH_MASK 0x1ffff
#endif
#define IN(k) ((((PH_MASK) >> (k)) & 1) && lo <= (k) && (k) < hi)
#ifndef REP_MASK
#define REP_MASK 0
#endif
#define NREP(k) (1 + (((REP_MASK) >> (k)) & 1))
#ifndef PR_MFMA
#define PR_MFMA 0
#endif
#ifndef PR_EPI
#define PR_EPI 0
#endif
#ifndef PR_GA
#define PR_GA 0
#endif
#ifndef PR_VF
#define PR_VF 0
#endif
#ifndef PR_KV
#define PR_KV 0
#endif
#ifndef PR_ML
#define PR_ML 0
#endif
#ifndef PR_TR
#define PR_TR 0
#endif
#ifndef PR_WP
#define PR_WP 0
#endif
#ifndef PR_H1
#define PR_H1 0
#endif
#ifndef PR_QK
#define PR_QK 0
#endif
#ifndef PR_PV
#define PR_PV 0
#endif
#define BOTH(k) (IN(k) && IN((k) + 1))
#define GRID_BAR(k) do { if (BOTH(k) && rep_ == NREP(k) - 1) xcd_barrier(bar); } while (0)

#define WOUT_T ((bf16*)(ws + WS_WOUT_T))
#define WCQ_T ((bf16*)(ws + WS_WCQ_T))
#define WCKV_T ((bf16*)(ws + WS_WCKV_T))
#define WCO_T ((bf16*)(ws + WS_WCO_T))
#define WGU_T ((bf16*)(ws + WS_WGU_T))
#define WDN_T ((bf16*)(ws + WS_WDN_T))
#define WIN_T ((bf16*)(ws + WS_WIN_T))
#define H1 ((bf16*)(ws + WS_H1))
#define MIXIN ((bf16*)(ws + WS_MIXIN))
#define MEMN ((bf16*)(ws + WS_MEMN))
#define KC ((bf16*)(ws + WS_KC))
#define MF ((bf16*)(ws + WS_WCKV_T + 4 * MiB))
#define VF ((bf16*)(ws + WS_WCKV_T))
#define VT ((bf16*)(ws + WS_VT))
#define GATES ((float*)(ws + WS_GATES))
#define QABS ((bf16*)(ws + WS_QABS))
#define CKVRAW ((float*)(ws + WS_CKVRAW))
#define QI ((bf16*)(ws + WS_QI))
#define SMALL ((float*)(ws + WS_SMALL))
#define MQKRAW ((float*)(ws + WS_MQKRAW))
#define MV ((bf16*)(ws + WS_MV))
#define MO ((bf16*)(ws + WS_MO))
#define CKVN ((bf16*)(ws + WS_CKVN))
#define KIDXN ((bf16*)(ws + WS_KIDXN))
#define QCM ((bf16*)(ws + WS_QCM))
#define KCM ((bf16*)(ws + WS_KCM))
#define LST ((float*)(ws + WS_LST))
#define NL ((float*)(ws + WS_NL))
#define NST (NL + NCH * 4 * 128)
#define CST ((bf16*)(ws + WS_CST))
#define VTM ((bf16*)(ws + WS_VTM))
#define PB ((bf16*)(ws + WS_VTM))
#define X1B ((bf16*)(ws + WS_X1B))
#define QC ((bf16*)(ws + WS_QC))
#define OC ((bf16*)(ws + WS_OC))
#define X2B ((bf16*)(ws + WS_X2B))
#define LIST ((int*)(ws + WS_LIST))
#define TOKE ((int*)(ws + WS_TOK))
#define TOKW ((float*)(ws + WS_TOK) + 2 * T)
#define RSTD3 ((float*)(ws + WS_TOK) + 4 * T)
#define ACT ((bf16*)(ws + WS_ACT))
#define Y ((bf16*)(ws + WS_Y))
#define WRH ((bf16*)(ws + WS_WR))
#define WRL (WRH + 48 * D)
#define BCNT ((int*)(ws + WS_TOK) + 8 * T)
#define TOKR ((int*)(ws + WS_TOK) + 6 * T)
#define SS2 ((float*)(ctl + CW_SS2))
#define CNT ((int*)(ctl + CW_CNT))

    if (IN(0)) for (int rep_ = 0; rep_ < NREP(0); ++rep_) {
        PHASE_IDS
        if (rep_) xcd_barrier(bar);
        LAS float* scr = (LAS float*)(lds + wave * 16384);
        const float* w_in = A_->in[I_W_IN]; const float* w_out = A_->in[I_W_OUT];
        constexpr int J_CKV = 32 * 4, J_QI = 32 * 8, J_KI = 32 * 1, J_MQK = 32 * 16, J_MV = 32 * 16, J_MO = 32 * 16, J_WO = 16 * 32, J_CQ = 32 * 32, J_CKVW = 32 * 64, J_CO = 32 * 32,
                      J_G = 32 * 256, J_U = 32 * 256, J_D = 32 * 256;
        constexpr int NITEMS = J_CKV + J_QI + J_KI + J_MQK + J_MV + J_MO + J_WO + J_CQ + J_CKVW + J_CO + J_G + J_U + J_D;
        LAS unsigned char* scr8 = (LAS unsigned char*)scr;
        for (int prt_ = 0; prt_ < 1 + PR_TR; ++prt_)
        for (int it = gw; it < NITEMS; it += NGW) {
            int r = it;
            if (r < J_CKV) { tr_item64(w_in + 1024, D_IN, 64 * (r / 4), 64 * (r % 4), nullptr, WIN_T, D, 2048, 0, scr8, lane); continue; } r -= J_CKV;
            if (r < J_QI) { tr_item64(w_in + 1280, D_IN, 64 * (r / 8), 64 * (r % 8), nullptr, WIN_T, D, 2304, 0, scr8, lane); continue; } r -= J_QI;
            if (r < J_KI) { tr_item64(w_in + 1792, D_IN, 64 * r, 0, nullptr, WIN_T, D, 2816, 0, scr8, lane); continue; } r -= J_KI;
            if (r < J_MQK) { tr_item64(w_in + 1864, D_IN, 64 * (r / 16), 64 * (r % 16), nullptr, WIN_T, D, 3072, 0, scr8, lane); continue; } r -= J_MQK;
            if (r < J_MV) { tr_item64(w_in + 2888, D_IN, 64 * (r / 16), 64 * (r % 16), nullptr, WIN_T, D, 4096, 0, scr8, lane); continue; } r -= J_MV;
            if (r < J_MO) { tr_item64(w_in + 3920, D_IN, 64 * (r / 16), 64 * (r % 16), nullptr, WIN_T, D, 5120, 0, scr8, lane); continue; } r -= J_MO;
            if (r < J_WO) { tr_item64(w_out + (size_t)1024 * D, D, 64 * (r / 32), 64 * (r % 32), nullptr, WOUT_T, KMIX, 0, 2048, scr8, lane); continue; } r -= J_WO;
            if (r < J_CQ) { cv_item64(A_->in[I_W_CQ], D, 64 * (r / 32), 64 * (r % 32), A_->in[I_NORM_X_G], 0.04419417382415922f, WCQ_T, D, lane); continue; } r -= J_CQ;
            if (r < J_CKVW) { tr_item64(A_->in[I_W_CKV], 2 * D, 64 * (r / 64), 64 * (r % 64), nullptr, WCKV_T, D, 0, 0, scr8, lane); continue; } r -= J_CKVW;
            if (r < J_CO) { tr_item64(A_->in[I_W_CO], D, 64 * (r / 32), 64 * (r % 32), nullptr, WCO_T, D, 0, 0, scr8, lane); continue; } r -= J_CO;
            if (r < J_G) { const int e = r / 256, q = r % 256, kb = q / 8, nb = q % 8;
                tr_item64(A_->in[I_W_GATE] + (size_t)e * D * DEXP, DEXP, 64 * kb, 64 * nb, A_->in[I_NORM_FFN_G], WGU_T + (size_t)e * 1024 * D, D, (nb / 2) * 128, 0, scr8, lane); continue; } r -= J_G;
            if (r < J_U) { const int e = r / 256, q = r % 256, kb = q / 8, nb = q % 8;
                tr_item64(A_->in[I_W_UP] + (size_t)e * D * DEXP, DEXP, 64 * kb, 64 * nb, A_->in[I_NORM_FFN_G], WGU_T + (size_t)e * 1024 * D, D, (nb / 2) * 128 + 128, 0, scr8, lane); continue; } r -= J_U;
            { const int e = r / 256, q = r % 256, kb = q / 32, nb = q % 32;
                tr_item64(A_->in[I_W_DOWN] + (size_t)e * DEXP * D, D, 64 * kb, 64 * nb, nullptr, WDN_T + (size_t)e * D * DEXP, DEXP, 0, 0, scr8, lane); }
        }
        for (int i = bx * 512 + tid; i < 192 * D; i += G * 512) { const int r = i / D, k = i % D; float v = 0.f;
            if (r < 8) v = w_in[(size_t)k * D_IN + 1856 + r]; else if (r < 16) v = w_in[(size_t)k * D_IN + 3912 + (r - 8)];
            WIN_T[(size_t)(2880 + r) * D + k] = (bf16)f2bf(v); }
        for (int i = bx * 512 + tid; i < 48 * D; i += G * 512) { const int o = i / D, k = i % D; float v = 0.f;
            if (o < 4) v = A_->in[I_W_GROUP][(size_t)k * 4 + o] * A_->in[I_NORM_FFN_G][k]; else if (o < 36) v = A_->in[I_W_ROUTER][(size_t)k * 32 + (o - 4)] * A_->in[I_NORM_FFN_G][k];
            const unsigned hb = f2bf(v); WRH[i] = (bf16)hb; WRL[i] = (bf16)f2bf(v - bf2f(hb)); }
        {
            const int r32 = lane & 31, hh = lane >> 5;
            const float* w_uk = A_->in[I_W_UK]; const float* w_uv = A_->in[I_W_UV];
#define CVT8(dst, pa, pb) do { const f32x4 x_ = (pa), y_ = (pb); u32x4 w_; w_.x = pk2(x_[0], x_[1]); w_.y = pk2(x_[2], x_[3]); w_.z = pk2(y_[0], y_[1]); w_.w = pk2(y_[2], y_[3]); dst = __builtin_bit_cast(bf16x8, w_); } while (0)
            for (int prw_ = 0; prw_ < 1 + PR_WP; ++prw_)
            for (int it = gw; it < 4096; it += NGW) {
                const bool isq = it < 2048; const int r = it & 2047, h = r >> 8, rt = (r >> 2) & 63, cg = r & 3;
                if (isq) {
                    const int ct = (r >> 5) & 7, kg = r & 31;
                    bf16x8 af[8];
                    { const float* ap = w_uk + (size_t)((ct * 32 + r32) * 8 + h) * 128 + 8 * hh;
#pragma unroll
                      for (int ks = 0; ks < 8; ++ks) CVT8(af[ks], *(const f32x4*)(ap + ks * 16), *(const f32x4*)(ap + ks * 16 + 4)); }
#pragma unroll 1
                    for (int kt = 0; kt < 2; ++kt) { const int k0 = kg * 64 + kt * 32; const float* bp = w_in + (size_t)(k0 + r32) * D_IN + h * 128 + 8 * hh;
                        f32x16 acc;
#pragma unroll
                        for (int i = 0; i < 16; ++i) acc[i] = 0.f;
#pragma unroll
                        for (int ks = 0; ks < 8; ++ks) { bf16x8 bfr; CVT8(bfr, *(const f32x4*)(bp + ks * 16), *(const f32x4*)(bp + ks * 16 + 4)); acc = __builtin_amdgcn_mfma_f32_32x32x16_bf16(af[ks], bfr, acc, 0, 0, 0); }
                        bf16* o = WIN_T + (size_t)(h * 256 + ct * 32 + 4 * hh) * D + k0 + r32;
#pragma unroll
                        for (int i = 0; i < 16; ++i) o[(size_t)((i & 3) + 8 * (i >> 2)) * D] = (bf16)f2bf(acc[i] * 0.08838834764831845f); }
                } else {
                    const float* pj[8];
#pragma unroll
                    for (int j = 0; j < 8; ++j) pj[j] = w_out + (size_t)(h * 128 + 8 * hh + j) * D + rt * 32 + r32;
                    const float* bp0 = w_uv + (size_t)((cg * 64 + r32) * 8 + h) * 128 + 8 * hh; const float* bp1 = bp0 + (size_t)32 * 8 * 128;
                    f32x16 acc0, acc1;
#pragma unroll
                    for (int i = 0; i < 16; ++i) { acc0[i] = 0.f; acc1[i] = 0.f; }
#pragma unroll 2
                    for (int ks = 0; ks < 8; ++ks) { u32x4 w_; w_.x = pk2(*pj[0], *pj[1]); w_.y = pk2(*pj[2], *pj[3]); w_.z = pk2(*pj[4], *pj[5]); w_.w = pk2(*pj[6], *pj[7]); const bf16x8 afr = __builtin_bit_cast(bf16x8, w_);
#pragma unroll
                        for (int j = 0; j < 8; ++j) pj[j] += (size_t)16 * D;
                        bf16x8 b0, b1; CVT8(b0, *(const f32x4*)(bp0 + ks * 16), *(const f32x4*)(bp0 + ks * 16 + 4)); CVT8(b1, *(const f32x4*)(bp1 + ks * 16), *(const f32x4*)(bp1 + ks * 16 + 4));
                        acc0 = __builtin_amdgcn_mfma_f32_32x32x16_bf16(afr, b0, acc0, 0, 0, 0); acc1 = __builtin_amdgcn_mfma_f32_32x32x16_bf16(afr, b1, acc1, 0, 0, 0); }
                    bf16* o = WOUT_T + (size_t)(rt * 32 + 4 * hh) * KMIX + h * 256 + cg * 64 + r32;
#pragma unroll
                    for (int i = 0; i < 16; ++i) { o[(size_t)((i & 3) + 8 * (i >> 2)) * KMIX] = (bf16)f2bf(acc0[i]); o[(size_t)((i & 3) + 8 * (i >> 2)) * KMIX + 32] = (bf16)f2bf(acc1[i]); }
                }
            }
#undef CVT8
        }
        for (int prh_ = 0; prh_ < 1 + PR_H1; ++prh_)
        for (int m = gw; m < T; m += NGW) rms_row_to_bf16(A_->in[I_X] + (size_t)m * D, A_->in[I_NORM_MIX_G], H1 + (size_t)m * D, lane);
        for (int m = gw; m < NMEM; m += NGW) rms_row_to_bf16(A_->in[I_MEM] + (size_t)m * D, A_->in[I_MEM_NORM_G], MEMN + (size_t)m * D, lane);
        GRID_BAR(0);
    }

    if (IN(1)) for (int rep_ = 0; rep_ < NREP(1); ++rep_) {
        PHASE_IDS
        if (rep_) xcd_barrier(bar);
        pg8::DenseOrder S; S.init(T, NPROJ, D, D, G, bx);
        pg8::EpiProj E{QABS, CKVRAW, QI, SMALL, MQKRAW, MV, MO};
        pg8::gemm_phase(lds, H1, WIN_T, D, S, E);
        GRID_BAR(1);
    }

    if (IN(2)) for (int rep_ = 0; rep_ < NREP(2); ++rep_) {
        PHASE_IDS
        if (rep_) xcd_barrier(bar);
#ifndef P2_SUB
#define P2_SUB 15
#endif
        if (P2_SUB & 1) {
            for (int prk_ = 0; prk_ < 1 + PR_KV; ++prk_)
            for (int id = bx; id < 256; id += G) {
                const int rt = id & 3, ct = id >> 2;
                mini_gemm64(lds, MEMN + (size_t)(rt * 64) * D, D, WCKV_T + (size_t)(ct * 64) * D, D, 16, KC + (size_t)(rt * 64) * 4096 + ct * 64, 4096u, wave, lane);
            }
        }
        __syncthreads();
        if (P2_SUB & 4) for (int t = gw; t < T; t += NGW) {
            const f32x4 v = ((const f32x4*)(CKVRAW + (size_t)t * 256))[lane];
            const float r = rsqrtf(wave_sum((v[0] * v[0] + v[1] * v[1]) + (v[2] * v[2] + v[3] * v[3])) * (1.f / 256.f) + EPS);
            const f32x4 g = ((const f32x4*)A_->in[I_KV_NORM_G])[lane];
            u32x2 w; w.x = pk2(v[0] * r * g[0], v[1] * r * g[1]); w.y = pk2(v[2] * r * g[2], v[3] * r * g[3]);
            ((u32x2*)(CKVN + (size_t)t * 256))[lane] = w;
            const float kv = SMALL[(size_t)t * 256 + lane];
            const float rk = rsqrtf(wave_sum(kv * kv) * (1.f / 64.f) + EPS);
            KIDXN[(size_t)t * 64 + lane] = (bf16)f2bf(kv * rk * A_->in[I_KIDX_NORM_G][lane]);
        }
        if (P2_SUB & 8) {
            LAS float* kq = (LAS float*)lds;
            LAS bf16* KWT = (LAS bf16*)(lds + 32768);
            LAS bf16* VTl = (LAS bf16*)(lds + 51200);
            LAS float* sw = (LAS float*)(lds + 98304);
            const float* conv_w = A_->in[I_CONV_W]; const float* conv_b = A_->in[I_CONV_B]; const float* gate_b = A_->in[I_GATE_B];
            const int r32 = lane & 31, hh = lane >> 5;
            for (int prm_ = 0; prm_ < 1 + PR_ML; ++prm_)
            for (int uu = bx; uu < NCH * 4; uu += G) {
                const int c = uu >> 2, h = uu & 3, t0 = c * CH;
                __syncthreads();
                if (wave == 0) {
                    const int t = t0 + lane; const float li = SMALL[(size_t)t * 256 + 72 + h] + gate_b[h]; const float mf = SMALL[(size_t)t * 256 + 76 + h] + gate_b[4 + h];
                    float bsc = fminf(mf, 0.f) - log1pf(__expf(-fabsf(mf)));
#pragma unroll
                    for (int o = 1; o < 64; o <<= 1) { const float v = __shfl_up(bsc, o); if (lane >= o) bsc += v; }
                    const float g = __shfl(bsc, 63); const float dec = g - bsc + li; const float mx = wave_max(dec);
                    sw[lane] = __expf(dec - mx); sw[128 + lane] = li; sw[192 + lane] = bsc;
                    GATES[GT_B + (size_t)t * 4 + h] = bsc; GATES[GT_LI + (size_t)t * 4 + h] = li;
                    if (lane == 0) { GATES[GT_G + c * 4 + h] = g; GATES[GT_MLOC + c * 4 + h] = mx; } }
                __syncthreads();
                { const int ch = tid & 255, th = tid >> 8; const int src = ch < 128 ? h * 128 + ch : 512 + h * 128 + (ch - 128);
                  const float cw0 = conv_w[src], cw1 = conv_w[1024 + src], cw2 = conv_w[2048 + src], cw3 = conv_w[3072 + src], cbias = conv_b[src];
                  const int tb = t0 + th * 32 - 3; float xr[35];
#pragma unroll
                  for (int i = 0; i < 35; ++i) xr[i] = (tb + i >= 0) ? MQKRAW[(size_t)(tb + i) * 1024 + src] : 0.f;
#pragma unroll
                  for (int i = 0; i < 32; ++i) { const int s_ = th * 32 + i, t = t0 + s_; float y = cbias + ((cw0 * xr[i] + cw1 * xr[i + 1]) + (cw2 * xr[i + 2] + cw3 * xr[i + 3]));
                      y = y / (1.f + __expf(-y));
                      if (ch < 128) QCM[(size_t)t * 512 + h * 128 + ch] = (bf16)f2bf(y * 0.08838834764831845f);
                      else { const unsigned kb = f2bf(y); KCM[(size_t)t * 512 + h * 128 + (ch - 128)] = (bf16)kb; const float kf = bf2f(kb); kq[s_ * 128 + (ch - 128)] = kf; KWT[(ch - 128) * 72 + s_] = (bf16)f2bf(sw[s_] * kf); } } }
#pragma unroll 1
                for (int e = tid; e < 64 * 32; e += 512) { const int s = e & 63, c8 = e >> 6; const u32x4 vv = *(const u32x4*)(MV + (size_t)(t0 + s) * 1024 + h * 256 + c8 * 8);
                    LAS bf16* d = VTl + (c8 * 8) * 72 + s;
                    d[0] = (bf16)(vv.x & 0xffffu); d[72] = (bf16)(vv.x >> 16); d[144] = (bf16)(vv.y & 0xffffu); d[216] = (bf16)(vv.y >> 16);
                    d[288] = (bf16)(vv.z & 0xffffu); d[360] = (bf16)(vv.z >> 16); d[432] = (bf16)(vv.w & 0xffffu); d[504] = (bf16)(vv.w >> 16); }
                __syncthreads();
#pragma unroll 1
                for (int e = tid; e < 256 * 8; e += 512) { const int dv = e >> 3, ch = e & 7; *(u32x4*)(VTM + ((size_t)(c * 4 + h) * 256 + dv) * 64 + ch * 8) = *(const LAS u32x4*)(VTl + dv * 72 + ch * 8); }
                {
                    bf16x8 af[4];
#pragma unroll
                    for (int ks = 0; ks < 4; ++ks) af[ks] = *(const LAS bf16x8*)(VTl + (wave * 32 + r32) * 72 + ks * 16 + 8 * hh);
#pragma unroll 1
                    for (int j = 0; j < 4; ++j) { f32x16 acc;
#pragma unroll
                        for (int i = 0; i < 16; ++i) acc[i] = 0.f;
#pragma unroll
                        for (int ks = 0; ks < 4; ++ks) { const bf16x8 bfr = *(const LAS bf16x8*)(KWT + (j * 32 + r32) * 72 + ks * 16 + 8 * hh); acc = __builtin_amdgcn_mfma_f32_32x32x16_bf16(af[ks], bfr, acc, 0, 0, 0); }
                        float* o = LST + ((size_t)(c * 4 + h) * 256 + wave * 32 + 4 * hh) * 128 + j * 32 + r32;
#pragma unroll
                        for (int i = 0; i < 16; ++i) o[(size_t)((i & 3) + 8 * (i >> 2)) * 128] = acc[i]; }
                }
                if (tid < 128) { float a = 0.f;
#pragma unroll 4
                    for (int s = 0; s < 64; ++s) a += sw[s] * kq[s * 128 + tid]; NL[(size_t)(c * 4 + h) * 128 + tid] = a; }
            }
        }
        GRID_BAR(2);
    }

    if (IN(3)) for (int rep_ = 0; rep_ < NREP(3); ++rep_) {
        PHASE_IDS
        if (rep_) xcd_barrier(bar);
#ifndef R_SCAN
#define R_SCAN 1
#endif
        for (int prv_ = 0; prv_ < 1 + PR_VF; ++prv_)
        for (int id = bx; id < 512; id += G) {
            const int h = id >> 7, rt = (id & 127) >> 2, ct = id & 3;
            mini_gemm64(lds, WCO_T + (size_t)(rt * 64) * D + h * 512, D, KC + (size_t)(ct * 64) * 4096 + 2048 + h * 512, 4096u, 4, VF + (size_t)(rt * 64) * 1024 + h * 256 + ct * 64, 1024u, wave, lane);
        }
        for (int prv_ = 0; prv_ < 1 + PR_VF; ++prv_)
        for (int id = bx; id < 512; id += G) {
            const int h = id >> 7, kt = (id & 127) >> 2, mt = id & 3;
            mini_gemm64(lds, KC + (size_t)(mt * 64) * 4096 + h * 512, 4096u, WCQ_T + (size_t)(kt * 64) * D + h * 512, D, 4, MF + (size_t)(h * 256 + mt * 64) * D + kt * 64, D, wave, lane);
        }
        for (int rscan_ = 0; rscan_ < R_SCAN; ++rscan_) {
            LAS float* am = (LAS float*)lds;
            LAS float* sm = am + 512;
            LAS float* gl = am + 1024;
            __syncthreads();
            gl[tid] = GATES[GT_G + tid]; gl[512 + tid] = GATES[GT_MLOC + tid];
            __syncthreads();
            if (tid < 4) { float m = 0.f;
#pragma unroll 1
                for (int k = 0; k < NCH; ++k) { const float g = gl[k * 4 + tid], ml = gl[512 + k * 4 + tid]; const float mn = fmaxf(g + m, ml);
                    am[tid * 128 + k] = __expf(g + m - mn); sm[tid * 128 + k] = __expf(ml - mn); if (bx == 0) GATES[GT_MPREV + k * 4 + tid] = m; m = mn; } }
            __syncthreads();
            for (int e = bx * 512 + tid; e < 4 * 32768; e += G * 512) { const int h = e >> 15, rem = e & 32767; float C = 0.f;
#pragma unroll 1
                for (int kb = 0; kb < NCH; kb += 32) { float l[32];
#pragma unroll
                    for (int i = 0; i < 32; ++i) l[i] = __builtin_nontemporal_load(LST + (size_t)((kb + i) * 4 + h) * 32768 + rem);
#pragma unroll
                    for (int i = 0; i < 32; ++i) { const int k = kb + i; CST[(size_t)(k * 4 + h) * 32768 + rem] = (bf16)f2bf(C); C = am[h * 128 + k] * C + sm[h * 128 + k] * l[i]; } } }
            if (bx == 0) { const int h = tid >> 7, dk = tid & 127; float n = 0.f;
#pragma unroll 1
                for (int kb = 0; kb < NCH; kb += 16) { float l[16];
#pragma unroll
                    for (int i = 0; i < 16; ++i) l[i] = NL[(size_t)((kb + i) * 4 + h) * 128 + dk];
#pragma unroll
                    for (int i = 0; i < 16; ++i) { const int k = kb + i; NST[(size_t)(k * 4 + h) * 128 + dk] = n; n = am[h * 128 + k] * n + sm[h * 128 + k] * l[i]; } } }
            __syncthreads();
        }
        {
            const int r32 = lane & 31, hh = lane >> 5;
            for (int L = bx; L < 1152; L += G) {
                int sl = 0, rem = L;
#pragma unroll 1
                while (rem >= 256 - 32 * sl) { rem -= 256 - 32 * sl; ++sl; }
                const int g = 32 * sl + rem, c = g >> 1, tq0 = g * 32 + wave * 4, N = 64 * (c + 1);
                const int jb = sl * 32, je = (N >> 5) < jb + 32 ? (N >> 5) : jb + 32;
                if (N <= 256) continue;
                unsigned short* rowb = (c < 127 ? (unsigned short*)A_->out + (size_t)2048 * c * (c + 1) : (unsigned short*)(ws + WS_SC127)) + (size_t)(tq0 & 63) * N + jb * 32;
                LAS unsigned short* stg = (LAS unsigned short*)(lds + wave * 8192);
                bf16x8 af[4]; float wq[16];
                { const bf16* qp = QI + (size_t)(tq0 + (r32 >> 3)) * 512 + (r32 & 7) * 64 + 8 * hh;
#pragma unroll
                  for (int ks = 0; ks < 4; ++ks) af[ks] = *(const bf16x8*)(qp + ks * 16);
#pragma unroll
                  for (int qq = 0; qq < 4; ++qq)
#pragma unroll
                      for (int i = 0; i < 4; ++i) wq[qq * 4 + i] = SMALL[(size_t)(tq0 + qq) * 256 + 64 + 4 * hh + i] * 0.04419417382415922f; }
#define IDX_GROUP(gi_) do { const int tile_ = jb + (gi_) * 8 + wave; if (tile_ < je) { _Pragma("unroll") for (int i4 = 0; i4 < 4; ++i4) { const int row_ = i4 * 8 + (lane >> 3); \
                        const bf16* gsrc_ = KIDXN + (size_t)(tile_ * 32 + row_) * 64 + (((lane & 7) ^ (row_ & 7)) * 8); \
                        const unsigned ldst_ = __builtin_amdgcn_readfirstlane((unsigned)(size_t)lds + 65536u + (unsigned)(((gi_) & 1) * 32768 + wave * 4096 + i4 * 1024)); unsigned keep_; \
                        asm volatile("s_mov_b32 %0, m0\n\ts_mov_b32 m0, %2\n\ts_nop 0\n\tglobal_load_lds_dwordx4 %1, off\n\ts_mov_b32 m0, %0" : "=&s"(keep_) : "v"(gsrc_), "s"(ldst_) : "memory"); } } } while (0)
#define IDX_LOAD(buf, gi_, tl_) do { const LAS unsigned char* kt_ = lds + 65536 + ((gi_) & 1) * 32768 + (tl_) * 4096 + r32 * 128; \
                    _Pragma("unroll") for (int ks = 0; ks < 4; ++ks) buf[ks] = *(const LAS bf16x8*)(kt_ + (((ks * 2 + hh) ^ (r32 & 7)) * 16)); } while (0)
#define RELU_(x_) __int_as_float(max(__float_as_int(x_), 0))
#define IDX_TILE(buf, jj) do { const int s0 = (jj) * 32; f32x16 acc; _Pragma("unroll") for (int i = 0; i < 16; ++i) acc[i] = 0.f; \
                        _Pragma("unroll") for (int ks = 0; ks < 4; ++ks) acc = __builtin_amdgcn_mfma_f32_32x32x16_bf16(af[ks], buf[ks], acc, 0, 0, 0); \
                        if (PR_MFMA) { f32x16 acc2; _Pragma("unroll") for (int i = 0; i < 16; ++i) acc2[i] = 0.f; _Pragma("unroll") for (int ks = 0; ks < 4; ++ks) acc2 = __builtin_amdgcn_mfma_f32_32x32x16_bf16(af[ks], buf[ks], acc2, 0, 0, 0); asm volatile("" :: "v"(acc2)); } \
                        if (PR_EPI) { f32x16 a3 = acc; asm volatile("" : "+v"(a3)); float p3[4]; _Pragma("unroll") for (int qq = 0; qq < 4; ++qq) p3[qq] = (wq[qq * 4] * fmaxf(a3[qq * 4], 0.f) + wq[qq * 4 + 1] * fmaxf(a3[qq * 4 + 1], 0.f)) + (wq[qq * 4 + 2] * fmaxf(a3[qq * 4 + 2], 0.f) + wq[qq * 4 + 3] * fmaxf(a3[qq * 4 + 3], 0.f)); \
                            _Pragma("unroll") for (int qq = 0; qq < 4; ++qq) p3[qq] += __shfl_xor(p3[qq], 32); asm volatile("" :: "v"(p3[0]), "v"(p3[1]), "v"(p3[2]), "v"(p3[3])); } \
                        float part[4]; \
                          \
                        _Pragma("unroll") for (int qq = 0; qq < 4; ++qq) part[qq] = (wq[qq * 4] * RELU_(acc[qq * 4]) + wq[qq * 4 + 1] * RELU_(acc[qq * 4 + 1])) + (wq[qq * 4 + 2] * RELU_(acc[qq * 4 + 2]) + wq[qq * 4 + 3] * RELU_(acc[qq * 4 + 3])); \
                        const auto s02_ = __builtin_amdgcn_permlane32_swap(__float_as_uint(part[0]), __float_as_uint(part[2]), false, false), s13_ = __builtin_amdgcn_permlane32_swap(__float_as_uint(part[1]), __float_as_uint(part[3]), false, false); \
                          \
                        const float v0 = __uint_as_float(s02_[0]) + __uint_as_float(s02_[1]), v1 = __uint_as_float(s13_[0]) + __uint_as_float(s13_[1]); \
                        unsigned u0 = __builtin_bit_cast(unsigned short, (_Float16)v0), u1 = __builtin_bit_cast(unsigned short, (_Float16)v1); \
                        u0 = (u0 == 0x8000u) ? 0u : u0; u1 = (u1 == 0x8000u) ? 0u : u1; \
                        stg[(2 * hh) * 1024 + s0 - jb * 32 + r32] = (unsigned short)((u0 & 0x8000u) ? ~u0 : (u0 | 0x8000u)); \
                        stg[(2 * hh + 1) * 1024 + s0 - jb * 32 + r32] = (unsigned short)((u1 & 0x8000u) ? ~u1 : (u1 | 0x8000u)); } while (0)
                { const int ngrp = (je - jb + 7) >> 3;
                  __syncthreads();
                  IDX_GROUP(0);
#pragma unroll 1
                  for (int gi = 0; gi < ngrp; ++gi) {
                      asm volatile("s_waitcnt vmcnt(0)" ::: "memory");
                      __syncthreads();
                      if (gi + 1 < ngrp) IDX_GROUP(gi + 1);
#pragma unroll 2
                      for (int tl = 0; tl < 8; ++tl) { const int jt = jb + gi * 8 + tl; if (jt < je) { bf16x8 kbf[4]; IDX_LOAD(kbf, gi, tl); IDX_TILE(kbf, jt); } }
                  } }
#undef IDX_GROUP
#undef IDX_LOAD
#undef IDX_TILE
                LDS_WAIT(); asm volatile("" ::: "memory");
                { const int nk = (je - jb) * 32, np = nk >> 3;
                  for (int i = lane; i < 4 * np; i += 64) { const int qq = i / np, p = i - qq * np; *(u32x4*)(rowb + (size_t)qq * N + p * 8) = *(const LAS u32x4*)(stg + qq * 1024 + p * 8); } }
                LDS_WAIT(); asm volatile("" ::: "memory");
            }
        }
        GRID_BAR(3);
    }
    if (IN(4)) for (int rep_ = 0; rep_ < NREP(4); ++rep_) {
        PHASE_IDS
        if (rep_) xcd_barrier(bar);
        {
            LAS unsigned short* stage = (LAS unsigned short*)lds;
            LAS int* hist = (LAS int*)(lds + MISC_OFF + 4096) + wave * 256;
            LAS int* sel = (LAS int*)(lds + MISC_OFF + 12288) + wave * 256;
            const int r16 = lane & 15, g4 = lane >> 4;
            for (int ui_ = 0; ui_ * G < T / 8; ++ui_) {
                const int uu = ui_ * G + ((ui_ & 1) ? (G - 1 - bx) : bx); if (uu >= T / 8) continue;
                const int t0 = uu * 8, t = t0 + wave, c = t0 >> 6, N = (c + 1) * 64, ng = N >> 6;
                int nsel = N;
                __syncthreads();
                if (N > 256) {
                    { const unsigned short* rb = (c < 127 ? (const unsigned short*)A_->out + (size_t)2048 * c * (c + 1) : (const unsigned short*)(ws + WS_SC127)) + (size_t)(t0 & 63) * N;
                      const int np = N >> 3;
                      for (int i = tid; i < 8 * np; i += 512) { const int qq = i / np, p = i - qq * np; *(LAS u32x4*)(stage + qq * 8192 + p * 8) = *(const u32x4*)(rb + (size_t)qq * N + p * 8); } }
                    __syncthreads();
                    unsigned kr[128];
#pragma unroll
                    for (int b8 = 0; b8 < 16; ++b8) {
#pragma unroll
                        for (int i = 0; i < 8; ++i) kr[b8 * 8 + i] = 0u;
                        if (b8 * 8 < ng) {
#pragma unroll
                            for (int i = 0; i < 8; ++i) kr[b8 * 8 + i] = (b8 * 8 + i < ng) ? (unsigned)stage[wave * 8192 + (b8 * 8 + i) * 64 + lane] : 0u; } }
                    __syncthreads();
                    int krem = 256; unsigned prefix = 0u;
#pragma unroll 1
                    for (int ps = 0; ps < 2; ++ps) { const int shift = 8 - 8 * ps;
                        hist[lane] = 0; hist[64 + lane] = 0; hist[128 + lane] = 0; hist[192 + lane] = 0;
#pragma unroll
                        for (int b8 = 0; b8 < 16; ++b8) { if (b8 * 8 < ng) {
#pragma unroll
                            for (int i = 0; i < 8; ++i) { const unsigned k = kr[b8 * 8 + i]; const bool mt = (k != 0u) && (ps == 0 || (k >> 8) == prefix);
                                if (mt) __hip_atomic_fetch_add(hist + (int)((k >> shift) & 255u), 1, __ATOMIC_RELAXED, __HIP_MEMORY_SCOPE_WORKGROUP); } } }
                        const int h0 = hist[4 * lane], h1 = hist[4 * lane + 1], h2 = hist[4 * lane + 2], h3 = hist[4 * lane + 3];
                        int sfx = h0 + h1 + h2 + h3;
#pragma unroll
                        for (int o = 1; o < 64; o <<= 1) { const int v = __shfl_down(sfx, o); if (lane + o < 64) sfx += v; }
                        const unsigned long long mge = __ballot(sfx >= krem);
                        const int ls = 63 - __builtin_clzll(mge);
                        const int above_l = (ls < 63) ? __builtin_amdgcn_readlane(sfx, (ls + 1) & 63) : 0;
                        const int b1 = __builtin_amdgcn_readlane(h1, ls), b2 = __builtin_amdgcn_readlane(h2, ls), b3 = __builtin_amdgcn_readlane(h3, ls);
                        int dg, above;
                        if (above_l + b3 >= krem) { dg = 3; above = above_l; } else if (above_l + b3 + b2 >= krem) { dg = 2; above = above_l + b3; }
                        else if (above_l + b3 + b2 + b1 >= krem) { dg = 1; above = above_l + b3 + b2; } else { dg = 0; above = above_l + b3 + b2 + b1; }
                        krem -= above; prefix = (prefix << 8) | (unsigned)(4 * ls + dg); }
                    const unsigned thr = prefix;
                    int ngt = 0;
#pragma unroll
                    for (int b8 = 0; b8 < 16; ++b8) { if (b8 * 8 < ng) {
#pragma unroll
                        for (int i = 0; i < 8; ++i) ngt += __popcll(__ballot(kr[b8 * 8 + i] > thr)); __builtin_amdgcn_sched_barrier(0); } }
                    const int need = 256 - ngt; int pg = 0, pe = 0; const unsigned long long ltm = (1ull << lane) - 1ull;
#pragma unroll
                    for (int b8 = 0; b8 < 16; ++b8) { if (b8 * 8 < ng) {
#pragma unroll
                        for (int i = 0; i < 8; ++i) { const int ri = b8 * 8 + i; const unsigned k = kr[ri]; const bool gt = k > thr, eq = k == thr;
                            const unsigned long long mg = __ballot(gt), me = __ballot(eq); const int sidx = ri * 64 + lane;
                            if (gt) sel[pg + __popcll(mg & ltm)] = sidx;
                            const int r = pe + __popcll(me & ltm); if (eq && r < need) sel[ngt + r] = sidx;
                            pg += __popcll(mg); pe += __popcll(me); if ((i & 3) == 3) __builtin_amdgcn_sched_barrier(0); } } }
                    nsel = 256;
                } else {
#pragma unroll
                    for (int i = 0; i < 4; ++i) sel[i * 64 + lane] = i * 64 + lane;
                }
                LDS_WAIT(); asm volatile("" ::: "memory");
                {
                    LAS unsigned char* cb = lds + wave * 16384;
                    bf16x8 qf[8];
                    { const bf16* qp = QABS + (size_t)t * 2048 + (r16 & 7) * 256 + 8 * g4;
#pragma unroll
                      for (int ks = 0; ks < 8; ++ks) qf[ks] = *(const bf16x8*)(qp + ks * 32); }
                    f32x4 O[16];
#pragma unroll
                    for (int i = 0; i < 16; ++i) O[i] = (f32x4){0.f, 0.f, 0.f, 0.f};
                    float mrun = -3.0e38f, lrun = 0.f;
                    const int tq = r16 >> 2, tp = r16 & 3;
                    const int nch = nsel >> 5;
#pragma unroll 1
                    for (int ch = 0; ch < nch; ++ch) { const int slot0 = ch * 32;
#pragma unroll
                        for (int k = 0; k < 16; ++k) { const int im = k >> 3, row = (k & 7) * 4 + g4; const int lc = r16 ^ (((row & 3) << 2) | ((row >> 2) & 3)); const int key = sel[slot0 + row];
                            __builtin_amdgcn_global_load_lds((const unsigned*)(CKVN + (size_t)key * 256 + im * 128 + lc * 8), (LAS unsigned*)(cb + im * 8192 + (k & 7) * 1024), 16, 0, 0); }
                        asm volatile("s_waitcnt vmcnt(0)" ::: "memory");
                        f32x4 s0 = (f32x4){0.f, 0.f, 0.f, 0.f}, s1 = s0;
#pragma unroll
                        for (int ks = 0; ks < 8; ++ks) { const int im = ks >> 2, lc = 4 * (ks & 3) + g4;
                            const int ra = r16, rb = 16 + r16;
                            const bf16x8 k0 = *(const LAS bf16x8*)(cb + im * 8192 + 256 * ra + 16 * (lc ^ (((ra & 3) << 2) | ((ra >> 2) & 3))));
                            const bf16x8 k1 = *(const LAS bf16x8*)(cb + im * 8192 + 256 * rb + 16 * (lc ^ (((rb & 3) << 2) | ((rb >> 2) & 3))));
                            s0 = __builtin_amdgcn_mfma_f32_16x16x32_bf16(k0, qf[ks], s0, 0, 0, 0); s1 = __builtin_amdgcn_mfma_f32_16x16x32_bf16(k1, qf[ks], s1, 0, 0, 0);
                            if ((ks & 1) == 1) __builtin_amdgcn_sched_barrier(0); }
                        float mx = fmaxf(fmaxf(fmaxf(s0[0], s0[1]), fmaxf(s0[2], s0[3])), fmaxf(fmaxf(s1[0], s1[1]), fmaxf(s1[2], s1[3])));
                        mx = fmaxf(mx, __shfl_xor(mx, 16)); mx = fmaxf(mx, __shfl_xor(mx, 32));
                        const float mnew = fmaxf(mrun, mx), alpha = __expf(mrun - mnew); mrun = mnew;
                        float p[8]; float ls = 0.f;
#pragma unroll
                        for (int i = 0; i < 4; ++i) { p[i] = __expf(s0[i] - mnew); p[4 + i] = __expf(s1[i] - mnew); ls += p[i] + p[4 + i]; }
                        ls += __shfl_xor(ls, 16); ls += __shfl_xor(ls, 32);
                        lrun = lrun * alpha + ls;
                        u32x4 pw; pw.x = pk2(p[0], p[1]); pw.y = pk2(p[2], p[3]); pw.z = pk2(p[4], p[5]); pw.w = pk2(p[6], p[7]);
                        const bf16x8 pf = __builtin_bit_cast(bf16x8, pw);
#pragma unroll
                        for (int i = 0; i < 16; ++i) O[i] = O[i] * alpha;
                        const unsigned cbase = (unsigned)(size_t)cb + 256u * (4 * g4 + tq) + 8u * (tp & 1);
#pragma unroll
                        for (int cq = 0; cq < 4; ++cq) {
                            u32x2 va[4], vb[4]; unsigned ad[4];
#pragma unroll
                            for (int j = 0; j < 4; ++j) { const int ct = cq * 4 + j; ad[j] = cbase + (unsigned)((ct >> 3) * 8192) + 16u * ((2 * (ct & 7) + (tp >> 1)) ^ ((tq << 2) | g4)); }
                            asm volatile("ds_read_b64_tr_b16 %0, %8\n\tds_read_b64_tr_b16 %1, %8 offset:4096\n\tds_read_b64_tr_b16 %2, %9\n\tds_read_b64_tr_b16 %3, %9 offset:4096\n\t"
                                         "ds_read_b64_tr_b16 %4, %10\n\tds_read_b64_tr_b16 %5, %10 offset:4096\n\tds_read_b64_tr_b16 %6, %11\n\tds_read_b64_tr_b16 %7, %11 offset:4096\n\ts_waitcnt lgkmcnt(0)"
                                         : "=&v"(va[0]), "=&v"(vb[0]), "=&v"(va[1]), "=&v"(vb[1]), "=&v"(va[2]), "=&v"(vb[2]), "=&v"(va[3]), "=&v"(vb[3])
                                         : "v"(ad[0]), "v"(ad[1]), "v"(ad[2]), "v"(ad[3]) : "memory");
#pragma unroll
                            for (int j = 0; j < 4; ++j) { u32x4 vv; vv.x = va[j].x; vv.y = va[j].y; vv.z = vb[j].x; vv.w = vb[j].y;
                                O[cq * 4 + j] = __builtin_amdgcn_mfma_f32_16x16x32_bf16(__builtin_bit_cast(bf16x8, vv), pf, O[cq * 4 + j], 0, 0, 0); } }
                    }
                    const float inv = 1.f / lrun;
                    if (r16 < 8) {
#pragma unroll
                        for (int i = 0; i < 16; ++i) { u32x2 w; w.x = pk2(O[i][0] * inv, O[i][1] * inv); w.y = pk2(O[i][2] * inv, O[i][3] * inv); *(u32x2*)(MIXIN + (size_t)t * KMIX + r16 * 256 + i * 16 + 4 * g4) = w; } }
                }
            }
        }
        __syncthreads();
    }

    if (IN(4)) for (int rep_ = 0; rep_ < NREP(4); ++rep_) {
        PHASE_IDS
        if (rep_) xcd_barrier(bar);
        LAS float* Sf = (LAS float*)lds;
        LAS bf16* Sb = (LAS bf16*)(lds + 16640);
        LAS float* ms = (LAS float*)(lds + 25856);
        LAS float* ssq = (LAS float*)(lds + 27904);
        const float* mlg = A_->in[I_ML_NORM_G];
        const int r32 = lane & 31, hh = lane >> 5;
        for (int uu = bx; uu < NCH * 4; uu += G) {
            const int c = uu >> 2, h = uu & 3, t0 = c * CH;
            __syncthreads();
            if (tid < 64) { const float b = GATES[GT_B + (size_t)(t0 + tid) * 4 + h], li = GATES[GT_LI + (size_t)(t0 + tid) * 4 + h]; ms[tid] = b; ms[64 + tid] = li - b; }
            if (tid < 128) ms[384 + tid] = NST[(size_t)(c * 4 + h) * 128 + tid];
            __syncthreads();
            float mt = 0.f;
            if (wave == 0) { const float mprev = GATES[GT_MPREV + c * 4 + h]; float pm = ms[64 + lane];
#pragma unroll
                for (int o = 1; o < 64; o <<= 1) { const float v = __shfl_up(pm, o); if (lane >= o) pm = fmaxf(pm, v); }
                const float mm = fmaxf(mprev, pm); mt = ms[lane] + mm; ms[128 + lane] = -mm; ms[192 + lane] = __expf(mprev - mm);
                float qn = 0.f; const bf16* qr = QCM + (size_t)(t0 + lane) * 512 + h * 128; u32x4 qq[16];
#pragma unroll
                for (int k8 = 0; k8 < 16; ++k8) qq[k8] = *(const u32x4*)(qr + k8 * 8);
#pragma unroll
                for (int k8 = 0; k8 < 16; ++k8) { const LAS float* np = ms + 384 + k8 * 8;
                    qn += (bf2f(qq[k8].x & 0xffffu) * np[0] + bf2f(qq[k8].x >> 16) * np[1]) + (bf2f(qq[k8].y & 0xffffu) * np[2] + bf2f(qq[k8].y >> 16) * np[3]) + (bf2f(qq[k8].z & 0xffffu) * np[4] + bf2f(qq[k8].z >> 16) * np[5]) + (bf2f(qq[k8].w & 0xffffu) * np[6] + bf2f(qq[k8].w >> 16) * np[7]); }
                ms[320 + lane] = qn; }
            __syncthreads();
            if (wave < 4) {
                const int tm = wave >> 1, tn = wave & 1;
                f32x16 acc;
#pragma unroll
                for (int i = 0; i < 16; ++i) acc[i] = 0.f;
                if (tn <= tm) { const bf16* qr = QCM + (size_t)(t0 + tm * 32 + r32) * 512 + h * 128 + 8 * hh; const bf16* kr = KCM + (size_t)(t0 + tn * 32 + r32) * 512 + h * 128 + 8 * hh;
#pragma unroll
                    for (int ks = 0; ks < 8; ++ks) acc = __builtin_amdgcn_mfma_f32_32x32x16_bf16(*(const bf16x8*)(qr + ks * 16), *(const bf16x8*)(kr + ks * 16), acc, 0, 0, 0); }
                const int sidx = tn * 32 + r32; const float us = ms[64 + sidx];
#pragma unroll
                for (int i = 0; i < 16; ++i) { const int t = tm * 32 + (i & 3) + 8 * (i >> 2) + 4 * hh; const float v = (sidx <= t) ? acc[i] * __expf(ms[128 + t] + us) : 0.f; Sf[t * 65 + sidx] = v; Sb[t * 72 + sidx] = (bf16)f2bf(v); }
            }
            __syncthreads();
            if (tid < 64) { float rs = 0.f;
#pragma unroll 4
                for (int s2 = 0; s2 < 64; ++s2) rs += Sf[tid * 65 + s2];
                const float dn = ms[192 + tid] * ms[320 + tid] + rs; ms[256 + tid] = fmaxf(fabsf(dn), __expf(-mt)); }
            f32x16 a1[2], a2[2];
#pragma unroll
            for (int tt = 0; tt < 2; ++tt)
#pragma unroll
                for (int i = 0; i < 16; ++i) { a1[tt][i] = 0.f; a2[tt][i] = 0.f; }
            { const bf16* cr = CST + ((size_t)(c * 4 + h) * 256 + wave * 32 + r32) * 128 + 8 * hh; const bf16* q0 = QCM + (size_t)(t0 + r32) * 512 + h * 128 + 8 * hh; const bf16* q1 = q0 + (size_t)32 * 512;
#pragma unroll
              for (int ks = 0; ks < 8; ++ks) { const bf16x8 cf = *(const bf16x8*)(cr + ks * 16); a1[0] = __builtin_amdgcn_mfma_f32_32x32x16_bf16(cf, *(const bf16x8*)(q0 + ks * 16), a1[0], 0, 0, 0); a1[1] = __builtin_amdgcn_mfma_f32_32x32x16_bf16(cf, *(const bf16x8*)(q1 + ks * 16), a1[1], 0, 0, 0); }
              const bf16* vr = VTM + ((size_t)(c * 4 + h) * 256 + wave * 32 + r32) * 64 + 8 * hh;
#pragma unroll
              for (int ks = 0; ks < 4; ++ks) { const bf16x8 vf = *(const bf16x8*)(vr + ks * 16); a2[0] = __builtin_amdgcn_mfma_f32_32x32x16_bf16(vf, *(const LAS bf16x8*)(Sb + r32 * 72 + ks * 16 + 8 * hh), a2[0], 0, 0, 0); a2[1] = __builtin_amdgcn_mfma_f32_32x32x16_bf16(vf, *(const LAS bf16x8*)(Sb + (32 + r32) * 72 + ks * 16 + 8 * hh), a2[1], 0, 0, 0); } }
            __syncthreads();
#pragma unroll
            for (int tt = 0; tt < 2; ++tt) { const int t = tt * 32 + r32; const float ai = ms[192 + t], idn = 1.f / ms[256 + t]; float p = 0.f;
#pragma unroll
                for (int i = 0; i < 16; ++i) { const float v = (ai * a1[tt][i] + a2[tt][i]) * idn; a1[tt][i] = v; p += v * v; }
                p += __shfl_xor(p, 32); if (hh == 0) ssq[wave * 64 + t] = p; }
            __syncthreads();
#pragma unroll
            for (int tt = 0; tt < 2; ++tt) { const int t = tt * 32 + r32; float sq = 0.f;
#pragma unroll
                for (int w2 = 0; w2 < 8; ++w2) sq += ssq[w2 * 64 + t];
                const float r = rsqrtf(sq * (1.f / 256.f) + EPS);
#pragma unroll
                for (int rq = 0; rq < 4; ++rq) { const int dv0 = h * 256 + wave * 32 + 8 * rq + 4 * hh; const f32x4 g = *(const f32x4*)(mlg + dv0); const u32x2 ob = *(const u32x2*)(MO + (size_t)(t0 + t) * 1024 + dv0);
                    const float o0 = bf2f(ob.x & 0xffffu), o1 = bf2f(ob.x >> 16), o2 = bf2f(ob.y & 0xffffu), o3 = bf2f(ob.y >> 16);
                    u32x2 w; w.x = pk2(a1[tt][4 * rq] * r * g[0] / (1.f + __expf(-o0)), a1[tt][4 * rq + 1] * r * g[1] / (1.f + __expf(-o1))); w.y = pk2(a1[tt][4 * rq + 2] * r * g[2] / (1.f + __expf(-o2)), a1[tt][4 * rq + 3] * r * g[3] / (1.f + __expf(-o3)));
                    *(u32x2*)(MIXIN + (size_t)(t0 + t) * KMIX + 2048 + dv0) = w; } }
        }
        GRID_BAR(4);
    }

    if (IN(6)) for (int rep_ = 0; rep_ < NREP(6); ++rep_) {
        PHASE_IDS
        if (rep_) xcd_barrier(bar);
        pg8::DenseOrder S; S.init(T, D, KMIX, KMIX, G, bx);
        pg8::EpiResidT<false> E{A_->in[I_X], X1B, SS2};
        pg8::gemm_phase(lds, MIXIN, WOUT_T, KMIX, S, E);
        GRID_BAR(6);
    }
    if (IN(7)) for (int rep_ = 0; rep_ < NREP(7); ++rep_) {
        PHASE_IDS
        if (rep_) xcd_barrier(bar);
        pg8::DenseOrder S; S.init(T, 1024, D, D, G, bx);
        pg8::EpiSoftmax E{PB, SS2};
        pg8::gemm_phase(lds, X1B, MF, D, S, E);
        GRID_BAR(7);
    }
    if (IN(10)) for (int rep_ = 0; rep_ < NREP(10); ++rep_) {
        PHASE_IDS
        if (rep_) xcd_barrier(bar);
        pg8::DenseOrder S; S.init(T, D, 1024, 1024, G, bx);
        pg8::EpiResidT<true> E{X1B, X2B, nullptr};
        pg8::gemm_phase(lds, PB, VF, 1024, S, E);
        GRID_BAR(10);
    }
    if (IN(11)) for (int rep_ = 0; rep_ < NREP(11); ++rep_) {
        PHASE_IDS
        if (rep_) xcd_barrier(bar);
        LAS float* part = (LAS float*)lds;
        LAS float* ssp = (LAS float*)(lds + 24576);
        LAS int* eb = (LAS int*)(lds + 24576 + 512);
        const int r16 = lane & 15, g4 = lane >> 4;
        for (int uu = bx; uu < T / 32; uu += G) {
            const int t0 = uu * 32; const int tt = wave & 1, ksl = wave >> 1;
            __syncthreads();
            {
                f32x4 acc[3];
#pragma unroll
                for (int i = 0; i < 3; ++i) acc[i] = (f32x4){0.f, 0.f, 0.f, 0.f};
                float ssq = 0.f;
                const bf16* xr = X2B + (size_t)(t0 + tt * 16 + r16) * D + ksl * 512 + 8 * g4;
                const bf16* wh = WRH + (size_t)r16 * D + ksl * 512 + 8 * g4; const bf16* wl = WRL + (size_t)r16 * D + ksl * 512 + 8 * g4;
#pragma unroll 4
                for (int ks = 0; ks < 16; ++ks) { const u32x4 xa = *(const u32x4*)(xr + ks * 32);
                    { const float f0 = bf2f(xa.x & 0xffffu), f1 = bf2f(xa.x >> 16), f2 = bf2f(xa.y & 0xffffu), f3 = bf2f(xa.y >> 16), f4 = bf2f(xa.z & 0xffffu), f5 = bf2f(xa.z >> 16), f6 = bf2f(xa.w & 0xffffu), f7 = bf2f(xa.w >> 16);
                      ssq += ((f0 * f0 + f1 * f1) + (f2 * f2 + f3 * f3)) + ((f4 * f4 + f5 * f5) + (f6 * f6 + f7 * f7)); }
                    const bf16x8 Ah = __builtin_bit_cast(bf16x8, xa);
#pragma unroll
                    for (int nt = 0; nt < 3; ++nt) { const bf16x8 Bh = *(const bf16x8*)(wh + (size_t)nt * 16 * D + ks * 32), Bl = *(const bf16x8*)(wl + (size_t)nt * 16 * D + ks * 32);
                        acc[nt] = __builtin_amdgcn_mfma_f32_16x16x32_bf16(Ah, Bh, acc[nt], 0, 0, 0); acc[nt] = __builtin_amdgcn_mfma_f32_16x16x32_bf16(Ah, Bl, acc[nt], 0, 0, 0); } }
#pragma unroll
                for (int nt = 0; nt < 3; ++nt)
#pragma unroll
                    for (int i = 0; i < 4; ++i) part[(ksl * 32 + tt * 16 + 4 * g4 + i) * 48 + nt * 16 + r16] = acc[nt][i];
                ssq += __shfl_xor(ssq, 16); ssq += __shfl_xor(ssq, 32);
                if (g4 == 0) ssp[ksl * 32 + tt * 16 + r16] = ssq;
            }
            __syncthreads();
            int e1 = 0, e2 = 0;
            if (tid < 32) { const int t = t0 + tid; const float rstd = rsqrtf((ssp[tid] + ssp[32 + tid] + ssp[64 + tid] + ssp[96 + tid]) * (1.f / D) + EPS);
                const LAS float* p0 = part + tid * 48;
#define LG(o) ((p0[(o)] + p0[32 * 48 + (o)] + p0[64 * 48 + (o)] + p0[96 * 48 + (o)]) * rstd)
                int gs = 0; float gmax = LG(0) + A_->in[I_B_GROUP][0]; float gv[4]; gv[0] = gmax;
#pragma unroll
                for (int i = 1; i < 4; ++i) { gv[i] = LG(i) + A_->in[I_B_GROUP][i]; if (gv[i] > gmax) { gmax = gv[i]; gs = i; } }
                float gsum = 0.f;
#pragma unroll
                for (int i = 0; i < 4; ++i) gsum += __expf(gv[i] - gmax);
                const float pg = 1.f / gsum;
                int i1 = 0, i2 = 0; float v1 = -3.0e38f, v2 = -3.0e38f;
#pragma unroll 1
                for (int i = 0; i < 8; ++i) { const float ev = LG(4 + gs * 8 + i) + A_->in[I_B_ROUTER][gs * 8 + i];
                    if (ev > v1) { v2 = v1; i2 = i1; v1 = ev; i1 = i; } else if (ev > v2) { v2 = ev; i2 = i; } }
#undef LG
                const float p2 = __expf(v2 - v1); const float g1 = pg / (1.f + p2), g2 = pg * p2 / (1.f + p2);
                e1 = gs * 8 + i1; e2 = gs * 8 + i2;
                eb[2 * tid] = e1; eb[2 * tid + 1] = e2;
                TOKW[2 * t] = g1; TOKW[2 * t + 1] = g2; RSTD3[t] = rstd; }
            __syncthreads();
            LAS int* ebase = eb + 64;
            if (tid >= 64 && tid < 96) { const int e = tid - 64; int c = 0;
#pragma unroll 1
                for (int a2 = 0; a2 < 64; ++a2) c += (eb[a2] == e) ? 1 : 0;
                ebase[e] = c ? atomicAdd(CNT + e, c) : 0; }
            __syncthreads();
            if (tid < 64) { const int e = eb[tid]; int rk = 0;
#pragma unroll 1
                for (int a2 = 0; a2 < tid; ++a2) rk += (eb[a2] == e) ? 1 : 0;
                const int slot = ebase[e] + rk; LIST[e * T + slot] = t0 + (tid >> 1); TOKE[2 * t0 + tid] = e * T + slot; }
        }
        GRID_BAR(11);
    }
    volatile LAS int* cnl = (volatile LAS int*)(MISC + 64); volatile LAS int* prel = (volatile LAS int*)(MISC + 128); volatile LAS int* tbl = (volatile LAS int*)(MISC + 192);
    volatile LAS int* mtl = (volatile LAS int*)(MISC + 256); volatile LAS int* tlr = (volatile LAS int*)(MISC + 288); volatile LAS int* tpre = (volatile LAS int*)(MISC + 320); volatile LAS int* fll = (volatile LAS int*)(MISC + 384);
    constexpr int MOE_TAIL = 96;
#define MOE_TABLES(ncol) do { __syncthreads(); if (tid < 64) { const int e = tid & 31; const int c = __hip_atomic_load(CNT + e, __ATOMIC_RELAXED, __HIP_MEMORY_SCOPE_AGENT);     \
        const int full = c >> 8, mt = (c + 255) >> 8; int p = mt * (ncol), tb = mt; \
        _Pragma("unroll") for (int d_ = 1; d_ < 32; d_ <<= 1) { const int q_ = __shfl_up(p, d_), r_ = __shfl_up(tb, d_); if (e >= d_) { p += q_; tb += r_; } } \
        if (tid < 32) { cnl[e] = c; prel[e] = p - mt * (ncol); tbl[e] = tb - mt; mtl[e] = mt; tlr[e] = 0; tpre[e] = 0; fll[e] = full; if (e == 31) { prel[32] = p; tbl[32] = tb; tpre[32] = 0; } } } __syncthreads(); } while (0)
#define MOE_GU(Lb, Le, nbk, cc) do { pg8::MoeOrder S{tbl, cnl, LIST, 4, (Lb), (Le), (nbk), (cc), (unsigned)D * 2u, (size_t)1024 * D * 2, (unsigned)D * 2u, 1}; \
        pg8::EpiSwiGLU E{ACT, LIST, RSTD3, cnl}; pg8::gemm_phase(lds, X2B, WGU_T, D, S, E); } while (0)
#define MOE_DN(Lb, Le, nbk, cc) do { pg8::MoeOrder S{tbl, cnl, LIST, 8, (Lb), (Le), (nbk), (cc), (unsigned)DEXP * 2u, (size_t)D * DEXP * 2, (unsigned)DEXP * 2u, 0}; \
        pg8::EpiBf16 E{Y, D}; pg8::gemm_phase(lds, ACT, WDN_T, DEXP, S, E); } while (0)
    if (IN(13)) for (int rep_ = 0; rep_ < NREP(13); ++rep_) {
        PHASE_IDS
        if (rep_) xcd_barrier(bar);
        MOE_TABLES(4);
        const int U1 = tbl[32] * 4;
        MOE_GU(0, U1 < G ? U1 : G, G, bx);
        GRID_BAR(13);
    }
    if (IN(14)) for (int rep_ = 0; rep_ < NREP(14); ++rep_) {
        PHASE_IDS
        if (rep_) xcd_barrier(bar);
        MOE_TABLES(4);
        const int RT = tbl[32], U1 = RT * 4; const int nb0 = U1 > G ? ((U1 - G) < G ? (U1 - G) : G) : 0; const int rta = (U1 < G ? U1 : G) >> 2;
        if (bx < nb0) MOE_GU(G, U1, nb0, bx);
        else MOE_DN(0, rta * 8, G - nb0, bx - nb0);
        GRID_BAR(14);
    }
    if (IN(15)) for (int rep_ = 0; rep_ < NREP(15); ++rep_) {
        PHASE_IDS
        if (rep_) xcd_barrier(bar);
        MOE_TABLES(8);
        const int RT = tbl[32], U1 = RT * 4; const int rta = (U1 < G ? U1 : G) >> 2;
        MOE_DN(rta * 8, RT * 8, G, bx);
        GRID_BAR(15);
    }
    if (IN(16)) for (int rep_ = 0; rep_ < NREP(16); ++rep_) {
        PHASE_IDS
        if (rep_) xcd_barrier(bar);
        MOE_TABLES(1);
        const float* fg = A_->in[I_FINAL_G];
        int a0n = 0, a1n = 0; float w0n = 0.f, w1n = 0.f;
        if (gw < T) { a0n = TOKE[2 * gw]; a1n = TOKE[2 * gw + 1]; w0n = TOKW[2 * gw]; w1n = TOKW[2 * gw + 1]; }
#pragma unroll 1
        for (int t = gw; t < T; t += NGW) {
            const int a0 = a0n, a1 = a1n; const float w0 = w0n, w1 = w1n;
            { const int tn = t + NGW; if (tn < T) { a0n = TOKE[2 * tn]; a1n = TOKE[2 * tn + 1]; w0n = TOKW[2 * tn]; w1n = TOKW[2 * tn + 1]; } }
            const size_t r0 = (size_t)tbl[a0 / T] * 256 + (a0 % T), r1 = (size_t)tbl[a1 / T] * 256 + (a1 % T);
            const u32x2* xr = (const u32x2*)(X2B + (size_t)t * D) + lane; f32x4* xo = (rep_ == NREP(16) - 1) ? (f32x4*)(A_->out + (size_t)t * D) + lane : (f32x4*)((float*)(ws + WS_X1B) + (size_t)t * D) + lane; const u32x2* y0 = (const u32x2*)(Y + r0 * D) + lane; const u32x2* y1 = (const u32x2*)(Y + r1 * D) + lane;
            f32x4 v[8]; float s = 0.f;
#pragma unroll
            for (int j = 0; j < 8; ++j) { const u32x2 xq = xr[64 * j]; v[j] = (f32x4){bf2f(xq.x & 0xffffu), bf2f(xq.x >> 16), bf2f(xq.y & 0xffffu), bf2f(xq.y >> 16)}; const u32x2 p = y0[64 * j], q = y1[64 * j];
                v[j][0] += w0 * bf2f(p.x & 0xffffu) + w1 * bf2f(q.x & 0xffffu); v[j][1] += w0 * bf2f(p.x >> 16) + w1 * bf2f(q.x >> 16);
                v[j][2] += w0 * bf2f(p.y & 0xffffu) + w1 * bf2f(q.y & 0xffffu); v[j][3] += w0 * bf2f(p.y >> 16) + w1 * bf2f(q.y >> 16);
                s += (v[j][0] * v[j][0] + v[j][1] * v[j][1]) + (v[j][2] * v[j][2] + v[j][3] * v[j][3]); }
            const float r = rsqrtf(wave_sum(s) * (1.f / D) + EPS);
#pragma unroll
            for (int j = 0; j < 8; ++j) { const f32x4 g = ((const f32x4*)fg)[lane + 64 * j]; xo[64 * j] = (f32x4){v[j][0] * r * g[0], v[j][1] * r * g[1], v[j][2] * r * g[2], v[j][3] * r * g[3]}; }
        }
    }
#undef IN
#undef BOTH
#undef GRID_BAR
}

extern "C" void kernel_launch(void* const* d_in, const int* in_sizes, int n_in, void* d_out, int out_size, void* d_ws, size_t ws_size, hipStream_t stream) {
    static int grid = 0;
    if (grid == 0) {
        if (n_in != 27 || out_size != T * D || ws_size < WS_END) { fprintf(stderr, "kernel_launch: unexpected problem (n_in %d out %d ws %zu)\n", n_in, out_size, ws_size); grid = -1; return; }
        int dev = 0, cus = 0, per_cu = 0;
        if (hipGetDevice(&dev) != hipSuccess || hipDeviceGetAttribute(&cus, hipDeviceAttributeMultiprocessorCount, dev) != hipSuccess) { grid = -1; return; }
        if (hipFuncSetAttribute((const void*)mega, hipFuncAttributeMaxDynamicSharedMemorySize, LDS_BYTES) != hipSuccess) { fprintf(stderr, "kernel_launch: hipFuncSetAttribute failed\n"); grid = -1; return; }
        if (hipOccupancyMaxActiveBlocksPerMultiprocessor(&per_cu, (const void*)mega, 512, LDS_BYTES) != hipSuccess || per_cu < 1) fprintf(stderr, "kernel_launch: occupancy query reports %d\n", per_cu);
        (void)hipGetLastError();
        grid = cus;
    }
    if (grid < 0) return;
    if (hipMemsetAsync((char*)d_ws + WS_CTL, 0, CTL_ZERO_BYTES, stream) != hipSuccess) return;
    Args a{};
    for (int i = 0; i < 27; ++i) a.in[i] = (const float*)d_in[i];
    a.out = (float*)d_out; a.ws = (unsigned char*)d_ws;
    if (MK_N_LAUNCHES == 1) { a.ph_lo = 0; a.ph_hi = NPHASE; hipLaunchKernelGGL(mega, dim3(grid), dim3(512), LDS_BYTES, stream, a); }
    else { for (int p = 0; p < NPHASE; ++p) { a.ph_lo = p; a.ph_hi = p + 1; hipLaunchKernelGGL(mega, dim3(grid), dim3(512), LDS_BYTES, stream, a); } }
}
```

```cpp
#include <hip/hip_runtime.h>
#include <cstdio>
#include <cstdint>

#ifndef MK_N_LAUNCHES
#define MK_N_LAUNCHES 1
#endif

#define GAS __attribute__((address_space(1)))
#define LAS __attribute__((address_space(3)))
typedef unsigned short bf16;
typedef short bf16x8 __attribute__((ext_vector_type(8)));
typedef float f32x4 __attribute__((ext_vector_type(4)));
typedef float f32x2 __attribute__((ext_vector_type(2)));
typedef float f32x16 __attribute__((ext_vector_type(16)));
typedef unsigned u32x4 __attribute__((ext_vector_type(4)));
typedef unsigned u32x2 __attribute__((ext_vector_type(2)));

constexpr int T = 8192, D = 2048, NMEM = 256;
constexpr int D_IN = 4944;
constexpr int NPROJ = 6144;
constexpr int KMIX = 3072;
constexpr int NCH = 128, CH = 64;
constexpr int NEXP = 32, DEXP = 512;
constexpr float EPS = 1e-6f;
constexpr int NPHASE = 17;

constexpr size_t MiB = 1u << 20;
constexpr size_t WS_CTL = 0, CTL_ZERO_BYTES = 256 * 1024;
constexpr size_t WS_WOUT_T = 1 * MiB;
constexpr size_t WS_WCQ_T = 13 * MiB;
constexpr size_t WS_WCKV_T = 21 * MiB;
constexpr size_t WS_WCO_T = 37 * MiB;
constexpr size_t WS_WGU_T = 45 * MiB;
constexpr size_t WS_WDN_T = 173 * MiB;
constexpr size_t WS_WIN_T = 237 * MiB;
constexpr size_t WS_H1 = 261 * MiB;
constexpr size_t WS_MIXIN = 237 * MiB;
constexpr size_t WS_SC127 = 285 * MiB;
constexpr size_t WS_MEMN = 293 * MiB;
constexpr size_t WS_KC = 294 * MiB;
constexpr size_t WS_VT = 295 * MiB;
constexpr size_t WS_GATES = 296 * MiB;
constexpr size_t WS_WR = 297 * MiB;
constexpr size_t WS_QABS = 298 * MiB;
constexpr size_t WS_CKVRAW = 330 * MiB;
constexpr size_t WS_QI = 338 * MiB;
constexpr size_t WS_SMALL = 346 * MiB;
constexpr size_t WS_MQKRAW = 354 * MiB;
constexpr size_t WS_MV = 386 * MiB;
constexpr size_t WS_MO = 402 * MiB;
constexpr size_t WS_CKVN = 418 * MiB;
constexpr size_t WS_KIDXN = 422 * MiB;
constexpr size_t WS_QCM = 423 * MiB;
constexpr size_t WS_KCM = 431 * MiB;
constexpr size_t WS_LST = 439 * MiB;
constexpr size_t WS_NL = 503 * MiB;
constexpr size_t WS_CST = 504 * MiB;
constexpr size_t WS_VTM = 536 * MiB;
constexpr size_t WS_X1B = 298 * MiB;
constexpr size_t WS_QC = 330 * MiB;
constexpr size_t WS_OC = 362 * MiB;
constexpr size_t WS_X2B = 394 * MiB;
constexpr size_t WS_LIST = 426 * MiB;
constexpr size_t WS_TOK = 427 * MiB;
constexpr size_t WS_ACT = 428 * MiB;
constexpr size_t WS_Y = 452 * MiB;
constexpr size_t WS_END = 552 * MiB;
constexpr int GT_B = 0;
constexpr int GT_LI = T * 4;
constexpr int GT_G = 2 * T * 4;
constexpr int GT_MLOC = GT_G + 512;
constexpr int GT_MPREV = GT_MLOC + 512;
constexpr int CW_BAR = 4096;
constexpr int CW_CNT = 8192;
constexpr int CW_SS2 = 16384;
static_assert((CW_SS2 + T) * 4 <= (int)CTL_ZERO_BYTES, "ctl");

constexpr int RING_BYTES = 131072;
constexpr int MISC_OFF = RING_BYTES;
constexpr int LDS_BYTES = 159744;

__device__ __forceinline__ float bf2f(unsigned b) { return __uint_as_float(b << 16); }
__device__ __forceinline__ unsigned f2bf(float f) { unsigned u = __float_as_uint(f); return (u + 0x7fffu + ((u >> 16) & 1u)) >> 16; }
__device__ __forceinline__ unsigned pk2(float lo, float hi) { return f2bf(lo) | (f2bf(hi) << 16); }
__device__ __forceinline__ float wave_sum(float v) {
#pragma unroll
    for (int o = 1; o < 64; o <<= 1) v += __shfl_xor(v, o);
    return v;
}
__device__ __forceinline__ float wave_max(float v) {
#pragma unroll
    for (int o = 1; o < 64; o <<= 1) v = fmaxf(v, __shfl_xor(v, o));
    return v;
}
#define LDS_WAIT() asm volatile("s_waitcnt lgkmcnt(0)" ::: "memory")

#define XB_TMO      128
#define XB_XCNT(j)  (256  + 64 * (j))
#define XB_XSUB(j)  (1280 + 64 * (j))
#define XB_XGEN(j)  (2304 + 64 * (j))
#define XB_TOP      3328
#define XB_TOPGEN   3392
#define XCD_BAR_WORDS 3456
#define XB_SPIN_CAP (1u << 18)
__device__ __forceinline__ unsigned xb_ld(unsigned* p)              { return __hip_atomic_load(p, __ATOMIC_RELAXED, __HIP_MEMORY_SCOPE_AGENT); }
__device__ __forceinline__ unsigned xb_add(unsigned* p, unsigned v) { return __hip_atomic_fetch_add(p, v, __ATOMIC_RELAXED, __HIP_MEMORY_SCOPE_AGENT); }
__device__ __forceinline__ unsigned xb_xcc_id() { return (unsigned)__builtin_amdgcn_s_getreg((3 << 11) | 20) & 0xFu; }
#define XB_SPIN(cond, bar) do { unsigned _sp = 0; while (cond) { __builtin_amdgcn_s_sleep(1); \
    if ((++_sp & 255u) == 0u) { if (xb_ld(&(bar)[XB_TMO])) break; if (_sp > XB_SPIN_CAP) { atomicAdd(&(bar)[XB_TMO], 1u); break; } } } } while (0)
struct XcdBarrier { unsigned* bar; unsigned x; volatile LAS unsigned* st; };
__device__ __forceinline__ XcdBarrier xcd_barrier_post(unsigned* bar, volatile LAS unsigned* st) {
    XcdBarrier b; b.bar = bar; b.x = xb_xcc_id(); b.st = st;
    if (threadIdx.x == 0) (void)xb_add(&bar[XB_XCNT(b.x)], 1u);
    return b;
}
__device__ __forceinline__ void xcd_barrier_complete(unsigned* bar, unsigned x, unsigned& nloc, unsigned& nx) {
    const unsigned G = gridDim.x * gridDim.y * gridDim.z;
    unsigned sum, cnt, mine, sp = 0u;
    for (;;) {
        sum = 0u; cnt = 0u; mine = 0u;
#pragma unroll
        for (unsigned j = 0; j < 16; ++j) { const unsigned c = xb_ld(&bar[XB_XCNT(j)]); sum += c; cnt += (c > 0u) ? 1u : 0u; mine = (j == x) ? c : mine; }
        if (sum == G) break;
        __builtin_amdgcn_s_sleep(1);
        if ((++sp & 255u) == 0u) { if (xb_ld(&bar[XB_TMO])) break; if (sp > XB_SPIN_CAP) { atomicAdd(&bar[XB_TMO], 1u); break; } }
    }
    nloc = mine > 0u ? mine : 1u; nx = cnt > 0u ? cnt : 1u;
}
__device__ __forceinline__ void xcd_barrier(const XcdBarrier& b, const int tid_) {
    asm volatile("s_waitcnt vmcnt(0)" ::: "memory");
    __syncthreads();
    if (tid_ == 0) {
        unsigned* bar = b.bar;
        __builtin_amdgcn_s_waitcnt(0);
        unsigned nloc = b.st[0], nx = b.st[1];
        if (nloc == 0u) { xcd_barrier_complete(bar, b.x, nloc, nx); b.st[0] = nloc; b.st[1] = nx; }
        const unsigned old = xb_add(&bar[XB_XSUB(b.x)], 1u);
        const unsigned gen = old / nloc;
        if (old + 1u == (gen + 1u) * nloc) {
            __builtin_amdgcn_fence(__ATOMIC_RELEASE, "agent");
            asm volatile("s_waitcnt vmcnt(0)" ::: "memory");
            const unsigned og = xb_add(&bar[XB_TOP], 1u);
            const unsigned tg = og / nx;
            if (og + 1u == (tg + 1u) * nx) xb_add(&bar[XB_TOPGEN], 1u);
            else XB_SPIN(xb_ld(&bar[XB_TOPGEN]) == tg, bar);
            __builtin_amdgcn_fence(__ATOMIC_ACQUIRE, "agent");
            xb_add(&bar[XB_XGEN(b.x)], 1u);
            asm volatile("s_waitcnt vmcnt(0)" ::: "memory");
        } else {
            XB_SPIN(xb_ld(&bar[XB_XGEN(b.x)]) == gen, bar);
            __builtin_amdgcn_fence(__ATOMIC_ACQUIRE, "agent");
            asm volatile("s_waitcnt vmcnt(0)" ::: "memory");
        }
    }
    __syncthreads();
}

namespace pg8 {
constexpr int BM = 256, BK = 64, HALF = 128, HTB = HALF * BK * 2, STAGE_BYTES = 8 * HTB, NXCD = 8, WGM = 8;
__host__ __device__ __forceinline__ int lds_byte(int r, int c) { const int st = (r >> 4) * 2 + (c >> 5), rr = r & 15, cc = c & 31, ob = rr * 64 + cc * 2; return st * 1024 + (ob ^ (((ob >> 9) & 1) << 5)); }
__host__ __device__ __forceinline__ void stage_rc(int b, int& R, int& C) { const int st = b / 1024, sb = b % 1024, swz = sb ^ (((sb >> 9) & 1) << 5); R = (st >> 1) * 16 + swz / 64; C = (st & 1) * 32 + (swz % 64) / 2; }

struct Unit { int pm, pn, e, rt; };

struct DenseOrder {
    static constexpr bool GATHER = false;
    int nM, nN, nwg, G, c; unsigned lda_bytes; unsigned kb;
    __device__ void init(int M, int N, int K, int lda, int G_, int c_) { nM = M / BM; nN = N / BM; nwg = nM * nN; G = G_; c = c_; lda_bytes = (unsigned)lda * 2u; kb = (unsigned)K * 2u; }
    __device__ bool next(int i, Unit& u) const {
        if (c < 0) return false;
        const long L = (long)i * G + c; if (L >= nwg) return false;
        int wgid = (int)L; { const int q = nwg / NXCD, r = nwg % NXCD, xcd = wgid % NXCD, off = wgid / NXCD; wgid = (xcd < r ? xcd * (q + 1) : r * (q + 1) + (xcd - r) * q) + off; }
        const int nig = WGM * nN, gid = wgid / nig, fm = gid * WGM, gsz = (nM - fm) < WGM ? (nM - fm) : WGM;
        u.pm = fm + ((wgid % nig) % gsz); u.pn = (wgid % nig) / gsz; u.e = 0; u.rt = 0; return true;
    }
    __device__ __forceinline__ unsigned a_row(const Unit& u, int r) const { return (unsigned)(u.pm * BM + r) * lda_bytes; }
    __device__ __forceinline__ size_t b_off(const Unit& u) const { return (size_t)u.pn * BM * kb; }
};

#define PG8_SA(b, h) (((b) * 2 + (h)) * HTB)
#define PG8_SB(b, h) ((4 + (b) * 2 + (h)) * HTB)
#define PG8_STAGEB(bufoff, gbase) do { _Pragma("unroll") for (int _i = 0; _i < 2; ++_i) \
        __builtin_amdgcn_global_load_lds((const unsigned*)((const char*)(gbase) + voffB[_i]), (LAS unsigned*)(lds + (bufoff) + ldsw + _i * 8192), 16, 0, 0); } while (0)
#define PG8_GLDS(src, dstoff) __builtin_amdgcn_global_load_lds((const unsigned*)(src), (LAS unsigned*)(lds + (dstoff)), 16, 0, 0)
#define PG8_STAGEA(bufoff, kbyte, h, NXT) do { if constexpr (Sched::GATHER) { const unsigned _o0 = (NXT) ? ((h) ? n10 : n00) : ((h) ? c10 : c00), _o1 = (NXT) ? ((h) ? n11 : n01) : ((h) ? c11 : c01); \
            PG8_GLDS(Ab + (kbyte) + _o0, (bufoff) + ldsw); PG8_GLDS(Ab + (kbyte) + _o1, (bufoff) + ldsw + 8192); } \
        else { const char* _b = ((NXT) ? nA : cA) + (kbyte) + ((h) ? hstepA : (size_t)0); PG8_GLDS(_b + voffA[0], (bufoff) + ldsw); PG8_GLDS(_b + voffA[1], (bufoff) + ldsw + 8192); } } while (0)
#define PG8_LDA(dst, b, h) do { _Pragma("unroll") for (int m = 0; m < 4; ++m) _Pragma("unroll") for (int k = 0; k < 2; ++k) dst[m][k] = *(const LAS bf16x8*)(lds + PG8_SA(b, h) + aoff + m * 2048 + k * 1024); } while (0)
#define PG8_LDB(dst, b, h) do { _Pragma("unroll") for (int n = 0; n < 2; ++n) _Pragma("unroll") for (int k = 0; k < 2; ++k) dst[n][k] = *(const LAS bf16x8*)(lds + PG8_SB(b, h) + boff + n * 2048 + k * 1024); } while (0)
#define PG8_MMA(ai, bj, At, Bt) do { __builtin_amdgcn_s_setprio(1); _Pragma("unroll") for (int m = 0; m < 4; ++m) _Pragma("unroll") for (int n = 0; n < 2; ++n) _Pragma("unroll") for (int k = 0; k < 2; ++k) \
        acc[ai][bj][m][n] = __builtin_amdgcn_mfma_f32_16x16x32_bf16(Bt[n][k], At[m][k], acc[ai][bj][m][n], 0, 0, 0); __builtin_amdgcn_s_setprio(0); } while (0)
#define PG8_WAIT_V(n) asm volatile("s_waitcnt vmcnt(" #n ")" ::: "memory")
#define PG8_WAIT_L(n) asm volatile("s_waitcnt lgkmcnt(" #n ")" ::: "memory")
#define PG8_BAR __builtin_amdgcn_s_barrier()
#define PG8_SCHED __builtin_amdgcn_sched_barrier(0)

template <class Epi, class Sched>
__device__ __forceinline__ void gemm_phase(const int tid_in, LAS unsigned char* lds, const bf16* A, const bf16* Bt, const int K, const Sched& S, const Epi& E) {
    int tid = tid_in; asm volatile("" : "+v"(tid));
    const int wid = __builtin_amdgcn_readfirstlane(tid >> 6), lane = tid & 63, wr = wid >> 2, wc = wid & 3, fr = lane & 15, fq = lane >> 4;
    int Kop_ = K; asm volatile("" : "+s"(Kop_));
    const int nt = Kop_ / BK;
    int sR[2], sC2[2]; unsigned voffB[2];
#pragma unroll
    for (int i = 0; i < 2; ++i) { int R, C; stage_rc(tid * 16 + i * 8192, R, C); sR[i] = R; sC2[i] = C * 2; voffB[i] = (unsigned)R * S.kb + (unsigned)C * 2u; }
    const unsigned kstep = (unsigned)(BK * 2);
    const size_t hstepB = (size_t)HALF * S.kb;
    const unsigned ldsw = (unsigned)wid * 1024u;
    const int aoff = lds_byte(wr * 64 + fr, fq * 8), boff = lds_byte(wc * 32 + fr, fq * 8);
    Unit cur, nxt; int ui = 0;
    if (!S.next(0, cur)) return;
    f32x4 acc[2][2][4][2];
#pragma unroll
    for (int a = 0; a < 2; ++a)
#pragma unroll
        for (int b = 0; b < 2; ++b)
#pragma unroll
            for (int m = 0; m < 4; ++m)
#pragma unroll
                for (int n = 0; n < 2; ++n) acc[a][b][m][n] = (f32x4){0.f, 0.f, 0.f, 0.f};
    bf16x8 At[4][2], B0[2][2], B1[2][2];
    const char* Ab = (const char*)A;
    unsigned c00 = 0, c01 = 0, c10 = 0, c11 = 0, n00 = 0, n01 = 0, n10 = 0, n11 = 0; unsigned voffA[2] = {0u, 0u}; const char* cA = Ab; const char* nA = Ab; size_t hstepA = 0;
    if constexpr (Sched::GATHER) { c00 = S.a_row(cur, sR[0]) + sC2[0]; c01 = S.a_row(cur, sR[1]) + sC2[1]; c10 = S.a_row(cur, 128 + sR[0]) + sC2[0]; c11 = S.a_row(cur, 128 + sR[1]) + sC2[1]; }
    else { voffA[0] = (unsigned)sR[0] * S.lda_bytes + sC2[0]; voffA[1] = (unsigned)sR[1] * S.lda_bytes + sC2[1]; hstepA = (size_t)HALF * S.lda_bytes; cA = Ab + (size_t)S.a_row(cur, 0); }
    const char* cB = (const char*)Bt + S.b_off(cur);
    PG8_STAGEB(PG8_SB(0, 0), cB); PG8_STAGEA(PG8_SA(0, 0), 0u, 0, false); PG8_STAGEB(PG8_SB(0, 1), cB + hstepB); PG8_STAGEA(PG8_SA(0, 1), 0u, 1, false);
    if (wr == 1) PG8_BAR;
    PG8_WAIT_V(4); PG8_BAR;
    PG8_STAGEB(PG8_SB(1, 0), cB + kstep); PG8_STAGEA(PG8_SA(1, 0), kstep, 0, false); PG8_STAGEB(PG8_SB(1, 1), cB + hstepB + kstep);
    PG8_WAIT_V(6); PG8_BAR;
    for (;;) {
        const bool has_next = S.next(ui + 1, nxt);
        const char* nB = cB;
        if constexpr (Sched::GATHER) { n00 = c00; n01 = c01; n10 = c10; n11 = c11; } else nA = cA;
        if (has_next) { nB = (const char*)Bt + S.b_off(nxt);
            if constexpr (Sched::GATHER) { n00 = S.a_row(nxt, sR[0]) + sC2[0]; n01 = S.a_row(nxt, sR[1]) + sC2[1]; n10 = S.a_row(nxt, 128 + sR[0]) + sC2[0]; n11 = S.a_row(nxt, 128 + sR[1]) + sC2[1]; }
            else nA = Ab + (size_t)S.a_row(nxt, 0); }
        for (int t = 0; t < nt; t += 2) {
            const bool last = (t == nt - 2);
            const unsigned k1 = (unsigned)(t + 1) * kstep;
            const unsigned k2 = last ? 0u : (unsigned)(t + 2) * kstep, k3 = k2 + kstep;
            const char* b2 = last ? nB : cB + (size_t)(t + 2) * kstep; const char* b3 = b2 + kstep;
            PG8_LDB(B0, 0, 0); PG8_SCHED; PG8_LDA(At, 0, 0); PG8_STAGEA(PG8_SA(1, 1), k1, 1, false);
            PG8_WAIT_L(8); PG8_BAR; PG8_WAIT_L(0); PG8_MMA(0, 0, At, B0); PG8_BAR; PG8_SCHED;
            PG8_LDB(B1, 0, 1); PG8_STAGEB(PG8_SB(0, 0), b2);
            PG8_BAR; PG8_WAIT_L(0); PG8_MMA(0, 1, At, B1); PG8_BAR;
            PG8_LDA(At, 0, 1); PG8_STAGEA(PG8_SA(0, 0), k2, 0, last);
            PG8_BAR; PG8_WAIT_L(0); PG8_MMA(1, 0, At, B0); PG8_BAR; PG8_SCHED;
            PG8_STAGEB(PG8_SB(0, 1), b2 + hstepB);
            PG8_WAIT_V(6); PG8_BAR; PG8_MMA(1, 1, At, B1); PG8_BAR;
            PG8_LDB(B0, 1, 0); PG8_SCHED; PG8_LDA(At, 1, 0); PG8_STAGEA(PG8_SA(0, 1), k2, 1, last);
            PG8_WAIT_L(8); PG8_BAR; PG8_WAIT_L(0); PG8_MMA(0, 0, At, B0); PG8_BAR; PG8_SCHED;
            PG8_LDB(B1, 1, 1); PG8_STAGEB(PG8_SB(1, 0), b3);
            PG8_BAR; PG8_WAIT_L(0); PG8_MMA(0, 1, At, B1); PG8_BAR;
            PG8_LDA(At, 1, 1); PG8_STAGEA(PG8_SA(1, 0), k3, 0, last);
            PG8_BAR; PG8_WAIT_L(0); PG8_MMA(1, 0, At, B0); PG8_BAR; PG8_SCHED;
            PG8_STAGEB(PG8_SB(1, 1), b3 + hstepB);
            PG8_WAIT_V(6); PG8_BAR; PG8_MMA(1, 1, At, B1); PG8_BAR;
        }
        if constexpr (!Epi::AFTER_DRAIN) E(acc, cur, wr, wc, fr, fq);
        if (!has_next) break;
#pragma unroll
        for (int a = 0; a < 2; ++a)
#pragma unroll
            for (int b = 0; b < 2; ++b)
#pragma unroll
                for (int m = 0; m < 4; ++m)
#pragma unroll
                    for (int n = 0; n < 2; ++n) acc[a][b][m][n] = (f32x4){0.f, 0.f, 0.f, 0.f};
        cur = nxt; if constexpr (Sched::GATHER) { c00 = n00; c01 = n01; c10 = n10; c11 = n11; } else cA = nA; cB = nB; ++ui;
    }
    PG8_WAIT_V(0);
    if (wr == 0) PG8_BAR;
    PG8_BAR;
    if constexpr (Epi::AFTER_DRAIN) E.fused(acc, cur, wr, wc, fr, fq, lds, wid, lane);
}

__device__ __forceinline__ void store_tile_f32(const f32x4 (&acc)[2][2][4][2], float* dst, int ld, int row0, int col0) {
#pragma unroll
    for (int ai = 0; ai < 2; ++ai)
#pragma unroll
        for (int m = 0; m < 4; ++m) { float* rowp = dst + (size_t)(row0 + ai * HALF + m * 16) * ld + col0;
#pragma unroll
            for (int bj = 0; bj < 2; ++bj)
#pragma unroll
                for (int n = 0; n < 2; ++n) *(f32x4*)(rowp + bj * HALF + n * 16) = acc[ai][bj][m][n]; }
}
__device__ __forceinline__ void store_tile_bf16(const f32x4 (&acc)[2][2][4][2], bf16* dst, int ld, int row0, int col0) {
#pragma unroll
    for (int ai = 0; ai < 2; ++ai)
#pragma unroll
        for (int m = 0; m < 4; ++m) { bf16* rowp = dst + (size_t)(row0 + ai * HALF + m * 16) * ld + col0;
#pragma unroll
            for (int bj = 0; bj < 2; ++bj)
#pragma unroll
                for (int n = 0; n < 2; ++n) { const f32x4 v = acc[ai][bj][m][n]; u32x2 w; w.x = pk2(v[0], v[1]); w.y = pk2(v[2], v[3]); *(u32x2*)(rowp + bj * HALF + n * 16) = w; } }
}
struct EpiBf16 {
    static constexpr bool AFTER_DRAIN = false;
    bf16* dst; int ld;
    __device__ __forceinline__ void operator()(const f32x4 (&acc)[2][2][4][2], const Unit& u, int wr, int wc, int fr, int fq) const {
        store_tile_bf16(acc, dst, ld, u.pm * BM + wr * 64 + fr, u.pn * BM + wc * 32 + 4 * fq);
    }
};
struct EpiProj {
    static constexpr bool AFTER_DRAIN = false;
    bf16* qabs; float* ckvraw; bf16* qi; float* small; float* mqkraw; bf16* mv; bf16* mo;
    __device__ __forceinline__ void operator()(const f32x4 (&acc)[2][2][4][2], const Unit& u, int wr, int wc, int fr, int fq) const {
        const int row0 = u.pm * BM + wr * 64 + fr, cl = wc * 32 + 4 * fq, pn = u.pn;
        if (pn < 8) store_tile_bf16(acc, qabs, 2048, row0, pn * 256 + cl);
        else if (pn == 8) store_tile_f32(acc, ckvraw, 256, row0, cl);
        else if (pn < 11) store_tile_bf16(acc, qi, 512, row0, (pn - 9) * 256 + cl);
        else if (pn == 11) store_tile_f32(acc, small, 256, row0, cl);
        else if (pn < 16) store_tile_f32(acc, mqkraw, 1024, row0, (pn - 12) * 256 + cl);
        else if (pn < 20) store_tile_bf16(acc, mv, 1024, row0, (pn - 16) * 256 + cl);
        else store_tile_bf16(acc, mo, 1024, row0, (pn - 20) * 256 + cl);
    }
};
template <bool BASE_BF16>
struct EpiResidT {
    static constexpr bool AFTER_DRAIN = false;
    const void* base; bf16* xb; float* ss;
    __device__ __forceinline__ void operator()(const f32x4 (&acc)[2][2][4][2], const Unit& u, int wr, int wc, int fr, int fq) const {
        const int row0 = u.pm * BM + wr * 64 + fr, col0 = u.pn * BM + wc * 32 + 4 * fq;
#pragma unroll
        for (int ai = 0; ai < 2; ++ai)
#pragma unroll
            for (int m = 0; m < 4; ++m) { const int row = row0 + ai * HALF + m * 16; const size_t off = (size_t)row * D + col0; float s = 0.f;
#pragma unroll
                for (int bj = 0; bj < 2; ++bj)
#pragma unroll
                    for (int n = 0; n < 2; ++n) { f32x4 b;
                        if constexpr (BASE_BF16) { const u32x2 p = *(const u32x2*)((const bf16*)base + off + bj * HALF + n * 16); b = (f32x4){bf2f(p.x & 0xffffu), bf2f(p.x >> 16), bf2f(p.y & 0xffffu), bf2f(p.y >> 16)}; }
                        else b = *(const f32x4*)((const float*)base + off + bj * HALF + n * 16);
                        const f32x4 v = b + acc[ai][bj][m][n];
                        u32x2 w; w.x = pk2(v[0], v[1]); w.y = pk2(v[2], v[3]); *(u32x2*)(xb + off + bj * HALF + n * 16) = w;
                        s += (v[0] * v[0] + v[1] * v[1]) + (v[2] * v[2] + v[3] * v[3]); }
                if (ss) { s += __shfl_xor(s, 16); s += __shfl_xor(s, 32); if (fq == 0) atomicAdd(ss + row, s); } }
    }
};
struct EpiCq {
    static constexpr bool AFTER_DRAIN = false;
    bf16* dst; const float* ss; float scale;
    __device__ __forceinline__ void operator()(const f32x4 (&acc)[2][2][4][2], const Unit& u, int wr, int wc, int fr, int fq) const {
        const int row0 = u.pm * BM + wr * 64 + fr, col0 = u.pn * BM + wc * 32 + 4 * fq;
#pragma unroll
        for (int ai = 0; ai < 2; ++ai)
#pragma unroll
            for (int m = 0; m < 4; ++m) { const int row = row0 + ai * HALF + m * 16; const float r = rsqrtf(ss[row] * (1.0f / D) + EPS) * scale; bf16* rowp = dst + (size_t)row * D + col0;
#pragma unroll
                for (int bj = 0; bj < 2; ++bj)
#pragma unroll
                    for (int n = 0; n < 2; ++n) { const f32x4 v = acc[ai][bj][m][n] * r; u32x2 w; w.x = pk2(v[0], v[1]); w.y = pk2(v[2], v[3]); *(u32x2*)(rowp + bj * HALF + n * 16) = w; } }
    }
};
struct XsOrder {
    static constexpr bool GATHER = false;
    int G, c; unsigned lda_bytes, kb;
    __device__ bool next(int i, Unit& u) const { const int L = i * G + c; if (i > 0 || L >= 128) return false; u.pm = L >> 2; u.pn = L & 3; u.e = 0; u.rt = 0; return true; }
    __device__ __forceinline__ unsigned a_row(const Unit& u, int r) const { return (unsigned)(u.pm * BM + r) * lda_bytes + (unsigned)u.pn * 1024u; }
    __device__ __forceinline__ size_t b_off(const Unit& u) const { return (size_t)u.pn * 1024; }
};
struct XoOrder {
    static constexpr bool GATHER = false;
    int G, c; unsigned lda_bytes, kb;
    __device__ bool next(int i, Unit& u) const { const int L = i * G + c; if (L >= 256) return false; u.pm = L >> 3; u.pn = L & 7; u.e = 0; u.rt = 0; return true; }
    __device__ __forceinline__ unsigned a_row(const Unit& u, int r) const { return (unsigned)(u.pm * BM + r) * lda_bytes + (unsigned)(u.pn >> 1) * 512u; }
    __device__ __forceinline__ size_t b_off(const Unit& u) const { return (size_t)u.pn * BM * kb; }
};
struct EpiSoftmax {
    static constexpr bool AFTER_DRAIN = true;
    bf16* P; const float* ss;
    __device__ __forceinline__ void fused(f32x4 (&acc)[2][2][4][2], const Unit& u, int wr, int wc, int fr, int fq, LAS unsigned char* lds, int wid, int lane) const {
        LAS float* Pm = (LAS float*)lds; LAS float* Ps = (LAS float*)(lds + 4096);
#pragma unroll
        for (int ai = 0; ai < 2; ++ai)
#pragma unroll
            for (int m = 0; m < 4; ++m) { float mx = -3.0e38f; const float rs = rsqrtf(ss[u.pm * BM + ai * HALF + wr * 64 + m * 16 + fr] * (1.0f / D) + EPS);
#pragma unroll
                for (int bj = 0; bj < 2; ++bj)
#pragma unroll
                    for (int n = 0; n < 2; ++n) { const f32x4 v = acc[ai][bj][m][n] * rs; acc[ai][bj][m][n] = v; mx = fmaxf(mx, fmaxf(fmaxf(v[0], v[1]), fmaxf(v[2], v[3]))); }
                mx = fmaxf(mx, __shfl_xor(mx, 16)); mx = fmaxf(mx, __shfl_xor(mx, 32));
                if (fq == 0) Pm[(ai * HALF + wr * 64 + m * 16 + fr) * 4 + wc] = mx; }
        asm volatile("s_waitcnt lgkmcnt(0)" ::: "memory"); __builtin_amdgcn_s_barrier(); asm volatile("" ::: "memory");
#pragma unroll
        for (int ai = 0; ai < 2; ++ai)
#pragma unroll
            for (int m = 0; m < 4; ++m) { const int r = ai * HALF + wr * 64 + m * 16 + fr; const f32x4 pm4 = *(const LAS f32x4*)(Pm + r * 4); const float mx = fmaxf(fmaxf(pm4[0], pm4[1]), fmaxf(pm4[2], pm4[3])); float sm = 0.f;
#pragma unroll
                for (int bj = 0; bj < 2; ++bj)
#pragma unroll
                    for (int n = 0; n < 2; ++n) { f32x4 v = acc[ai][bj][m][n];
#pragma unroll
                        for (int j = 0; j < 4; ++j) { v[j] = __expf(v[j] - mx); sm += v[j]; }
                        acc[ai][bj][m][n] = v; }
                sm += __shfl_xor(sm, 16); sm += __shfl_xor(sm, 32);
                if (fq == 0) Ps[r * 4 + wc] = sm; }
        asm volatile("s_waitcnt lgkmcnt(0)" ::: "memory"); __builtin_amdgcn_s_barrier(); asm volatile("" ::: "memory");
#pragma unroll
        for (int ai = 0; ai < 2; ++ai)
#pragma unroll
            for (int m = 0; m < 4; ++m) { const int r = ai * HALF + wr * 64 + m * 16 + fr; const f32x4 ps4 = *(const LAS f32x4*)(Ps + r * 4); const float inv = 1.f / ((ps4[0] + ps4[1]) + (ps4[2] + ps4[3]));
                bf16* rowp = P + (size_t)(u.pm * BM + r) * 1024 + u.pn * 256 + wc * 32 + 4 * fq;
#pragma unroll
                for (int bj = 0; bj < 2; ++bj)
#pragma unroll
                    for (int n = 0; n < 2; ++n) { const f32x4 v = acc[ai][bj][m][n] * inv; u32x2 w; w.x = pk2(v[0], v[1]); w.y = pk2(v[2], v[3]); *(u32x2*)(rowp + bj * HALF + n * 16) = w; } }
    }
};
struct MoeOrder {
    static constexpr bool GATHER = true;
    const volatile LAS int* tb; const volatile LAS int* cn; const int* list; int ncol; int Lbeg, Lend, nb, c; unsigned a_ld_bytes; size_t b_exp_bytes; unsigned kb; int gather;
    __device__ bool next(int i, Unit& u) const {
        if (c < 0 || nb <= 0) return false;
        const int L = Lbeg + i * nb + c; if (L >= Lend) return false;
        const int g = L / ncol; int e = 0;
#pragma unroll 1
        for (int j = 1; j < 32; ++j) if (g >= tb[j]) e = j;
        u.e = e; u.rt = g - tb[e]; u.pn = L - g * ncol; u.pm = g; return true;
    }
    __device__ __forceinline__ unsigned a_row(const Unit& u, int r) const {
        if (gather) { int idx = u.rt * 256 + r; const int cnt = cn[u.e]; idx = idx < cnt ? idx : cnt - 1; const int tok = list[u.e * T + idx]; return (unsigned)tok * a_ld_bytes; }
        return (unsigned)(u.pm * 256 + r) * a_ld_bytes;
    }
    __device__ __forceinline__ size_t b_off(const Unit& u) const { return (size_t)u.e * b_exp_bytes + (size_t)u.pn * BM * kb; }
};
struct EpiSwiGLU {
    static constexpr bool AFTER_DRAIN = false;
    bf16* act; const int* list; const float* rstd; const volatile LAS int* cn;
    __device__ __forceinline__ void operator()(const f32x4 (&acc)[2][2][4][2], const Unit& u, int wr, int wc, int fr, int fq) const {
        const int cnt = cn[u.e];
#pragma unroll
        for (int ai = 0; ai < 2; ++ai)
#pragma unroll
            for (int m = 0; m < 4; ++m) { const int rl = ai * HALF + wr * 64 + m * 16 + fr; int idx = u.rt * 256 + rl; idx = idx < cnt ? idx : cnt - 1; const float r = rstd[list[u.e * T + idx]];
                bf16* rowp = act + (size_t)(u.pm * 256 + rl) * DEXP + u.pn * 128 + wc * 32 + 4 * fq;
#pragma unroll
                for (int n = 0; n < 2; ++n) { const f32x4 g = acc[ai][0][m][n] * r, uu = acc[ai][1][m][n] * r; f32x4 a;
#pragma unroll
                    for (int j = 0; j < 4; ++j) a[j] = g[j] / (1.0f + __expf(-g[j])) * uu[j];
                    u32x2 w; w.x = pk2(a[0], a[1]); w.y = pk2(a[2], a[3]); *(u32x2*)(rowp + n * 16) = w; } }
    }
};
}

struct Args { const float* in[27]; float* out; unsigned char* ws; int ph_lo, ph_hi; };
enum { I_X = 0, I_MEM, I_NORM_MIX_G, I_W_IN, I_KV_NORM_G, I_KIDX_NORM_G, I_W_UK, I_W_UV, I_CONV_W, I_CONV_B, I_GATE_B, I_ML_NORM_G, I_W_OUT, I_NORM_X_G, I_MEM_NORM_G,
       I_W_CQ, I_W_CKV, I_W_CO, I_NORM_FFN_G, I_W_GROUP, I_B_GROUP, I_W_ROUTER, I_B_ROUTER, I_W_GATE, I_W_UP, I_W_DOWN, I_FINAL_G };

__device__ __forceinline__ void tr_item(const float* W, size_t ldw, int k0, int n0, const float* kscale, bf16* WT, size_t ldt, int drow0, int dcol0, LAS float* scr, int lane) {
#pragma unroll 8
    for (int i = 0; i < 32; ++i) { const int kk = 2 * i + (lane >> 5); float v = W[(size_t)(k0 + kk) * ldw + n0 + (lane & 31)]; if (kscale) v *= kscale[k0 + kk]; scr[kk * 33 + (lane & 31)] = v; }
    LDS_WAIT(); asm volatile("" ::: "memory");
    const int c = lane & 7;
#pragma unroll
    for (int j = 0; j < 4; ++j) { const int n = (lane >> 3) + 8 * j; const LAS float* s = scr + (8 * c) * 33 + n;
        u32x4 o; o.x = pk2(s[0 * 33], s[1 * 33]); o.y = pk2(s[2 * 33], s[3 * 33]); o.z = pk2(s[4 * 33], s[5 * 33]); o.w = pk2(s[6 * 33], s[7 * 33]);
        *(u32x4*)(WT + (size_t)(drow0 + n0 + n) * ldt + dcol0 + k0 + 8 * c) = o; }
    LDS_WAIT(); asm volatile("" ::: "memory");
}
__device__ __forceinline__ void tr_item64(const float* W, size_t ldw, int k0, int n0, const float* kscale, bf16* WT, size_t ldt, int drow0, int dcol0, LAS unsigned char* scr, int lane) {
    const int nq = lane & 15, kq = lane >> 4;
    const float* src = W + (size_t)(k0 + 2 * kq) * ldw + n0 + 4 * nq;
    f32x4 a[8], b[8];
#pragma unroll
    for (int i = 0; i < 8; ++i) { a[i] = __builtin_nontemporal_load((const f32x4*)(src + (size_t)(8 * i) * ldw)); b[i] = __builtin_nontemporal_load((const f32x4*)(src + (size_t)(8 * i + 1) * ldw)); }
#pragma unroll
    for (int i = 0; i < 8; ++i) { float sa = 1.f, sb = 1.f; if (kscale) { sa = kscale[k0 + 8 * i + 2 * kq]; sb = kscale[k0 + 8 * i + 2 * kq + 1]; }
#pragma unroll
        for (int j = 0; j < 4; ++j) { const int n = 4 * nq + j; *(LAS unsigned*)(scr + n * 128 + 16 * (i ^ (nq & 7)) + 4 * kq) = pk2(a[i][j] * sa, b[i][j] * sb); } }
    LDS_WAIT(); asm volatile("" ::: "memory");
#pragma unroll
    for (int m = 0; m < 8; ++m) { const int n = (lane >> 3) + 8 * m, c = lane & 7; const u32x4 v = *(const LAS u32x4*)(scr + n * 128 + 16 * (c ^ ((n >> 2) & 7)));
        __builtin_nontemporal_store(v, (u32x4*)(WT + (size_t)(drow0 + n0 + n) * ldt + dcol0 + k0 + 8 * c)); }
    LDS_WAIT(); asm volatile("" ::: "memory");
}
__device__ __forceinline__ void cv_item64(const float* W, size_t ldw, int k0, int n0, const float* kscale, float scale, bf16* O, size_t ldo, int lane) {
    const int c4 = (lane & 15) * 4, rr = lane >> 4;
    f32x4 v[16];
#pragma unroll
    for (int i = 0; i < 16; ++i) v[i] = __builtin_nontemporal_load((const f32x4*)(W + (size_t)(k0 + i * 4 + rr) * ldw + n0 + c4));
#pragma unroll
    for (int i = 0; i < 16; ++i) { const float g = kscale[k0 + i * 4 + rr] * scale; u32x2 w; w.x = pk2(v[i][0] * g, v[i][1] * g); w.y = pk2(v[i][2] * g, v[i][3] * g);
        *(u32x2*)(O + (size_t)(k0 + i * 4 + rr) * ldo + n0 + c4) = w; }
}
__device__ __forceinline__ void rms_row_to_bf16(const float* xrow, const float* g, bf16* orow, int lane) {
    const f32x4* xr = (const f32x4*)xrow + lane; const f32x4* gr = (const f32x4*)g + lane;
    f32x4 v[8]; float s = 0.f;
#pragma unroll
    for (int j = 0; j < 8; ++j) { v[j] = xr[64 * j]; s += (v[j][0] * v[j][0] + v[j][1] * v[j][1]) + (v[j][2] * v[j][2] + v[j][3] * v[j][3]); }
    const float r = rsqrtf(wave_sum(s) * (1.f / D) + EPS);
    u32x2* o8 = (u32x2*)orow + lane;
#pragma unroll
    for (int j = 0; j < 8; ++j) { const f32x4 gg = gr[64 * j]; u32x2 w; w.x = pk2(v[j][0] * r * gg[0], v[j][1] * r * gg[1]); w.y = pk2(v[j][2] * r * gg[2], v[j][3] * r * gg[3]); o8[64 * j] = w; }
}

__device__ __forceinline__ void mini_gemm64(LAS unsigned char* lds, const bf16* Ap, const unsigned lda, const bf16* Bp, const unsigned ldb, const int nch, bf16* o, const unsigned ldo, const int wave, const int lane) {
    const int r32 = lane & 31, hh = lane >> 5; const int tm = wave & 1, tn = (wave >> 1) & 1, kh = wave >> 2;
#define KV_DMA(kc_) do { _Pragma("unroll") for (int i4 = 0; i4 < 4; ++i4) { const int ii = wave * 4 + i4; const int isb = ii >> 4, row_ = (ii & 15) * 4 + (lane >> 4); \
        const bf16* gsrc_ = (isb ? Bp + (size_t)row_ * ldb : Ap + (size_t)row_ * lda) + (kc_) * 128 + (((lane & 15) ^ (row_ & 15)) * 8); \
        const unsigned ldst_ = __builtin_amdgcn_readfirstlane((unsigned)(size_t)lds + (unsigned)(((kc_) & 1) * 32768 + isb * 16384 + (ii & 15) * 1024)); unsigned keep_; \
        asm volatile("s_mov_b32 %0, m0\n\ts_mov_b32 m0, %2\n\ts_nop 0\n\tglobal_load_lds_dwordx4 %1, off\n\ts_mov_b32 m0, %0" : "=&s"(keep_) : "v"(gsrc_), "s"(ldst_) : "memory"); } } while (0)
    f32x16 acc;
#pragma unroll
    for (int i = 0; i < 16; ++i) acc[i] = 0.f;
    asm volatile("s_waitcnt vmcnt(0)" ::: "memory");
    __syncthreads();
    KV_DMA(0);
#pragma unroll 1
    for (int kc = 0; kc < nch; ++kc) {
        asm volatile("s_waitcnt vmcnt(0)" ::: "memory");
        __syncthreads();
        if (kc + 1 < nch) KV_DMA(kc + 1);
        const LAS unsigned char* ba = lds + (kc & 1) * 32768 + (tm * 32 + r32) * 256; const LAS unsigned char* bb = lds + (kc & 1) * 32768 + 16384 + (tn * 32 + r32) * 256;
#pragma unroll
        for (int k4 = 0; k4 < 4; ++k4) { const int ch = (kh * 4 + k4) * 2 + hh;
            const bf16x8 af = *(const LAS bf16x8*)(ba + ((ch ^ (r32 & 15)) * 16)), bfr = *(const LAS bf16x8*)(bb + ((ch ^ (r32 & 15)) * 16));
            acc = __builtin_amdgcn_mfma_f32_32x32x16_bf16(af, bfr, acc, 0, 0, 0); }
    }
#undef KV_DMA
    __syncthreads();
    LAS float* xb = (LAS float*)(lds + 65536) + (wave & 3) * 1024;
    if (kh == 1) {
#pragma unroll
        for (int i = 0; i < 16; ++i) xb[i * 64 + lane] = acc[i]; }
    __syncthreads();
    if (kh == 0) { bf16* op = o + (size_t)(tm * 32 + 4 * hh) * ldo + tn * 32 + r32;
#pragma unroll
        for (int i = 0; i < 16; ++i) op[(size_t)((i & 3) + 8 * (i >> 2)) * ldo] = (bf16)f2bf(acc[i] + xb[i * 64 + lane]); }
}


__global__ void __launch_bounds__(512, 2) mega(Args args) {
    extern __shared__ __attribute__((aligned(16))) unsigned char lds_raw[];
    LAS unsigned char* lds = (LAS unsigned char*)lds_raw;
    volatile LAS unsigned* MISC = (volatile LAS unsigned*)(lds + MISC_OFF);
    const int tid0 = threadIdx.x;
    const int wave0_ = __builtin_amdgcn_readfirstlane(tid0 >> 6);
    const int G = gridDim.x, bx = blockIdx.x;
#define PHASE_IDS const Args* A_ = (const Args*)__builtin_amdgcn_kernarg_segment_ptr(); asm volatile("" : "+s"(A_)); int tid; asm volatile("v_mbcnt_lo_u32_b32 %0, -1, 0\n\tv_mbcnt_hi_u32_b32 %0, -1, %0" : "=v"(tid)); tid += wave0_ * 64; asm volatile("" : "+v"(tid)); const int lane = tid & 63, wave = __builtin_amdgcn_readfirstlane(tid >> 6); const int gw = bx * 8 + wave, NGW = G * 8; (void)lane; (void)gw; (void)NGW;
    const Args* A_ = (const Args*)__builtin_amdgcn_kernarg_segment_ptr();
    unsigned char* ws = args.ws;
    unsigned* ctl = (unsigned*)(ws + WS_CTL);
    const int lo = args.ph_lo, hi = args.ph_hi;
    for (int u = tid0; u < 1024; u += 512) MISC[u] = 0u;
    __syncthreads();
    XcdBarrier bar; bar.bar = ctl + CW_BAR; bar.x = 0; bar.st = MISC;
    if (hi - lo > 1) bar = xcd_barrier_post(ctl + CW_BAR, MISC);
#ifndef PH_MASK
#define PH_MASK 0x1ffff
#endif
#define IN(k) ((((PH_MASK) >> (k)) & 1) && lo <= (k) && (k) < hi)
#ifndef REP_MASK
#define REP_MASK 0
#endif
#define NREP(k) (1 + (((REP_MASK) >> (k)) & 1))
#ifndef PR_MFMA
#define PR_MFMA 0
#endif
#ifndef PR_EPI
#define PR_EPI 0
#endif
#ifndef PR_GA
#define PR_GA 0
#endif
#ifndef PR_VF
#define PR_VF 0
#endif
#ifndef PR_KV
#define PR_KV 0
#endif
#ifndef PR_ML
#define PR_ML 0
#endif
#ifndef PR_TR
#define PR_TR 0
#endif
#ifndef PR_WP
#define PR_WP 0
#endif
#ifndef PR_H1
#define PR_H1 0
#endif
#ifndef PR_QK
#define PR_QK 0
#endif
#ifndef PR_PV
#define PR_PV 0
#endif
#define BOTH(k) (IN(k) && IN((k) + 1))
#define GRID_BAR(k) do { if (BOTH(k) && rep_ == NREP(k) - 1) xcd_barrier(bar, tid); } while (0)

#define WOUT_T ((bf16*)(ws + WS_WOUT_T))
#define WCQ_T ((bf16*)(ws + WS_WCQ_T))
#define WCKV_T ((bf16*)(ws + WS_WCKV_T))
#define WCO_T ((bf16*)(ws + WS_WCO_T))
#define WGU_T ((bf16*)(ws + WS_WGU_T))
#define WDN_T ((bf16*)(ws + WS_WDN_T))
#define WIN_T ((bf16*)(ws + WS_WIN_T))
#define H1 ((bf16*)(ws + WS_H1))
#define MIXIN ((bf16*)(ws + WS_MIXIN))
#define MEMN ((bf16*)(ws + WS_MEMN))
#define KC ((bf16*)(ws + WS_KC))
#define MF ((bf16*)(ws + WS_WCKV_T + 4 * MiB))
#define VF ((bf16*)(ws + WS_WCKV_T))
#define VT ((bf16*)(ws + WS_VT))
#define GATES ((float*)(ws + WS_GATES))
#define QABS ((bf16*)(ws + WS_QABS))
#define CKVRAW ((float*)(ws + WS_CKVRAW))
#define QI ((bf16*)(ws + WS_QI))
#define SMALL ((float*)(ws + WS_SMALL))
#define MQKRAW ((float*)(ws + WS_MQKRAW))
#define MV ((bf16*)(ws + WS_MV))
#define MO ((bf16*)(ws + WS_MO))
#define CKVN ((bf16*)(ws + WS_CKVN))
#define KIDXN ((bf16*)(ws + WS_KIDXN))
#define QCM ((bf16*)(ws + WS_QCM))
#define KCM ((bf16*)(ws + WS_KCM))
#define LST ((float*)(ws + WS_LST))
#define NL ((float*)(ws + WS_NL))
#define NST (NL + NCH * 4 * 128)
#define CST ((bf16*)(ws + WS_CST))
#define VTM ((bf16*)(ws + WS_VTM))
#define PB ((bf16*)(ws + WS_VTM))
#define X1B ((bf16*)(ws + WS_X1B))
#define QC ((bf16*)(ws + WS_QC))
#define OC ((bf16*)(ws + WS_OC))
#define X2B ((bf16*)(ws + WS_X2B))
#define LIST ((int*)(ws + WS_LIST))
#define TOKE ((int*)(ws + WS_TOK))
#define TOKW ((float*)(ws + WS_TOK) + 2 * T)
#define RSTD3 ((float*)(ws + WS_TOK) + 4 * T)
#define ACT ((bf16*)(ws + WS_ACT))
#define Y ((bf16*)(ws + WS_Y))
#define WRH ((bf16*)(ws + WS_WR))
#define WRL (WRH + 48 * D)
#define BCNT ((int*)(ws + WS_TOK) + 8 * T)
#define TOKR ((int*)(ws + WS_TOK) + 6 * T)
#define SS2 ((float*)(ctl + CW_SS2))
#define CNT ((int*)(ctl + CW_CNT))

    if (IN(0)) for (int rep_ = 0; rep_ < NREP(0); ++rep_) {
        PHASE_IDS
        if (rep_) xcd_barrier(bar, tid);
        LAS float* scr = (LAS float*)(lds + wave * 16384);
        const float* w_in = A_->in[I_W_IN]; const float* w_out = A_->in[I_W_OUT];
        constexpr int J_CKV = 32 * 4, J_QI = 32 * 8, J_KI = 32 * 1, J_MQK = 32 * 16, J_MV = 32 * 16, J_MO = 32 * 16, J_WO = 16 * 32, J_CQ = 32 * 32, J_CKVW = 32 * 64, J_CO = 32 * 32,
                      J_G = 32 * 256, J_U = 32 * 256, J_D = 32 * 256;
        constexpr int NITEMS = J_CKV + J_QI + J_KI + J_MQK + J_MV + J_MO + J_WO + J_CQ + J_CKVW + J_CO + J_G + J_U + J_D;
        LAS unsigned char* scr8 = (LAS unsigned char*)scr;
        for (int prt_ = 0; prt_ < 1 + PR_TR; ++prt_)
        for (int it = gw; it < NITEMS; it += NGW) {
            int r = it;
            if (r < J_CKV) { tr_item64(w_in + 1024, D_IN, 64 * (r / 4), 64 * (r % 4), nullptr, WIN_T, D, 2048, 0, scr8, lane); continue; } r -= J_CKV;
            if (r < J_QI) { tr_item64(w_in + 1280, D_IN, 64 * (r / 8), 64 * (r % 8), nullptr, WIN_T, D, 2304, 0, scr8, lane); continue; } r -= J_QI;
            if (r < J_KI) { tr_item64(w_in + 1792, D_IN, 64 * r, 0, nullptr, WIN_T, D, 2816, 0, scr8, lane); continue; } r -= J_KI;
            if (r < J_MQK) { tr_item64(w_in + 1864, D_IN, 64 * (r / 16), 64 * (r % 16), nullptr, WIN_T, D, 3072, 0, scr8, lane); continue; } r -= J_MQK;
            if (r < J_MV) { tr_item64(w_in + 2888, D_IN, 64 * (r / 16), 64 * (r % 16), nullptr, WIN_T, D, 4096, 0, scr8, lane); continue; } r -= J_MV;
            if (r < J_MO) { tr_item64(w_in + 3920, D_IN, 64 * (r / 16), 64 * (r % 16), nullptr, WIN_T, D, 5120, 0, scr8, lane); continue; } r -= J_MO;
            if (r < J_WO) { tr_item64(w_out + (size_t)1024 * D, D, 64 * (r / 32), 64 * (r % 32), nullptr, WOUT_T, KMIX, 0, 2048, scr8, lane); continue; } r -= J_WO;
            if (r < J_CQ) { cv_item64(A_->in[I_W_CQ], D, 64 * (r / 32), 64 * (r % 32), A_->in[I_NORM_X_G], 0.04419417382415922f, WCQ_T, D, lane); continue; } r -= J_CQ;
            if (r < J_CKVW) { tr_item64(A_->in[I_W_CKV], 2 * D, 64 * (r / 64), 64 * (r % 64), nullptr, WCKV_T, D, 0, 0, scr8, lane); continue; } r -= J_CKVW;
            if (r < J_CO) { tr_item64(A_->in[I_W_CO], D, 64 * (r / 32), 64 * (r % 32), nullptr, WCO_T, D, 0, 0, scr8, lane); continue; } r -= J_CO;
            if (r < J_G) { const int e = r / 256, q = r % 256, kb = q / 8, nb = q % 8;
                tr_item64(A_->in[I_W_GATE] + (size_t)e * D * DEXP, DEXP, 64 * kb, 64 * nb, A_->in[I_NORM_FFN_G], WGU_T + (size_t)e * 1024 * D, D, (nb / 2) * 128, 0, scr8, lane); continue; } r -= J_G;
            if (r < J_U) { const int e = r / 256, q = r % 256, kb = q / 8, nb = q % 8;
                tr_item64(A_->in[I_W_UP] + (size_t)e * D * DEXP, DEXP, 64 * kb, 64 * nb, A_->in[I_NORM_FFN_G], WGU_T + (size_t)e * 1024 * D, D, (nb / 2) * 128 + 128, 0, scr8, lane); continue; } r -= J_U;
            { const int e = r / 256, q = r % 256, kb = q / 32, nb = q % 32;
                tr_item64(A_->in[I_W_DOWN] + (size_t)e * DEXP * D, D, 64 * kb, 64 * nb, nullptr, WDN_T + (size_t)e * D * DEXP, DEXP, 0, 0, scr8, lane); }
        }
        for (int i = bx * 512 + tid; i < 192 * D; i += G * 512) { const int r = i / D, k = i % D; float v = 0.f;
            if (r < 8) v = w_in[(size_t)k * D_IN + 1856 + r]; else if (r < 16) v = w_in[(size_t)k * D_IN + 3912 + (r - 8)];
            WIN_T[(size_t)(2880 + r) * D + k] = (bf16)f2bf(v); }
        for (int i = bx * 512 + tid; i < 48 * D; i += G * 512) { const int o = i / D, k = i % D; float v = 0.f;
            if (o < 4) v = A_->in[I_W_GROUP][(size_t)k * 4 + o] * A_->in[I_NORM_FFN_G][k]; else if (o < 36) v = A_->in[I_W_ROUTER][(size_t)k * 32 + (o - 4)] * A_->in[I_NORM_FFN_G][k];
            const unsigned hb = f2bf(v); WRH[i] = (bf16)hb; WRL[i] = (bf16)f2bf(v - bf2f(hb)); }
        {
            const int r32 = lane & 31, hh = lane >> 5;
            const float* w_uk = A_->in[I_W_UK]; const float* w_uv = A_->in[I_W_UV];
#define CVT8(dst, pa, pb) do { const f32x4 x_ = (pa), y_ = (pb); u32x4 w_; w_.x = pk2(x_[0], x_[1]); w_.y = pk2(x_[2], x_[3]); w_.z = pk2(y_[0], y_[1]); w_.w = pk2(y_[2], y_[3]); dst = __builtin_bit_cast(bf16x8, w_); } while (0)
            for (int prw_ = 0; prw_ < 1 + PR_WP; ++prw_)
            for (int it = gw; it < 4096; it += NGW) {
                const bool isq = it < 2048; const int r = it & 2047, h = r >> 8, rt = (r >> 2) & 63, cg = r & 3;
                if (isq) {
                    const int ct = (r >> 5) & 7, kg = r & 31;
                    bf16x8 af[8];
                    { const float* ap = w_uk + (size_t)((ct * 32 + r32) * 8 + h) * 128 + 8 * hh;
#pragma unroll
                      for (int ks = 0; ks < 8; ++ks) CVT8(af[ks], *(const f32x4*)(ap + ks * 16), *(const f32x4*)(ap + ks * 16 + 4)); }
#pragma unroll 1
                    for (int kt = 0; kt < 2; ++kt) { const int k0 = kg * 64 + kt * 32; const float* bp = w_in + (size_t)(k0 + r32) * D_IN + h * 128 + 8 * hh;
                        f32x16 acc;
#pragma unroll
                        for (int i = 0; i < 16; ++i) acc[i] = 0.f;
#pragma unroll
                        for (int ks = 0; ks < 8; ++ks) { bf16x8 bfr; CVT8(bfr, *(const f32x4*)(bp + ks * 16), *(const f32x4*)(bp + ks * 16 + 4)); acc = __builtin_amdgcn_mfma_f32_32x32x16_bf16(af[ks], bfr, acc, 0, 0, 0); }
                        bf16* o = WIN_T + (size_t)(h * 256 + ct * 32 + 4 * hh) * D + k0 + r32;
#pragma unroll
                        for (int i = 0; i < 16; ++i) o[(size_t)((i & 3) + 8 * (i >> 2)) * D] = (bf16)f2bf(acc[i] * 0.08838834764831845f); }
                } else {
                    const float* pj[8];
#pragma unroll
                    for (int j = 0; j < 8; ++j) pj[j] = w_out + (size_t)(h * 128 + 8 * hh + j) * D + rt * 32 + r32;
                    const float* bp0 = w_uv + (size_t)((cg * 64 + r32) * 8 + h) * 128 + 8 * hh; const float* bp1 = bp0 + (size_t)32 * 8 * 128;
                    f32x16 acc0, acc1;
#pragma unroll
                    for (int i = 0; i < 16; ++i) { acc0[i] = 0.f; acc1[i] = 0.f; }
#pragma unroll 2
                    for (int ks = 0; ks < 8; ++ks) { u32x4 w_; w_.x = pk2(*pj[0], *pj[1]); w_.y = pk2(*pj[2], *pj[3]); w_.z = pk2(*pj[4], *pj[5]); w_.w = pk2(*pj[6], *pj[7]); const bf16x8 afr = __builtin_bit_cast(bf16x8, w_);
#pragma unroll
                        for (int j = 0; j < 8; ++j) pj[j] += (size_t)16 * D;
                        bf16x8 b0, b1; CVT8(b0, *(const f32x4*)(bp0 + ks * 16), *(const f32x4*)(bp0 + ks * 16 + 4)); CVT8(b1, *(const f32x4*)(bp1 + ks * 16), *(const f32x4*)(bp1 + ks * 16 + 4));
                        acc0 = __builtin_amdgcn_mfma_f32_32x32x16_bf16(afr, b0, acc0, 0, 0, 0); acc1 = __builtin_amdgcn_mfma_f32_32x32x16_bf16(afr, b1, acc1, 0, 0, 0); }
                    bf16* o = WOUT_T + (size_t)(rt * 32 + 4 * hh) * KMIX + h * 256 + cg * 64 + r32;
#pragma unroll
                    for (int i = 0; i < 16; ++i) { o[(size_t)((i & 3) + 8 * (i >> 2)) * KMIX] = (bf16)f2bf(acc0[i]); o[(size_t)((i & 3) + 8 * (i >> 2)) * KMIX + 32] = (bf16)f2bf(acc1[i]); }
                }
            }
#undef CVT8
        }
        for (int prh_ = 0; prh_ < 1 + PR_H1; ++prh_)
        for (int m = gw; m < T; m += NGW) rms_row_to_bf16(A_->in[I_X] + (size_t)m * D, A_->in[I_NORM_MIX_G], H1 + (size_t)m * D, lane);
        for (int m = gw; m < NMEM; m += NGW) rms_row_to_bf16(A_->in[I_MEM] + (size_t)m * D, A_->in[I_MEM_NORM_G], MEMN + (size_t)m * D, lane);
        GRID_BAR(0);
    }

    if (IN(1)) for (int rep_ = 0; rep_ < NREP(1); ++rep_) {
        PHASE_IDS
        if (rep_) xcd_barrier(bar, tid);
        pg8::DenseOrder S; S.init(T, NPROJ, D, D, G, bx);
        pg8::EpiProj E{QABS, CKVRAW, QI, SMALL, MQKRAW, MV, MO};
        pg8::gemm_phase(tid, lds, H1, WIN_T, D, S, E);
        GRID_BAR(1);
    }

    if (IN(2)) for (int rep_ = 0; rep_ < NREP(2); ++rep_) {
        PHASE_IDS
        if (rep_) xcd_barrier(bar, tid);
#ifndef P2_SUB
#define P2_SUB 15
#endif
        if (P2_SUB & 1) {
            for (int prk_ = 0; prk_ < 1 + PR_KV; ++prk_)
            for (int id = bx; id < 256; id += G) {
                const int rt = id & 3, ct = id >> 2;
                mini_gemm64(lds, MEMN + (size_t)(rt * 64) * D, D, WCKV_T + (size_t)(ct * 64) * D, D, 16, KC + (size_t)(rt * 64) * 4096 + ct * 64, 4096u, wave, lane);
            }
        }
        __syncthreads();
        if (P2_SUB & 4) for (int t = gw; t < T; t += NGW) {
            const f32x4 v = ((const f32x4*)(CKVRAW + (size_t)t * 256))[lane];
            const float r = rsqrtf(wave_sum((v[0] * v[0] + v[1] * v[1]) + (v[2] * v[2] + v[3] * v[3])) * (1.f / 256.f) + EPS);
            const f32x4 g = ((const f32x4*)A_->in[I_KV_NORM_G])[lane];
            u32x2 w; w.x = pk2(v[0] * r * g[0], v[1] * r * g[1]); w.y = pk2(v[2] * r * g[2], v[3] * r * g[3]);
            ((u32x2*)(CKVN + (size_t)t * 256))[lane] = w;
            const float kv = SMALL[(size_t)t * 256 + lane];
            const float rk = rsqrtf(wave_sum(kv * kv) * (1.f / 64.f) + EPS);
            KIDXN[(size_t)t * 64 + lane] = (bf16)f2bf(kv * rk * A_->in[I_KIDX_NORM_G][lane]);
        }
        if (P2_SUB & 8) {
            LAS float* kq = (LAS float*)lds;
            LAS bf16* KWT = (LAS bf16*)(lds + 32768);
            LAS bf16* VTl = (LAS bf16*)(lds + 51200);
            LAS float* sw = (LAS float*)(lds + 98304);
            const float* conv_w = A_->in[I_CONV_W]; const float* conv_b = A_->in[I_CONV_B]; const float* gate_b = A_->in[I_GATE_B];
            const int r32 = lane & 31, hh = lane >> 5;
            for (int prm_ = 0; prm_ < 1 + PR_ML; ++prm_)
            for (int uu = bx; uu < NCH * 4; uu += G) {
                const int c = uu >> 2, h = uu & 3, t0 = c * CH;
                __syncthreads();
                if (wave == 0) {
                    const int t = t0 + lane; const float li = SMALL[(size_t)t * 256 + 72 + h] + gate_b[h]; const float mf = SMALL[(size_t)t * 256 + 76 + h] + gate_b[4 + h];
                    float bsc = fminf(mf, 0.f) - log1pf(__expf(-fabsf(mf)));
#pragma unroll
                    for (int o = 1; o < 64; o <<= 1) { const float v = __shfl_up(bsc, o); if (lane >= o) bsc += v; }
                    const float g = __shfl(bsc, 63); const float dec = g - bsc + li; const float mx = wave_max(dec);
                    sw[lane] = __expf(dec - mx); sw[128 + lane] = li; sw[192 + lane] = bsc;
                    GATES[GT_B + (size_t)t * 4 + h] = bsc; GATES[GT_LI + (size_t)t * 4 + h] = li;
                    if (lane == 0) { GATES[GT_G + c * 4 + h] = g; GATES[GT_MLOC + c * 4 + h] = mx; } }
                __syncthreads();
                { const int ch = tid & 255, th = tid >> 8; const int src = ch < 128 ? h * 128 + ch : 512 + h * 128 + (ch - 128);
                  const float cw0 = conv_w[src], cw1 = conv_w[1024 + src], cw2 = conv_w[2048 + src], cw3 = conv_w[3072 + src], cbias = conv_b[src];
                  const int tb = t0 + th * 32 - 3; float xr[35];
#pragma unroll
                  for (int i = 0; i < 35; ++i) xr[i] = (tb + i >= 0) ? MQKRAW[(size_t)(tb + i) * 1024 + src] : 0.f;
#pragma unroll
                  for (int i = 0; i < 32; ++i) { const int s_ = th * 32 + i, t = t0 + s_; float y = cbias + ((cw0 * xr[i] + cw1 * xr[i + 1]) + (cw2 * xr[i + 2] + cw3 * xr[i + 3]));
                      y = y / (1.f + __expf(-y));
                      if (ch < 128) QCM[(size_t)t * 512 + h * 128 + ch] = (bf16)f2bf(y * 0.08838834764831845f);
                      else { const unsigned kb = f2bf(y); KCM[(size_t)t * 512 + h * 128 + (ch - 128)] = (bf16)kb; const float kf = bf2f(kb); kq[s_ * 128 + (ch - 128)] = kf; KWT[(ch - 128) * 72 + s_] = (bf16)f2bf(sw[s_] * kf); } } }
#pragma unroll 1
                for (int e = tid; e < 64 * 32; e += 512) { const int s = e & 63, c8 = e >> 6; const u32x4 vv = *(const u32x4*)(MV + (size_t)(t0 + s) * 1024 + h * 256 + c8 * 8);
                    LAS bf16* d = VTl + (c8 * 8) * 72 + s;
                    d[0] = (bf16)(vv.x & 0xffffu); d[72] = (bf16)(vv.x >> 16); d[144] = (bf16)(vv.y & 0xffffu); d[216] = (bf16)(vv.y >> 16);
                    d[288] = (bf16)(vv.z & 0xffffu); d[360] = (bf16)(vv.z >> 16); d[432] = (bf16)(vv.w & 0xffffu); d[504] = (bf16)(vv.w >> 16); }
                __syncthreads();
#pragma unroll 1
                for (int e = tid; e < 256 * 8; e += 512) { const int dv = e >> 3, ch = e & 7; *(u32x4*)(VTM + ((size_t)(c * 4 + h) * 256 + dv) * 64 + ch * 8) = *(const LAS u32x4*)(VTl + dv * 72 + ch * 8); }
                {
                    bf16x8 af[4];
#pragma unroll
                    for (int ks = 0; ks < 4; ++ks) af[ks] = *(const LAS bf16x8*)(VTl + (wave * 32 + r32) * 72 + ks * 16 + 8 * hh);
#pragma unroll 1
                    for (int j = 0; j < 4; ++j) { f32x16 acc;
#pragma unroll
                        for (int i = 0; i < 16; ++i) acc[i] = 0.f;
#pragma unroll
                        for (int ks = 0; ks < 4; ++ks) { const bf16x8 bfr = *(const LAS bf16x8*)(KWT + (j * 32 + r32) * 72 + ks * 16 + 8 * hh); acc = __builtin_amdgcn_mfma_f32_32x32x16_bf16(af[ks], bfr, acc, 0, 0, 0); }
                        float* o = LST + ((size_t)(c * 4 + h) * 256 + wave * 32 + 4 * hh) * 128 + j * 32 + r32;
#pragma unroll
                        for (int i = 0; i < 16; ++i) o[(size_t)((i & 3) + 8 * (i >> 2)) * 128] = acc[i]; }
                }
                if (tid < 128) { float a = 0.f;
#pragma unroll 4
                    for (int s = 0; s < 64; ++s) a += sw[s] * kq[s * 128 + tid]; NL[(size_t)(c * 4 + h) * 128 + tid] = a; }
            }
        }
        GRID_BAR(2);
    }

    if (IN(3)) for (int rep_ = 0; rep_ < NREP(3); ++rep_) {
        PHASE_IDS
        if (rep_) xcd_barrier(bar, tid);
#ifndef R_SCAN
#define R_SCAN 1
#endif
        for (int prv_ = 0; prv_ < 1 + PR_VF; ++prv_)
        for (int id = bx; id < 512; id += G) {
            const int h = id >> 7, rt = (id & 127) >> 2, ct = id & 3;
            mini_gemm64(lds, WCO_T + (size_t)(rt * 64) * D + h * 512, D, KC + (size_t)(ct * 64) * 4096 + 2048 + h * 512, 4096u, 4, VF + (size_t)(rt * 64) * 1024 + h * 256 + ct * 64, 1024u, wave, lane);
        }
        for (int prv_ = 0; prv_ < 1 + PR_VF; ++prv_)
        for (int id = bx; id < 512; id += G) {
            const int h = id >> 7, kt = (id & 127) >> 2, mt = id & 3;
            mini_gemm64(lds, KC + (size_t)(mt * 64) * 4096 + h * 512, 4096u, WCQ_T + (size_t)(kt * 64) * D + h * 512, D, 4, MF + (size_t)(h * 256 + mt * 64) * D + kt * 64, D, wave, lane);
        }
        for (int rscan_ = 0; rscan_ < R_SCAN; ++rscan_) {
            LAS float* am = (LAS float*)lds;
            LAS float* sm = am + 512;
            LAS float* gl = am + 1024;
            __syncthreads();
            gl[tid] = GATES[GT_G + tid]; gl[512 + tid] = GATES[GT_MLOC + tid];
            __syncthreads();
            if (tid < 4) { float m = 0.f;
#pragma unroll 1
                for (int k = 0; k < NCH; ++k) { const float g = gl[k * 4 + tid], ml = gl[512 + k * 4 + tid]; const float mn = fmaxf(g + m, ml);
                    am[tid * 128 + k] = __expf(g + m - mn); sm[tid * 128 + k] = __expf(ml - mn); if (bx == 0) GATES[GT_MPREV + k * 4 + tid] = m; m = mn; } }
            __syncthreads();
            for (int e = bx * 512 + tid; e < 4 * 32768; e += G * 512) { const int h = e >> 15, rem = e & 32767; float C = 0.f;
#pragma unroll 1
                for (int kb = 0; kb < NCH; kb += 32) { float l[32];
#pragma unroll
                    for (int i = 0; i < 32; ++i) l[i] = __builtin_nontemporal_load(LST + (size_t)((kb + i) * 4 + h) * 32768 + rem);
#pragma unroll
                    for (int i = 0; i < 32; ++i) { const int k = kb + i; CST[(size_t)(k * 4 + h) * 32768 + rem] = (bf16)f2bf(C); C = am[h * 128 + k] * C + sm[h * 128 + k] * l[i]; } } }
            if (bx == 0) { const int h = tid >> 7, dk = tid & 127; float n = 0.f;
#pragma unroll 1
                for (int kb = 0; kb < NCH; kb += 16) { float l[16];
#pragma unroll
                    for (int i = 0; i < 16; ++i) l[i] = NL[(size_t)((kb + i) * 4 + h) * 128 + dk];
#pragma unroll
                    for (int i = 0; i < 16; ++i) { const int k = kb + i; NST[(size_t)(k * 4 + h) * 128 + dk] = n; n = am[h * 128 + k] * n + sm[h * 128 + k] * l[i]; } } }
            __syncthreads();
        }
        {
            const int r32 = lane & 31, hh = lane >> 5;
            for (int L = bx; L < 1152; L += G) {
                int sl = 0, rem = L;
#pragma unroll 1
                while (rem >= 256 - 32 * sl) { rem -= 256 - 32 * sl; ++sl; }
                const int g = 32 * sl + rem, c = g >> 1, tq0 = g * 32 + wave * 4, N = 64 * (c + 1);
                const int jb = sl * 32, je = (N >> 5) < jb + 32 ? (N >> 5) : jb + 32;
                if (N <= 256) continue;
                unsigned short* rowb = (c < 127 ? (unsigned short*)A_->out + (size_t)2048 * c * (c + 1) : (unsigned short*)(ws + WS_SC127)) + (size_t)(tq0 & 63) * N + jb * 32;
                LAS unsigned short* stg = (LAS unsigned short*)(lds + wave * 8192);
                bf16x8 af[4]; float wq[16];
                { const bf16* qp = QI + (size_t)(tq0 + (r32 >> 3)) * 512 + (r32 & 7) * 64 + 8 * hh;
#pragma unroll
                  for (int ks = 0; ks < 4; ++ks) af[ks] = *(const bf16x8*)(qp + ks * 16);
#pragma unroll
                  for (int qq = 0; qq < 4; ++qq)
#pragma unroll
                      for (int i = 0; i < 4; ++i) wq[qq * 4 + i] = SMALL[(size_t)(tq0 + qq) * 256 + 64 + 4 * hh + i] * 0.04419417382415922f; }
#define IDX_GROUP(gi_) do { const int tile_ = jb + (gi_) * 8 + wave; if (tile_ < je) { _Pragma("unroll") for (int i4 = 0; i4 < 4; ++i4) { const int row_ = i4 * 8 + (lane >> 3); \
                        const bf16* gsrc_ = KIDXN + (size_t)(tile_ * 32 + row_) * 64 + (((lane & 7) ^ (row_ & 7)) * 8); \
                        const unsigned ldst_ = __builtin_amdgcn_readfirstlane((unsigned)(size_t)lds + 65536u + (unsigned)(((gi_) & 1) * 32768 + wave * 4096 + i4 * 1024)); unsigned keep_; \
                        asm volatile("s_mov_b32 %0, m0\n\ts_mov_b32 m0, %2\n\ts_nop 0\n\tglobal_load_lds_dwordx4 %1, off\n\ts_mov_b32 m0, %0" : "=&s"(keep_) : "v"(gsrc_), "s"(ldst_) : "memory"); } } } while (0)
#define IDX_LOAD(buf, gi_, tl_) do { const LAS unsigned char* kt_ = lds + 65536 + ((gi_) & 1) * 32768 + (tl_) * 4096 + r32 * 128; \
                    _Pragma("unroll") for (int ks = 0; ks < 4; ++ks) buf[ks] = *(const LAS bf16x8*)(kt_ + (((ks * 2 + hh) ^ (r32 & 7)) * 16)); } while (0)
#define RELU_(x_) __int_as_float(max(__float_as_int(x_), 0))
#define IDX_TILE(buf, jj) do { const int s0 = (jj) * 32; f32x16 acc; _Pragma("unroll") for (int i = 0; i < 16; ++i) acc[i] = 0.f; \
                        _Pragma("unroll") for (int ks = 0; ks < 4; ++ks) acc = __builtin_amdgcn_mfma_f32_32x32x16_bf16(af[ks], buf[ks], acc, 0, 0, 0); \
                        if (PR_MFMA) { f32x16 acc2; _Pragma("unroll") for (int i = 0; i < 16; ++i) acc2[i] = 0.f; _Pragma("unroll") for (int ks = 0; ks < 4; ++ks) acc2 = __builtin_amdgcn_mfma_f32_32x32x16_bf16(af[ks], buf[ks], acc2, 0, 0, 0); asm volatile("" :: "v"(acc2)); } \
                        if (PR_EPI) { f32x16 a3 = acc; asm volatile("" : "+v"(a3)); float p3[4]; _Pragma("unroll") for (int qq = 0; qq < 4; ++qq) p3[qq] = (wq[qq * 4] * fmaxf(a3[qq * 4], 0.f) + wq[qq * 4 + 1] * fmaxf(a3[qq * 4 + 1], 0.f)) + (wq[qq * 4 + 2] * fmaxf(a3[qq * 4 + 2], 0.f) + wq[qq * 4 + 3] * fmaxf(a3[qq * 4 + 3], 0.f)); \
                            _Pragma("unroll") for (int qq = 0; qq < 4; ++qq) p3[qq] += __shfl_xor(p3[qq], 32); asm volatile("" :: "v"(p3[0]), "v"(p3[1]), "v"(p3[2]), "v"(p3[3])); } \
                        float part[4]; \
                          \
                        _Pragma("unroll") for (int qq = 0; qq < 4; ++qq) part[qq] = (wq[qq * 4] * RELU_(acc[qq * 4]) + wq[qq * 4 + 1] * RELU_(acc[qq * 4 + 1])) + (wq[qq * 4 + 2] * RELU_(acc[qq * 4 + 2]) + wq[qq * 4 + 3] * RELU_(acc[qq * 4 + 3])); \
                        const auto s02_ = __builtin_amdgcn_permlane32_swap(__float_as_uint(part[0]), __float_as_uint(part[2]), false, false), s13_ = __builtin_amdgcn_permlane32_swap(__float_as_uint(part[1]), __float_as_uint(part[3]), false, false); \
                          \
                        const float v0 = __uint_as_float(s02_[0]) + __uint_as_float(s02_[1]), v1 = __uint_as_float(s13_[0]) + __uint_as_float(s13_[1]); \
                        unsigned u0 = __builtin_bit_cast(unsigned short, (_Float16)v0), u1 = __builtin_bit_cast(unsigned short, (_Float16)v1); \
                        u0 = (u0 == 0x8000u) ? 0u : u0; u1 = (u1 == 0x8000u) ? 0u : u1; \
                        stg[(2 * hh) * 1024 + s0 - jb * 32 + r32] = (unsigned short)((u0 & 0x8000u) ? ~u0 : (u0 | 0x8000u)); \
                        stg[(2 * hh + 1) * 1024 + s0 - jb * 32 + r32] = (unsigned short)((u1 & 0x8000u) ? ~u1 : (u1 | 0x8000u)); } while (0)
                { const int ngrp = (je - jb + 7) >> 3;
                  __syncthreads();
                  IDX_GROUP(0);
#pragma unroll 1
                  for (int gi = 0; gi < ngrp; ++gi) {
                      asm volatile("s_waitcnt vmcnt(0)" ::: "memory");
                      __syncthreads();
                      if (gi + 1 < ngrp) IDX_GROUP(gi + 1);
#pragma unroll 2
                      for (int tl = 0; tl < 8; ++tl) { const int jt = jb + gi * 8 + tl; if (jt < je) { bf16x8 kbf[4]; IDX_LOAD(kbf, gi, tl); IDX_TILE(kbf, jt); } }
                  } }
#undef IDX_GROUP
#undef IDX_LOAD
#undef IDX_TILE
                LDS_WAIT(); asm volatile("" ::: "memory");
                { const int nk = (je - jb) * 32, np = nk >> 3;
                  for (int i = lane; i < 4 * np; i += 64) { const int qq = i / np, p = i - qq * np; *(u32x4*)(rowb + (size_t)qq * N + p * 8) = *(const LAS u32x4*)(stg + qq * 1024 + p * 8); } }
                LDS_WAIT(); asm volatile("" ::: "memory");
            }
        }
        GRID_BAR(3);
    }
    if (IN(4)) for (int rep_ = 0; rep_ < NREP(4); ++rep_) {
        PHASE_IDS
        if (rep_) xcd_barrier(bar, tid);
        {
            LAS int* hist = (LAS int*)(lds + MISC_OFF + 4096) + wave * 256;
            LAS int* sel = (LAS int*)(lds + MISC_OFF + 12288) + wave * 256;
            const int r16 = lane & 15, g4 = lane >> 4;
            __syncthreads();
#pragma unroll 1
            for (int ui_ = 0; ui_ * G < T / 8; ++ui_) {
                const int uu = ui_ * G + ((ui_ & 1) ? (G - 1 - bx) : bx); if (uu >= T / 8) continue;
                const int t0 = uu * 8, t = t0 + wave, c = t0 >> 6, N = (c + 1) * 64, ng = N >> 6;
                {
                        if (N > 256) {
                            const unsigned short* rb = (c < 127 ? (const unsigned short*)A_->out + (size_t)2048 * c * (c + 1) : (const unsigned short*)(ws + WS_SC127)) + (size_t)(t & 63) * N;
                            unsigned kr[128];
#pragma unroll
                            for (int b8 = 0; b8 < 16; ++b8) {
#pragma unroll
                                for (int i = 0; i < 8; ++i) kr[b8 * 8 + i] = 0u;
                                if (b8 * 8 < ng) { const bool ok = b8 * 512 + lane * 8 < N;
                                    u32x4 v = *(const GAS u32x4*)(rb + (ok ? b8 * 512 + lane * 8 : 0)); if (!ok) v = (u32x4){0u, 0u, 0u, 0u};
                                    kr[b8 * 8 + 0] = v.x & 0xffffu; kr[b8 * 8 + 1] = v.x >> 16; kr[b8 * 8 + 2] = v.y & 0xffffu; kr[b8 * 8 + 3] = v.y >> 16;
                                    kr[b8 * 8 + 4] = v.z & 0xffffu; kr[b8 * 8 + 5] = v.z >> 16; kr[b8 * 8 + 6] = v.w & 0xffffu; kr[b8 * 8 + 7] = v.w >> 16; } }
                            int krem = 256; unsigned prefix = 0u;
#pragma unroll 1
                            for (int ps = 0; ps < 2; ++ps) { const int shift = 8 - 8 * ps;
                                hist[lane] = 0; hist[64 + lane] = 0; hist[128 + lane] = 0; hist[192 + lane] = 0;
#pragma unroll
                                for (int b8 = 0; b8 < 16; ++b8) { if (b8 * 8 < ng) {
#pragma unroll
                                    for (int i = 0; i < 8; ++i) { const unsigned k = kr[b8 * 8 + i]; const bool mt = (k != 0u) && (ps == 0 || (k >> 8) == prefix);
                                        if (mt) __hip_atomic_fetch_add(hist + (int)((k >> shift) & 255u), 1, __ATOMIC_RELAXED, __HIP_MEMORY_SCOPE_WORKGROUP); } } }
                                const int h0 = hist[4 * lane], h1 = hist[4 * lane + 1], h2 = hist[4 * lane + 2], h3 = hist[4 * lane + 3];
                                int sfx = h0 + h1 + h2 + h3;
#pragma unroll
                                for (int o = 1; o < 64; o <<= 1) { const int v = __shfl_down(sfx, o); if (lane + o < 64) sfx += v; }
                                const unsigned long long mge = __ballot(sfx >= krem);
                                const int ls = 63 - __builtin_clzll(mge);
                                const int above_l = (ls < 63) ? __builtin_amdgcn_readlane(sfx, (ls + 1) & 63) : 0;
                                const int b1 = __builtin_amdgcn_readlane(h1, ls), b2 = __builtin_amdgcn_readlane(h2, ls), b3 = __builtin_amdgcn_readlane(h3, ls);
                                int dg, above;
                                if (above_l + b3 >= krem) { dg = 3; above = above_l; } else if (above_l + b3 + b2 >= krem) { dg = 2; above = above_l + b3; }
                                else if (above_l + b3 + b2 + b1 >= krem) { dg = 1; above = above_l + b3 + b2; } else { dg = 0; above = above_l + b3 + b2 + b1; }
                                krem -= above; prefix = (prefix << 8) | (unsigned)(4 * ls + dg); }
                            const unsigned thr = prefix;
                            int ngt = 0;
#pragma unroll
                            for (int b8 = 0; b8 < 16; ++b8) { if (b8 * 8 < ng) {
#pragma unroll
                                for (int i = 0; i < 8; ++i) ngt += __popcll(__ballot(kr[b8 * 8 + i] > thr)); __builtin_amdgcn_sched_barrier(0); } }
                            const int need = 256 - ngt; int pg = 0, pe = 0; const unsigned long long ltm = (1ull << lane) - 1ull;
#pragma unroll
                            for (int b8 = 0; b8 < 16; ++b8) { if (b8 * 8 < ng) {
#pragma unroll
                                for (int i = 0; i < 8; ++i) { const int ri = b8 * 8 + i; const unsigned k = kr[ri]; const bool gt = k > thr, eq = k == thr;
                                    const unsigned long long mg = __ballot(gt), me = __ballot(eq); const int sidx = b8 * 512 + lane * 8 + i;
                                    if (gt) sel[pg + __popcll(mg & ltm)] = sidx;
                                    const int r = pe + __popcll(me & ltm); if (eq && r < need) sel[ngt + r] = sidx;
                                    pg += __popcll(mg); pe += __popcll(me); if ((i & 3) == 3) __builtin_amdgcn_sched_barrier(0); } } }
                        } else {
#pragma unroll
                            for (int i = 0; i < 4; ++i) sel[i * 64 + lane] = i * 64 + lane;
                        }
                        LDS_WAIT(); asm volatile("" ::: "memory");
                }
                {
                        LAS unsigned char* cb = lds + wave * 16384;
                        const int nch = (N > 256 ? 256 : N) >> 5;
                        bf16x8 qf[8];
                        { const bf16* qp = QABS + (size_t)t * 2048 + (r16 & 7) * 256 + 8 * g4;
#pragma unroll
                          for (int ks = 0; ks < 8; ++ks) qf[ks] = *(const bf16x8*)(qp + ks * 32); }
                        f32x4 O[16];
#pragma unroll
                        for (int i = 0; i < 16; ++i) O[i] = (f32x4){0.f, 0.f, 0.f, 0.f};
                        float mrun = -3.0e38f, lrun = 0.f;
                        const int tq = r16 >> 2, tp = r16 & 3;
#pragma unroll 1
                        for (int ch = 0; ch < nch; ++ch) { const int slot0 = ch * 32;
#pragma unroll
                            for (int k = 0; k < 16; ++k) { const int im = k >> 3, row = (k & 7) * 4 + g4; const int lc = r16 ^ (((row & 3) << 2) | ((row >> 2) & 3)); const int key = sel[slot0 + row];
                                __builtin_amdgcn_global_load_lds((const unsigned*)(CKVN + (size_t)key * 256 + im * 128 + lc * 8), (LAS unsigned*)(cb + im * 8192 + (k & 7) * 1024), 16, 0, 0); }
                            asm volatile("s_waitcnt vmcnt(0)" ::: "memory");
                            const LAS unsigned char* cbc = cb;
                            f32x4 s0 = (f32x4){0.f, 0.f, 0.f, 0.f}, s1 = s0;
#pragma unroll
                            for (int ks = 0; ks < 8; ++ks) { const int im = ks >> 2, lc = 4 * (ks & 3) + g4;
                                const int ra = r16, rb = 16 + r16;
                                const bf16x8 k0 = *(const LAS bf16x8*)(cbc + im * 8192 + 256 * ra + 16 * (lc ^ (((ra & 3) << 2) | ((ra >> 2) & 3))));
                                const bf16x8 k1 = *(const LAS bf16x8*)(cbc + im * 8192 + 256 * rb + 16 * (lc ^ (((rb & 3) << 2) | ((rb >> 2) & 3))));
                                s0 = __builtin_amdgcn_mfma_f32_16x16x32_bf16(k0, qf[ks], s0, 0, 0, 0); s1 = __builtin_amdgcn_mfma_f32_16x16x32_bf16(k1, qf[ks], s1, 0, 0, 0);
                                if ((ks & 1) == 1) __builtin_amdgcn_sched_barrier(0); }
                            float mx = fmaxf(fmaxf(fmaxf(s0[0], s0[1]), fmaxf(s0[2], s0[3])), fmaxf(fmaxf(s1[0], s1[1]), fmaxf(s1[2], s1[3])));
                            mx = fmaxf(mx, __shfl_xor(mx, 16)); mx = fmaxf(mx, __shfl_xor(mx, 32));
                            const float mnew = fmaxf(mrun, mx), alpha = __expf(mrun - mnew); mrun = mnew;
                            float p[8]; float ls = 0.f;
#pragma unroll
                            for (int i = 0; i < 4; ++i) { p[i] = __expf(s0[i] - mnew); p[4 + i] = __expf(s1[i] - mnew); ls += p[i] + p[4 + i]; }
                            ls += __shfl_xor(ls, 16); ls += __shfl_xor(ls, 32);
                            lrun = lrun * alpha + ls;
                            u32x4 pw; pw.x = pk2(p[0], p[1]); pw.y = pk2(p[2], p[3]); pw.z = pk2(p[4], p[5]); pw.w = pk2(p[6], p[7]);
                            const bf16x8 pf = __builtin_bit_cast(bf16x8, pw);
#pragma unroll
                            for (int i = 0; i < 16; ++i) O[i] = O[i] * alpha;
                            const unsigned cbase = (unsigned)(size_t)cbc + 256u * (4 * g4 + tq) + 8u * (tp & 1);
#pragma unroll
                            for (int cq = 0; cq < 4; ++cq) {
                                u32x2 va[4], vb[4]; unsigned ad[4];
#pragma unroll
                                for (int j = 0; j < 4; ++j) { const int ct = cq * 4 + j; ad[j] = cbase + (unsigned)((ct >> 3) * 8192) + 16u * ((2 * (ct & 7) + (tp >> 1)) ^ ((tq << 2) | g4)); }
                                asm volatile("ds_read_b64_tr_b16 %0, %8\n\tds_read_b64_tr_b16 %1, %8 offset:4096\n\tds_read_b64_tr_b16 %2, %9\n\tds_read_b64_tr_b16 %3, %9 offset:4096\n\t"
                                             "ds_read_b64_tr_b16 %4, %10\n\tds_read_b64_tr_b16 %5, %10 offset:4096\n\tds_read_b64_tr_b16 %6, %11\n\tds_read_b64_tr_b16 %7, %11 offset:4096\n\ts_waitcnt lgkmcnt(0)"
                                             : "=&v"(va[0]), "=&v"(vb[0]), "=&v"(va[1]), "=&v"(vb[1]), "=&v"(va[2]), "=&v"(vb[2]), "=&v"(va[3]), "=&v"(vb[3])
                                             : "v"(ad[0]), "v"(ad[1]), "v"(ad[2]), "v"(ad[3]) : "memory");
#pragma unroll
                                for (int j = 0; j < 4; ++j) { u32x4 vv; vv.x = va[j].x; vv.y = va[j].y; vv.z = vb[j].x; vv.w = vb[j].y;
                                    O[cq * 4 + j] = __builtin_amdgcn_mfma_f32_16x16x32_bf16(__builtin_bit_cast(bf16x8, vv), pf, O[cq * 4 + j], 0, 0, 0); } }
                        }
                        const float inv = 1.f / lrun;
                        if (r16 < 8) {
#pragma unroll
                            for (int i = 0; i < 16; ++i) { u32x2 w; w.x = pk2(O[i][0] * inv, O[i][1] * inv); w.y = pk2(O[i][2] * inv, O[i][3] * inv); *(u32x2*)(MIXIN + (size_t)t * KMIX + r16 * 256 + i * 16 + 4 * g4) = w; } }
                }
            }
        }
        __syncthreads();
    }

    if (IN(4)) for (int rep_ = 0; rep_ < NREP(4); ++rep_) {
        PHASE_IDS
        if (rep_) xcd_barrier(bar, tid);
        LAS float* Sf = (LAS float*)lds;
        LAS bf16* Sb = (LAS bf16*)(lds + 16640);
        LAS float* ms = (LAS float*)(lds + 25856);
        LAS float* ssq = (LAS float*)(lds + 27904);
        const float* mlg = A_->in[I_ML_NORM_G];
        const int r32 = lane & 31, hh = lane >> 5;
        for (int uu = bx; uu < NCH * 4; uu += G) {
            const int c = uu >> 2, h = uu & 3, t0 = c * CH;
            __syncthreads();
            if (tid < 64) { const float b = GATES[GT_B + (size_t)(t0 + tid) * 4 + h], li = GATES[GT_LI + (size_t)(t0 + tid) * 4 + h]; ms[tid] = b; ms[64 + tid] = li - b; }
            if (tid < 128) ms[384 + tid] = NST[(size_t)(c * 4 + h) * 128 + tid];
            __syncthreads();
            float mt = 0.f;
            if (wave == 0) { const float mprev = GATES[GT_MPREV + c * 4 + h]; float pm = ms[64 + lane];
#pragma unroll
                for (int o = 1; o < 64; o <<= 1) { const float v = __shfl_up(pm, o); if (lane >= o) pm = fmaxf(pm, v); }
                const float mm = fmaxf(mprev, pm); mt = ms[lane] + mm; ms[128 + lane] = -mm; ms[192 + lane] = __expf(mprev - mm);
                float qn = 0.f; const bf16* qr = QCM + (size_t)(t0 + lane) * 512 + h * 128; u32x4 qq[16];
#pragma unroll
                for (int k8 = 0; k8 < 16; ++k8) qq[k8] = *(const u32x4*)(qr + k8 * 8);
#pragma unroll
                for (int k8 = 0; k8 < 16; ++k8) { const LAS float* np = ms + 384 + k8 * 8;
                    qn += (bf2f(qq[k8].x & 0xffffu) * np[0] + bf2f(qq[k8].x >> 16) * np[1]) + (bf2f(qq[k8].y & 0xffffu) * np[2] + bf2f(qq[k8].y >> 16) * np[3]) + (bf2f(qq[k8].z & 0xffffu) * np[4] + bf2f(qq[k8].z >> 16) * np[5]) + (bf2f(qq[k8].w & 0xffffu) * np[6] + bf2f(qq[k8].w >> 16) * np[7]); }
                ms[320 + lane] = qn; }
            __syncthreads();
            if (wave < 4) {
                const int tm = wave >> 1, tn = wave & 1;
                f32x16 acc;
#pragma unroll
                for (int i = 0; i < 16; ++i) acc[i] = 0.f;
                if (tn <= tm) { const bf16* qr = QCM + (size_t)(t0 + tm * 32 + r32) * 512 + h * 128 + 8 * hh; const bf16* kr = KCM + (size_t)(t0 + tn * 32 + r32) * 512 + h * 128 + 8 * hh;
#pragma unroll
                    for (int ks = 0; ks < 8; ++ks) acc = __builtin_amdgcn_mfma_f32_32x32x16_bf16(*(const bf16x8*)(qr + ks * 16), *(const bf16x8*)(kr + ks * 16), acc, 0, 0, 0); }
                const int sidx = tn * 32 + r32; const float us = ms[64 + sidx];
#pragma unroll
                for (int i = 0; i < 16; ++i) { const int t = tm * 32 + (i & 3) + 8 * (i >> 2) + 4 * hh; const float v = (sidx <= t) ? acc[i] * __expf(ms[128 + t] + us) : 0.f; Sf[t * 65 + sidx] = v; Sb[t * 72 + sidx] = (bf16)f2bf(v); }
            }
            __syncthreads();
            if (tid < 64) { float rs = 0.f;
#pragma unroll 4
                for (int s2 = 0; s2 < 64; ++s2) rs += Sf[tid * 65 + s2];
                const float dn = ms[192 + tid] * ms[320 + tid] + rs; ms[256 + tid] = fmaxf(fabsf(dn), __expf(-mt)); }
            f32x16 a1[2], a2[2];
#pragma unroll
            for (int tt = 0; tt < 2; ++tt)
#pragma unroll
                for (int i = 0; i < 16; ++i) { a1[tt][i] = 0.f; a2[tt][i] = 0.f; }
            { const bf16* cr = CST + ((size_t)(c * 4 + h) * 256 + wave * 32 + r32) * 128 + 8 * hh; const bf16* q0 = QCM + (size_t)(t0 + r32) * 512 + h * 128 + 8 * hh; const bf16* q1 = q0 + (size_t)32 * 512;
#pragma unroll
              for (int ks = 0; ks < 8; ++ks) { const bf16x8 cf = *(const bf16x8*)(cr + ks * 16); a1[0] = __builtin_amdgcn_mfma_f32_32x32x16_bf16(cf, *(const bf16x8*)(q0 + ks * 16), a1[0], 0, 0, 0); a1[1] = __builtin_amdgcn_mfma_f32_32x32x16_bf16(cf, *(const bf16x8*)(q1 + ks * 16), a1[1], 0, 0, 0); }
              const bf16* vr = VTM + ((size_t)(c * 4 + h) * 256 + wave * 32 + r32) * 64 + 8 * hh;
#pragma unroll
              for (int ks = 0; ks < 4; ++ks) { const bf16x8 vf = *(const bf16x8*)(vr + ks * 16); a2[0] = __builtin_amdgcn_mfma_f32_32x32x16_bf16(vf, *(const LAS bf16x8*)(Sb + r32 * 72 + ks * 16 + 8 * hh), a2[0], 0, 0, 0); a2[1] = __builtin_amdgcn_mfma_f32_32x32x16_bf16(vf, *(const LAS bf16x8*)(Sb + (32 + r32) * 72 + ks * 16 + 8 * hh), a2[1], 0, 0, 0); } }
            __syncthreads();
#pragma unroll
            for (int tt = 0; tt < 2; ++tt) { const int t = tt * 32 + r32; const float ai = ms[192 + t], idn = 1.f / ms[256 + t]; float p = 0.f;
#pragma unroll
                for (int i = 0; i < 16; ++i) { const float v = (ai * a1[tt][i] + a2[tt][i]) * idn; a1[tt][i] = v; p += v * v; }
                p += __shfl_xor(p, 32); if (hh == 0) ssq[wave * 64 + t] = p; }
            __syncthreads();
#pragma unroll
            for (int tt = 0; tt < 2; ++tt) { const int t = tt * 32 + r32; float sq = 0.f;
#pragma unroll
                for (int w2 = 0; w2 < 8; ++w2) sq += ssq[w2 * 64 + t];
                const float r = rsqrtf(sq * (1.f / 256.f) + EPS);
#pragma unroll
                for (int rq = 0; rq < 4; ++rq) { const int dv0 = h * 256 + wave * 32 + 8 * rq + 4 * hh; const f32x4 g = *(const f32x4*)(mlg + dv0); const u32x2 ob = *(const u32x2*)(MO + (size_t)(t0 + t) * 1024 + dv0);
                    const float o0 = bf2f(ob.x & 0xffffu), o1 = bf2f(ob.x >> 16), o2 = bf2f(ob.y & 0xffffu), o3 = bf2f(ob.y >> 16);
                    u32x2 w; w.x = pk2(a1[tt][4 * rq] * r * g[0] / (1.f + __expf(-o0)), a1[tt][4 * rq + 1] * r * g[1] / (1.f + __expf(-o1))); w.y = pk2(a1[tt][4 * rq + 2] * r * g[2] / (1.f + __expf(-o2)), a1[tt][4 * rq + 3] * r * g[3] / (1.f + __expf(-o3)));
                    *(u32x2*)(MIXIN + (size_t)(t0 + t) * KMIX + 2048 + dv0) = w; } }
        }
        GRID_BAR(4);
    }

    if (IN(6)) for (int rep_ = 0; rep_ < NREP(6); ++rep_) {
        PHASE_IDS
        if (rep_) xcd_barrier(bar, tid);
        pg8::DenseOrder S; S.init(T, D, KMIX, KMIX, G, bx);
        pg8::EpiResidT<false> E{A_->in[I_X], X1B, SS2};
        pg8::gemm_phase(tid, lds, MIXIN, WOUT_T, KMIX, S, E);
        GRID_BAR(6);
    }
    if (IN(7)) for (int rep_ = 0; rep_ < NREP(7); ++rep_) {
        PHASE_IDS
        if (rep_) xcd_barrier(bar, tid);
        pg8::DenseOrder S; S.init(T, 1024, D, D, G, bx);
        pg8::EpiSoftmax E{PB, SS2};
        pg8::gemm_phase(tid, lds, X1B, MF, D, S, E);
        GRID_BAR(7);
    }
    if (IN(10)) for (int rep_ = 0; rep_ < NREP(10); ++rep_) {
        PHASE_IDS
        if (rep_) xcd_barrier(bar, tid);
        pg8::DenseOrder S; S.init(T, D, 1024, 1024, G, bx);
        pg8::EpiResidT<true> E{X1B, X2B, nullptr};
        pg8::gemm_phase(tid, lds, PB, VF, 1024, S, E);
        GRID_BAR(10);
    }
    if (IN(11)) for (int rep_ = 0; rep_ < NREP(11); ++rep_) {
        PHASE_IDS
        if (rep_) xcd_barrier(bar, tid);
        LAS float* part = (LAS float*)lds;
        LAS float* ssp = (LAS float*)(lds + 24576);
        LAS int* eb = (LAS int*)(lds + 24576 + 512);
        const int r16 = lane & 15, g4 = lane >> 4;
        for (int uu = bx; uu < T / 32; uu += G) {
            const int t0 = uu * 32; const int tt = wave & 1, ksl = wave >> 1;
            __syncthreads();
            {
                f32x4 acc[3];
#pragma unroll
                for (int i = 0; i < 3; ++i) acc[i] = (f32x4){0.f, 0.f, 0.f, 0.f};
                float ssq = 0.f;
                const bf16* xr = X2B + (size_t)(t0 + tt * 16 + r16) * D + ksl * 512 + 8 * g4;
                const bf16* wh = WRH + (size_t)r16 * D + ksl * 512 + 8 * g4; const bf16* wl = WRL + (size_t)r16 * D + ksl * 512 + 8 * g4;
#pragma unroll 4
                for (int ks = 0; ks < 16; ++ks) { const u32x4 xa = *(const u32x4*)(xr + ks * 32);
                    { const float f0 = bf2f(xa.x & 0xffffu), f1 = bf2f(xa.x >> 16), f2 = bf2f(xa.y & 0xffffu), f3 = bf2f(xa.y >> 16), f4 = bf2f(xa.z & 0xffffu), f5 = bf2f(xa.z >> 16), f6 = bf2f(xa.w & 0xffffu), f7 = bf2f(xa.w >> 16);
                      ssq += ((f0 * f0 + f1 * f1) + (f2 * f2 + f3 * f3)) + ((f4 * f4 + f5 * f5) + (f6 * f6 + f7 * f7)); }
                    const bf16x8 Ah = __builtin_bit_cast(bf16x8, xa);
#pragma unroll
                    for (int nt = 0; nt < 3; ++nt) { const bf16x8 Bh = *(const bf16x8*)(wh + (size_t)nt * 16 * D + ks * 32), Bl = *(const bf16x8*)(wl + (size_t)nt * 16 * D + ks * 32);
                        acc[nt] = __builtin_amdgcn_mfma_f32_16x16x32_bf16(Ah, Bh, acc[nt], 0, 0, 0); acc[nt] = __builtin_amdgcn_mfma_f32_16x16x32_bf16(Ah, Bl, acc[nt], 0, 0, 0); } }
#pragma unroll
                for (int nt = 0; nt < 3; ++nt)
#pragma unroll
                    for (int i = 0; i < 4; ++i) part[(ksl * 32 + tt * 16 + 4 * g4 + i) * 48 + nt * 16 + r16] = acc[nt][i];
                ssq += __shfl_xor(ssq, 16); ssq += __shfl_xor(ssq, 32);
                if (g4 == 0) ssp[ksl * 32 + tt * 16 + r16] = ssq;
            }
            __syncthreads();
            int e1 = 0, e2 = 0;
            if (tid < 32) { const int t = t0 + tid; const float rstd = rsqrtf((ssp[tid] + ssp[32 + tid] + ssp[64 + tid] + ssp[96 + tid]) * (1.f / D) + EPS);
                const LAS float* p0 = part + tid * 48;
#define LG(o) ((p0[(o)] + p0[32 * 48 + (o)] + p0[64 * 48 + (o)] + p0[96 * 48 + (o)]) * rstd)
                int gs = 0; float gmax = LG(0) + A_->in[I_B_GROUP][0]; float gv[4]; gv[0] = gmax;
#pragma unroll
                for (int i = 1; i < 4; ++i) { gv[i] = LG(i) + A_->in[I_B_GROUP][i]; if (gv[i] > gmax) { gmax = gv[i]; gs = i; } }
                float gsum = 0.f;
#pragma unroll
                for (int i = 0; i < 4; ++i) gsum += __expf(gv[i] - gmax);
                const float pg = 1.f / gsum;
                int i1 = 0, i2 = 0; float v1 = -3.0e38f, v2 = -3.0e38f;
#pragma unroll 1
                for (int i = 0; i < 8; ++i) { const float ev = LG(4 + gs * 8 + i) + A_->in[I_B_ROUTER][gs * 8 + i];
                    if (ev > v1) { v2 = v1; i2 = i1; v1 = ev; i1 = i; } else if (ev > v2) { v2 = ev; i2 = i; } }
#undef LG
                const float p2 = __expf(v2 - v1); const float g1 = pg / (1.f + p2), g2 = pg * p2 / (1.f + p2);
                e1 = gs * 8 + i1; e2 = gs * 8 + i2;
                eb[2 * tid] = e1; eb[2 * tid + 1] = e2;
                TOKW[2 * t] = g1; TOKW[2 * t + 1] = g2; RSTD3[t] = rstd; }
            __syncthreads();
            LAS int* ebase = eb + 64;
            if (tid >= 64 && tid < 96) { const int e = tid - 64; int c = 0;
#pragma unroll 1
                for (int a2 = 0; a2 < 64; ++a2) c += (eb[a2] == e) ? 1 : 0;
                ebase[e] = c ? atomicAdd(CNT + e, c) : 0; }
            __syncthreads();
            if (tid < 64) { const int e = eb[tid]; int rk = 0;
#pragma unroll 1
                for (int a2 = 0; a2 < tid; ++a2) rk += (eb[a2] == e) ? 1 : 0;
                const int slot = ebase[e] + rk; LIST[e * T + slot] = t0 + (tid >> 1); TOKE[2 * t0 + tid] = e * T + slot; }
        }
        GRID_BAR(11);
    }
    volatile LAS int* cnl = (volatile LAS int*)(MISC + 64); volatile LAS int* prel = (volatile LAS int*)(MISC + 128); volatile LAS int* tbl = (volatile LAS int*)(MISC + 192);
    volatile LAS int* mtl = (volatile LAS int*)(MISC + 256); volatile LAS int* tlr = (volatile LAS int*)(MISC + 288); volatile LAS int* tpre = (volatile LAS int*)(MISC + 320); volatile LAS int* fll = (volatile LAS int*)(MISC + 384);
    constexpr int MOE_TAIL = 96;
#define MOE_TABLES(ncol) do { __syncthreads(); if (tid < 64) { const int e = tid & 31; const int c = __hip_atomic_load(CNT + e, __ATOMIC_RELAXED, __HIP_MEMORY_SCOPE_AGENT);     \
        const int full = c >> 8, mt = (c + 255) >> 8; int p = mt * (ncol), tb = mt; \
        _Pragma("unroll") for (int d_ = 1; d_ < 32; d_ <<= 1) { const int q_ = __shfl_up(p, d_), r_ = __shfl_up(tb, d_); if (e >= d_) { p += q_; tb += r_; } } \
        if (tid < 32) { cnl[e] = c; prel[e] = p - mt * (ncol); tbl[e] = tb - mt; mtl[e] = mt; tlr[e] = 0; tpre[e] = 0; fll[e] = full; if (e == 31) { prel[32] = p; tbl[32] = tb; tpre[32] = 0; } } } __syncthreads(); } while (0)
#define MOE_GU(Lb, Le, nbk, cc) do { pg8::MoeOrder S{tbl, cnl, LIST, 4, (Lb), (Le), (nbk), (cc), (unsigned)D * 2u, (size_t)1024 * D * 2, (unsigned)D * 2u, 1}; \
        pg8::EpiSwiGLU E{ACT, LIST, RSTD3, cnl}; pg8::gemm_phase(tid, lds, X2B, WGU_T, D, S, E); } while (0)
#define MOE_DN(Lb, Le, nbk, cc) do { pg8::MoeOrder S{tbl, cnl, LIST, 8, (Lb), (Le), (nbk), (cc), (unsigned)DEXP * 2u, (size_t)D * DEXP * 2, (unsigned)DEXP * 2u, 0}; \
        pg8::EpiBf16 E{Y, D}; pg8::gemm_phase(tid, lds, ACT, WDN_T, DEXP, S, E); } while (0)
    if (IN(13)) for (int rep_ = 0; rep_ < NREP(13); ++rep_) {
        PHASE_IDS
        if (rep_) xcd_barrier(bar, tid);
        MOE_TABLES(4);
        const int U1 = tbl[32] * 4;
        MOE_GU(0, U1 < G ? U1 : G, G, bx);
        GRID_BAR(13);
    }
    if (IN(14)) for (int rep_ = 0; rep_ < NREP(14); ++rep_) {
        PHASE_IDS
        if (rep_) xcd_barrier(bar, tid);
        MOE_TABLES(4);
        const int RT = tbl[32], U1 = RT * 4; const int nb0 = U1 > G ? ((U1 - G) < G ? (U1 - G) : G) : 0; const int rta = (U1 < G ? U1 : G) >> 2;
        if (bx < nb0) MOE_GU(G, U1, nb0, bx);
        else MOE_DN(0, rta * 8, G - nb0, bx - nb0);
        GRID_BAR(14);
    }
    if (IN(15)) for (int rep_ = 0; rep_ < NREP(15); ++rep_) {
        PHASE_IDS
        if (rep_) xcd_barrier(bar, tid);
        MOE_TABLES(8);
        const int RT = tbl[32], U1 = RT * 4; const int rta = (U1 < G ? U1 : G) >> 2;
        MOE_DN(rta * 8, RT * 8, G, bx);
        GRID_BAR(15);
    }
    if (IN(16)) for (int rep_ = 0; rep_ < NREP(16); ++rep_) {
        PHASE_IDS
        if (rep_) xcd_barrier(bar, tid);
        MOE_TABLES(1);
        const float* fg = A_->in[I_FINAL_G];
        int a0n = 0, a1n = 0; float w0n = 0.f, w1n = 0.f;
        if (gw < T) { a0n = TOKE[2 * gw]; a1n = TOKE[2 * gw + 1]; w0n = TOKW[2 * gw]; w1n = TOKW[2 * gw + 1]; }
#pragma unroll 1
        for (int t = gw; t < T; t += NGW) {
            const int a0 = a0n, a1 = a1n; const float w0 = w0n, w1 = w1n;
            { const int tn = t + NGW; if (tn < T) { a0n = TOKE[2 * tn]; a1n = TOKE[2 * tn + 1]; w0n = TOKW[2 * tn]; w1n = TOKW[2 * tn + 1]; } }
            const size_t r0 = (size_t)tbl[a0 / T] * 256 + (a0 % T), r1 = (size_t)tbl[a1 / T] * 256 + (a1 % T);
            const u32x2* xr = (const u32x2*)(X2B + (size_t)t * D) + lane; f32x4* xo = (rep_ == NREP(16) - 1) ? (f32x4*)(A_->out + (size_t)t * D) + lane : (f32x4*)((float*)(ws + WS_X1B) + (size_t)t * D) + lane; const u32x2* y0 = (const u32x2*)(Y + r0 * D) + lane; const u32x2* y1 = (const u32x2*)(Y + r1 * D) + lane;
            f32x4 v[8]; float s = 0.f;
#pragma unroll
            for (int j = 0; j < 8; ++j) { const u32x2 xq = xr[64 * j]; v[j] = (f32x4){bf2f(xq.x & 0xffffu), bf2f(xq.x >> 16), bf2f(xq.y & 0xffffu), bf2f(xq.y >> 16)}; const u32x2 p = y0[64 * j], q = y1[64 * j];
                v[j][0] += w0 * bf2f(p.x & 0xffffu) + w1 * bf2f(q.x & 0xffffu); v[j][1] += w0 * bf2f(p.x >> 16) + w1 * bf2f(q.x >> 16);
                v[j][2] += w0 * bf2f(p.y & 0xffffu) + w1 * bf2f(q.y & 0xffffu); v[j][3] += w0 * bf2f(p.y >> 16) + w1 * bf2f(q.y >> 16);
                s += (v[j][0] * v[j][0] + v[j][1] * v[j][1]) + (v[j][2] * v[j][2] + v[j][3] * v[j][3]); }
            const float r = rsqrtf(wave_sum(s) * (1.f / D) + EPS);
#pragma unroll
            for (int j = 0; j < 8; ++j) { const f32x4 g = ((const f32x4*)fg)[lane + 64 * j]; xo[64 * j] = (f32x4){v[j][0] * r * g[0], v[j][1] * r * g[1], v[j][2] * r * g[2], v[j][3] * r * g[3]}; }
        }
    }
#undef IN
#undef BOTH
#undef GRID_BAR
}

extern "C" void kernel_launch(void* const* d_in, const int* in_sizes, int n_in, void* d_out, int out_size, void* d_ws, size_t ws_size, hipStream_t stream) {
    static int grid = 0;
    if (grid == 0) {
        if (n_in != 27 || out_size != T * D || ws_size < WS_END) { fprintf(stderr, "kernel_launch: unexpected problem (n_in %d out %d ws %zu)\n", n_in, out_size, ws_size); grid = -1; return; }
        int dev = 0, cus = 0, per_cu = 0;
        if (hipGetDevice(&dev) != hipSuccess || hipDeviceGetAttribute(&cus, hipDeviceAttributeMultiprocessorCount, dev) != hipSuccess) { grid = -1; return; }
        if (hipFuncSetAttribute((const void*)mega, hipFuncAttributeMaxDynamicSharedMemorySize, LDS_BYTES) != hipSuccess) { fprintf(stderr, "kernel_launch: hipFuncSetAttribute failed\n"); grid = -1; return; }
        if (hipOccupancyMaxActiveBlocksPerMultiprocessor(&per_cu, (const void*)mega, 512, LDS_BYTES) != hipSuccess || per_cu < 1) fprintf(stderr, "kernel_launch: occupancy query reports %d\n", per_cu);
        (void)hipGetLastError();
        grid = cus;
    }
    if (grid < 0) return;
    if (hipMemsetAsync((char*)d_ws + WS_CTL, 0, CTL_ZERO_BYTES, stream) != hipSuccess) return;
    Args a{};
    for (int i = 0; i < 27; ++i) a.in[i] = (const float*)d_in[i];
    a.out = (float*)d_out; a.ws = (unsigned char*)d_ws;
    if (MK_N_LAUNCHES == 1) { a.ph_lo = 0; a.ph_hi = NPHASE; hipLaunchKernelGGL(mega, dim3(grid), dim3(512), LDS_BYTES, stream, a); }
    else { for (int p = 0; p < NPHASE; ++p) { a.ph_lo = p; a.ph_hi = p + 1; hipLaunchKernelGGL(mega, dim3(grid), dim3(512), LDS_BYTES, stream, a); } }
}
```

```cpp
#include <hip/hip_runtime.h>
#include <cstdio>
#include <cstdint>

#ifndef MK_N_LAUNCHES
#define MK_N_LAUNCHES 1
#endif

#define GAS __attribute__((address_space(1)))
#define LAS __attribute__((address_space(3)))
typedef unsigned short bf16;
typedef short bf16x8 __attribute__((ext_vector_type(8)));
typedef float f32x4 __attribute__((ext_vector_type(4)));
typedef float f32x2 __attribute__((ext_vector_type(2)));
typedef float f32x16 __attribute__((ext_vector_type(16)));
typedef unsigned u32x4 __attribute__((ext_vector_type(4)));
typedef unsigned u32x2 __attribute__((ext_vector_type(2)));

constexpr int T = 8192, D = 2048, NMEM = 256;
constexpr int D_IN = 4944;
constexpr int NPROJ = 6144;
constexpr int KMIX = 3072;
constexpr int NCH = 128, CH = 64;
constexpr int NEXP = 32, DEXP = 512;
constexpr float EPS = 1e-6f;
constexpr int NPHASE = 17;

constexpr size_t MiB = 1u << 20;
constexpr size_t WS_CTL = 0, CTL_ZERO_BYTES = 256 * 1024;
constexpr size_t WS_WOUT_T = 1 * MiB;
constexpr size_t WS_WCQ_T = 13 * MiB;
constexpr size_t WS_WCKV_T = 21 * MiB;
constexpr size_t WS_WCO_T = 37 * MiB;
constexpr size_t WS_WGU_T = 45 * MiB;
constexpr size_t WS_WDN_T = 173 * MiB;
constexpr size_t WS_WIN_T = 237 * MiB;
constexpr size_t WS_H1 = 261 * MiB;
constexpr size_t WS_MIXIN = 237 * MiB;
constexpr size_t WS_SC127 = 285 * MiB;
constexpr size_t WS_MEMN = 293 * MiB;
constexpr size_t WS_KC = 294 * MiB;
constexpr size_t WS_VT = 295 * MiB;
constexpr size_t WS_GATES = 296 * MiB;
constexpr size_t WS_WR = 297 * MiB;
constexpr size_t WS_QABS = 298 * MiB;
constexpr size_t WS_CKVRAW = 330 * MiB;
constexpr size_t WS_QI = 338 * MiB;
constexpr size_t WS_SMALL = 346 * MiB;
constexpr size_t WS_MQKRAW = 354 * MiB;
constexpr size_t WS_MV = 386 * MiB;
constexpr size_t WS_MO = 402 * MiB;
constexpr size_t WS_CKVN = 418 * MiB;
constexpr size_t WS_KIDXN = 422 * MiB;
constexpr size_t WS_QCM = 423 * MiB;
constexpr size_t WS_KCM = 431 * MiB;
constexpr size_t WS_LST = 439 * MiB;
constexpr size_t WS_NL = 503 * MiB;
constexpr size_t WS_CST = 504 * MiB;
constexpr size_t WS_VTM = 536 * MiB;
constexpr size_t WS_X1B = 298 * MiB;
constexpr size_t WS_QC = 330 * MiB;
constexpr size_t WS_OC = 362 * MiB;
constexpr size_t WS_X2B = 394 * MiB;
constexpr size_t WS_LIST = 426 * MiB;
constexpr size_t WS_TOK = 427 * MiB;
constexpr size_t WS_ACT = 428 * MiB;
constexpr size_t WS_Y = 452 * MiB;
constexpr size_t WS_END = 552 * MiB;
constexpr int GT_B = 0;
constexpr int GT_LI = T * 4;
constexpr int GT_G = 2 * T * 4;
constexpr int GT_MLOC = GT_G + 512;
constexpr int GT_MPREV = GT_MLOC + 512;
constexpr int CW_BAR = 4096;
constexpr int CW_CNT = 8192;
constexpr int CW_SS2 = 16384;
static_assert((CW_SS2 + T) * 4 <= (int)CTL_ZERO_BYTES, "ctl");

constexpr int RING_BYTES = 131072;
constexpr int MISC_OFF = RING_BYTES;
constexpr int LDS_BYTES = 159744;

__device__ __forceinline__ float bf2f(unsigned b) { return __uint_as_float(b << 16); }
__device__ __forceinline__ unsigned f2bf(float f) { unsigned u = __float_as_uint(f); return (u + 0x7fffu + ((u >> 16) & 1u)) >> 16; }
__device__ __forceinline__ unsigned pk2(float lo, float hi) { return f2bf(lo) | (f2bf(hi) << 16); }
__device__ __forceinline__ float wave_sum(float v) {
#pragma unroll
    for (int o = 1; o < 64; o <<= 1) v += __shfl_xor(v, o);
    return v;
}
__device__ __forceinline__ float wave_max(float v) {
#pragma unroll
    for (int o = 1; o < 64; o <<= 1) v = fmaxf(v, __shfl_xor(v, o));
    return v;
}
#define LDS_WAIT() asm volatile("s_waitcnt lgkmcnt(0)" ::: "memory")

#define XB_TMO      128
#define XB_XCNT(j)  (256  + 64 * (j))
#define XB_XSUB(j)  (1280 + 64 * (j))
#define XB_XGEN(j)  (2304 + 64 * (j))
#define XB_TOP      3328
#define XB_TOPGEN   3392
#define XCD_BAR_WORDS 3456
#define XB_SPIN_CAP (1u << 18)
__device__ __forceinline__ unsigned xb_ld(unsigned* p)              { return __hip_atomic_load(p, __ATOMIC_RELAXED, __HIP_MEMORY_SCOPE_AGENT); }
__device__ __forceinline__ unsigned xb_add(unsigned* p, unsigned v) { return __hip_atomic_fetch_add(p, v, __ATOMIC_RELAXED, __HIP_MEMORY_SCOPE_AGENT); }
__device__ __forceinline__ unsigned xb_xcc_id() { return (unsigned)__builtin_amdgcn_s_getreg((3 << 11) | 20) & 0xFu; }
#define XB_SPIN(cond, bar) do { unsigned _sp = 0; while (cond) { __builtin_amdgcn_s_sleep(1); \
    if ((++_sp & 255u) == 0u) { if (xb_ld(&(bar)[XB_TMO])) break; if (_sp > XB_SPIN_CAP) { atomicAdd(&(bar)[XB_TMO], 1u); break; } } } } while (0)
struct XcdBarrier { unsigned* bar; unsigned x; volatile LAS unsigned* st; };
__device__ __forceinline__ XcdBarrier xcd_barrier_post(unsigned* bar, volatile LAS unsigned* st) {
    XcdBarrier b; b.bar = bar; b.x = xb_xcc_id(); b.st = st;
    if (threadIdx.x == 0) (void)xb_add(&bar[XB_XCNT(b.x)], 1u);
    return b;
}
__device__ __forceinline__ void xcd_barrier_complete(unsigned* bar, unsigned x, unsigned& nloc, unsigned& nx) {
    const unsigned G = gridDim.x * gridDim.y * gridDim.z;
    unsigned sum, cnt, mine, sp = 0u;
    for (;;) {
        sum = 0u; cnt = 0u; mine = 0u;
#pragma unroll
        for (unsigned j = 0; j < 16; ++j) { const unsigned c = xb_ld(&bar[XB_XCNT(j)]); sum += c; cnt += (c > 0u) ? 1u : 0u; mine = (j == x) ? c : mine; }
        if (sum == G) break;
        __builtin_amdgcn_s_sleep(1);
        if ((++sp & 255u) == 0u) { if (xb_ld(&bar[XB_TMO])) break; if (sp > XB_SPIN_CAP) { atomicAdd(&bar[XB_TMO], 1u); break; } }
    }
    nloc = mine > 0u ? mine : 1u; nx = cnt > 0u ? cnt : 1u;
}
__device__ __forceinline__ void xcd_barrier(const XcdBarrier& b, const int tid_) {
    asm volatile("s_waitcnt vmcnt(0)" ::: "memory");
    __syncthreads();
    if (tid_ == 0) {
        unsigned* bar = b.bar;
        __builtin_amdgcn_s_waitcnt(0);
        unsigned nloc = b.st[0], nx = b.st[1];
        if (nloc == 0u) { xcd_barrier_complete(bar, b.x, nloc, nx); b.st[0] = nloc; b.st[1] = nx; }
        const unsigned old = xb_add(&bar[XB_XSUB(b.x)], 1u);
        const unsigned gen = old / nloc;
        if (old + 1u == (gen + 1u) * nloc) {
            __builtin_amdgcn_fence(__ATOMIC_RELEASE, "agent");
            asm volatile("s_waitcnt vmcnt(0)" ::: "memory");
            const unsigned og = xb_add(&bar[XB_TOP], 1u);
            const unsigned tg = og / nx;
            if (og + 1u == (tg + 1u) * nx) xb_add(&bar[XB_TOPGEN], 1u);
            else XB_SPIN(xb_ld(&bar[XB_TOPGEN]) == tg, bar);
            __builtin_amdgcn_fence(__ATOMIC_ACQUIRE, "agent");
            xb_add(&bar[XB_XGEN(b.x)], 1u);
            asm volatile("s_waitcnt vmcnt(0)" ::: "memory");
        } else {
            XB_SPIN(xb_ld(&bar[XB_XGEN(b.x)]) == gen, bar);
            __builtin_amdgcn_fence(__ATOMIC_ACQUIRE, "agent");
            asm volatile("s_waitcnt vmcnt(0)" ::: "memory");
        }
    }
    __syncthreads();
}

namespace pg8 {
constexpr int BM = 256, BK = 64, HALF = 128, HTB = HALF * BK * 2, STAGE_BYTES = 8 * HTB, NXCD = 8, WGM = 8;
__host__ __device__ __forceinline__ int lds_byte(int r, int c) { const int st = (r >> 4) * 2 + (c >> 5), rr = r & 15, cc = c & 31, ob = rr * 64 + cc * 2; return st * 1024 + (ob ^ (((ob >> 9) & 1) << 5)); }
__host__ __device__ __forceinline__ void stage_rc(int b, int& R, int& C) { const int st = b / 1024, sb = b % 1024, swz = sb ^ (((sb >> 9) & 1) << 5); R = (st >> 1) * 16 + swz / 64; C = (st & 1) * 32 + (swz % 64) / 2; }

struct Unit { int pm, pn, e, rt; };

struct DenseOrder {
    static constexpr bool GATHER = false;
    int nM, nN, nwg, G, c; unsigned lda_bytes; unsigned kb;
    __device__ void init(int M, int N, int K, int lda, int G_, int c_) { nM = M / BM; nN = N / BM; nwg = nM * nN; G = G_; c = c_; lda_bytes = (unsigned)lda * 2u; kb = (unsigned)K * 2u; }
    __device__ bool next(int i, Unit& u) const {
        if (c < 0) return false;
        const long L = (long)i * G + c; if (L >= nwg) return false;
        int wgid = (int)L; { const int q = nwg / NXCD, r = nwg % NXCD, xcd = wgid % NXCD, off = wgid / NXCD; wgid = (xcd < r ? xcd * (q + 1) : r * (q + 1) + (xcd - r) * q) + off; }
        const int nig = WGM * nN, gid = wgid / nig, fm = gid * WGM, gsz = (nM - fm) < WGM ? (nM - fm) : WGM;
        u.pm = fm + ((wgid % nig) % gsz); u.pn = (wgid % nig) / gsz; u.e = 0; u.rt = 0; return true;
    }
    __device__ __forceinline__ unsigned a_row(const Unit& u, int r) const { return (unsigned)(u.pm * BM + r) * lda_bytes; }
    __device__ __forceinline__ size_t b_off(const Unit& u) const { return (size_t)u.pn * BM * kb; }
};

#define PG8_SA(b, h) (((b) * 2 + (h)) * HTB)
#define PG8_SB(b, h) ((4 + (b) * 2 + (h)) * HTB)
#define PG8_STAGEB(bufoff, gbase) do { _Pragma("unroll") for (int _i = 0; _i < 2; ++_i) \
        __builtin_amdgcn_global_load_lds((const unsigned*)((const char*)(gbase) + voffB[_i]), (LAS unsigned*)(lds + (bufoff) + ldsw + _i * 8192), 16, 0, 0); } while (0)
#define PG8_GLDS(src, dstoff) __builtin_amdgcn_global_load_lds((const unsigned*)(src), (LAS unsigned*)(lds + (dstoff)), 16, 0, 0)
#define PG8_STAGEA(bufoff, kbyte, h, NXT) do { if constexpr (Sched::GATHER) { const unsigned _o0 = (NXT) ? ((h) ? n10 : n00) : ((h) ? c10 : c00), _o1 = (NXT) ? ((h) ? n11 : n01) : ((h) ? c11 : c01); \
            PG8_GLDS(Ab + (kbyte) + _o0, (bufoff) + ldsw); PG8_GLDS(Ab + (kbyte) + _o1, (bufoff) + ldsw + 8192); } \
        else { const char* _b = ((NXT) ? nA : cA) + (kbyte) + ((h) ? hstepA : (size_t)0); PG8_GLDS(_b + voffA[0], (bufoff) + ldsw); PG8_GLDS(_b + voffA[1], (bufoff) + ldsw + 8192); } } while (0)
#define PG8_LDA(dst, b, h) do { _Pragma("unroll") for (int m = 0; m < 4; ++m) _Pragma("unroll") for (int k = 0; k < 2; ++k) dst[m][k] = *(const LAS bf16x8*)(lds + PG8_SA(b, h) + aoff + m * 2048 + k * 1024); } while (0)
#define PG8_LDB(dst, b, h) do { _Pragma("unroll") for (int n = 0; n < 2; ++n) _Pragma("unroll") for (int k = 0; k < 2; ++k) dst[n][k] = *(const LAS bf16x8*)(lds + PG8_SB(b, h) + boff + n * 2048 + k * 1024); } while (0)
#define PG8_MMA(ai, bj, At, Bt) do { __builtin_amdgcn_s_setprio(1); _Pragma("unroll") for (int m = 0; m < 4; ++m) _Pragma("unroll") for (int n = 0; n < 2; ++n) _Pragma("unroll") for (int k = 0; k < 2; ++k) \
        acc[ai][bj][m][n] = __builtin_amdgcn_mfma_f32_16x16x32_bf16(Bt[n][k], At[m][k], acc[ai][bj][m][n], 0, 0, 0); __builtin_amdgcn_s_setprio(0); } while (0)
#define PG8_WAIT_V(n) asm volatile("s_waitcnt vmcnt(" #n ")" ::: "memory")
#define PG8_WAIT_L(n) asm volatile("s_waitcnt lgkmcnt(" #n ")" ::: "memory")
#define PG8_BAR __builtin_amdgcn_s_barrier()
#define PG8_SCHED __builtin_amdgcn_sched_barrier(0)

template <class Epi, class Sched>
__device__ __forceinline__ void gemm_phase(const int tid_in, LAS unsigned char* lds, const bf16* A, const bf16* Bt, const int K, const Sched& S, const Epi& E) {
    int tid = tid_in; asm volatile("" : "+v"(tid));
    const int wid = __builtin_amdgcn_readfirstlane(tid >> 6), lane = tid & 63, wr = wid >> 2, wc = wid & 3, fr = lane & 15, fq = lane >> 4;
    int Kop_ = K; asm volatile("" : "+s"(Kop_));
    const int nt = Kop_ / BK;
    int sR[2], sC2[2]; unsigned voffB[2];
#pragma unroll
    for (int i = 0; i < 2; ++i) { int R, C; stage_rc(tid * 16 + i * 8192, R, C); sR[i] = R; sC2[i] = C * 2; voffB[i] = (unsigned)R * S.kb + (unsigned)C * 2u; }
    const unsigned kstep = (unsigned)(BK * 2);
    const size_t hstepB = (size_t)HALF * S.kb;
    const unsigned ldsw = (unsigned)wid * 1024u;
    const int aoff = lds_byte(wr * 64 + fr, fq * 8), boff = lds_byte(wc * 32 + fr, fq * 8);
    Unit cur, nxt; int ui = 0;
    if (!S.next(0, cur)) return;
    f32x4 acc[2][2][4][2];
#pragma unroll
    for (int a = 0; a < 2; ++a)
#pragma unroll
        for (int b = 0; b < 2; ++b)
#pragma unroll
            for (int m = 0; m < 4; ++m)
#pragma unroll
                for (int n = 0; n < 2; ++n) acc[a][b][m][n] = (f32x4){0.f, 0.f, 0.f, 0.f};
    bf16x8 At[4][2], B0[2][2], B1[2][2];
    const char* Ab = (const char*)A;
    unsigned c00 = 0, c01 = 0, c10 = 0, c11 = 0, n00 = 0, n01 = 0, n10 = 0, n11 = 0; unsigned voffA[2] = {0u, 0u}; const char* cA = Ab; const char* nA = Ab; size_t hstepA = 0;
    if constexpr (Sched::GATHER) { c00 = S.a_row(cur, sR[0]) + sC2[0]; c01 = S.a_row(cur, sR[1]) + sC2[1]; c10 = S.a_row(cur, 128 + sR[0]) + sC2[0]; c11 = S.a_row(cur, 128 + sR[1]) + sC2[1]; }
    else { voffA[0] = (unsigned)sR[0] * S.lda_bytes + sC2[0]; voffA[1] = (unsigned)sR[1] * S.lda_bytes + sC2[1]; hstepA = (size_t)HALF * S.lda_bytes; cA = Ab + (size_t)S.a_row(cur, 0); }
    const char* cB = (const char*)Bt + S.b_off(cur);
    PG8_STAGEB(PG8_SB(0, 0), cB); PG8_STAGEA(PG8_SA(0, 0), 0u, 0, false); PG8_STAGEB(PG8_SB(0, 1), cB + hstepB); PG8_STAGEA(PG8_SA(0, 1), 0u, 1, false);
    if (wr == 1) PG8_BAR;
    PG8_WAIT_V(4); PG8_BAR;
    PG8_STAGEB(PG8_SB(1, 0), cB + kstep); PG8_STAGEA(PG8_SA(1, 0), kstep, 0, false); PG8_STAGEB(PG8_SB(1, 1), cB + hstepB + kstep);
    PG8_WAIT_V(6); PG8_BAR;
    for (;;) {
        const bool has_next = S.next(ui + 1, nxt);
        const char* nB = cB;
        if constexpr (Sched::GATHER) { n00 = c00; n01 = c01; n10 = c10; n11 = c11; } else nA = cA;
        if (has_next) { nB = (const char*)Bt + S.b_off(nxt);
            if constexpr (Sched::GATHER) { n00 = S.a_row(nxt, sR[0]) + sC2[0]; n01 = S.a_row(nxt, sR[1]) + sC2[1]; n10 = S.a_row(nxt, 128 + sR[0]) + sC2[0]; n11 = S.a_row(nxt, 128 + sR[1]) + sC2[1]; }
            else nA = Ab + (size_t)S.a_row(nxt, 0); }
        for (int t = 0; t < nt; t += 2) {
            const bool last = (t == nt - 2);
            const unsigned k1 = (unsigned)(t + 1) * kstep;
            const unsigned k2 = last ? 0u : (unsigned)(t + 2) * kstep, k3 = k2 + kstep;
            const char* b2 = last ? nB : cB + (size_t)(t + 2) * kstep; const char* b3 = b2 + kstep;
            PG8_LDB(B0, 0, 0); PG8_SCHED; PG8_LDA(At, 0, 0); PG8_STAGEA(PG8_SA(1, 1), k1, 1, false);
            PG8_WAIT_L(8); PG8_BAR; PG8_WAIT_L(0); PG8_MMA(0, 0, At, B0); PG8_BAR; PG8_SCHED;
            PG8_LDB(B1, 0, 1); PG8_STAGEB(PG8_SB(0, 0), b2);
            PG8_BAR; PG8_WAIT_L(0); PG8_MMA(0, 1, At, B1); PG8_BAR;
            PG8_LDA(At, 0, 1); PG8_STAGEA(PG8_SA(0, 0), k2, 0, last);
            PG8_BAR; PG8_WAIT_L(0); PG8_MMA(1, 0, At, B0); PG8_BAR; PG8_SCHED;
            PG8_STAGEB(PG8_SB(0, 1), b2 + hstepB);
            PG8_WAIT_V(6); PG8_BAR; PG8_MMA(1, 1, At, B1); PG8_BAR;
            PG8_LDB(B0, 1, 0); PG8_SCHED; PG8_LDA(At, 1, 0); PG8_STAGEA(PG8_SA(0, 1), k2, 1, last);
            PG8_WAIT_L(8); PG8_BAR; PG8_WAIT_L(0); PG8_MMA(0, 0, At, B0); PG8_BAR; PG8_SCHED;
            PG8_LDB(B1, 1, 1); PG8_STAGEB(PG8_SB(1, 0), b3);
            PG8_BAR; PG8_WAIT_L(0); PG8_MMA(0, 1, At, B1); PG8_BAR;
            PG8_LDA(At, 1, 1); PG8_STAGEA(PG8_SA(1, 0), k3, 0, last);
            PG8_BAR; PG8_WAIT_L(0); PG8_MMA(1, 0, At, B0); PG8_BAR; PG8_SCHED;
            PG8_STAGEB(PG8_SB(1, 1), b3 + hstepB);
            PG8_WAIT_V(6); PG8_BAR; PG8_MMA(1, 1, At, B1); PG8_BAR;
        }
        if constexpr (!Epi::AFTER_DRAIN) E(acc, cur, wr, wc, fr, fq);
        if (!has_next) break;
#pragma unroll
        for (int a = 0; a < 2; ++a)
#pragma unroll
            for (int b = 0; b < 2; ++b)
#pragma unroll
                for (int m = 0; m < 4; ++m)
#pragma unroll
                    for (int n = 0; n < 2; ++n) acc[a][b][m][n] = (f32x4){0.f, 0.f, 0.f, 0.f};
        cur = nxt; if constexpr (Sched::GATHER) { c00 = n00; c01 = n01; c10 = n10; c11 = n11; } else cA = nA; cB = nB; ++ui;
    }
    PG8_WAIT_V(0);
    if (wr == 0) PG8_BAR;
    PG8_BAR;
    if constexpr (Epi::AFTER_DRAIN) E.fused(acc, cur, wr, wc, fr, fq, lds, wid, lane);
}

__device__ __forceinline__ void store_tile_f32(const f32x4 (&acc)[2][2][4][2], float* dst, int ld, int row0, int col0) {
#pragma unroll
    for (int ai = 0; ai < 2; ++ai)
#pragma unroll
        for (int m = 0; m < 4; ++m) { float* rowp = dst + (size_t)(row0 + ai * HALF + m * 16) * ld + col0;
#pragma unroll
            for (int bj = 0; bj < 2; ++bj)
#pragma unroll
                for (int n = 0; n < 2; ++n) *(f32x4*)(rowp + bj * HALF + n * 16) = acc[ai][bj][m][n]; }
}
__device__ __forceinline__ void store_tile_bf16(const f32x4 (&acc)[2][2][4][2], bf16* dst, int ld, int row0, int col0) {
#pragma unroll
    for (int ai = 0; ai < 2; ++ai)
#pragma unroll
        for (int m = 0; m < 4; ++m) { bf16* rowp = dst + (size_t)(row0 + ai * HALF + m * 16) * ld + col0;
#pragma unroll
            for (int bj = 0; bj < 2; ++bj)
#pragma unroll
                for (int n = 0; n < 2; ++n) { const f32x4 v = acc[ai][bj][m][n]; u32x2 w; w.x = pk2(v[0], v[1]); w.y = pk2(v[2], v[3]); *(u32x2*)(rowp + bj * HALF + n * 16) = w; } }
}
struct EpiBf16 {
    static constexpr bool AFTER_DRAIN = false;
    bf16* dst; int ld;
    __device__ __forceinline__ void operator()(const f32x4 (&acc)[2][2][4][2], const Unit& u, int wr, int wc, int fr, int fq) const {
        store_tile_bf16(acc, dst, ld, u.pm * BM + wr * 64 + fr, u.pn * BM + wc * 32 + 4 * fq);
    }
};
struct EpiProj {
    static constexpr bool AFTER_DRAIN = false;
    bf16* qabs; float* ckvraw; bf16* qi; float* small; float* mqkraw; bf16* mv; bf16* mo;
    __device__ __forceinline__ void operator()(const f32x4 (&acc)[2][2][4][2], const Unit& u, int wr, int wc, int fr, int fq) const {
        const int row0 = u.pm * BM + wr * 64 + fr, cl = wc * 32 + 4 * fq, pn = u.pn;
        if (pn < 8) store_tile_bf16(acc, qabs, 2048, row0, pn * 256 + cl);
        else if (pn == 8) store_tile_f32(acc, ckvraw, 256, row0, cl);
        else if (pn < 11) store_tile_bf16(acc, qi, 512, row0, (pn - 9) * 256 + cl);
        else if (pn == 11) store_tile_f32(acc, small, 256, row0, cl);
        else if (pn < 16) store_tile_f32(acc, mqkraw, 1024, row0, (pn - 12) * 256 + cl);
        else if (pn < 20) store_tile_bf16(acc, mv, 1024, row0, (pn - 16) * 256 + cl);
        else store_tile_bf16(acc, mo, 1024, row0, (pn - 20) * 256 + cl);
    }
};
template <bool BASE_BF16>
struct EpiResidT {
    static constexpr bool AFTER_DRAIN = false;
    const void* base; bf16* xb; float* ss;
    __device__ __forceinline__ void operator()(const f32x4 (&acc)[2][2][4][2], const Unit& u, int wr, int wc, int fr, int fq) const {
        const int row0 = u.pm * BM + wr * 64 + fr, col0 = u.pn * BM + wc * 32 + 4 * fq;
#pragma unroll
        for (int ai = 0; ai < 2; ++ai)
#pragma unroll
            for (int m = 0; m < 4; ++m) { const int row = row0 + ai * HALF + m * 16; const size_t off = (size_t)row * D + col0; float s = 0.f;
#pragma unroll
                for (int bj = 0; bj < 2; ++bj)
#pragma unroll
                    for (int n = 0; n < 2; ++n) { f32x4 b;
                        if constexpr (BASE_BF16) { const u32x2 p = *(const u32x2*)((const bf16*)base + off + bj * HALF + n * 16); b = (f32x4){bf2f(p.x & 0xffffu), bf2f(p.x >> 16), bf2f(p.y & 0xffffu), bf2f(p.y >> 16)}; }
                        else b = *(const f32x4*)((const float*)base + off + bj * HALF + n * 16);
                        const f32x4 v = b + acc[ai][bj][m][n];
                        u32x2 w; w.x = pk2(v[0], v[1]); w.y = pk2(v[2], v[3]); *(u32x2*)(xb + off + bj * HALF + n * 16) = w;
                        s += (v[0] * v[0] + v[1] * v[1]) + (v[2] * v[2] + v[3] * v[3]); }
                if (ss) { s += __shfl_xor(s, 16); s += __shfl_xor(s, 32); if (fq == 0) atomicAdd(ss + row, s); } }
    }
};
struct EpiCq {
    static constexpr bool AFTER_DRAIN = false;
    bf16* dst; const float* ss; float scale;
    __device__ __forceinline__ void operator()(const f32x4 (&acc)[2][2][4][2], const Unit& u, int wr, int wc, int fr, int fq) const {
        const int row0 = u.pm * BM + wr * 64 + fr, col0 = u.pn * BM + wc * 32 + 4 * fq;
#pragma unroll
        for (int ai = 0; ai < 2; ++ai)
#pragma unroll
            for (int m = 0; m < 4; ++m) { const int row = row0 + ai * HALF + m * 16; const float r = rsqrtf(ss[row] * (1.0f / D) + EPS) * scale; bf16* rowp = dst + (size_t)row * D + col0;
#pragma unroll
                for (int bj = 0; bj < 2; ++bj)
#pragma unroll
                    for (int n = 0; n < 2; ++n) { const f32x4 v = acc[ai][bj][m][n] * r; u32x2 w; w.x = pk2(v[0], v[1]); w.y = pk2(v[2], v[3]); *(u32x2*)(rowp + bj * HALF + n * 16) = w; } }
    }
};
struct XsOrder {
    static constexpr bool GATHER = false;
    int G, c; unsigned lda_bytes, kb;
    __device__ bool next(int i, Unit& u) const { const int L = i * G + c; if (i > 0 || L >= 128) return false; u.pm = L >> 2; u.pn = L & 3; u.e = 0; u.rt = 0; return true; }
    __device__ __forceinline__ unsigned a_row(const Unit& u, int r) const { return (unsigned)(u.pm * BM + r) * lda_bytes + (unsigned)u.pn * 1024u; }
    __device__ __forceinline__ size_t b_off(const Unit& u) const { return (size_t)u.pn * 1024; }
};
struct XoOrder {
    static constexpr bool GATHER = false;
    int G, c; unsigned lda_bytes, kb;
    __device__ bool next(int i, Unit& u) const { const int L = i * G + c; if (L >= 256) return false; u.pm = L >> 3; u.pn = L & 7; u.e = 0; u.rt = 0; return true; }
    __device__ __forceinline__ unsigned a_row(const Unit& u, int r) const { return (unsigned)(u.pm * BM + r) * lda_bytes + (unsigned)(u.pn >> 1) * 512u; }
    __device__ __forceinline__ size_t b_off(const Unit& u) const { return (size_t)u.pn * BM * kb; }
};
struct EpiSoftmax {
    static constexpr bool AFTER_DRAIN = true;
    bf16* P; const float* ss;
    __device__ __forceinline__ void fused(f32x4 (&acc)[2][2][4][2], const Unit& u, int wr, int wc, int fr, int fq, LAS unsigned char* lds, int wid, int lane) const {
        LAS float* Pm = (LAS float*)lds; LAS float* Ps = (LAS float*)(lds + 4096);
#pragma unroll
        for (int ai = 0; ai < 2; ++ai)
#pragma unroll
            for (int m = 0; m < 4; ++m) { float mx = -3.0e38f; const float rs = rsqrtf(ss[u.pm * BM + ai * HALF + wr * 64 + m * 16 + fr] * (1.0f / D) + EPS);
#pragma unroll
                for (int bj = 0; bj < 2; ++bj)
#pragma unroll
                    for (int n = 0; n < 2; ++n) { const f32x4 v = acc[ai][bj][m][n] * rs; acc[ai][bj][m][n] = v; mx = fmaxf(mx, fmaxf(fmaxf(v[0], v[1]), fmaxf(v[2], v[3]))); }
                mx = fmaxf(mx, __shfl_xor(mx, 16)); mx = fmaxf(mx, __shfl_xor(mx, 32));
                if (fq == 0) Pm[(ai * HALF + wr * 64 + m * 16 + fr) * 4 + wc] = mx; }
        asm volatile("s_waitcnt lgkmcnt(0)" ::: "memory"); __builtin_amdgcn_s_barrier(); asm volatile("" ::: "memory");
#pragma unroll
        for (int ai = 0; ai < 2; ++ai)
#pragma unroll
            for (int m = 0; m < 4; ++m) { const int r = ai * HALF + wr * 64 + m * 16 + fr; const f32x4 pm4 = *(const LAS f32x4*)(Pm + r * 4); const float mx = fmaxf(fmaxf(pm4[0], pm4[1]), fmaxf(pm4[2], pm4[3])); float sm = 0.f;
#pragma unroll
                for (int bj = 0; bj < 2; ++bj)
#pragma unroll
                    for (int n = 0; n < 2; ++n) { f32x4 v = acc[ai][bj][m][n];
#pragma unroll
                        for (int j = 0; j < 4; ++j) { v[j] = __expf(v[j] - mx); sm += v[j]; }
                        acc[ai][bj][m][n] = v; }
                sm += __shfl_xor(sm, 16); sm += __shfl_xor(sm, 32);
                if (fq == 0) Ps[r * 4 + wc] = sm; }
        asm volatile("s_waitcnt lgkmcnt(0)" ::: "memory"); __builtin_amdgcn_s_barrier(); asm volatile("" ::: "memory");
#pragma unroll
        for (int ai = 0; ai < 2; ++ai)
#pragma unroll
            for (int m = 0; m < 4; ++m) { const int r = ai * HALF + wr * 64 + m * 16 + fr; const f32x4 ps4 = *(const LAS f32x4*)(Ps + r * 4); const float inv = 1.f / ((ps4[0] + ps4[1]) + (ps4[2] + ps4[3]));
                bf16* rowp = P + (size_t)(u.pm * BM + r) * 1024 + u.pn * 256 + wc * 32 + 4 * fq;
#pragma unroll
                for (int bj = 0; bj < 2; ++bj)
#pragma unroll
                    for (int n = 0; n < 2; ++n) { const f32x4 v = acc[ai][bj][m][n] * inv; u32x2 w; w.x = pk2(v[0], v[1]); w.y = pk2(v[2], v[3]); *(u32x2*)(rowp + bj * HALF + n * 16) = w; } }
    }
};
struct MoeOrder {
    static constexpr bool GATHER = true;
    const volatile LAS int* tb; const volatile LAS int* cn; const int* list; int ncol; int Lbeg, Lend, nb, c; unsigned a_ld_bytes; size_t b_exp_bytes; unsigned kb; int gather;
    __device__ bool next(int i, Unit& u) const {
        if (c < 0 || nb <= 0) return false;
        const int L = Lbeg + i * nb + c; if (L >= Lend) return false;
        const int g = L / ncol; int e = 0;
#pragma unroll 1
        for (int j = 1; j < 32; ++j) if (g >= tb[j]) e = j;
        u.e = e; u.rt = g - tb[e]; u.pn = L - g * ncol; u.pm = g; return true;
    }
    __device__ __forceinline__ unsigned a_row(const Unit& u, int r) const {
        if (gather) { int idx = u.rt * 256 + r; const int cnt = cn[u.e]; idx = idx < cnt ? idx : cnt - 1; const int tok = list[u.e * T + idx]; return (unsigned)tok * a_ld_bytes; }
        return (unsigned)(u.pm * 256 + r) * a_ld_bytes;
    }
    __device__ __forceinline__ size_t b_off(const Unit& u) const { return (size_t)u.e * b_exp_bytes + (size_t)u.pn * BM * kb; }
};
struct EpiSwiGLU {
    static constexpr bool AFTER_DRAIN = false;
    bf16* act; const int* list; const float* rstd; const volatile LAS int* cn;
    __device__ __forceinline__ void operator()(const f32x4 (&acc)[2][2][4][2], const Unit& u, int wr, int wc, int fr, int fq) const {
        const int cnt = cn[u.e];
#pragma unroll
        for (int ai = 0; ai < 2; ++ai)
#pragma unroll
            for (int m = 0; m < 4; ++m) { const int rl = ai * HALF + wr * 64 + m * 16 + fr; int idx = u.rt * 256 + rl; idx = idx < cnt ? idx : cnt - 1; const float r = rstd[list[u.e * T + idx]];
                bf16* rowp = act + (size_t)(u.pm * 256 + rl) * DEXP + u.pn * 128 + wc * 32 + 4 * fq;
#pragma unroll
                for (int n = 0; n < 2; ++n) { const f32x4 g = acc[ai][0][m][n] * r, uu = acc[ai][1][m][n] * r; f32x4 a;
#pragma unroll
                    for (int j = 0; j < 4; ++j) a[j] = g[j] / (1.0f + __expf(-g[j])) * uu[j];
                    u32x2 w; w.x = pk2(a[0], a[1]); w.y = pk2(a[2], a[3]); *(u32x2*)(rowp + n * 16) = w; } }
    }
};
}

struct Args { const float* in[27]; float* out; unsigned char* ws; int ph_lo, ph_hi; };
enum { I_X = 0, I_MEM, I_NORM_MIX_G, I_W_IN, I_KV_NORM_G, I_KIDX_NORM_G, I_W_UK, I_W_UV, I_CONV_W, I_CONV_B, I_GATE_B, I_ML_NORM_G, I_W_OUT, I_NORM_X_G, I_MEM_NORM_G,
       I_W_CQ, I_W_CKV, I_W_CO, I_NORM_FFN_G, I_W_GROUP, I_B_GROUP, I_W_ROUTER, I_B_ROUTER, I_W_GATE, I_W_UP, I_W_DOWN, I_FINAL_G };

__device__ __forceinline__ void tr_item(const float* W, size_t ldw, int k0, int n0, const float* kscale, bf16* WT, size_t ldt, int drow0, int dcol0, LAS float* scr, int lane) {
#pragma unroll 8
    for (int i = 0; i < 32; ++i) { const int kk = 2 * i + (lane >> 5); float v = W[(size_t)(k0 + kk) * ldw + n0 + (lane & 31)]; if (kscale) v *= kscale[k0 + kk]; scr[kk * 33 + (lane & 31)] = v; }
    LDS_WAIT(); asm volatile("" ::: "memory");
    const int c = lane & 7;
#pragma unroll
    for (int j = 0; j < 4; ++j) { const int n = (lane >> 3) + 8 * j; const LAS float* s = scr + (8 * c) * 33 + n;
        u32x4 o; o.x = pk2(s[0 * 33], s[1 * 33]); o.y = pk2(s[2 * 33], s[3 * 33]); o.z = pk2(s[4 * 33], s[5 * 33]); o.w = pk2(s[6 * 33], s[7 * 33]);
        *(u32x4*)(WT + (size_t)(drow0 + n0 + n) * ldt + dcol0 + k0 + 8 * c) = o; }
    LDS_WAIT(); asm volatile("" ::: "memory");
}
__device__ __forceinline__ void tr_item64(const float* W, size_t ldw, int k0, int n0, const float* kscale, bf16* WT, size_t ldt, int drow0, int dcol0, LAS unsigned char* scr, int lane) {
    const int nq = lane & 15, kq = lane >> 4;
    const float* src = W + (size_t)(k0 + 2 * kq) * ldw + n0 + 4 * nq;
    f32x4 a[8], b[8];
#pragma unroll
    for (int i = 0; i < 8; ++i) { a[i] = __builtin_nontemporal_load((const f32x4*)(src + (size_t)(8 * i) * ldw)); b[i] = __builtin_nontemporal_load((const f32x4*)(src + (size_t)(8 * i + 1) * ldw)); }
#pragma unroll
    for (int i = 0; i < 8; ++i) { float sa = 1.f, sb = 1.f; if (kscale) { sa = kscale[k0 + 8 * i + 2 * kq]; sb = kscale[k0 + 8 * i + 2 * kq + 1]; }
#pragma unroll
        for (int j = 0; j < 4; ++j) { const int n = 4 * nq + j; *(LAS unsigned*)(scr + n * 128 + 16 * (i ^ (nq & 7)) + 4 * kq) = pk2(a[i][j] * sa, b[i][j] * sb); } }
    LDS_WAIT(); asm volatile("" ::: "memory");
#pragma unroll
    for (int m = 0; m < 8; ++m) { const int n = (lane >> 3) + 8 * m, c = lane & 7; const u32x4 v = *(const LAS u32x4*)(scr + n * 128 + 16 * (c ^ ((n >> 2) & 7)));
        __builtin_nontemporal_store(v, (u32x4*)(WT + (size_t)(drow0 + n0 + n) * ldt + dcol0 + k0 + 8 * c)); }
    LDS_WAIT(); asm volatile("" ::: "memory");
}
__device__ __forceinline__ void cv_item64(const float* W, size_t ldw, int k0, int n0, const float* kscale, float scale, bf16* O, size_t ldo, int lane) {
    const int c4 = (lane & 15) * 4, rr = lane >> 4;
    f32x4 v[16];
#pragma unroll
    for (int i = 0; i < 16; ++i) v[i] = __builtin_nontemporal_load((const f32x4*)(W + (size_t)(k0 + i * 4 + rr) * ldw + n0 + c4));
#pragma unroll
    for (int i = 0; i < 16; ++i) { const float g = kscale[k0 + i * 4 + rr] * scale; u32x2 w; w.x = pk2(v[i][0] * g, v[i][1] * g); w.y = pk2(v[i][2] * g, v[i][3] * g);
        *(u32x2*)(O + (size_t)(k0 + i * 4 + rr) * ldo + n0 + c4) = w; }
}
__device__ __forceinline__ void rms_row_to_bf16(const float* xrow, const float* g, bf16* orow, int lane) {
    const f32x4* xr = (const f32x4*)xrow + lane; const f32x4* gr = (const f32x4*)g + lane;
    f32x4 v[8]; float s = 0.f;
#pragma unroll
    for (int j = 0; j < 8; ++j) { v[j] = xr[64 * j]; s += (v[j][0] * v[j][0] + v[j][1] * v[j][1]) + (v[j][2] * v[j][2] + v[j][3] * v[j][3]); }
    const float r = rsqrtf(wave_sum(s) * (1.f / D) + EPS);
    u32x2* o8 = (u32x2*)orow + lane;
#pragma unroll
    for (int j = 0; j < 8; ++j) { const f32x4 gg = gr[64 * j]; u32x2 w; w.x = pk2(v[j][0] * r * gg[0], v[j][1] * r * gg[1]); w.y = pk2(v[j][2] * r * gg[2], v[j][3] * r * gg[3]); o8[64 * j] = w; }
}

__device__ __forceinline__ void mini_gemm64(LAS unsigned char* lds, const bf16* Ap, const unsigned lda, const bf16* Bp, const unsigned ldb, const int nch, bf16* o, const unsigned ldo, const int wave, const int lane) {
    const int r32 = lane & 31, hh = lane >> 5; const int tm = wave & 1, tn = (wave >> 1) & 1, kh = wave >> 2;
#define KV_DMA(kc_) do { _Pragma("unroll") for (int i4 = 0; i4 < 4; ++i4) { const int ii = wave * 4 + i4; const int isb = ii >> 4, row_ = (ii & 15) * 4 + (lane >> 4); \
        const bf16* gsrc_ = (isb ? Bp + (size_t)row_ * ldb : Ap + (size_t)row_ * lda) + (kc_) * 128 + (((lane & 15) ^ (row_ & 15)) * 8); \
        const unsigned ldst_ = __builtin_amdgcn_readfirstlane((unsigned)(size_t)lds + (unsigned)(((kc_) & 1) * 32768 + isb * 16384 + (ii & 15) * 1024)); unsigned keep_; \
        asm volatile("s_mov_b32 %0, m0\n\ts_mov_b32 m0, %2\n\ts_nop 0\n\tglobal_load_lds_dwordx4 %1, off\n\ts_mov_b32 m0, %0" : "=&s"(keep_) : "v"(gsrc_), "s"(ldst_) : "memory"); } } while (0)
    f32x16 acc;
#pragma unroll
    for (int i = 0; i < 16; ++i) acc[i] = 0.f;
    asm volatile("s_waitcnt vmcnt(0)" ::: "memory");
    __syncthreads();
    KV_DMA(0);
#pragma unroll 1
    for (int kc = 0; kc < nch; ++kc) {
        asm volatile("s_waitcnt vmcnt(0)" ::: "memory");
        __syncthreads();
        if (kc + 1 < nch) KV_DMA(kc + 1);
        const LAS unsigned char* ba = lds + (kc & 1) * 32768 + (tm * 32 + r32) * 256; const LAS unsigned char* bb = lds + (kc & 1) * 32768 + 16384 + (tn * 32 + r32) * 256;
#pragma unroll
        for (int k4 = 0; k4 < 4; ++k4) { const int ch = (kh * 4 + k4) * 2 + hh;
            const bf16x8 af = *(const LAS bf16x8*)(ba + ((ch ^ (r32 & 15)) * 16)), bfr = *(const LAS bf16x8*)(bb + ((ch ^ (r32 & 15)) * 16));
            acc = __builtin_amdgcn_mfma_f32_32x32x16_bf16(af, bfr, acc, 0, 0, 0); }
    }
#undef KV_DMA
    __syncthreads();
    LAS float* xb = (LAS float*)(lds + 65536) + (wave & 3) * 1024;
    if (kh == 1) {
#pragma unroll
        for (int i = 0; i < 16; ++i) xb[i * 64 + lane] = acc[i]; }
    __syncthreads();
    if (kh == 0) { bf16* op = o + (size_t)(tm * 32 + 4 * hh) * ldo + tn * 32 + r32;
#pragma unroll
        for (int i = 0; i < 16; ++i) op[(size_t)((i & 3) + 8 * (i >> 2)) * ldo] = (bf16)f2bf(acc[i] + xb[i * 64 + lane]); }
}


__global__ void __launch_bounds__(512, 2) mega(Args args) {
    extern __shared__ __attribute__((aligned(16))) unsigned char lds_raw[];
    LAS unsigned char* lds = (LAS unsigned char*)lds_raw;
    volatile LAS unsigned* MISC = (volatile LAS unsigned*)(lds + MISC_OFF);
    const int tid0 = threadIdx.x;
    const int wave0_ = __builtin_amdgcn_readfirstlane(tid0 >> 6);
    const int G = gridDim.x, bx = blockIdx.x;
#define PHASE_IDS const Args* A_ = (const Args*)__builtin_amdgcn_kernarg_segment_ptr(); asm volatile("" : "+s"(A_)); int tid; asm volatile("v_mbcnt_lo_u32_b32 %0, -1, 0\n\tv_mbcnt_hi_u32_b32 %0, -1, %0" : "=v"(tid)); tid += wave0_ * 64; asm volatile("" : "+v"(tid)); const int lane = tid & 63, wave = __builtin_amdgcn_readfirstlane(tid >> 6); const int gw = bx * 8 + wave, NGW = G * 8; (void)lane; (void)gw; (void)NGW;
    const Args* A_ = (const Args*)__builtin_amdgcn_kernarg_segment_ptr();
    unsigned char* ws = args.ws;
    unsigned* ctl = (unsigned*)(ws + WS_CTL);
    const int lo = args.ph_lo, hi = args.ph_hi;
    for (int u = tid0; u < 1024; u += 512) MISC[u] = 0u;
    __syncthreads();
    XcdBarrier bar; bar.bar = ctl + CW_BAR; bar.x = 0; bar.st = MISC;
    if (hi - lo > 1) bar = xcd_barrier_post(ctl + CW_BAR, MISC);
#ifndef PH_MASK
#define PH_MASK 0x1ffff
#endif
#define IN(k) ((((PH_MASK) >> (k)) & 1) && lo <= (k) && (k) < hi)
#ifndef REP_MASK
#define REP_MASK 0
#endif
#define NREP(k) (1 + (((REP_MASK) >> (k)) & 1))
#ifndef PR_MFMA
#define PR_MFMA 0
#endif
#ifndef PR_EPI
#define PR_EPI 0
#endif
#ifndef PR_GA
#define PR_GA 0
#endif
#ifndef PR_VF
#define PR_VF 0
#endif
#ifndef PR_KV
#define PR_KV 0
#endif
#ifndef PR_ML
#define PR_ML 0
#endif
#ifndef PR_TR
#define PR_TR 0
#endif
#ifndef PR_WP
#define PR_WP 0
#endif
#ifndef PR_H1
#define PR_H1 0
#endif
#ifndef PR_QK
#define PR_QK 0
#endif
#ifndef PR_PV
#define PR_PV 0
#endif
#define BOTH(k) (IN(k) && IN((k) + 1))
#define GRID_BAR(k) do { if (BOTH(k) && rep_ == NREP(k) - 1) xcd_barrier(bar, tid); } while (0)

#define WOUT_T ((bf16*)(ws + WS_WOUT_T))
#define WCQ_T ((bf16*)(ws + WS_WCQ_T))
#define WCKV_T ((bf16*)(ws + WS_WCKV_T))
#define WCO_T ((bf16*)(ws + WS_WCO_T))
#define WGU_T ((bf16*)(ws + WS_WGU_T))
#define WDN_T ((bf16*)(ws + WS_WDN_T))
#define WIN_T ((bf16*)(ws + WS_WIN_T))
#define H1 ((bf16*)(ws + WS_H1))
#define MIXIN ((bf16*)(ws + WS_MIXIN))
#define MEMN ((bf16*)(ws + WS_MEMN))
#define KC ((bf16*)(ws + WS_KC))
#define MF ((bf16*)(ws + WS_WCKV_T + 4 * MiB))
#define VF ((bf16*)(ws + WS_WCKV_T))
#define VT ((bf16*)(ws + WS_VT))
#define GATES ((float*)(ws + WS_GATES))
#define QABS ((bf16*)(ws + WS_QABS))
#define CKVRAW ((float*)(ws + WS_CKVRAW))
#define QI ((bf16*)(ws + WS_QI))
#define SMALL ((float*)(ws + WS_SMALL))
#define MQKRAW ((float*)(ws + WS_MQKRAW))
#define MV ((bf16*)(ws + WS_MV))
#define MO ((bf16*)(ws + WS_MO))
#define CKVN ((bf16*)(ws + WS_CKVN))
#define KIDXN ((bf16*)(ws + WS_KIDXN))
#define QCM ((bf16*)(ws + WS_QCM))
#define KCM ((bf16*)(ws + WS_KCM))
#define LST ((float*)(ws + WS_LST))
#define NL ((float*)(ws + WS_NL))
#define NST (NL + NCH * 4 * 128)
#define CST ((bf16*)(ws + WS_CST))
#define VTM ((bf16*)(ws + WS_VTM))
#define PB ((bf16*)(ws + WS_VTM))
#define X1B ((bf16*)(ws + WS_X1B))
#define QC ((bf16*)(ws + WS_QC))
#define OC ((bf16*)(ws + WS_OC))
#define X2B ((bf16*)(ws + WS_X2B))
#define LIST ((int*)(ws + WS_LIST))
#define TOKE ((int*)(ws + WS_TOK))
#define TOKW ((float*)(ws + WS_TOK) + 2 * T)
#define RSTD3 ((float*)(ws + WS_TOK) + 4 * T)
#define ACT ((bf16*)(ws + WS_ACT))
#define Y ((bf16*)(ws + WS_Y))
#define WRH ((bf16*)(ws + WS_WR))
#define WRL (WRH + 48 * D)
#define BCNT ((int*)(ws + WS_TOK) + 8 * T)
#define TOKR ((int*)(ws + WS_TOK) + 6 * T)
#define SS2 ((float*)(ctl + CW_SS2))
#define CNT ((int*)(ctl + CW_CNT))

    if (IN(0)) for (int rep_ = 0; rep_ < NREP(0); ++rep_) {
        PHASE_IDS
        if (rep_) xcd_barrier(bar, tid);
        LAS float* scr = (LAS float*)(lds + wave * 16384);
        const float* w_in = A_->in[I_W_IN]; const float* w_out = A_->in[I_W_OUT];
        constexpr int J_CKV = 32 * 4, J_QI = 32 * 8, J_KI = 32 * 1, J_MQK = 32 * 16, J_MV = 32 * 16, J_MO = 32 * 16, J_WO = 16 * 32, J_CQ = 32 * 32, J_CKVW = 32 * 64, J_CO = 32 * 32,
                      J_G = 32 * 256, J_U = 32 * 256, J_D = 32 * 256;
        constexpr int NITEMS = J_CKV + J_QI + J_KI + J_MQK + J_MV + J_MO + J_WO + J_CQ + J_CKVW + J_CO + J_G + J_U + J_D;
        LAS unsigned char* scr8 = (LAS unsigned char*)scr;
        for (int prt_ = 0; prt_ < 1 + PR_TR; ++prt_)
        for (int it = gw; it < NITEMS; it += NGW) {
            int r = it;
            if (r < J_CKV) { tr_item64(w_in + 1024, D_IN, 64 * (r / 4), 64 * (r % 4), nullptr, WIN_T, D, 2048, 0, scr8, lane); continue; } r -= J_CKV;
            if (r < J_QI) { tr_item64(w_in + 1280, D_IN, 64 * (r / 8), 64 * (r % 8), nullptr, WIN_T, D, 2304, 0, scr8, lane); continue; } r -= J_QI;
            if (r < J_KI) { tr_item64(w_in + 1792, D_IN, 64 * r, 0, nullptr, WIN_T, D, 2816, 0, scr8, lane); continue; } r -= J_KI;
            if (r < J_MQK) { tr_item64(w_in + 1864, D_IN, 64 * (r / 16), 64 * (r % 16), nullptr, WIN_T, D, 3072, 0, scr8, lane); continue; } r -= J_MQK;
            if (r < J_MV) { tr_item64(w_in + 2888, D_IN, 64 * (r / 16), 64 * (r % 16), nullptr, WIN_T, D, 4096, 0, scr8, lane); continue; } r -= J_MV;
            if (r < J_MO) { tr_item64(w_in + 3920, D_IN, 64 * (r / 16), 64 * (r % 16), nullptr, WIN_T, D, 5120, 0, scr8, lane); continue; } r -= J_MO;
            if (r < J_WO) { tr_item64(w_out + (size_t)1024 * D, D, 64 * (r / 32), 64 * (r % 32), nullptr, WOUT_T, KMIX, 0, 2048, scr8, lane); continue; } r -= J_WO;
            if (r < J_CQ) { cv_item64(A_->in[I_W_CQ], D, 64 * (r / 32), 64 * (r % 32), A_->in[I_NORM_X_G], 0.04419417382415922f, WCQ_T, D, lane); continue; } r -= J_CQ;
            if (r < J_CKVW) { tr_item64(A_->in[I_W_CKV], 2 * D, 64 * (r / 64), 64 * (r % 64), nullptr, WCKV_T, D, 0, 0, scr8, lane); continue; } r -= J_CKVW;
            if (r < J_CO) { tr_item64(A_->in[I_W_CO], D, 64 * (r / 32), 64 * (r % 32), nullptr, WCO_T, D, 0, 0, scr8, lane); continue; } r -= J_CO;
            if (r < J_G) { const int e = r / 256, q = r % 256, kb = q / 8, nb = q % 8;
                tr_item64(A_->in[I_W_GATE] + (size_t)e * D * DEXP, DEXP, 64 * kb, 64 * nb, A_->in[I_NORM_FFN_G], WGU_T + (size_t)e * 1024 * D, D, (nb / 2) * 128, 0, scr8, lane); continue; } r -= J_G;
            if (r < J_U) { const int e = r / 256, q = r % 256, kb = q / 8, nb = q % 8;
                tr_item64(A_->in[I_W_UP] + (size_t)e * D * DEXP, DEXP, 64 * kb, 64 * nb, A_->in[I_NORM_FFN_G], WGU_T + (size_t)e * 1024 * D, D, (nb / 2) * 128 + 128, 0, scr8, lane); continue; } r -= J_U;
            { const int e = r / 256, q = r % 256, kb = q / 32, nb = q % 32;
                tr_item64(A_->in[I_W_DOWN] + (size_t)e * DEXP * D, D, 64 * kb, 64 * nb, nullptr, WDN_T + (size_t)e * D * DEXP, DEXP, 0, 0, scr8, lane); }
        }
        for (int i = bx * 512 + tid; i < 192 * D; i += G * 512) { const int r = i / D, k = i % D; float v = 0.f;
            if (r < 8) v = w_in[(size_t)k * D_IN + 1856 + r]; else if (r < 16) v = w_in[(size_t)k * D_IN + 3912 + (r - 8)];
            WIN_T[(size_t)(2880 + r) * D + k] = (bf16)f2bf(v); }
        for (int i = bx * 512 + tid; i < 48 * D; i += G * 512) { const int o = i / D, k = i % D; float v = 0.f;
            if (o < 4) v = A_->in[I_W_GROUP][(size_t)k * 4 + o] * A_->in[I_NORM_FFN_G][k]; else if (o < 36) v = A_->in[I_W_ROUTER][(size_t)k * 32 + (o - 4)] * A_->in[I_NORM_FFN_G][k];
            const unsigned hb = f2bf(v); WRH[i] = (bf16)hb; WRL[i] = (bf16)f2bf(v - bf2f(hb)); }
        {
            const int r32 = lane & 31, hh = lane >> 5;
            const float* w_uk = A_->in[I_W_UK]; const float* w_uv = A_->in[I_W_UV];
#define CVT8(dst, pa, pb) do { const f32x4 x_ = (pa), y_ = (pb); u32x4 w_; w_.x = pk2(x_[0], x_[1]); w_.y = pk2(x_[2], x_[3]); w_.z = pk2(y_[0], y_[1]); w_.w = pk2(y_[2], y_[3]); dst = __builtin_bit_cast(bf16x8, w_); } while (0)
            for (int prw_ = 0; prw_ < 1 + PR_WP; ++prw_)
            for (int it = gw; it < 4096; it += NGW) {
                const bool isq = it < 2048; const int r = it & 2047, h = r >> 8, rt = (r >> 2) & 63, cg = r & 3;
                if (isq) {
                    const int ct = (r >> 5) & 7, kg = r & 31;
                    bf16x8 af[8];
                    { const float* ap = w_uk + (size_t)((ct * 32 + r32) * 8 + h) * 128 + 8 * hh;
#pragma unroll
                      for (int ks = 0; ks < 8; ++ks) CVT8(af[ks], *(const f32x4*)(ap + ks * 16), *(const f32x4*)(ap + ks * 16 + 4)); }
#pragma unroll 1
                    for (int kt = 0; kt < 2; ++kt) { const int k0 = kg * 64 + kt * 32; const float* bp = w_in + (size_t)(k0 + r32) * D_IN + h * 128 + 8 * hh;
                        f32x16 acc;
#pragma unroll
                        for (int i = 0; i < 16; ++i) acc[i] = 0.f;
#pragma unroll
                        for (int ks = 0; ks < 8; ++ks) { bf16x8 bfr; CVT8(bfr, *(const f32x4*)(bp + ks * 16), *(const f32x4*)(bp + ks * 16 + 4)); acc = __builtin_amdgcn_mfma_f32_32x32x16_bf16(af[ks], bfr, acc, 0, 0, 0); }
                        bf16* o = WIN_T + (size_t)(h * 256 + ct * 32 + 4 * hh) * D + k0 + r32;
#pragma unroll
                        for (int i = 0; i < 16; ++i) o[(size_t)((i & 3) + 8 * (i >> 2)) * D] = (bf16)f2bf(acc[i] * 0.08838834764831845f); }
                } else {
                    const float* pj[8];
#pragma unroll
                    for (int j = 0; j < 8; ++j) pj[j] = w_out + (size_t)(h * 128 + 8 * hh + j) * D + rt * 32 + r32;
                    const float* bp0 = w_uv + (size_t)((cg * 64 + r32) * 8 + h) * 128 + 8 * hh; const float* bp1 = bp0 + (size_t)32 * 8 * 128;
                    f32x16 acc0, acc1;
#pragma unroll
                    for (int i = 0; i < 16; ++i) { acc0[i] = 0.f; acc1[i] = 0.f; }
#pragma unroll 2
                    for (int ks = 0; ks < 8; ++ks) { u32x4 w_; w_.x = pk2(*pj[0], *pj[1]); w_.y = pk2(*pj[2], *pj[3]); w_.z = pk2(*pj[4], *pj[5]); w_.w = pk2(*pj[6], *pj[7]); const bf16x8 afr = __builtin_bit_cast(bf16x8, w_);
#pragma unroll
                        for (int j = 0; j < 8; ++j) pj[j] += (size_t)16 * D;
                        bf16x8 b0, b1; CVT8(b0, *(const f32x4*)(bp0 + ks * 16), *(const f32x4*)(bp0 + ks * 16 + 4)); CVT8(b1, *(const f32x4*)(bp1 + ks * 16), *(const f32x4*)(bp1 + ks * 16 + 4));
                        acc0 = __builtin_amdgcn_mfma_f32_32x32x16_bf16(afr, b0, acc0, 0, 0, 0); acc1 = __builtin_amdgcn_mfma_f32_32x32x16_bf16(afr, b1, acc1, 0, 0, 0); }
                    bf16* o = WOUT_T + (size_t)(rt * 32 + 4 * hh) * KMIX + h * 256 + cg * 64 + r32;
#pragma unroll
                    for (int i = 0; i < 16; ++i) { o[(size_t)((i & 3) + 8 * (i >> 2)) * KMIX] = (bf16)f2bf(acc0[i]); o[(size_t)((i & 3) + 8 * (i >> 2)) * KMIX + 32] = (bf16)f2bf(acc1[i]); }
                }
            }
#undef CVT8
        }
        for (int prh_ = 0; prh_ < 1 + PR_H1; ++prh_)
        for (int m = gw; m < T; m += NGW) rms_row_to_bf16(A_->in[I_X] + (size_t)m * D, A_->in[I_NORM_MIX_G], H1 + (size_t)m * D, lane);
        for (int m = gw; m < NMEM; m += NGW) rms_row_to_bf16(A_->in[I_MEM] + (size_t)m * D, A_->in[I_MEM_NORM_G], MEMN + (size_t)m * D, lane);
        GRID_BAR(0);
    }

    if (IN(1)) for (int rep_ = 0; rep_ < NREP(1); ++rep_) {
        PHASE_IDS
        if (rep_) xcd_barrier(bar, tid);
        pg8::DenseOrder S; S.init(T, NPROJ, D, D, G, bx);
        pg8::EpiProj E{QABS, CKVRAW, QI, SMALL, MQKRAW, MV, MO};
        pg8::gemm_phase(tid, lds, H1, WIN_T, D, S, E);
        GRID_BAR(1);
    }

    if (IN(2)) for (int rep_ = 0; rep_ < NREP(2); ++rep_) {
        PHASE_IDS
        if (rep_) xcd_barrier(bar, tid);
#ifndef P2_SUB
#define P2_SUB 15
#endif
        if (P2_SUB & 1) {
            for (int prk_ = 0; prk_ < 1 + PR_KV; ++prk_)
            for (int id = bx; id < 256; id += G) {
                const int rt = id & 3, ct = id >> 2;
                mini_gemm64(lds, MEMN + (size_t)(rt * 64) * D, D, WCKV_T + (size_t)(ct * 64) * D, D, 16, KC + (size_t)(rt * 64) * 4096 + ct * 64, 4096u, wave, lane);
            }
        }
        __syncthreads();
        if (P2_SUB & 4) for (int t = gw; t < T; t += NGW) {
            const f32x4 v = ((const f32x4*)(CKVRAW + (size_t)t * 256))[lane];
            const float r = rsqrtf(wave_sum((v[0] * v[0] + v[1] * v[1]) + (v[2] * v[2] + v[3] * v[3])) * (1.f / 256.f) + EPS);
            const f32x4 g = ((const f32x4*)A_->in[I_KV_NORM_G])[lane];
            u32x2 w; w.x = pk2(v[0] * r * g[0], v[1] * r * g[1]); w.y = pk2(v[2] * r * g[2], v[3] * r * g[3]);
            ((u32x2*)(CKVN + (size_t)t * 256))[lane] = w;
            const float kv = SMALL[(size_t)t * 256 + lane];
            const float rk = rsqrtf(wave_sum(kv * kv) * (1.f / 64.f) + EPS);
            KIDXN[(size_t)t * 64 + lane] = (bf16)f2bf(kv * rk * A_->in[I_KIDX_NORM_G][lane]);
        }
        if (P2_SUB & 8) {
            LAS float* kq = (LAS float*)lds;
            LAS bf16* KWT = (LAS bf16*)(lds + 32768);
            LAS bf16* VTl = (LAS bf16*)(lds + 51200);
            LAS float* sw = (LAS float*)(lds + 98304);
            const float* conv_w = A_->in[I_CONV_W]; const float* conv_b = A_->in[I_CONV_B]; const float* gate_b = A_->in[I_GATE_B];
            const int r32 = lane & 31, hh = lane >> 5;
            for (int prm_ = 0; prm_ < 1 + PR_ML; ++prm_)
            for (int uu = bx; uu < NCH * 4; uu += G) {
                const int c = uu >> 2, h = uu & 3, t0 = c * CH;
                __syncthreads();
                if (wave == 0) {
                    const int t = t0 + lane; const float li = SMALL[(size_t)t * 256 + 72 + h] + gate_b[h]; const float mf = SMALL[(size_t)t * 256 + 76 + h] + gate_b[4 + h];
                    float bsc = fminf(mf, 0.f) - log1pf(__expf(-fabsf(mf)));
#pragma unroll
                    for (int o = 1; o < 64; o <<= 1) { const float v = __shfl_up(bsc, o); if (lane >= o) bsc += v; }
                    const float g = __shfl(bsc, 63); const float dec = g - bsc + li; const float mx = wave_max(dec);
                    sw[lane] = __expf(dec - mx); sw[128 + lane] = li; sw[192 + lane] = bsc;
                    GATES[GT_B + (size_t)t * 4 + h] = bsc; GATES[GT_LI + (size_t)t * 4 + h] = li;
                    if (lane == 0) { GATES[GT_G + c * 4 + h] = g; GATES[GT_MLOC + c * 4 + h] = mx; } }
                __syncthreads();
                { const int ch = tid & 255, th = tid >> 8; const int src = ch < 128 ? h * 128 + ch : 512 + h * 128 + (ch - 128);
                  const float cw0 = conv_w[src], cw1 = conv_w[1024 + src], cw2 = conv_w[2048 + src], cw3 = conv_w[3072 + src], cbias = conv_b[src];
                  const int tb = t0 + th * 32 - 3; float xr[35];
#pragma unroll
                  for (int i = 0; i < 35; ++i) xr[i] = (tb + i >= 0) ? MQKRAW[(size_t)(tb + i) * 1024 + src] : 0.f;
#pragma unroll
                  for (int i = 0; i < 32; ++i) { const int s_ = th * 32 + i, t = t0 + s_; float y = cbias + ((cw0 * xr[i] + cw1 * xr[i + 1]) + (cw2 * xr[i + 2] + cw3 * xr[i + 3]));
                      y = y / (1.f + __expf(-y));
                      if (ch < 128) QCM[(size_t)t * 512 + h * 128 + ch] = (bf16)f2bf(y * 0.08838834764831845f);
                      else { const unsigned kb = f2bf(y); KCM[(size_t)t * 512 + h * 128 + (ch - 128)] = (bf16)kb; const float kf = bf2f(kb); kq[s_ * 128 + (ch - 128)] = kf; KWT[(ch - 128) * 72 + s_] = (bf16)f2bf(sw[s_] * kf); } } }
#pragma unroll 1
                for (int e = tid; e < 64 * 32; e += 512) { const int s = e & 63, c8 = e >> 6; const u32x4 vv = *(const u32x4*)(MV + (size_t)(t0 + s) * 1024 + h * 256 + c8 * 8);
                    LAS bf16* d = VTl + (c8 * 8) * 72 + s;
                    d[0] = (bf16)(vv.x & 0xffffu); d[72] = (bf16)(vv.x >> 16); d[144] = (bf16)(vv.y & 0xffffu); d[216] = (bf16)(vv.y >> 16);
                    d[288] = (bf16)(vv.z & 0xffffu); d[360] = (bf16)(vv.z >> 16); d[432] = (bf16)(vv.w & 0xffffu); d[504] = (bf16)(vv.w >> 16); }
                __syncthreads();
#pragma unroll 1
                for (int e = tid; e < 256 * 8; e += 512) { const int dv = e >> 3, ch = e & 7; *(u32x4*)(VTM + ((size_t)(c * 4 + h) * 256 + dv) * 64 + ch * 8) = *(const LAS u32x4*)(VTl + dv * 72 + ch * 8); }
                {
                    bf16x8 af[4];
#pragma unroll
                    for (int ks = 0; ks < 4; ++ks) af[ks] = *(const LAS bf16x8*)(VTl + (wave * 32 + r32) * 72 + ks * 16 + 8 * hh);
#pragma unroll 1
                    for (int j = 0; j < 4; ++j) { f32x16 acc;
#pragma unroll
                        for (int i = 0; i < 16; ++i) acc[i] = 0.f;
#pragma unroll
                        for (int ks = 0; ks < 4; ++ks) { const bf16x8 bfr = *(const LAS bf16x8*)(KWT + (j * 32 + r32) * 72 + ks * 16 + 8 * hh); acc = __builtin_amdgcn_mfma_f32_32x32x16_bf16(af[ks], bfr, acc, 0, 0, 0); }
                        float* o = LST + ((size_t)(c * 4 + h) * 256 + wave * 32 + 4 * hh) * 128 + j * 32 + r32;
#pragma unroll
                        for (int i = 0; i < 16; ++i) o[(size_t)((i & 3) + 8 * (i >> 2)) * 128] = acc[i]; }
                }
                if (tid < 128) { float a = 0.f;
#pragma unroll 4
                    for (int s = 0; s < 64; ++s) a += sw[s] * kq[s * 128 + tid]; NL[(size_t)(c * 4 + h) * 128 + tid] = a; }
            }
        }
        GRID_BAR(2);
    }

    if (IN(3)) for (int rep_ = 0; rep_ < NREP(3); ++rep_) {
        PHASE_IDS
        if (rep_) xcd_barrier(bar, tid);
#ifndef R_SCAN
#define R_SCAN 1
#endif
        for (int prv_ = 0; prv_ < 1 + PR_VF; ++prv_)
        for (int id = bx; id < 512; id += G) {
            const int h = id >> 7, rt = (id & 127) >> 2, ct = id & 3;
            mini_gemm64(lds, WCO_T + (size_t)(rt * 64) * D + h * 512, D, KC + (size_t)(ct * 64) * 4096 + 2048 + h * 512, 4096u, 4, VF + (size_t)(rt * 64) * 1024 + h * 256 + ct * 64, 1024u, wave, lane);
        }
        for (int prv_ = 0; prv_ < 1 + PR_VF; ++prv_)
        for (int id = bx; id < 512; id += G) {
            const int h = id >> 7, kt = (id & 127) >> 2, mt = id & 3;
            mini_gemm64(lds, KC + (size_t)(mt * 64) * 4096 + h * 512, 4096u, WCQ_T + (size_t)(kt * 64) * D + h * 512, D, 4, MF + (size_t)(h * 256 + mt * 64) * D + kt * 64, D, wave, lane);
        }
        for (int rscan_ = 0; rscan_ < R_SCAN; ++rscan_) {
            LAS float* am = (LAS float*)lds;
            LAS float* sm = am + 512;
            LAS float* gl = am + 1024;
            __syncthreads();
            gl[tid] = GATES[GT_G + tid]; gl[512 + tid] = GATES[GT_MLOC + tid];
            __syncthreads();
            if (tid < 4) { float m = 0.f;
#pragma unroll 1
                for (int k = 0; k < NCH; ++k) { const float g = gl[k * 4 + tid], ml = gl[512 + k * 4 + tid]; const float mn = fmaxf(g + m, ml);
                    am[tid * 128 + k] = __expf(g + m - mn); sm[tid * 128 + k] = __expf(ml - mn); if (bx == 0) GATES[GT_MPREV + k * 4 + tid] = m; m = mn; } }
            __syncthreads();
            for (int e = bx * 512 + tid; e < 4 * 32768; e += G * 512) { const int h = e >> 15, rem = e & 32767; float C = 0.f;
#pragma unroll 1
                for (int kb = 0; kb < NCH; kb += 32) { float l[32];
#pragma unroll
                    for (int i = 0; i < 32; ++i) l[i] = __builtin_nontemporal_load(LST + (size_t)((kb + i) * 4 + h) * 32768 + rem);
#pragma unroll
                    for (int i = 0; i < 32; ++i) { const int k = kb + i; CST[(size_t)(k * 4 + h) * 32768 + rem] = (bf16)f2bf(C); C = am[h * 128 + k] * C + sm[h * 128 + k] * l[i]; } } }
            if (bx == 0) { const int h = tid >> 7, dk = tid & 127; float n = 0.f;
#pragma unroll 1
                for (int kb = 0; kb < NCH; kb += 16) { float l[16];
#pragma unroll
                    for (int i = 0; i < 16; ++i) l[i] = NL[(size_t)((kb + i) * 4 + h) * 128 + dk];
#pragma unroll
                    for (int i = 0; i < 16; ++i) { const int k = kb + i; NST[(size_t)(k * 4 + h) * 128 + dk] = n; n = am[h * 128 + k] * n + sm[h * 128 + k] * l[i]; } } }
            __syncthreads();
        }
        {
            const int r32 = lane & 31, hh = lane >> 5;
            for (int L = bx; L < 1152; L += G) {
                int sl = 0, rem = L;
#pragma unroll 1
                while (rem >= 256 - 32 * sl) { rem -= 256 - 32 * sl; ++sl; }
                const int g = 32 * sl + rem, c = g >> 1, tq0 = g * 32 + wave * 4, N = 64 * (c + 1);
                const int jb = sl * 32, je = (N >> 5) < jb + 32 ? (N >> 5) : jb + 32;
                if (N <= 256) continue;
                unsigned short* rowb = (c < 127 ? (unsigned short*)A_->out + (size_t)2048 * c * (c + 1) : (unsigned short*)(ws + WS_SC127)) + (size_t)(tq0 & 63) * N + jb * 32;
                LAS unsigned short* stg = (LAS unsigned short*)(lds + wave * 8192);
                bf16x8 af[4]; float wq[16];
                { const bf16* qp = QI + (size_t)(tq0 + (r32 >> 3)) * 512 + (r32 & 7) * 64 + 8 * hh;
#pragma unroll
                  for (int ks = 0; ks < 4; ++ks) af[ks] = *(const bf16x8*)(qp + ks * 16);
#pragma unroll
                  for (int qq = 0; qq < 4; ++qq)
#pragma unroll
                      for (int i = 0; i < 4; ++i) wq[qq * 4 + i] = SMALL[(size_t)(tq0 + qq) * 256 + 64 + 4 * hh + i] * 0.04419417382415922f; }
#define IDX_GROUP(gi_) do { const int tile_ = jb + (gi_) * 8 + wave; if (tile_ < je) { _Pragma("unroll") for (int i4 = 0; i4 < 4; ++i4) { const int row_ = i4 * 8 + (lane >> 3); \
                        const bf16* gsrc_ = KIDXN + (size_t)(tile_ * 32 + row_) * 64 + (((lane & 7) ^ (row_ & 7)) * 8); \
                        const unsigned ldst_ = __builtin_amdgcn_readfirstlane((unsigned)(size_t)lds + 65536u + (unsigned)(((gi_) & 1) * 32768 + wave * 4096 + i4 * 1024)); unsigned keep_; \
                        asm volatile("s_mov_b32 %0, m0\n\ts_mov_b32 m0, %2\n\ts_nop 0\n\tglobal_load_lds_dwordx4 %1, off\n\ts_mov_b32 m0, %0" : "=&s"(keep_) : "v"(gsrc_), "s"(ldst_) : "memory"); } } } while (0)
#define IDX_LOAD(buf, gi_, tl_) do { const LAS unsigned char* kt_ = lds + 65536 + ((gi_) & 1) * 32768 + (tl_) * 4096 + r32 * 128; \
                    _Pragma("unroll") for (int ks = 0; ks < 4; ++ks) buf[ks] = *(const LAS bf16x8*)(kt_ + (((ks * 2 + hh) ^ (r32 & 7)) * 16)); } while (0)
#define RELU_(x_) __int_as_float(max(__float_as_int(x_), 0))
#define IDX_TILE(buf, jj) do { const int s0 = (jj) * 32; f32x16 acc; _Pragma("unroll") for (int i = 0; i < 16; ++i) acc[i] = 0.f; \
                        _Pragma("unroll") for (int ks = 0; ks < 4; ++ks) acc = __builtin_amdgcn_mfma_f32_32x32x16_bf16(af[ks], buf[ks], acc, 0, 0, 0); \
                        if (PR_MFMA) { f32x16 acc2; _Pragma("unroll") for (int i = 0; i < 16; ++i) acc2[i] = 0.f; _Pragma("unroll") for (int ks = 0; ks < 4; ++ks) acc2 = __builtin_amdgcn_mfma_f32_32x32x16_bf16(af[ks], buf[ks], acc2, 0, 0, 0); asm volatile("" :: "v"(acc2)); } \
                        if (PR_EPI) { f32x16 a3 = acc; asm volatile("" : "+v"(a3)); float p3[4]; _Pragma("unroll") for (int qq = 0; qq < 4; ++qq) p3[qq] = (wq[qq * 4] * fmaxf(a3[qq * 4], 0.f) + wq[qq * 4 + 1] * fmaxf(a3[qq * 4 + 1], 0.f)) + (wq[qq * 4 + 2] * fmaxf(a3[qq * 4 + 2], 0.f) + wq[qq * 4 + 3] * fmaxf(a3[qq * 4 + 3], 0.f)); \
                            _Pragma("unroll") for (int qq = 0; qq < 4; ++qq) p3[qq] += __shfl_xor(p3[qq], 32); asm volatile("" :: "v"(p3[0]), "v"(p3[1]), "v"(p3[2]), "v"(p3[3])); } \
                        float part[4]; \
                          \
                        _Pragma("unroll") for (int qq = 0; qq < 4; ++qq) part[qq] = (wq[qq * 4] * RELU_(acc[qq * 4]) + wq[qq * 4 + 1] * RELU_(acc[qq * 4 + 1])) + (wq[qq * 4 + 2] * RELU_(acc[qq * 4 + 2]) + wq[qq * 4 + 3] * RELU_(acc[qq * 4 + 3])); \
                        const auto s02_ = __builtin_amdgcn_permlane32_swap(__float_as_uint(part[0]), __float_as_uint(part[2]), false, false), s13_ = __builtin_amdgcn_permlane32_swap(__float_as_uint(part[1]), __float_as_uint(part[3]), false, false); \
                          \
                        const float v0 = __uint_as_float(s02_[0]) + __uint_as_float(s02_[1]), v1 = __uint_as_float(s13_[0]) + __uint_as_float(s13_[1]); \
                        unsigned u0 = __builtin_bit_cast(unsigned short, (_Float16)v0), u1 = __builtin_bit_cast(unsigned short, (_Float16)v1); \
                        u0 = (u0 == 0x8000u) ? 0u : u0; u1 = (u1 == 0x8000u) ? 0u : u1; \
                        stg[(2 * hh) * 1024 + s0 - jb * 32 + r32] = (unsigned short)((u0 & 0x8000u) ? ~u0 : (u0 | 0x8000u)); \
                        stg[(2 * hh + 1) * 1024 + s0 - jb * 32 + r32] = (unsigned short)((u1 & 0x8000u) ? ~u1 : (u1 | 0x8000u)); } while (0)
                { const int ngrp = (je - jb + 7) >> 3;
                  __syncthreads();
                  IDX_GROUP(0);
#pragma unroll 1
                  for (int gi = 0; gi < ngrp; ++gi) {
                      asm volatile("s_waitcnt vmcnt(0)" ::: "memory");
                      __syncthreads();
                      if (gi + 1 < ngrp) IDX_GROUP(gi + 1);
#pragma unroll 2
                      for (int tl = 0; tl < 8; ++tl) { const int jt = jb + gi * 8 + tl; if (jt < je) { bf16x8 kbf[4]; IDX_LOAD(kbf, gi, tl); IDX_TILE(kbf, jt); } }
                  } }
#undef IDX_GROUP
#undef IDX_LOAD
#undef IDX_TILE
                LDS_WAIT(); asm volatile("" ::: "memory");
                { const int nk = (je - jb) * 32, np = nk >> 3;
                  for (int i = lane; i < 4 * np; i += 64) { const int qq = i / np, p = i - qq * np; *(u32x4*)(rowb + (size_t)qq * N + p * 8) = *(const LAS u32x4*)(stg + qq * 1024 + p * 8); } }
                LDS_WAIT(); asm volatile("" ::: "memory");
            }
        }
        GRID_BAR(3);
    }
    if (IN(4)) for (int rep_ = 0; rep_ < NREP(4); ++rep_) {
        PHASE_IDS
        if (rep_) xcd_barrier(bar, tid);
        {
            LAS int* hist = (LAS int*)(lds + MISC_OFF + 4096) + wave * 256;
            LAS int* sel = (LAS int*)(lds + MISC_OFF + 12288) + wave * 256;
            const int r16 = lane & 15, g4 = lane >> 4;
            __syncthreads();
#pragma unroll 1
            for (int ui_ = 0; ui_ * G < T / 8; ++ui_) {
                const int uu = ui_ * G + ((ui_ & 1) ? (G - 1 - bx) : bx); if (uu >= T / 8) continue;
                const int t0 = uu * 8, t = t0 + wave, c = t0 >> 6, N = (c + 1) * 64, ng = N >> 6;
                {
                        if (N > 256) {
                            const unsigned short* rb = (c < 127 ? (const unsigned short*)A_->out + (size_t)2048 * c * (c + 1) : (const unsigned short*)(ws + WS_SC127)) + (size_t)(t & 63) * N;
                            unsigned kr[128];
#pragma unroll
                            for (int b8 = 0; b8 < 16; ++b8) {
#pragma unroll
                                for (int i = 0; i < 8; ++i) kr[b8 * 8 + i] = 0u;
                                if (b8 * 8 < ng) { const bool ok = b8 * 512 + lane * 8 < N;
                                    u32x4 v = *(const GAS u32x4*)(rb + (ok ? b8 * 512 + lane * 8 : 0)); if (!ok) v = (u32x4){0u, 0u, 0u, 0u};
                                    kr[b8 * 8 + 0] = v.x & 0xffffu; kr[b8 * 8 + 1] = v.x >> 16; kr[b8 * 8 + 2] = v.y & 0xffffu; kr[b8 * 8 + 3] = v.y >> 16;
                                    kr[b8 * 8 + 4] = v.z & 0xffffu; kr[b8 * 8 + 5] = v.z >> 16; kr[b8 * 8 + 6] = v.w & 0xffffu; kr[b8 * 8 + 7] = v.w >> 16; } }
                            int krem = 256; unsigned prefix = 0u;
#pragma unroll 1
                            for (int ps = 0; ps < 2; ++ps) { const int shift = 8 - 8 * ps;
                                hist[lane] = 0; hist[64 + lane] = 0; hist[128 + lane] = 0; hist[192 + lane] = 0;
#pragma unroll
                                for (int b8 = 0; b8 < 16; ++b8) { if (b8 * 8 < ng) {
#pragma unroll
                                    for (int i = 0; i < 8; ++i) { const unsigned k = kr[b8 * 8 + i]; const bool mt = (k != 0u) && (ps == 0 || (k >> 8) == prefix);
                                        if (mt) __hip_atomic_fetch_add(hist + (int)((k >> shift) & 255u), 1, __ATOMIC_RELAXED, __HIP_MEMORY_SCOPE_WORKGROUP); } } }
                                const int h0 = hist[4 * lane], h1 = hist[4 * lane + 1], h2 = hist[4 * lane + 2], h3 = hist[4 * lane + 3];
                                int sfx = h0 + h1 + h2 + h3;
#pragma unroll
                                for (int o = 1; o < 64; o <<= 1) { const int v = __shfl_down(sfx, o); if (lane + o < 64) sfx += v; }
                                const unsigned long long mge = __ballot(sfx >= krem);
                                const int ls = 63 - __builtin_clzll(mge);
                                const int above_l = (ls < 63) ? __builtin_amdgcn_readlane(sfx, (ls + 1) & 63) : 0;
                                const int b1 = __builtin_amdgcn_readlane(h1, ls), b2 = __builtin_amdgcn_readlane(h2, ls), b3 = __builtin_amdgcn_readlane(h3, ls);
                                int dg, above;
                                if (above_l + b3 >= krem) { dg = 3; above = above_l; } else if (above_l + b3 + b2 >= krem) { dg = 2; above = above_l + b3; }
                                else if (above_l + b3 + b2 + b1 >= krem) { dg = 1; above = above_l + b3 + b2; } else { dg = 0; above = above_l + b3 + b2 + b1; }
                                krem -= above; prefix = (prefix << 8) | (unsigned)(4 * ls + dg); }
                            const unsigned thr = prefix;
                            int cg = 0; const int thi = (int)thr;
#pragma unroll
                            for (int b8 = 0; b8 < 16; ++b8) { if (b8 * 8 < ng) {
#pragma unroll
                                for (int i = 0; i < 8; ++i) { const int k = (int)kr[b8 * 8 + i]; cg += (int)((unsigned)(thi - k) >> 31); } } }
#pragma unroll
                            for (int o = 1; o < 64; o <<= 1) cg += __shfl_xor(cg, o);
                            const int ngt = __builtin_amdgcn_readfirstlane(cg), need = 256 - ngt;
                            int pg = 0, pe = 0; const unsigned long long ltm = (1ull << lane) - 1ull;
                            const int dump = (int)(((LAS int*)(lds + MISC_OFF + 20480) + wave * 64 + lane) - sel);
#pragma unroll
                            for (int b8 = 0; b8 < 16; ++b8) { if (b8 * 8 < ng) {
#pragma unroll
                                for (int i = 0; i < 8; ++i) { const unsigned k = kr[b8 * 8 + i]; const int sidx = b8 * 512 + lane * 8 + i; const bool gt = k > thr, eq = k == thr;
                                    const unsigned long long mg = __ballot(gt), me = __ballot(eq);
                                    const int pos = (int)__builtin_amdgcn_mbcnt_hi((unsigned)(mg >> 32), __builtin_amdgcn_mbcnt_lo((unsigned)mg, (unsigned)pg));
                                    sel[gt ? pos : dump] = sidx; pg += __popcll(mg);
                                    if (me) { const int r = pe + __popcll(me & ltm); if (eq && r < need) sel[ngt + r] = sidx; pe += __popcll(me); } } } }
                        } else {
#pragma unroll
                            for (int i = 0; i < 4; ++i) sel[i * 64 + lane] = i * 64 + lane;
                        }
                        LDS_WAIT(); asm volatile("" ::: "memory");
                }
                {
                        LAS unsigned char* cb = lds + wave * 16384;
                        const int nch = (N > 256 ? 256 : N) >> 5;
                        bf16x8 qf[8];
                        { const bf16* qp = QABS + (size_t)t * 2048 + (r16 & 7) * 256 + 8 * g4;
#pragma unroll
                          for (int ks = 0; ks < 8; ++ks) qf[ks] = *(const bf16x8*)(qp + ks * 32); }
                        f32x4 O[16];
#pragma unroll
                        for (int i = 0; i < 16; ++i) O[i] = (f32x4){0.f, 0.f, 0.f, 0.f};
                        float mrun = -3.0e38f, lrun = 0.f;
                        const int tq = r16 >> 2, tp = r16 & 3;
#pragma unroll 1
                        for (int ch = 0; ch < nch; ++ch) { const int slot0 = ch * 32;
#pragma unroll
                            for (int k = 0; k < 16; ++k) { const int im = k >> 3, row = (k & 7) * 4 + g4; const int lc = r16 ^ (((row & 3) << 2) | ((row >> 2) & 3)); const int key = sel[slot0 + row];
                                __builtin_amdgcn_global_load_lds((const unsigned*)(CKVN + (size_t)key * 256 + im * 128 + lc * 8), (LAS unsigned*)(cb + im * 8192 + (k & 7) * 1024), 16, 0, 0); }
                            asm volatile("s_waitcnt vmcnt(0)" ::: "memory");
                            const LAS unsigned char* cbc = cb;
                            f32x4 s0 = (f32x4){0.f, 0.f, 0.f, 0.f}, s1 = s0;
#pragma unroll
                            for (int ks = 0; ks < 8; ++ks) { const int im = ks >> 2, lc = 4 * (ks & 3) + g4;
                                const int ra = r16, rb = 16 + r16;
                                const bf16x8 k0 = *(const LAS bf16x8*)(cbc + im * 8192 + 256 * ra + 16 * (lc ^ (((ra & 3) << 2) | ((ra >> 2) & 3))));
                                const bf16x8 k1 = *(const LAS bf16x8*)(cbc + im * 8192 + 256 * rb + 16 * (lc ^ (((rb & 3) << 2) | ((rb >> 2) & 3))));
                                s0 = __builtin_amdgcn_mfma_f32_16x16x32_bf16(k0, qf[ks], s0, 0, 0, 0); s1 = __builtin_amdgcn_mfma_f32_16x16x32_bf16(k1, qf[ks], s1, 0, 0, 0);
                                if ((ks & 1) == 1) __builtin_amdgcn_sched_barrier(0); }
                            float mx = fmaxf(fmaxf(fmaxf(s0[0], s0[1]), fmaxf(s0[2], s0[3])), fmaxf(fmaxf(s1[0], s1[1]), fmaxf(s1[2], s1[3])));
                            mx = fmaxf(mx, __shfl_xor(mx, 16)); mx = fmaxf(mx, __shfl_xor(mx, 32));
                            const float mnew = fmaxf(mrun, mx), alpha = __expf(mrun - mnew); mrun = mnew;
                            float p[8]; float ls = 0.f;
#pragma unroll
                            for (int i = 0; i < 4; ++i) { p[i] = __expf(s0[i] - mnew); p[4 + i] = __expf(s1[i] - mnew); ls += p[i] + p[4 + i]; }
                            ls += __shfl_xor(ls, 16); ls += __shfl_xor(ls, 32);
                            lrun = lrun * alpha + ls;
                            u32x4 pw; pw.x = pk2(p[0], p[1]); pw.y = pk2(p[2], p[3]); pw.z = pk2(p[4], p[5]); pw.w = pk2(p[6], p[7]);
                            const bf16x8 pf = __builtin_bit_cast(bf16x8, pw);
#pragma unroll
                            for (int i = 0; i < 16; ++i) O[i] = O[i] * alpha;
                            const unsigned cbase = (unsigned)(size_t)cbc + 256u * (4 * g4 + tq) + 8u * (tp & 1);
#pragma unroll
                            for (int cq = 0; cq < 4; ++cq) {
                                u32x2 va[4], vb[4]; unsigned ad[4];
#pragma unroll
                                for (int j = 0; j < 4; ++j) { const int ct = cq * 4 + j; ad[j] = cbase + (unsigned)((ct >> 3) * 8192) + 16u * ((2 * (ct & 7) + (tp >> 1)) ^ ((tq << 2) | g4)); }
                                asm volatile("ds_read_b64_tr_b16 %0, %8\n\tds_read_b64_tr_b16 %1, %8 offset:4096\n\tds_read_b64_tr_b16 %2, %9\n\tds_read_b64_tr_b16 %3, %9 offset:4096\n\t"
                                             "ds_read_b64_tr_b16 %4, %10\n\tds_read_b64_tr_b16 %5, %10 offset:4096\n\tds_read_b64_tr_b16 %6, %11\n\tds_read_b64_tr_b16 %7, %11 offset:4096\n\ts_waitcnt lgkmcnt(0)"
                                             : "=&v"(va[0]), "=&v"(vb[0]), "=&v"(va[1]), "=&v"(vb[1]), "=&v"(va[2]), "=&v"(vb[2]), "=&v"(va[3]), "=&v"(vb[3])
                                             : "v"(ad[0]), "v"(ad[1]), "v"(ad[2]), "v"(ad[3]) : "memory");
#pragma unroll
                                for (int j = 0; j < 4; ++j) { u32x4 vv; vv.x = va[j].x; vv.y = va[j].y; vv.z = vb[j].x; vv.w = vb[j].y;
                                    O[cq * 4 + j] = __builtin_amdgcn_mfma_f32_16x16x32_bf16(__builtin_bit_cast(bf16x8, vv), pf, O[cq * 4 + j], 0, 0, 0); } }
                        }
                        const float inv = 1.f / lrun;
                        if (r16 < 8) {
#pragma unroll
                            for (int i = 0; i < 16; ++i) { u32x2 w; w.x = pk2(O[i][0] * inv, O[i][1] * inv); w.y = pk2(O[i][2] * inv, O[i][3] * inv); *(u32x2*)(MIXIN + (size_t)t * KMIX + r16 * 256 + i * 16 + 4 * g4) = w; } }
                }
            }
        }
        __syncthreads();
    }

    if (IN(4)) for (int rep_ = 0; rep_ < NREP(4); ++rep_) {
        PHASE_IDS
        if (rep_) xcd_barrier(bar, tid);
        LAS float* Sf = (LAS float*)lds;
        LAS bf16* Sb = (LAS bf16*)(lds + 16640);
        LAS float* ms = (LAS float*)(lds + 25856);
        LAS float* ssq = (LAS float*)(lds + 27904);
        const float* mlg = A_->in[I_ML_NORM_G];
        const int r32 = lane & 31, hh = lane >> 5;
        for (int uu = bx; uu < NCH * 4; uu += G) {
            const int c = uu >> 2, h = uu & 3, t0 = c * CH;
            __syncthreads();
            if (tid < 64) { const float b = GATES[GT_B + (size_t)(t0 + tid) * 4 + h], li = GATES[GT_LI + (size_t)(t0 + tid) * 4 + h]; ms[tid] = b; ms[64 + tid] = li - b; }
            if (tid < 128) ms[384 + tid] = NST[(size_t)(c * 4 + h) * 128 + tid];
            __syncthreads();
            float mt = 0.f;
            if (wave == 0) { const float mprev = GATES[GT_MPREV + c * 4 + h]; float pm = ms[64 + lane];
#pragma unroll
                for (int o = 1; o < 64; o <<= 1) { const float v = __shfl_up(pm, o); if (lane >= o) pm = fmaxf(pm, v); }
                const float mm = fmaxf(mprev, pm); mt = ms[lane] + mm; ms[128 + lane] = -mm; ms[192 + lane] = __expf(mprev - mm);
                float qn = 0.f; const bf16* qr = QCM + (size_t)(t0 + lane) * 512 + h * 128; u32x4 qq[16];
#pragma unroll
                for (int k8 = 0; k8 < 16; ++k8) qq[k8] = *(const u32x4*)(qr + k8 * 8);
#pragma unroll
                for (int k8 = 0; k8 < 16; ++k8) { const LAS float* np = ms + 384 + k8 * 8;
                    qn += (bf2f(qq[k8].x & 0xffffu) * np[0] + bf2f(qq[k8].x >> 16) * np[1]) + (bf2f(qq[k8].y & 0xffffu) * np[2] + bf2f(qq[k8].y >> 16) * np[3]) + (bf2f(qq[k8].z & 0xffffu) * np[4] + bf2f(qq[k8].z >> 16) * np[5]) + (bf2f(qq[k8].w & 0xffffu) * np[6] + bf2f(qq[k8].w >> 16) * np[7]); }
                ms[320 + lane] = qn; }
            __syncthreads();
            if (wave < 4) {
                const int tm = wave >> 1, tn = wave & 1;
                f32x16 acc;
#pragma unroll
                for (int i = 0; i < 16; ++i) acc[i] = 0.f;
                if (tn <= tm) { const bf16* qr = QCM + (size_t)(t0 + tm * 32 + r32) * 512 + h * 128 + 8 * hh; const bf16* kr = KCM + (size_t)(t0 + tn * 32 + r32) * 512 + h * 128 + 8 * hh;
#pragma unroll
                    for (int ks = 0; ks < 8; ++ks) acc = __builtin_amdgcn_mfma_f32_32x32x16_bf16(*(const bf16x8*)(qr + ks * 16), *(const bf16x8*)(kr + ks * 16), acc, 0, 0, 0); }
                const int sidx = tn * 32 + r32; const float us = ms[64 + sidx];
#pragma unroll
                for (int i = 0; i < 16; ++i) { const int t = tm * 32 + (i & 3) + 8 * (i >> 2) + 4 * hh; const float v = (sidx <= t) ? acc[i] * __expf(ms[128 + t] + us) : 0.f; Sf[t * 65 + sidx] = v; Sb[t * 72 + sidx] = (bf16)f2bf(v); }
            }
            __syncthreads();
            if (tid < 64) { float rs = 0.f;
#pragma unroll 4
                for (int s2 = 0; s2 < 64; ++s2) rs += Sf[tid * 65 + s2];
                const float dn = ms[192 + tid] * ms[320 + tid] + rs; ms[256 + tid] = fmaxf(fabsf(dn), __expf(-mt)); }
            f32x16 a1[2], a2[2];
#pragma unroll
            for (int tt = 0; tt < 2; ++tt)
#pragma unroll
                for (int i = 0; i < 16; ++i) { a1[tt][i] = 0.f; a2[tt][i] = 0.f; }
            { const bf16* cr = CST + ((size_t)(c * 4 + h) * 256 + wave * 32 + r32) * 128 + 8 * hh; const bf16* q0 = QCM + (size_t)(t0 + r32) * 512 + h * 128 + 8 * hh; const bf16* q1 = q0 + (size_t)32 * 512;
#pragma unroll
              for (int ks = 0; ks < 8; ++ks) { const bf16x8 cf = *(const bf16x8*)(cr + ks * 16); a1[0] = __builtin_amdgcn_mfma_f32_32x32x16_bf16(cf, *(const bf16x8*)(q0 + ks * 16), a1[0], 0, 0, 0); a1[1] = __builtin_amdgcn_mfma_f32_32x32x16_bf16(cf, *(const bf16x8*)(q1 + ks * 16), a1[1], 0, 0, 0); }
              const bf16* vr = VTM + ((size_t)(c * 4 + h) * 256 + wave * 32 + r32) * 64 + 8 * hh;
#pragma unroll
              for (int ks = 0; ks < 4; ++ks) { const bf16x8 vf = *(const bf16x8*)(vr + ks * 16); a2[0] = __builtin_amdgcn_mfma_f32_32x32x16_bf16(vf, *(const LAS bf16x8*)(Sb + r32 * 72 + ks * 16 + 8 * hh), a2[0], 0, 0, 0); a2[1] = __builtin_amdgcn_mfma_f32_32x32x16_bf16(vf, *(const LAS bf16x8*)(Sb + (32 + r32) * 72 + ks * 16 + 8 * hh), a2[1], 0, 0, 0); } }
            __syncthreads();
#pragma unroll
            for (int tt = 0; tt < 2; ++tt) { const int t = tt * 32 + r32; const float ai = ms[192 + t], idn = 1.f / ms[256 + t]; float p = 0.f;
#pragma unroll
                for (int i = 0; i < 16; ++i) { const float v = (ai * a1[tt][i] + a2[tt][i]) * idn; a1[tt][i] = v; p += v * v; }
                p += __shfl_xor(p, 32); if (hh == 0) ssq[wave * 64 + t] = p; }
            __syncthreads();
#pragma unroll
            for (int tt = 0; tt < 2; ++tt) { const int t = tt * 32 + r32; float sq = 0.f;
#pragma unroll
                for (int w2 = 0; w2 < 8; ++w2) sq += ssq[w2 * 64 + t];
                const float r = rsqrtf(sq * (1.f / 256.f) + EPS);
#pragma unroll
                for (int rq = 0; rq < 4; ++rq) { const int dv0 = h * 256 + wave * 32 + 8 * rq + 4 * hh; const f32x4 g = *(const f32x4*)(mlg + dv0); const u32x2 ob = *(const u32x2*)(MO + (size_t)(t0 + t) * 1024 + dv0);
                    const float o0 = bf2f(ob.x & 0xffffu), o1 = bf2f(ob.x >> 16), o2 = bf2f(ob.y & 0xffffu), o3 = bf2f(ob.y >> 16);
                    u32x2 w; w.x = pk2(a1[tt][4 * rq] * r * g[0] / (1.f + __expf(-o0)), a1[tt][4 * rq + 1] * r * g[1] / (1.f + __expf(-o1))); w.y = pk2(a1[tt][4 * rq + 2] * r * g[2] / (1.f + __expf(-o2)), a1[tt][4 * rq + 3] * r * g[3] / (1.f + __expf(-o3)));
                    *(u32x2*)(MIXIN + (size_t)(t0 + t) * KMIX + 2048 + dv0) = w; } }
        }
        GRID_BAR(4);
    }

    if (IN(6)) for (int rep_ = 0; rep_ < NREP(6); ++rep_) {
        PHASE_IDS
        if (rep_) xcd_barrier(bar, tid);
        pg8::DenseOrder S; S.init(T, D, KMIX, KMIX, G, bx);
        pg8::EpiResidT<false> E{A_->in[I_X], X1B, SS2};
        pg8::gemm_phase(tid, lds, MIXIN, WOUT_T, KMIX, S, E);
        GRID_BAR(6);
    }
    if (IN(7)) for (int rep_ = 0; rep_ < NREP(7); ++rep_) {
        PHASE_IDS
        if (rep_) xcd_barrier(bar, tid);
        pg8::DenseOrder S; S.init(T, 1024, D, D, G, bx);
        pg8::EpiSoftmax E{PB, SS2};
        pg8::gemm_phase(tid, lds, X1B, MF, D, S, E);
        GRID_BAR(7);
    }
    if (IN(10)) for (int rep_ = 0; rep_ < NREP(10); ++rep_) {
        PHASE_IDS
        if (rep_) xcd_barrier(bar, tid);
        pg8::DenseOrder S; S.init(T, D, 1024, 1024, G, bx);
        pg8::EpiResidT<true> E{X1B, X2B, nullptr};
        pg8::gemm_phase(tid, lds, PB, VF, 1024, S, E);
        GRID_BAR(10);
    }
    if (IN(11)) for (int rep_ = 0; rep_ < NREP(11); ++rep_) {
        PHASE_IDS
        if (rep_) xcd_barrier(bar, tid);
        LAS float* part = (LAS float*)lds;
        LAS float* ssp = (LAS float*)(lds + 24576);
        LAS int* eb = (LAS int*)(lds + 24576 + 512);
        const int r16 = lane & 15, g4 = lane >> 4;
        for (int uu = bx; uu < T / 32; uu += G) {
            const int t0 = uu * 32; const int tt = wave & 1, ksl = wave >> 1;
            __syncthreads();
            {
                f32x4 acc[3];
#pragma unroll
                for (int i = 0; i < 3; ++i) acc[i] = (f32x4){0.f, 0.f, 0.f, 0.f};
                float ssq = 0.f;
                const bf16* xr = X2B + (size_t)(t0 + tt * 16 + r16) * D + ksl * 512 + 8 * g4;
                const bf16* wh = WRH + (size_t)r16 * D + ksl * 512 + 8 * g4; const bf16* wl = WRL + (size_t)r16 * D + ksl * 512 + 8 * g4;
#pragma unroll 4
                for (int ks = 0; ks < 16; ++ks) { const u32x4 xa = *(const u32x4*)(xr + ks * 32);
                    { const float f0 = bf2f(xa.x & 0xffffu), f1 = bf2f(xa.x >> 16), f2 = bf2f(xa.y & 0xffffu), f3 = bf2f(xa.y >> 16), f4 = bf2f(xa.z & 0xffffu), f5 = bf2f(xa.z >> 16), f6 = bf2f(xa.w & 0xffffu), f7 = bf2f(xa.w >> 16);
                      ssq += ((f0 * f0 + f1 * f1) + (f2 * f2 + f3 * f3)) + ((f4 * f4 + f5 * f5) + (f6 * f6 + f7 * f7)); }
                    const bf16x8 Ah = __builtin_bit_cast(bf16x8, xa);
#pragma unroll
                    for (int nt = 0; nt < 3; ++nt) { const bf16x8 Bh = *(const bf16x8*)(wh + (size_t)nt * 16 * D + ks * 32), Bl = *(const bf16x8*)(wl + (size_t)nt * 16 * D + ks * 32);
                        acc[nt] = __builtin_amdgcn_mfma_f32_16x16x32_bf16(Ah, Bh, acc[nt], 0, 0, 0); acc[nt] = __builtin_amdgcn_mfma_f32_16x16x32_bf16(Ah, Bl, acc[nt], 0, 0, 0); } }
#pragma unroll
                for (int nt = 0; nt < 3; ++nt)
#pragma unroll
                    for (int i = 0; i < 4; ++i) part[(ksl * 32 + tt * 16 + 4 * g4 + i) * 48 + nt * 16 + r16] = acc[nt][i];
                ssq += __shfl_xor(ssq, 16); ssq += __shfl_xor(ssq, 32);
                if (g4 == 0) ssp[ksl * 32 + tt * 16 + r16] = ssq;
            }
            __syncthreads();
            int e1 = 0, e2 = 0;
            if (tid < 32) { const int t = t0 + tid; const float rstd = rsqrtf((ssp[tid] + ssp[32 + tid] + ssp[64 + tid] + ssp[96 + tid]) * (1.f / D) + EPS);
                const LAS float* p0 = part + tid * 48;
#define LG(o) ((p0[(o)] + p0[32 * 48 + (o)] + p0[64 * 48 + (o)] + p0[96 * 48 + (o)]) * rstd)
                int gs = 0; float gmax = LG(0) + A_->in[I_B_GROUP][0]; float gv[4]; gv[0] = gmax;
#pragma unroll
                for (int i = 1; i < 4; ++i) { gv[i] = LG(i) + A_->in[I_B_GROUP][i]; if (gv[i] > gmax) { gmax = gv[i]; gs = i; } }
                float gsum = 0.f;
#pragma unroll
                for (int i = 0; i < 4; ++i) gsum += __expf(gv[i] - gmax);
                const float pg = 1.f / gsum;
                int i1 = 0, i2 = 0; float v1 = -3.0e38f, v2 = -3.0e38f;
#pragma unroll 1
                for (int i = 0; i < 8; ++i) { const float ev = LG(4 + gs * 8 + i) + A_->in[I_B_ROUTER][gs * 8 + i];
                    if (ev > v1) { v2 = v1; i2 = i1; v1 = ev; i1 = i; } else if (ev > v2) { v2 = ev; i2 = i; } }
#undef LG
                const float p2 = __expf(v2 - v1); const float g1 = pg / (1.f + p2), g2 = pg * p2 / (1.f + p2);
                e1 = gs * 8 + i1; e2 = gs * 8 + i2;
                eb[2 * tid] = e1; eb[2 * tid + 1] = e2;
                TOKW[2 * t] = g1; TOKW[2 * t + 1] = g2; RSTD3[t] = rstd; }
            __syncthreads();
            LAS int* ebase = eb + 64;
            if (tid >= 64 && tid < 96) { const int e = tid - 64; int c = 0;
#pragma unroll 1
                for (int a2 = 0; a2 < 64; ++a2) c += (eb[a2] == e) ? 1 : 0;
                ebase[e] = c ? atomicAdd(CNT + e, c) : 0; }
            __syncthreads();
            if (tid < 64) { const int e = eb[tid]; int rk = 0;
#pragma unroll 1
                for (int a2 = 0; a2 < tid; ++a2) rk += (eb[a2] == e) ? 1 : 0;
                const int slot = ebase[e] + rk; LIST[e * T + slot] = t0 + (tid >> 1); TOKE[2 * t0 + tid] = e * T + slot; }
        }
        GRID_BAR(11);
    }
    volatile LAS int* cnl = (volatile LAS int*)(MISC + 64); volatile LAS int* prel = (volatile LAS int*)(MISC + 128); volatile LAS int* tbl = (volatile LAS int*)(MISC + 192);
    volatile LAS int* mtl = (volatile LAS int*)(MISC + 256); volatile LAS int* tlr = (volatile LAS int*)(MISC + 288); volatile LAS int* tpre = (volatile LAS int*)(MISC + 320); volatile LAS int* fll = (volatile LAS int*)(MISC + 384);
    constexpr int MOE_TAIL = 96;
#define MOE_TABLES(ncol) do { __syncthreads(); if (tid < 64) { const int e = tid & 31; const int c = __hip_atomic_load(CNT + e, __ATOMIC_RELAXED, __HIP_MEMORY_SCOPE_AGENT);     \
        const int full = c >> 8, mt = (c + 255) >> 8; int p = mt * (ncol), tb = mt; \
        _Pragma("unroll") for (int d_ = 1; d_ < 32; d_ <<= 1) { const int q_ = __shfl_up(p, d_), r_ = __shfl_up(tb, d_); if (e >= d_) { p += q_; tb += r_; } } \
        if (tid < 32) { cnl[e] = c; prel[e] = p - mt * (ncol); tbl[e] = tb - mt; mtl[e] = mt; tlr[e] = 0; tpre[e] = 0; fll[e] = full; if (e == 31) { prel[32] = p; tbl[32] = tb; tpre[32] = 0; } } } __syncthreads(); } while (0)
#define MOE_GU(Lb, Le, nbk, cc) do { pg8::MoeOrder S{tbl, cnl, LIST, 4, (Lb), (Le), (nbk), (cc), (unsigned)D * 2u, (size_t)1024 * D * 2, (unsigned)D * 2u, 1}; \
        pg8::EpiSwiGLU E{ACT, LIST, RSTD3, cnl}; pg8::gemm_phase(tid, lds, X2B, WGU_T, D, S, E); } while (0)
#define MOE_DN(Lb, Le, nbk, cc) do { pg8::MoeOrder S{tbl, cnl, LIST, 8, (Lb), (Le), (nbk), (cc), (unsigned)DEXP * 2u, (size_t)D * DEXP * 2, (unsigned)DEXP * 2u, 0}; \
        pg8::EpiBf16 E{Y, D}; pg8::gemm_phase(tid, lds, ACT, WDN_T, DEXP, S, E); } while (0)
    if (IN(13)) for (int rep_ = 0; rep_ < NREP(13); ++rep_) {
        PHASE_IDS
        if (rep_) xcd_barrier(bar, tid);
        MOE_TABLES(4);
        const int U1 = tbl[32] * 4;
        MOE_GU(0, U1 < G ? U1 : G, G, bx);
        GRID_BAR(13);
    }
    if (IN(14)) for (int rep_ = 0; rep_ < NREP(14); ++rep_) {
        PHASE_IDS
        if (rep_) xcd_barrier(bar, tid);
        MOE_TABLES(4);
        const int RT = tbl[32], U1 = RT * 4; const int nb0 = U1 > G ? ((U1 - G) < G ? (U1 - G) : G) : 0; const int rta = (U1 < G ? U1 : G) >> 2;
        if (bx < nb0) MOE_GU(G, U1, nb0, bx);
        else MOE_DN(0, rta * 8, G - nb0, bx - nb0);
        GRID_BAR(14);
    }
    if (IN(15)) for (int rep_ = 0; rep_ < NREP(15); ++rep_) {
        PHASE_IDS
        if (rep_) xcd_barrier(bar, tid);
        MOE_TABLES(8);
        const int RT = tbl[32], U1 = RT * 4; const int rta = (U1 < G ? U1 : G) >> 2;
        MOE_DN(rta * 8, RT * 8, G, bx);
        GRID_BAR(15);
    }
    if (IN(16)) for (int rep_ = 0; rep_ < NREP(16); ++rep_) {
        PHASE_IDS
        if (rep_) xcd_barrier(bar, tid);
        MOE_TABLES(1);
        const float* fg = A_->in[I_FINAL_G];
        int a0n = 0, a1n = 0; float w0n = 0.f, w1n = 0.f;
        if (gw < T) { a0n = TOKE[2 * gw]; a1n = TOKE[2 * gw + 1]; w0n = TOKW[2 * gw]; w1n = TOKW[2 * gw + 1]; }
#pragma unroll 1
        for (int t = gw; t < T; t += NGW) {
            const int a0 = a0n, a1 = a1n; const float w0 = w0n, w1 = w1n;
            { const int tn = t + NGW; if (tn < T) { a0n = TOKE[2 * tn]; a1n = TOKE[2 * tn + 1]; w0n = TOKW[2 * tn]; w1n = TOKW[2 * tn + 1]; } }
            const size_t r0 = (size_t)tbl[a0 / T] * 256 + (a0 % T), r1 = (size_t)tbl[a1 / T] * 256 + (a1 % T);
            const u32x2* xr = (const u32x2*)(X2B + (size_t)t * D) + lane; f32x4* xo = (rep_ == NREP(16) - 1) ? (f32x4*)(A_->out + (size_t)t * D) + lane : (f32x4*)((float*)(ws + WS_X1B) + (size_t)t * D) + lane; const u32x2* y0 = (const u32x2*)(Y + r0 * D) + lane; const u32x2* y1 = (const u32x2*)(Y + r1 * D) + lane;
            f32x4 v[8]; float s = 0.f;
#pragma unroll
            for (int j = 0; j < 8; ++j) { const u32x2 xq = xr[64 * j]; v[j] = (f32x4){bf2f(xq.x & 0xffffu), bf2f(xq.x >> 16), bf2f(xq.y & 0xffffu), bf2f(xq.y >> 16)}; const u32x2 p = y0[64 * j], q = y1[64 * j];
                v[j][0] += w0 * bf2f(p.x & 0xffffu) + w1 * bf2f(q.x & 0xffffu); v[j][1] += w0 * bf2f(p.x >> 16) + w1 * bf2f(q.x >> 16);
                v[j][2] += w0 * bf2f(p.y & 0xffffu) + w1 * bf2f(q.y & 0xffffu); v[j][3] += w0 * bf2f(p.y >> 16) + w1 * bf2f(q.y >> 16);
                s += (v[j][0] * v[j][0] + v[j][1] * v[j][1]) + (v[j][2] * v[j][2] + v[j][3] * v[j][3]); }
            const float r = rsqrtf(wave_sum(s) * (1.f / D) + EPS);
#pragma unroll
            for (int j = 0; j < 8; ++j) { const f32x4 g = ((const f32x4*)fg)[lane + 64 * j]; xo[64 * j] = (f32x4){v[j][0] * r * g[0], v[j][1] * r * g[1], v[j][2] * r * g[2], v[j][3] * r * g[3]}; }
        }
    }
#undef IN
#undef BOTH
#undef GRID_BAR
}

extern "C" void kernel_launch(void* const* d_in, const int* in_sizes, int n_in, void* d_out, int out_size, void* d_ws, size_t ws_size, hipStream_t stream) {
    static int grid = 0;
    if (grid == 0) {
        if (n_in != 27 || out_size != T * D || ws_size < WS_END) { fprintf(stderr, "kernel_launch: unexpected problem (n_in %d out %d ws %zu)\n", n_in, out_size, ws_size); grid = -1; return; }
        int dev = 0, cus = 0, per_cu = 0;
        if (hipGetDevice(&dev) != hipSuccess || hipDeviceGetAttribute(&cus, hipDeviceAttributeMultiprocessorCount, dev) != hipSuccess) { grid = -1; return; }
        if (hipFuncSetAttribute((const void*)mega, hipFuncAttributeMaxDynamicSharedMemorySize, LDS_BYTES) != hipSuccess) { fprintf(stderr, "kernel_launch: hipFuncSetAttribute failed\n"); grid = -1; return; }
        if (hipOccupancyMaxActiveBlocksPerMultiprocessor(&per_cu, (const void*)mega, 512, LDS_BYTES) != hipSuccess || per_cu < 1) fprintf(stderr, "kernel_launch: occupancy query reports %d\n", per_cu);
        (void)hipGetLastError();
        grid = cus;
    }
    if (grid < 0) return;
    if (hipMemsetAsync((char*)d_ws + WS_CTL, 0, CTL_ZERO_BYTES, stream) != hipSuccess) return;
    Args a{};
    for (int i = 0; i < 27; ++i) a.in[i] = (const float*)d_in[i];
    a.out = (float*)d_out; a.ws = (unsigned char*)d_ws;
    if (MK_N_LAUNCHES == 1) { a.ph_lo = 0; a.ph_hi = NPHASE; hipLaunchKernelGGL(mega, dim3(grid), dim3(512), LDS_BYTES, stream, a); }
    else { for (int p = 0; p < NPHASE; ++p) { a.ph_lo = p; a.ph_hi = p + 1; hipLaunchKernelGGL(mega, dim3(grid), dim3(512), LDS_BYTES, stream, a); } }
}
```

```cpp
#include <hip/hip_runtime.h>
#include <cstdio>
#include <cstdint>

#ifndef MK_N_LAUNCHES
#define MK_N_LAUNCHES 1
#endif

#define GAS __attribute__((address_space(1)))
#define LAS __attribute__((address_space(3)))
typedef unsigned short bf16;
typedef short bf16x8 __attribute__((ext_vector_type(8)));
typedef float f32x4 __attribute__((ext_vector_type(4)));
typedef float f32x2 __attribute__((ext_vector_type(2)));
typedef float f32x16 __attribute__((ext_vector_type(16)));
typedef unsigned u32x4 __attribute__((ext_vector_type(4)));
typedef unsigned u32x2 __attribute__((ext_vector_type(2)));

constexpr int T = 8192, D = 2048, NMEM = 256;
constexpr int D_IN = 4944;
constexpr int NPROJ = 6144;
constexpr int KMIX = 3072;
constexpr int NCH = 128, CH = 64;
constexpr int NEXP = 32, DEXP = 512;
constexpr float EPS = 1e-6f;
constexpr int NPHASE = 17;

constexpr size_t MiB = 1u << 20;
constexpr size_t WS_CTL = 0, CTL_ZERO_BYTES = 256 * 1024;
constexpr size_t WS_WOUT_T = 1 * MiB;
constexpr size_t WS_WCQ_T = 13 * MiB;
constexpr size_t WS_WCKV_T = 21 * MiB;
constexpr size_t WS_WCO_T = 37 * MiB;
constexpr size_t WS_WGU_T = 45 * MiB;
constexpr size_t WS_WDN_T = 173 * MiB;
constexpr size_t WS_WIN_T = 237 * MiB;
constexpr size_t WS_H1 = 261 * MiB;
constexpr size_t WS_MIXIN = 237 * MiB;
constexpr size_t WS_SC127 = 285 * MiB;
constexpr size_t WS_MEMN = 293 * MiB;
constexpr size_t WS_KC = 294 * MiB;
constexpr size_t WS_VT = 295 * MiB;
constexpr size_t WS_GATES = 296 * MiB;
constexpr size_t WS_WR = 297 * MiB;
constexpr size_t WS_QABS = 298 * MiB;
constexpr size_t WS_CKVRAW = 330 * MiB;
constexpr size_t WS_QI = 338 * MiB;
constexpr size_t WS_SMALL = 346 * MiB;
constexpr size_t WS_MQKRAW = 354 * MiB;
constexpr size_t WS_MV = 386 * MiB;
constexpr size_t WS_MO = 402 * MiB;
constexpr size_t WS_CKVN = 418 * MiB;
constexpr size_t WS_KIDXN = 422 * MiB;
constexpr size_t WS_QCM = 423 * MiB;
constexpr size_t WS_KCM = 431 * MiB;
constexpr size_t WS_LST = 439 * MiB;
constexpr size_t WS_NL = 503 * MiB;
constexpr size_t WS_CST = 504 * MiB;
constexpr size_t WS_VTM = 536 * MiB;
constexpr size_t WS_X1B = 298 * MiB;
constexpr size_t WS_QC = 330 * MiB;
constexpr size_t WS_OC = 362 * MiB;
constexpr size_t WS_X2B = 394 * MiB;
constexpr size_t WS_LIST = 426 * MiB;
constexpr size_t WS_TOK = 427 * MiB;
constexpr size_t WS_ACT = 428 * MiB;
constexpr size_t WS_Y = 452 * MiB;
constexpr size_t WS_END = 552 * MiB;
constexpr int GT_B = 0;
constexpr int GT_LI = T * 4;
constexpr int GT_G = 2 * T * 4;
constexpr int GT_MLOC = GT_G + 512;
constexpr int GT_MPREV = GT_MLOC + 512;
constexpr int CW_BAR = 4096;
constexpr int CW_CNT = 8192;
constexpr int CW_SS2 = 16384;
static_assert((CW_SS2 + T) * 4 <= (int)CTL_ZERO_BYTES, "ctl");

constexpr int RING_BYTES = 131072;
constexpr int MISC_OFF = RING_BYTES;
constexpr int LDS_BYTES = 159744;

__device__ __forceinline__ float bf2f(unsigned b) { return __uint_as_float(b << 16); }
__device__ __forceinline__ unsigned f2bf(float f) { unsigned u = __float_as_uint(f); return (u + 0x7fffu + ((u >> 16) & 1u)) >> 16; }
__device__ __forceinline__ unsigned pk2(float lo, float hi) { return f2bf(lo) | (f2bf(hi) << 16); }
__device__ __forceinline__ float wave_sum(float v) {
#pragma unroll
    for (int o = 1; o < 64; o <<= 1) v += __shfl_xor(v, o);
    return v;
}
__device__ __forceinline__ float wave_max(float v) {
#pragma unroll
    for (int o = 1; o < 64; o <<= 1) v = fmaxf(v, __shfl_xor(v, o));
    return v;
}
#define LDS_WAIT() asm volatile("s_waitcnt lgkmcnt(0)" ::: "memory")

#define XB_TMO      128
#define XB_XCNT(j)  (256  + 64 * (j))
#define XB_XSUB(j)  (1280 + 64 * (j))
#define XB_XGEN(j)  (2304 + 64 * (j))
#define XB_TOP      3328
#define XB_TOPGEN   3392
#define XCD_BAR_WORDS 3456
#define XB_SPIN_CAP (1u << 18)
__device__ __forceinline__ unsigned xb_ld(unsigned* p)              { return __hip_atomic_load(p, __ATOMIC_RELAXED, __HIP_MEMORY_SCOPE_AGENT); }
__device__ __forceinline__ unsigned xb_add(unsigned* p, unsigned v) { return __hip_atomic_fetch_add(p, v, __ATOMIC_RELAXED, __HIP_MEMORY_SCOPE_AGENT); }
__device__ __forceinline__ unsigned xb_xcc_id() { return (unsigned)__builtin_amdgcn_s_getreg((3 << 11) | 20) & 0xFu; }
#define XB_SPIN(cond, bar) do { unsigned _sp = 0; while (cond) { __builtin_amdgcn_s_sleep(1); \
    if ((++_sp & 255u) == 0u) { if (xb_ld(&(bar)[XB_TMO])) break; if (_sp > XB_SPIN_CAP) { atomicAdd(&(bar)[XB_TMO], 1u); break; } } } } while (0)
struct XcdBarrier { unsigned* bar; unsigned x; volatile LAS unsigned* st; };
__device__ __forceinline__ XcdBarrier xcd_barrier_post(unsigned* bar, volatile LAS unsigned* st) {
    XcdBarrier b; b.bar = bar; b.x = xb_xcc_id(); b.st = st;
    if (threadIdx.x == 0) (void)xb_add(&bar[XB_XCNT(b.x)], 1u);
    return b;
}
__device__ __forceinline__ void xcd_barrier_complete(unsigned* bar, unsigned x, unsigned& nloc, unsigned& nx) {
    const unsigned G = gridDim.x * gridDim.y * gridDim.z;
    unsigned sum, cnt, mine, sp = 0u;
    for (;;) {
        sum = 0u; cnt = 0u; mine = 0u;
#pragma unroll
        for (unsigned j = 0; j < 16; ++j) { const unsigned c = xb_ld(&bar[XB_XCNT(j)]); sum += c; cnt += (c > 0u) ? 1u : 0u; mine = (j == x) ? c : mine; }
        if (sum == G) break;
        __builtin_amdgcn_s_sleep(1);
        if ((++sp & 255u) == 0u) { if (xb_ld(&bar[XB_TMO])) break; if (sp > XB_SPIN_CAP) { atomicAdd(&bar[XB_TMO], 1u); break; } }
    }
    nloc = mine > 0u ? mine : 1u; nx = cnt > 0u ? cnt : 1u;
}
__device__ __forceinline__ void xcd_barrier(const XcdBarrier& b, const int tid_) {
    asm volatile("s_waitcnt vmcnt(0)" ::: "memory");
    __syncthreads();
    if (tid_ == 0) {
        unsigned* bar = b.bar;
        __builtin_amdgcn_s_waitcnt(0);
        unsigned nloc = b.st[0], nx = b.st[1];
        if (nloc == 0u) { xcd_barrier_complete(bar, b.x, nloc, nx); b.st[0] = nloc; b.st[1] = nx; }
        const unsigned old = xb_add(&bar[XB_XSUB(b.x)], 1u);
        const unsigned gen = old / nloc;
        if (old + 1u == (gen + 1u) * nloc) {
            __builtin_amdgcn_fence(__ATOMIC_RELEASE, "agent");
            asm volatile("s_waitcnt vmcnt(0)" ::: "memory");
            const unsigned og = xb_add(&bar[XB_TOP], 1u);
            const unsigned tg = og / nx;
            if (og + 1u == (tg + 1u) * nx) xb_add(&bar[XB_TOPGEN], 1u);
            else XB_SPIN(xb_ld(&bar[XB_TOPGEN]) == tg, bar);
            __builtin_amdgcn_fence(__ATOMIC_ACQUIRE, "agent");
            xb_add(&bar[XB_XGEN(b.x)], 1u);
            asm volatile("s_waitcnt vmcnt(0)" ::: "memory");
        } else {
            XB_SPIN(xb_ld(&bar[XB_XGEN(b.x)]) == gen, bar);
            __builtin_amdgcn_fence(__ATOMIC_ACQUIRE, "agent");
            asm volatile("s_waitcnt vmcnt(0)" ::: "memory");
        }
    }
    __syncthreads();
}

namespace pg8 {
constexpr int BM = 256, BK = 64, HALF = 128, HTB = HALF * BK * 2, STAGE_BYTES = 8 * HTB, NXCD = 8, WGM = 8;
__host__ __device__ __forceinline__ int lds_byte(int r, int c) { const int st = (r >> 4) * 2 + (c >> 5), rr = r & 15, cc = c & 31, ob = rr * 64 + cc * 2; return st * 1024 + (ob ^ (((ob >> 9) & 1) << 5)); }
__host__ __device__ __forceinline__ void stage_rc(int b, int& R, int& C) { const int st = b / 1024, sb = b % 1024, swz = sb ^ (((sb >> 9) & 1) << 5); R = (st >> 1) * 16 + swz / 64; C = (st & 1) * 32 + (swz % 64) / 2; }

struct Unit { int pm, pn, e, rt; };

struct DenseOrder {
    static constexpr bool GATHER = false;
    int nM, nN, nwg, G, c; unsigned lda_bytes; unsigned kb;
    __device__ void init(int M, int N, int K, int lda, int G_, int c_) { nM = M / BM; nN = N / BM; nwg = nM * nN; G = G_; c = c_; lda_bytes = (unsigned)lda * 2u; kb = (unsigned)K * 2u; }
    __device__ bool next(int i, Unit& u) const {
        if (c < 0) return false;
        const long L = (long)i * G + c; if (L >= nwg) return false;
        int wgid = (int)L; { const int q = nwg / NXCD, r = nwg % NXCD, xcd = wgid % NXCD, off = wgid / NXCD; wgid = (xcd < r ? xcd * (q + 1) : r * (q + 1) + (xcd - r) * q) + off; }
        const int nig = WGM * nN, gid = wgid / nig, fm = gid * WGM, gsz = (nM - fm) < WGM ? (nM - fm) : WGM;
        u.pm = fm + ((wgid % nig) % gsz); u.pn = (wgid % nig) / gsz; u.e = 0; u.rt = 0; return true;
    }
    __device__ __forceinline__ unsigned a_row(const Unit& u, int r) const { return (unsigned)(u.pm * BM + r) * lda_bytes; }
    __device__ __forceinline__ size_t b_off(const Unit& u) const { return (size_t)u.pn * BM * kb; }
};

#define PG8_SA(b, h) (((b) * 2 + (h)) * HTB)
#define PG8_SB(b, h) ((4 + (b) * 2 + (h)) * HTB)
#define PG8_STAGEB(bufoff, gbase) do { _Pragma("unroll") for (int _i = 0; _i < 2; ++_i) \
        __builtin_amdgcn_global_load_lds((const unsigned*)((const char*)(gbase) + voffB[_i]), (LAS unsigned*)(lds + (bufoff) + ldsw + _i * 8192), 16, 0, 0); } while (0)
#define PG8_GLDS(src, dstoff) __builtin_amdgcn_global_load_lds((const unsigned*)(src), (LAS unsigned*)(lds + (dstoff)), 16, 0, 0)
#define PG8_STAGEA(bufoff, kbyte, h, NXT) do { if constexpr (Sched::GATHER) { const unsigned _o0 = (NXT) ? ((h) ? n10 : n00) : ((h) ? c10 : c00), _o1 = (NXT) ? ((h) ? n11 : n01) : ((h) ? c11 : c01); \
            PG8_GLDS(Ab + (kbyte) + _o0, (bufoff) + ldsw); PG8_GLDS(Ab + (kbyte) + _o1, (bufoff) + ldsw + 8192); } \
        else { const char* _b = ((NXT) ? nA : cA) + (kbyte) + ((h) ? hstepA : (size_t)0); PG8_GLDS(_b + voffA[0], (bufoff) + ldsw); PG8_GLDS(_b + voffA[1], (bufoff) + ldsw + 8192); } } while (0)
#define PG8_LDA(dst, b, h) do { _Pragma("unroll") for (int m = 0; m < 4; ++m) _Pragma("unroll") for (int k = 0; k < 2; ++k) dst[m][k] = *(const LAS bf16x8*)(lds + PG8_SA(b, h) + aoff + m * 2048 + k * 1024); } while (0)
#define PG8_LDB(dst, b, h) do { _Pragma("unroll") for (int n = 0; n < 2; ++n) _Pragma("unroll") for (int k = 0; k < 2; ++k) dst[n][k] = *(const LAS bf16x8*)(lds + PG8_SB(b, h) + boff + n * 2048 + k * 1024); } while (0)
#define PG8_MMA(ai, bj, At, Bt) do { __builtin_amdgcn_s_setprio(1); _Pragma("unroll") for (int m = 0; m < 4; ++m) _Pragma("unroll") for (int n = 0; n < 2; ++n) _Pragma("unroll") for (int k = 0; k < 2; ++k) \
        acc[ai][bj][m][n] = __builtin_amdgcn_mfma_f32_16x16x32_bf16(Bt[n][k], At[m][k], acc[ai][bj][m][n], 0, 0, 0); __builtin_amdgcn_s_setprio(0); } while (0)
#define PG8_WAIT_V(n) asm volatile("s_waitcnt vmcnt(" #n ")" ::: "memory")
#define PG8_WAIT_L(n) asm volatile("s_waitcnt lgkmcnt(" #n ")" ::: "memory")
#define PG8_BAR __builtin_amdgcn_s_barrier()
#define PG8_SCHED __builtin_amdgcn_sched_barrier(0)

template <class Epi, class Sched>
__device__ __forceinline__ void gemm_phase(const int tid_in, LAS unsigned char* lds, const bf16* A, const bf16* Bt, const int K, const Sched& S, const Epi& E) {
    int tid = tid_in; asm volatile("" : "+v"(tid));
    const int wid = __builtin_amdgcn_readfirstlane(tid >> 6), lane = tid & 63, wr = wid >> 2, wc = wid & 3, fr = lane & 15, fq = lane >> 4;
    int Kop_ = K; asm volatile("" : "+s"(Kop_));
    const int nt = Kop_ / BK;
    int sR[2], sC2[2]; unsigned voffB[2];
#pragma unroll
    for (int i = 0; i < 2; ++i) { int R, C; stage_rc(tid * 16 + i * 8192, R, C); sR[i] = R; sC2[i] = C * 2; voffB[i] = (unsigned)R * S.kb + (unsigned)C * 2u; }
    const unsigned kstep = (unsigned)(BK * 2);
    const size_t hstepB = (size_t)HALF * S.kb;
    const unsigned ldsw = (unsigned)wid * 1024u;
    const int aoff = lds_byte(wr * 64 + fr, fq * 8), boff = lds_byte(wc * 32 + fr, fq * 8);
    Unit cur, nxt; int ui = 0;
    if (!S.next(0, cur)) return;
    f32x4 acc[2][2][4][2];
#pragma unroll
    for (int a = 0; a < 2; ++a)
#pragma unroll
        for (int b = 0; b < 2; ++b)
#pragma unroll
            for (int m = 0; m < 4; ++m)
#pragma unroll
                for (int n = 0; n < 2; ++n) acc[a][b][m][n] = (f32x4){0.f, 0.f, 0.f, 0.f};
    bf16x8 At[4][2], B0[2][2], B1[2][2];
    const char* Ab = (const char*)A;
    unsigned c00 = 0, c01 = 0, c10 = 0, c11 = 0, n00 = 0, n01 = 0, n10 = 0, n11 = 0; unsigned voffA[2] = {0u, 0u}; const char* cA = Ab; const char* nA = Ab; size_t hstepA = 0;
    if constexpr (Sched::GATHER) { c00 = S.a_row(cur, sR[0]) + sC2[0]; c01 = S.a_row(cur, sR[1]) + sC2[1]; c10 = S.a_row(cur, 128 + sR[0]) + sC2[0]; c11 = S.a_row(cur, 128 + sR[1]) + sC2[1]; }
    else { voffA[0] = (unsigned)sR[0] * S.lda_bytes + sC2[0]; voffA[1] = (unsigned)sR[1] * S.lda_bytes + sC2[1]; hstepA = (size_t)HALF * S.lda_bytes; cA = Ab + (size_t)S.a_row(cur, 0); }
    const char* cB = (const char*)Bt + S.b_off(cur);
    PG8_STAGEB(PG8_SB(0, 0), cB); PG8_STAGEA(PG8_SA(0, 0), 0u, 0, false); PG8_STAGEB(PG8_SB(0, 1), cB + hstepB); PG8_STAGEA(PG8_SA(0, 1), 0u, 1, false);
    if (wr == 1) PG8_BAR;
    PG8_WAIT_V(4); PG8_BAR;
    PG8_STAGEB(PG8_SB(1, 0), cB + kstep); PG8_STAGEA(PG8_SA(1, 0), kstep, 0, false); PG8_STAGEB(PG8_SB(1, 1), cB + hstepB + kstep);
    PG8_WAIT_V(6); PG8_BAR;
    for (;;) {
        const bool has_next = S.next(ui + 1, nxt);
        const char* nB = cB;
        if constexpr (Sched::GATHER) { n00 = c00; n01 = c01; n10 = c10; n11 = c11; } else nA = cA;
        if (has_next) { nB = (const char*)Bt + S.b_off(nxt);
            if constexpr (Sched::GATHER) { n00 = S.a_row(nxt, sR[0]) + sC2[0]; n01 = S.a_row(nxt, sR[1]) + sC2[1]; n10 = S.a_row(nxt, 128 + sR[0]) + sC2[0]; n11 = S.a_row(nxt, 128 + sR[1]) + sC2[1]; }
            else nA = Ab + (size_t)S.a_row(nxt, 0); }
        for (int t = 0; t < nt; t += 2) {
            const bool last = (t == nt - 2);
            const unsigned k1 = (unsigned)(t + 1) * kstep;
            const unsigned k2 = last ? 0u : (unsigned)(t + 2) * kstep, k3 = k2 + kstep;
            const char* b2 = last ? nB : cB + (size_t)(t + 2) * kstep; const char* b3 = b2 + kstep;
            PG8_LDB(B0, 0, 0); PG8_SCHED; PG8_LDA(At, 0, 0); PG8_STAGEA(PG8_SA(1, 1), k1, 1, false);
            PG8_WAIT_L(8); PG8_BAR; PG8_WAIT_L(0); PG8_MMA(0, 0, At, B0); PG8_BAR; PG8_SCHED;
            PG8_LDB(B1, 0, 1); PG8_STAGEB(PG8_SB(0, 0), b2);
            PG8_BAR; PG8_WAIT_L(0); PG8_MMA(0, 1, At, B1); PG8_BAR;
            PG8_LDA(At, 0, 1); PG8_STAGEA(PG8_SA(0, 0), k2, 0, last);
            PG8_BAR; PG8_WAIT_L(0); PG8_MMA(1, 0, At, B0); PG8_BAR; PG8_SCHED;
            PG8_STAGEB(PG8_SB(0, 1), b2 + hstepB);
            PG8_WAIT_V(6); PG8_BAR; PG8_MMA(1, 1, At, B1); PG8_BAR;
            PG8_LDB(B0, 1, 0); PG8_SCHED; PG8_LDA(At, 1, 0); PG8_STAGEA(PG8_SA(0, 1), k2, 1, last);
            PG8_WAIT_L(8); PG8_BAR; PG8_WAIT_L(0); PG8_MMA(0, 0, At, B0); PG8_BAR; PG8_SCHED;
            PG8_LDB(B1, 1, 1); PG8_STAGEB(PG8_SB(1, 0), b3);
            PG8_BAR; PG8_WAIT_L(0); PG8_MMA(0, 1, At, B1); PG8_BAR;
            PG8_LDA(At, 1, 1); PG8_STAGEA(PG8_SA(1, 0), k3, 0, last);
            PG8_BAR; PG8_WAIT_L(0); PG8_MMA(1, 0, At, B0); PG8_BAR; PG8_SCHED;
            PG8_STAGEB(PG8_SB(1, 1), b3 + hstepB);
            PG8_WAIT_V(6); PG8_BAR; PG8_MMA(1, 1, At, B1); PG8_BAR;
        }
        if constexpr (!Epi::AFTER_DRAIN) E(acc, cur, wr, wc, fr, fq);
        if (!has_next) break;
#pragma unroll
        for (int a = 0; a < 2; ++a)
#pragma unroll
            for (int b = 0; b < 2; ++b)
#pragma unroll
                for (int m = 0; m < 4; ++m)
#pragma unroll
                    for (int n = 0; n < 2; ++n) acc[a][b][m][n] = (f32x4){0.f, 0.f, 0.f, 0.f};
        cur = nxt; if constexpr (Sched::GATHER) { c00 = n00; c01 = n01; c10 = n10; c11 = n11; } else cA = nA; cB = nB; ++ui;
    }
    PG8_WAIT_V(0);
    if (wr == 0) PG8_BAR;
    PG8_BAR;
    if constexpr (Epi::AFTER_DRAIN) E.fused(acc, cur, wr, wc, fr, fq, lds, wid, lane);
}

__device__ __forceinline__ void store_tile_f32(const f32x4 (&acc)[2][2][4][2], float* dst, int ld, int row0, int col0) {
#pragma unroll
    for (int ai = 0; ai < 2; ++ai)
#pragma unroll
        for (int m = 0; m < 4; ++m) { float* rowp = dst + (size_t)(row0 + ai * HALF + m * 16) * ld + col0;
#pragma unroll
            for (int bj = 0; bj < 2; ++bj)
#pragma unroll
                for (int n = 0; n < 2; ++n) *(f32x4*)(rowp + bj * HALF + n * 16) = acc[ai][bj][m][n]; }
}
__device__ __forceinline__ void store_tile_bf16(const f32x4 (&acc)[2][2][4][2], bf16* dst, int ld, int row0, int col0) {
#pragma unroll
    for (int ai = 0; ai < 2; ++ai)
#pragma unroll
        for (int m = 0; m < 4; ++m) { bf16* rowp = dst + (size_t)(row0 + ai * HALF + m * 16) * ld + col0;
#pragma unroll
            for (int bj = 0; bj < 2; ++bj)
#pragma unroll
                for (int n = 0; n < 2; ++n) { const f32x4 v = acc[ai][bj][m][n]; u32x2 w; w.x = pk2(v[0], v[1]); w.y = pk2(v[2], v[3]); *(u32x2*)(rowp + bj * HALF + n * 16) = w; } }
}
struct EpiBf16 {
    static constexpr bool AFTER_DRAIN = false;
    bf16* dst; int ld;
    __device__ __forceinline__ void operator()(const f32x4 (&acc)[2][2][4][2], const Unit& u, int wr, int wc, int fr, int fq) const {
        store_tile_bf16(acc, dst, ld, u.pm * BM + wr * 64 + fr, u.pn * BM + wc * 32 + 4 * fq);
    }
};
struct EpiProj {
    static constexpr bool AFTER_DRAIN = false;
    bf16* qabs; float* ckvraw; bf16* qi; float* small; float* mqkraw; bf16* mv; bf16* mo;
    __device__ __forceinline__ void operator()(const f32x4 (&acc)[2][2][4][2], const Unit& u, int wr, int wc, int fr, int fq) const {
        const int row0 = u.pm * BM + wr * 64 + fr, cl = wc * 32 + 4 * fq, pn = u.pn;
        if (pn < 8) store_tile_bf16(acc, qabs, 2048, row0, pn * 256 + cl);
        else if (pn == 8) store_tile_f32(acc, ckvraw, 256, row0, cl);
        else if (pn < 11) store_tile_bf16(acc, qi, 512, row0, (pn - 9) * 256 + cl);
        else if (pn == 11) store_tile_f32(acc, small, 256, row0, cl);
        else if (pn < 16) store_tile_f32(acc, mqkraw, 1024, row0, (pn - 12) * 256 + cl);
        else if (pn < 20) store_tile_bf16(acc, mv, 1024, row0, (pn - 16) * 256 + cl);
        else store_tile_bf16(acc, mo, 1024, row0, (pn - 20) * 256 + cl);
    }
};
template <bool BASE_BF16>
struct EpiResidT {
    static constexpr bool AFTER_DRAIN = false;
    const void* base; bf16* xb; float* ss;
    __device__ __forceinline__ void operator()(const f32x4 (&acc)[2][2][4][2], const Unit& u, int wr, int wc, int fr, int fq) const {
        const int row0 = u.pm * BM + wr * 64 + fr, col0 = u.pn * BM + wc * 32 + 4 * fq;
#pragma unroll
        for (int ai = 0; ai < 2; ++ai)
#pragma unroll
            for (int m = 0; m < 4; ++m) { const int row = row0 + ai * HALF + m * 16; const size_t off = (size_t)row * D + col0; float s = 0.f;
#pragma unroll
                for (int bj = 0; bj < 2; ++bj)
#pragma unroll
                    for (int n = 0; n < 2; ++n) { f32x4 b;
                        if constexpr (BASE_BF16) { const u32x2 p = *(const u32x2*)((const bf16*)base + off + bj * HALF + n * 16); b = (f32x4){bf2f(p.x & 0xffffu), bf2f(p.x >> 16), bf2f(p.y & 0xffffu), bf2f(p.y >> 16)}; }
                        else b = *(const f32x4*)((const float*)base + off + bj * HALF + n * 16);
                        const f32x4 v = b + acc[ai][bj][m][n];
                        u32x2 w; w.x = pk2(v[0], v[1]); w.y = pk2(v[2], v[3]); *(u32x2*)(xb + off + bj * HALF + n * 16) = w;
                        s += (v[0] * v[0] + v[1] * v[1]) + (v[2] * v[2] + v[3] * v[3]); }
                if (ss) { s += __shfl_xor(s, 16); s += __shfl_xor(s, 32); if (fq == 0) atomicAdd(ss + row, s); } }
    }
};
struct EpiCq {
    static constexpr bool AFTER_DRAIN = false;
    bf16* dst; const float* ss; float scale;
    __device__ __forceinline__ void operator()(const f32x4 (&acc)[2][2][4][2], const Unit& u, int wr, int wc, int fr, int fq) const {
        const int row0 = u.pm * BM + wr * 64 + fr, col0 = u.pn * BM + wc * 32 + 4 * fq;
#pragma unroll
        for (int ai = 0; ai < 2; ++ai)
#pragma unroll
            for (int m = 0; m < 4; ++m) { const int row = row0 + ai * HALF + m * 16; const float r = rsqrtf(ss[row] * (1.0f / D) + EPS) * scale; bf16* rowp = dst + (size_t)row * D + col0;
#pragma unroll
                for (int bj = 0; bj < 2; ++bj)
#pragma unroll
                    for (int n = 0; n < 2; ++n) { const f32x4 v = acc[ai][bj][m][n] * r; u32x2 w; w.x = pk2(v[0], v[1]); w.y = pk2(v[2], v[3]); *(u32x2*)(rowp + bj * HALF + n * 16) = w; } }
    }
};
struct XsOrder {
    static constexpr bool GATHER = false;
    int G, c; unsigned lda_bytes, kb;
    __device__ bool next(int i, Unit& u) const { const int L = i * G + c; if (i > 0 || L >= 128) return false; u.pm = L >> 2; u.pn = L & 3; u.e = 0; u.rt = 0; return true; }
    __device__ __forceinline__ unsigned a_row(const Unit& u, int r) const { return (unsigned)(u.pm * BM + r) * lda_bytes + (unsigned)u.pn * 1024u; }
    __device__ __forceinline__ size_t b_off(const Unit& u) const { return (size_t)u.pn * 1024; }
};
struct XoOrder {
    static constexpr bool GATHER = false;
    int G, c; unsigned lda_bytes, kb;
    __device__ bool next(int i, Unit& u) const { const int L = i * G + c; if (L >= 256) return false; u.pm = L >> 3; u.pn = L & 7; u.e = 0; u.rt = 0; return true; }
    __device__ __forceinline__ unsigned a_row(const Unit& u, int r) const { return (unsigned)(u.pm * BM + r) * lda_bytes + (unsigned)(u.pn >> 1) * 512u; }
    __device__ __forceinline__ size_t b_off(const Unit& u) const { return (size_t)u.pn * BM * kb; }
};
struct EpiSoftmax {
    static constexpr bool AFTER_DRAIN = true;
    bf16* P; const float* ss;
    __device__ __forceinline__ void fused(f32x4 (&acc)[2][2][4][2], const Unit& u, int wr, int wc, int fr, int fq, LAS unsigned char* lds, int wid, int lane) const {
        LAS float* Pm = (LAS float*)lds; LAS float* Ps = (LAS float*)(lds + 4096);
#pragma unroll
        for (int ai = 0; ai < 2; ++ai)
#pragma unroll
            for (int m = 0; m < 4; ++m) { float mx = -3.0e38f; const float rs = rsqrtf(ss[u.pm * BM + ai * HALF + wr * 64 + m * 16 + fr] * (1.0f / D) + EPS);
#pragma unroll
                for (int bj = 0; bj < 2; ++bj)
#pragma unroll
                    for (int n = 0; n < 2; ++n) { const f32x4 v = acc[ai][bj][m][n] * rs; acc[ai][bj][m][n] = v; mx = fmaxf(mx, fmaxf(fmaxf(v[0], v[1]), fmaxf(v[2], v[3]))); }
                mx = fmaxf(mx, __shfl_xor(mx, 16)); mx = fmaxf(mx, __shfl_xor(mx, 32));
                if (fq == 0) Pm[(ai * HALF + wr * 64 + m * 16 + fr) * 4 + wc] = mx; }
        asm volatile("s_waitcnt lgkmcnt(0)" ::: "memory"); __builtin_amdgcn_s_barrier(); asm volatile("" ::: "memory");
#pragma unroll
        for (int ai = 0; ai < 2; ++ai)
#pragma unroll
            for (int m = 0; m < 4; ++m) { const int r = ai * HALF + wr * 64 + m * 16 + fr; const f32x4 pm4 = *(const LAS f32x4*)(Pm + r * 4); const float mx = fmaxf(fmaxf(pm4[0], pm4[1]), fmaxf(pm4[2], pm4[3])); float sm = 0.f;
#pragma unroll
                for (int bj = 0; bj < 2; ++bj)
#pragma unroll
                    for (int n = 0; n < 2; ++n) { f32x4 v = acc[ai][bj][m][n];
#pragma unroll
                        for (int j = 0; j < 4; ++j) { v[j] = __expf(v[j] - mx); sm += v[j]; }
                        acc[ai][bj][m][n] = v; }
                sm += __shfl_xor(sm, 16); sm += __shfl_xor(sm, 32);
                if (fq == 0) Ps[r * 4 + wc] = sm; }
        asm volatile("s_waitcnt lgkmcnt(0)" ::: "memory"); __builtin_amdgcn_s_barrier(); asm volatile("" ::: "memory");
#pragma unroll
        for (int ai = 0; ai < 2; ++ai)
#pragma unroll
            for (int m = 0; m < 4; ++m) { const int r = ai * HALF + wr * 64 + m * 16 + fr; const f32x4 ps4 = *(const LAS f32x4*)(Ps + r * 4); const float inv = 1.f / ((ps4[0] + ps4[1]) + (ps4[2] + ps4[3]));
                bf16* rowp = P + (size_t)(u.pm * BM + r) * 1024 + u.pn * 256 + wc * 32 + 4 * fq;
#pragma unroll
                for (int bj = 0; bj < 2; ++bj)
#pragma unroll
                    for (int n = 0; n < 2; ++n) { const f32x4 v = acc[ai][bj][m][n] * inv; u32x2 w; w.x = pk2(v[0], v[1]); w.y = pk2(v[2], v[3]); *(u32x2*)(rowp + bj * HALF + n * 16) = w; } }
    }
};
struct MoeOrder {
    static constexpr bool GATHER = true;
    const volatile LAS int* tb; const volatile LAS int* cn; const int* list; int ncol; int Lbeg, Lend, nb, c; unsigned a_ld_bytes; size_t b_exp_bytes; unsigned kb; int gather;
    __device__ bool next(int i, Unit& u) const {
        if (c < 0 || nb <= 0) return false;
        const int L = Lbeg + i * nb + c; if (L >= Lend) return false;
        const int g = L / ncol; int e = 0;
#pragma unroll 1
        for (int j = 1; j < 32; ++j) if (g >= tb[j]) e = j;
        u.e = e; u.rt = g - tb[e]; u.pn = L - g * ncol; u.pm = g; return true;
    }
    __device__ __forceinline__ unsigned a_row(const Unit& u, int r) const {
        if (gather) { int idx = u.rt * 256 + r; const int cnt = cn[u.e]; idx = idx < cnt ? idx : cnt - 1; const int tok = list[u.e * T + idx]; return (unsigned)tok * a_ld_bytes; }
        return (unsigned)(u.pm * 256 + r) * a_ld_bytes;
    }
    __device__ __forceinline__ size_t b_off(const Unit& u) const { return (size_t)u.e * b_exp_bytes + (size_t)u.pn * BM * kb; }
};
struct EpiSwiGLU {
    static constexpr bool AFTER_DRAIN = false;
    bf16* act; const int* list; const float* rstd; const volatile LAS int* cn;
    __device__ __forceinline__ void operator()(const f32x4 (&acc)[2][2][4][2], const Unit& u, int wr, int wc, int fr, int fq) const {
        const int cnt = cn[u.e];
#pragma unroll
        for (int ai = 0; ai < 2; ++ai)
#pragma unroll
            for (int m = 0; m < 4; ++m) { const int rl = ai * HALF + wr * 64 + m * 16 + fr; int idx = u.rt * 256 + rl; idx = idx < cnt ? idx : cnt - 1; const float r = rstd[list[u.e * T + idx]];
                bf16* rowp = act + (size_t)(u.pm * 256 + rl) * DEXP + u.pn * 128 + wc * 32 + 4 * fq;
#pragma unroll
                for (int n = 0; n < 2; ++n) { const f32x4 g = acc[ai][0][m][n] * r, uu = acc[ai][1][m][n] * r; f32x4 a;
#pragma unroll
                    for (int j = 0; j < 4; ++j) a[j] = g[j] / (1.0f + __expf(-g[j])) * uu[j];
                    u32x2 w; w.x = pk2(a[0], a[1]); w.y = pk2(a[2], a[3]); *(u32x2*)(rowp + n * 16) = w; } }
    }
};
}

struct Args { const float* in[27]; float* out; unsigned char* ws; int ph_lo, ph_hi; };
enum { I_X = 0, I_MEM, I_NORM_MIX_G, I_W_IN, I_KV_NORM_G, I_KIDX_NORM_G, I_W_UK, I_W_UV, I_CONV_W, I_CONV_B, I_GATE_B, I_ML_NORM_G, I_W_OUT, I_NORM_X_G, I_MEM_NORM_G,
       I_W_CQ, I_W_CKV, I_W_CO, I_NORM_FFN_G, I_W_GROUP, I_B_GROUP, I_W_ROUTER, I_B_ROUTER, I_W_GATE, I_W_UP, I_W_DOWN, I_FINAL_G };

__device__ __forceinline__ void tr_item(const float* W, size_t ldw, int k0, int n0, const float* kscale, bf16* WT, size_t ldt, int drow0, int dcol0, LAS float* scr, int lane) {
#pragma unroll 8
    for (int i = 0; i < 32; ++i) { const int kk = 2 * i + (lane >> 5); float v = W[(size_t)(k0 + kk) * ldw + n0 + (lane & 31)]; if (kscale) v *= kscale[k0 + kk]; scr[kk * 33 + (lane & 31)] = v; }
    LDS_WAIT(); asm volatile("" ::: "memory");
    const int c = lane & 7;
#pragma unroll
    for (int j = 0; j < 4; ++j) { const int n = (lane >> 3) + 8 * j; const LAS float* s = scr + (8 * c) * 33 + n;
        u32x4 o; o.x = pk2(s[0 * 33], s[1 * 33]); o.y = pk2(s[2 * 33], s[3 * 33]); o.z = pk2(s[4 * 33], s[5 * 33]); o.w = pk2(s[6 * 33], s[7 * 33]);
        *(u32x4*)(WT + (size_t)(drow0 + n0 + n) * ldt + dcol0 + k0 + 8 * c) = o; }
    LDS_WAIT(); asm volatile("" ::: "memory");
}
__device__ __forceinline__ void tr_item64(const float* W, size_t ldw, int k0, int n0, const float* kscale, bf16* WT, size_t ldt, int drow0, int dcol0, LAS unsigned char* scr, int lane) {
    const int nq = lane & 15, kq = lane >> 4;
    const float* src = W + (size_t)(k0 + 2 * kq) * ldw + n0 + 4 * nq;
    f32x4 a[8], b[8];
#pragma unroll
    for (int i = 0; i < 8; ++i) { a[i] = __builtin_nontemporal_load((const f32x4*)(src + (size_t)(8 * i) * ldw)); b[i] = __builtin_nontemporal_load((const f32x4*)(src + (size_t)(8 * i + 1) * ldw)); }
#pragma unroll
    for (int i = 0; i < 8; ++i) { float sa = 1.f, sb = 1.f; if (kscale) { sa = kscale[k0 + 8 * i + 2 * kq]; sb = kscale[k0 + 8 * i + 2 * kq + 1]; }
#pragma unroll
        for (int j = 0; j < 4; ++j) { const int n = 4 * nq + j; *(LAS unsigned*)(scr + n * 128 + 16 * (i ^ (nq & 7)) + 4 * kq) = pk2(a[i][j] * sa, b[i][j] * sb); } }
    LDS_WAIT(); asm volatile("" ::: "memory");
#pragma unroll
    for (int m = 0; m < 8; ++m) { const int n = (lane >> 3) + 8 * m, c = lane & 7; const u32x4 v = *(const LAS u32x4*)(scr + n * 128 + 16 * (c ^ ((n >> 2) & 7)));
        __builtin_nontemporal_store(v, (u32x4*)(WT + (size_t)(drow0 + n0 + n) * ldt + dcol0 + k0 + 8 * c)); }
    LDS_WAIT(); asm volatile("" ::: "memory");
}
__device__ __forceinline__ void cv_item64(const float* W, size_t ldw, int k0, int n0, const float* kscale, float scale, bf16* O, size_t ldo, int lane) {
    const int c4 = (lane & 15) * 4, rr = lane >> 4;
    f32x4 v[16];
#pragma unroll
    for (int i = 0; i < 16; ++i) v[i] = __builtin_nontemporal_load((const f32x4*)(W + (size_t)(k0 + i * 4 + rr) * ldw + n0 + c4));
#pragma unroll
    for (int i = 0; i < 16; ++i) { const float g = kscale[k0 + i * 4 + rr] * scale; u32x2 w; w.x = pk2(v[i][0] * g, v[i][1] * g); w.y = pk2(v[i][2] * g, v[i][3] * g);
        *(u32x2*)(O + (size_t)(k0 + i * 4 + rr) * ldo + n0 + c4) = w; }
}
__device__ __forceinline__ void rms_row_to_bf16(const float* xrow, const float* g, bf16* orow, int lane) {
    const f32x4* xr = (const f32x4*)xrow + lane; const f32x4* gr = (const f32x4*)g + lane;
    f32x4 v[8]; float s = 0.f;
#pragma unroll
    for (int j = 0; j < 8; ++j) { v[j] = xr[64 * j]; s += (v[j][0] * v[j][0] + v[j][1] * v[j][1]) + (v[j][2] * v[j][2] + v[j][3] * v[j][3]); }
    const float r = rsqrtf(wave_sum(s) * (1.f / D) + EPS);
    u32x2* o8 = (u32x2*)orow + lane;
#pragma unroll
    for (int j = 0; j < 8; ++j) { const f32x4 gg = gr[64 * j]; u32x2 w; w.x = pk2(v[j][0] * r * gg[0], v[j][1] * r * gg[1]); w.y = pk2(v[j][2] * r * gg[2], v[j][3] * r * gg[3]); o8[64 * j] = w; }
}

__device__ __forceinline__ void mini_gemm64(LAS unsigned char* lds, const bf16* Ap, const unsigned lda, const bf16* Bp, const unsigned ldb, const int nch, bf16* o, const unsigned ldo, const int wave, const int lane) {
    const int r32 = lane & 31, hh = lane >> 5; const int tm = wave & 1, tn = (wave >> 1) & 1, kh = wave >> 2;
#define KV_DMA(kc_) do { _Pragma("unroll") for (int i4 = 0; i4 < 4; ++i4) { const int ii = wave * 4 + i4; const int isb = ii >> 4, row_ = (ii & 15) * 4 + (lane >> 4); \
        const bf16* gsrc_ = (isb ? Bp + (size_t)row_ * ldb : Ap + (size_t)row_ * lda) + (kc_) * 128 + (((lane & 15) ^ (row_ & 15)) * 8); \
        const unsigned ldst_ = __builtin_amdgcn_readfirstlane((unsigned)(size_t)lds + (unsigned)(((kc_) & 3) * 32768 + isb * 16384 + (ii & 15) * 1024)); unsigned keep_; \
        asm volatile("s_mov_b32 %0, m0\n\ts_mov_b32 m0, %2\n\ts_nop 0\n\tglobal_load_lds_dwordx4 %1, off\n\ts_mov_b32 m0, %0" : "=&s"(keep_) : "v"(gsrc_), "s"(ldst_) : "memory"); } } while (0)
    f32x16 acc;
#pragma unroll
    for (int i = 0; i < 16; ++i) acc[i] = 0.f;
    asm volatile("s_waitcnt vmcnt(0)" ::: "memory");
    __syncthreads();
    KV_DMA(0); if (nch > 1) KV_DMA(1); if (nch > 2) KV_DMA(2);
#pragma unroll 1
    for (int kc = 0; kc < nch; ++kc) {
        const int ahead = nch - 1 - kc;
        if (ahead >= 2) asm volatile("s_waitcnt vmcnt(8)" ::: "memory"); else if (ahead == 1) asm volatile("s_waitcnt vmcnt(4)" ::: "memory"); else asm volatile("s_waitcnt vmcnt(0)" ::: "memory");
        __syncthreads();
        if (kc + 3 < nch) KV_DMA(kc + 3);
        const LAS unsigned char* ba = lds + (kc & 3) * 32768 + (tm * 32 + r32) * 256; const LAS unsigned char* bb = lds + (kc & 3) * 32768 + 16384 + (tn * 32 + r32) * 256;
#pragma unroll
        for (int k4 = 0; k4 < 4; ++k4) { const int ch = (kh * 4 + k4) * 2 + hh;
            const bf16x8 af = *(const LAS bf16x8*)(ba + ((ch ^ (r32 & 15)) * 16)), bfr = *(const LAS bf16x8*)(bb + ((ch ^ (r32 & 15)) * 16));
            acc = __builtin_amdgcn_mfma_f32_32x32x16_bf16(af, bfr, acc, 0, 0, 0); }
    }
#undef KV_DMA
    __syncthreads();
    LAS float* xb = (LAS float*)lds + (wave & 3) * 1024;
    if (kh == 1) {
#pragma unroll
        for (int i = 0; i < 16; ++i) xb[i * 64 + lane] = acc[i]; }
    __syncthreads();
    if (kh == 0) { bf16* op = o + (size_t)(tm * 32 + 4 * hh) * ldo + tn * 32 + r32;
#pragma unroll
        for (int i = 0; i < 16; ++i) op[(size_t)((i & 3) + 8 * (i >> 2)) * ldo] = (bf16)f2bf(acc[i] + xb[i * 64 + lane]); }
}

__global__ void __launch_bounds__(512, 2) mega(Args args) {
    extern __shared__ __attribute__((aligned(16))) unsigned char lds_raw[];
    LAS unsigned char* lds = (LAS unsigned char*)lds_raw;
    volatile LAS unsigned* MISC = (volatile LAS unsigned*)(lds + MISC_OFF);
    const int tid0 = threadIdx.x;
    const int wave0_ = __builtin_amdgcn_readfirstlane(tid0 >> 6);
    const int G = gridDim.x, bx = blockIdx.x;
#define PHASE_IDS const Args* A_ = (const Args*)__builtin_amdgcn_kernarg_segment_ptr(); asm volatile("" : "+s"(A_)); int tid; asm volatile("v_mbcnt_lo_u32_b32 %0, -1, 0\n\tv_mbcnt_hi_u32_b32 %0, -1, %0" : "=v"(tid)); tid += wave0_ * 64; asm volatile("" : "+v"(tid)); const int lane = tid & 63, wave = __builtin_amdgcn_readfirstlane(tid >> 6); const int gw = bx * 8 + wave, NGW = G * 8; (void)lane; (void)gw; (void)NGW;
    const Args* A_ = (const Args*)__builtin_amdgcn_kernarg_segment_ptr();
    unsigned char* ws = args.ws;
    unsigned* ctl = (unsigned*)(ws + WS_CTL);
    const int lo = args.ph_lo, hi = args.ph_hi;
    for (int u = tid0; u < 1024; u += 512) MISC[u] = 0u;
    __syncthreads();
    XcdBarrier bar; bar.bar = ctl + CW_BAR; bar.x = 0; bar.st = MISC;
    if (hi - lo > 1) bar = xcd_barrier_post(ctl + CW_BAR, MISC);
#ifndef PH_MASK
#define PH_MASK 0x1ffff
#endif
#define IN(k) ((((PH_MASK) >> (k)) & 1) && lo <= (k) && (k) < hi)
#ifndef REP_MASK
#define REP_MASK 0
#endif
#define NREP(k) (1 + (((REP_MASK) >> (k)) & 1))
#ifndef PR_MFMA
#define PR_MFMA 0
#endif
#ifndef PR_EPI
#define PR_EPI 0
#endif
#ifndef PR_GA
#define PR_GA 0
#endif
#ifndef PR_VF
#define PR_VF 0
#endif
#ifndef PR_KV
#define PR_KV 0
#endif
#ifndef PR_ML
#define PR_ML 0
#endif
#ifndef PR_TR
#define PR_TR 0
#endif
#ifndef PR_WP
#define PR_WP 0
#endif
#ifndef PR_H1
#define PR_H1 0
#endif
#ifndef PR_QK
#define PR_QK 0
#endif
#ifndef PR_PV
#define PR_PV 0
#endif
#define BOTH(k) (IN(k) && IN((k) + 1))
#define GRID_BAR(k) do { if (BOTH(k) && rep_ == NREP(k) - 1) xcd_barrier(bar, tid); } while (0)

#define WOUT_T ((bf16*)(ws + WS_WOUT_T))
#define WCQ_T ((bf16*)(ws + WS_WCQ_T))
#define WCKV_T ((bf16*)(ws + WS_WCKV_T))
#define WCO_T ((bf16*)(ws + WS_WCO_T))
#define WGU_T ((bf16*)(ws + WS_WGU_T))
#define WDN_T ((bf16*)(ws + WS_WDN_T))
#define WIN_T ((bf16*)(ws + WS_WIN_T))
#define H1 ((bf16*)(ws + WS_H1))
#define MIXIN ((bf16*)(ws + WS_MIXIN))
#define MEMN ((bf16*)(ws + WS_MEMN))
#define KC ((bf16*)(ws + WS_KC))
#define MF ((bf16*)(ws + WS_WCKV_T + 4 * MiB))
#define VF ((bf16*)(ws + WS_WCKV_T))
#define VT ((bf16*)(ws + WS_VT))
#define GATES ((float*)(ws + WS_GATES))
#define QABS ((bf16*)(ws + WS_QABS))
#define CKVRAW ((float*)(ws + WS_CKVRAW))
#define QI ((bf16*)(ws + WS_QI))
#define SMALL ((float*)(ws + WS_SMALL))
#define MQKRAW ((float*)(ws + WS_MQKRAW))
#define MV ((bf16*)(ws + WS_MV))
#define MO ((bf16*)(ws + WS_MO))
#define CKVN ((bf16*)(ws + WS_CKVN))
#define KIDXN ((bf16*)(ws + WS_KIDXN))
#define QCM ((bf16*)(ws + WS_QCM))
#define KCM ((bf16*)(ws + WS_KCM))
#define LST ((float*)(ws + WS_LST))
#define NL ((float*)(ws + WS_NL))
#define NST (NL + NCH * 4 * 128)
#define CST ((bf16*)(ws + WS_CST))
#define VTM ((bf16*)(ws + WS_VTM))
#define PB ((bf16*)(ws + WS_VTM))
#define X1B ((bf16*)(ws + WS_X1B))
#define QC ((bf16*)(ws + WS_QC))
#define OC ((bf16*)(ws + WS_OC))
#define X2B ((bf16*)(ws + WS_X2B))
#define LIST ((int*)(ws + WS_LIST))
#define TOKE ((int*)(ws + WS_TOK))
#define TOKW ((float*)(ws + WS_TOK) + 2 * T)
#define RSTD3 ((float*)(ws + WS_TOK) + 4 * T)
#define ACT ((bf16*)(ws + WS_ACT))
#define Y ((bf16*)(ws + WS_Y))
#define WRH ((bf16*)(ws + WS_WR))
#define WRL (WRH + 48 * D)
#define BCNT ((int*)(ws + WS_TOK) + 8 * T)
#define TOKR ((int*)(ws + WS_TOK) + 6 * T)
#define SS2 ((float*)(ctl + CW_SS2))
#define CNT ((int*)(ctl + CW_CNT))

    if (IN(0)) for (int rep_ = 0; rep_ < NREP(0); ++rep_) {
        PHASE_IDS
        if (rep_) xcd_barrier(bar, tid);
        LAS float* scr = (LAS float*)(lds + wave * 16384);
        const float* w_in = A_->in[I_W_IN]; const float* w_out = A_->in[I_W_OUT];
        constexpr int J_CKV = 32 * 4, J_QI = 32 * 8, J_KI = 32 * 1, J_MQK = 32 * 16, J_MV = 32 * 16, J_MO = 32 * 16, J_WO = 16 * 32, J_CQ = 32 * 32, J_CKVW = 32 * 64, J_CO = 32 * 32,
                      J_G = 32 * 256, J_U = 32 * 256, J_D = 32 * 256;
        constexpr int NITEMS = J_CKV + J_QI + J_KI + J_MQK + J_MV + J_MO + J_WO + J_CQ + J_CKVW + J_CO + J_G + J_U + J_D;
        LAS unsigned char* scr8 = (LAS unsigned char*)scr;
        for (int prt_ = 0; prt_ < 1 + PR_TR; ++prt_)
        for (int it = gw; it < NITEMS; it += NGW) {
            int r = it;
            if (r < J_CKV) { tr_item64(w_in + 1024, D_IN, 64 * (r / 4), 64 * (r % 4), nullptr, WIN_T, D, 2048, 0, scr8, lane); continue; } r -= J_CKV;
            if (r < J_QI) { tr_item64(w_in + 1280, D_IN, 64 * (r / 8), 64 * (r % 8), nullptr, WIN_T, D, 2304, 0, scr8, lane); continue; } r -= J_QI;
            if (r < J_KI) { tr_item64(w_in + 1792, D_IN, 64 * r, 0, nullptr, WIN_T, D, 2816, 0, scr8, lane); continue; } r -= J_KI;
            if (r < J_MQK) { tr_item64(w_in + 1864, D_IN, 64 * (r / 16), 64 * (r % 16), nullptr, WIN_T, D, 3072, 0, scr8, lane); continue; } r -= J_MQK;
            if (r < J_MV) { tr_item64(w_in + 2888, D_IN, 64 * (r / 16), 64 * (r % 16), nullptr, WIN_T, D, 4096, 0, scr8, lane); continue; } r -= J_MV;
            if (r < J_MO) { tr_item64(w_in + 3920, D_IN, 64 * (r / 16), 64 * (r % 16), nullptr, WIN_T, D, 5120, 0, scr8, lane); continue; } r -= J_MO;
            if (r < J_WO) { tr_item64(w_out + (size_t)1024 * D, D, 64 * (r / 32), 64 * (r % 32), nullptr, WOUT_T, KMIX, 0, 2048, scr8, lane); continue; } r -= J_WO;
            if (r < J_CQ) { cv_item64(A_->in[I_W_CQ], D, 64 * (r / 32), 64 * (r % 32), A_->in[I_NORM_X_G], 0.04419417382415922f, WCQ_T, D, lane); continue; } r -= J_CQ;
            if (r < J_CKVW) { tr_item64(A_->in[I_W_CKV], 2 * D, 64 * (r / 64), 64 * (r % 64), nullptr, WCKV_T, D, 0, 0, scr8, lane); continue; } r -= J_CKVW;
            if (r < J_CO) { tr_item64(A_->in[I_W_CO], D, 64 * (r / 32), 64 * (r % 32), nullptr, WCO_T, D, 0, 0, scr8, lane); continue; } r -= J_CO;
            if (r < J_G) { const int e = r / 256, q = r % 256, kb = q / 8, nb = q % 8;
                tr_item64(A_->in[I_W_GATE] + (size_t)e * D * DEXP, DEXP, 64 * kb, 64 * nb, A_->in[I_NORM_FFN_G], WGU_T + (size_t)e * 1024 * D, D, (nb / 2) * 128, 0, scr8, lane); continue; } r -= J_G;
            if (r < J_U) { const int e = r / 256, q = r % 256, kb = q / 8, nb = q % 8;
                tr_item64(A_->in[I_W_UP] + (size_t)e * D * DEXP, DEXP, 64 * kb, 64 * nb, A_->in[I_NORM_FFN_G], WGU_T + (size_t)e * 1024 * D, D, (nb / 2) * 128 + 128, 0, scr8, lane); continue; } r -= J_U;
            { const int e = r / 256, q = r % 256, kb = q / 32, nb = q % 32;
                tr_item64(A_->in[I_W_DOWN] + (size_t)e * DEXP * D, D, 64 * kb, 64 * nb, nullptr, WDN_T + (size_t)e * D * DEXP, DEXP, 0, 0, scr8, lane); }
        }
        for (int i = bx * 512 + tid; i < 192 * D; i += G * 512) { const int r = i / D, k = i % D; float v = 0.f;
            if (r < 8) v = w_in[(size_t)k * D_IN + 1856 + r]; else if (r < 16) v = w_in[(size_t)k * D_IN + 3912 + (r - 8)];
            WIN_T[(size_t)(2880 + r) * D + k] = (bf16)f2bf(v); }
        for (int i = bx * 512 + tid; i < 48 * D; i += G * 512) { const int o = i / D, k = i % D; float v = 0.f;
            if (o < 4) v = A_->in[I_W_GROUP][(size_t)k * 4 + o] * A_->in[I_NORM_FFN_G][k]; else if (o < 36) v = A_->in[I_W_ROUTER][(size_t)k * 32 + (o - 4)] * A_->in[I_NORM_FFN_G][k];
            const unsigned hb = f2bf(v); WRH[i] = (bf16)hb; WRL[i] = (bf16)f2bf(v - bf2f(hb)); }
        {
            const int r32 = lane & 31, hh = lane >> 5;
            const float* w_uk = A_->in[I_W_UK]; const float* w_uv = A_->in[I_W_UV];
#define CVT8(dst, pa, pb) do { const f32x4 x_ = (pa), y_ = (pb); u32x4 w_; w_.x = pk2(x_[0], x_[1]); w_.y = pk2(x_[2], x_[3]); w_.z = pk2(y_[0], y_[1]); w_.w = pk2(y_[2], y_[3]); dst = __builtin_bit_cast(bf16x8, w_); } while (0)
            for (int prw_ = 0; prw_ < 1 + PR_WP; ++prw_)
            for (int it = gw; it < 4096; it += NGW) {
                const bool isq = it < 2048; const int r = it & 2047, h = r >> 8, rt = (r >> 2) & 63, cg = r & 3;
                if (isq) {
                    const int ct = (r >> 5) & 7, kg = r & 31;
                    bf16x8 af[8];
                    { const float* ap = w_uk + (size_t)((ct * 32 + r32) * 8 + h) * 128 + 8 * hh;
#pragma unroll
                      for (int ks = 0; ks < 8; ++ks) CVT8(af[ks], *(const f32x4*)(ap + ks * 16), *(const f32x4*)(ap + ks * 16 + 4)); }
#pragma unroll 1
                    for (int kt = 0; kt < 2; ++kt) { const int k0 = kg * 64 + kt * 32; const float* bp = w_in + (size_t)(k0 + r32) * D_IN + h * 128 + 8 * hh;
                        f32x16 acc;
#pragma unroll
                        for (int i = 0; i < 16; ++i) acc[i] = 0.f;
#pragma unroll
                        for (int ks = 0; ks < 8; ++ks) { bf16x8 bfr; CVT8(bfr, *(const f32x4*)(bp + ks * 16), *(const f32x4*)(bp + ks * 16 + 4)); acc = __builtin_amdgcn_mfma_f32_32x32x16_bf16(af[ks], bfr, acc, 0, 0, 0); }
                        bf16* o = WIN_T + (size_t)(h * 256 + ct * 32 + 4 * hh) * D + k0 + r32;
#pragma unroll
                        for (int i = 0; i < 16; ++i) o[(size_t)((i & 3) + 8 * (i >> 2)) * D] = (bf16)f2bf(acc[i] * 0.08838834764831845f); }
                } else {
                    const float* pj[8];
#pragma unroll
                    for (int j = 0; j < 8; ++j) pj[j] = w_out + (size_t)(h * 128 + 8 * hh + j) * D + rt * 32 + r32;
                    const float* bp0 = w_uv + (size_t)((cg * 64 + r32) * 8 + h) * 128 + 8 * hh; const float* bp1 = bp0 + (size_t)32 * 8 * 128;
                    f32x16 acc0, acc1;
#pragma unroll
                    for (int i = 0; i < 16; ++i) { acc0[i] = 0.f; acc1[i] = 0.f; }
#pragma unroll 2
                    for (int ks = 0; ks < 8; ++ks) { u32x4 w_; w_.x = pk2(*pj[0], *pj[1]); w_.y = pk2(*pj[2], *pj[3]); w_.z = pk2(*pj[4], *pj[5]); w_.w = pk2(*pj[6], *pj[7]); const bf16x8 afr = __builtin_bit_cast(bf16x8, w_);
#pragma unroll
                        for (int j = 0; j < 8; ++j) pj[j] += (size_t)16 * D;
                        bf16x8 b0, b1; CVT8(b0, *(const f32x4*)(bp0 + ks * 16), *(const f32x4*)(bp0 + ks * 16 + 4)); CVT8(b1, *(const f32x4*)(bp1 + ks * 16), *(const f32x4*)(bp1 + ks * 16 + 4));
                        acc0 = __builtin_amdgcn_mfma_f32_32x32x16_bf16(afr, b0, acc0, 0, 0, 0); acc1 = __builtin_amdgcn_mfma_f32_32x32x16_bf16(afr, b1, acc1, 0, 0, 0); }
                    bf16* o = WOUT_T + (size_t)(rt * 32 + 4 * hh) * KMIX + h * 256 + cg * 64 + r32;
#pragma unroll
                    for (int i = 0; i < 16; ++i) { o[(size_t)((i & 3) + 8 * (i >> 2)) * KMIX] = (bf16)f2bf(acc0[i]); o[(size_t)((i & 3) + 8 * (i >> 2)) * KMIX + 32] = (bf16)f2bf(acc1[i]); }
                }
            }
#undef CVT8
        }
        for (int prh_ = 0; prh_ < 1 + PR_H1; ++prh_)
        for (int m = gw; m < T; m += NGW) rms_row_to_bf16(A_->in[I_X] + (size_t)m * D, A_->in[I_NORM_MIX_G], H1 + (size_t)m * D, lane);
        for (int m = gw; m < NMEM; m += NGW) rms_row_to_bf16(A_->in[I_MEM] + (size_t)m * D, A_->in[I_MEM_NORM_G], MEMN + (size_t)m * D, lane);
        GRID_BAR(0);
    }

    if (IN(1)) for (int rep_ = 0; rep_ < NREP(1); ++rep_) {
        PHASE_IDS
        if (rep_) xcd_barrier(bar, tid);
        pg8::DenseOrder S; S.init(T, NPROJ, D, D, G, bx);
        pg8::EpiProj E{QABS, CKVRAW, QI, SMALL, MQKRAW, MV, MO};
        pg8::gemm_phase(tid, lds, H1, WIN_T, D, S, E);
        GRID_BAR(1);
    }

    if (IN(2)) for (int rep_ = 0; rep_ < NREP(2); ++rep_) {
        PHASE_IDS
        if (rep_) xcd_barrier(bar, tid);
#ifndef P2_SUB
#define P2_SUB 15
#endif
        if (P2_SUB & 1) {
            for (int prk_ = 0; prk_ < 1 + PR_KV; ++prk_)
            for (int id = bx; id < 256; id += G) {
                const int rt = id & 3, ct = id >> 2;
                mini_gemm64(lds, MEMN + (size_t)(rt * 64) * D, D, WCKV_T + (size_t)(ct * 64) * D, D, 16, KC + (size_t)(rt * 64) * 4096 + ct * 64, 4096u, wave, lane);
            }
        }
        __syncthreads();
        if (P2_SUB & 4) for (int t = gw; t < T; t += NGW) {
            const f32x4 v = ((const f32x4*)(CKVRAW + (size_t)t * 256))[lane];
            const float r = rsqrtf(wave_sum((v[0] * v[0] + v[1] * v[1]) + (v[2] * v[2] + v[3] * v[3])) * (1.f / 256.f) + EPS);
            const f32x4 g = ((const f32x4*)A_->in[I_KV_NORM_G])[lane];
            u32x2 w; w.x = pk2(v[0] * r * g[0], v[1] * r * g[1]); w.y = pk2(v[2] * r * g[2], v[3] * r * g[3]);
            ((u32x2*)(CKVN + (size_t)t * 256))[lane] = w;
            const float kv = SMALL[(size_t)t * 256 + lane];
            const float rk = rsqrtf(wave_sum(kv * kv) * (1.f / 64.f) + EPS);
            KIDXN[(size_t)t * 64 + lane] = (bf16)f2bf(kv * rk * A_->in[I_KIDX_NORM_G][lane]);
        }
        if (P2_SUB & 8) {
            LAS float* kq = (LAS float*)lds;
            LAS bf16* KWT = (LAS bf16*)(lds + 32768);
            LAS bf16* VTl = (LAS bf16*)(lds + 51200);
            LAS float* sw = (LAS float*)(lds + 98304);
            const float* conv_w = A_->in[I_CONV_W]; const float* conv_b = A_->in[I_CONV_B]; const float* gate_b = A_->in[I_GATE_B];
            const int r32 = lane & 31, hh = lane >> 5;
            for (int prm_ = 0; prm_ < 1 + PR_ML; ++prm_)
            for (int uu = bx; uu < NCH * 4; uu += G) {
                const int c = uu >> 2, h = uu & 3, t0 = c * CH;
                __syncthreads();
                if (wave == 0) {
                    const int t = t0 + lane; const float li = SMALL[(size_t)t * 256 + 72 + h] + gate_b[h]; const float mf = SMALL[(size_t)t * 256 + 76 + h] + gate_b[4 + h];
                    float bsc = fminf(mf, 0.f) - log1pf(__expf(-fabsf(mf)));
#pragma unroll
                    for (int o = 1; o < 64; o <<= 1) { const float v = __shfl_up(bsc, o); if (lane >= o) bsc += v; }
                    const float g = __shfl(bsc, 63); const float dec = g - bsc + li; const float mx = wave_max(dec);
                    sw[lane] = __expf(dec - mx); sw[128 + lane] = li; sw[192 + lane] = bsc;
                    GATES[GT_B + (size_t)t * 4 + h] = bsc; GATES[GT_LI + (size_t)t * 4 + h] = li;
                    if (lane == 0) { GATES[GT_G + c * 4 + h] = g; GATES[GT_MLOC + c * 4 + h] = mx; } }
                __syncthreads();
                { const int ch = tid & 255, th = tid >> 8; const int src = ch < 128 ? h * 128 + ch : 512 + h * 128 + (ch - 128);
                  const float cw0 = conv_w[src], cw1 = conv_w[1024 + src], cw2 = conv_w[2048 + src], cw3 = conv_w[3072 + src], cbias = conv_b[src];
                  const int tb = t0 + th * 32 - 3; float xr[35];
#pragma unroll
                  for (int i = 0; i < 35; ++i) xr[i] = (tb + i >= 0) ? MQKRAW[(size_t)(tb + i) * 1024 + src] : 0.f;
#pragma unroll
                  for (int i = 0; i < 32; ++i) { const int s_ = th * 32 + i, t = t0 + s_; float y = cbias + ((cw0 * xr[i] + cw1 * xr[i + 1]) + (cw2 * xr[i + 2] + cw3 * xr[i + 3]));
                      y = y / (1.f + __expf(-y));
                      if (ch < 128) QCM[(size_t)t * 512 + h * 128 + ch] = (bf16)f2bf(y * 0.08838834764831845f);
                      else { const unsigned kb = f2bf(y); KCM[(size_t)t * 512 + h * 128 + (ch - 128)] = (bf16)kb; const float kf = bf2f(kb); kq[s_ * 128 + (ch - 128)] = kf; KWT[(ch - 128) * 72 + s_] = (bf16)f2bf(sw[s_] * kf); } } }
#pragma unroll 1
                for (int e = tid; e < 64 * 32; e += 512) { const int s = e & 63, c8 = e >> 6; const u32x4 vv = *(const u32x4*)(MV + (size_t)(t0 + s) * 1024 + h * 256 + c8 * 8);
                    LAS bf16* d = VTl + (c8 * 8) * 72 + s;
                    d[0] = (bf16)(vv.x & 0xffffu); d[72] = (bf16)(vv.x >> 16); d[144] = (bf16)(vv.y & 0xffffu); d[216] = (bf16)(vv.y >> 16);
                    d[288] = (bf16)(vv.z & 0xffffu); d[360] = (bf16)(vv.z >> 16); d[432] = (bf16)(vv.w & 0xffffu); d[504] = (bf16)(vv.w >> 16); }
                __syncthreads();
#pragma unroll 1
                for (int e = tid; e < 256 * 8; e += 512) { const int dv = e >> 3, ch = e & 7; *(u32x4*)(VTM + ((size_t)(c * 4 + h) * 256 + dv) * 64 + ch * 8) = *(const LAS u32x4*)(VTl + dv * 72 + ch * 8); }
                {
                    bf16x8 af[4];
#pragma unroll
                    for (int ks = 0; ks < 4; ++ks) af[ks] = *(const LAS bf16x8*)(VTl + (wave * 32 + r32) * 72 + ks * 16 + 8 * hh);
#pragma unroll 1
                    for (int j = 0; j < 4; ++j) { f32x16 acc;
#pragma unroll
                        for (int i = 0; i < 16; ++i) acc[i] = 0.f;
#pragma unroll
                        for (int ks = 0; ks < 4; ++ks) { const bf16x8 bfr = *(const LAS bf16x8*)(KWT + (j * 32 + r32) * 72 + ks * 16 + 8 * hh); acc = __builtin_amdgcn_mfma_f32_32x32x16_bf16(af[ks], bfr, acc, 0, 0, 0); }
                        float* o = LST + ((size_t)(c * 4 + h) * 256 + wave * 32 + 4 * hh) * 128 + j * 32 + r32;
#pragma unroll
                        for (int i = 0; i < 16; ++i) o[(size_t)((i & 3) + 8 * (i >> 2)) * 128] = acc[i]; }
                }
                if (tid < 128) { float a = 0.f;
#pragma unroll 4
                    for (int s = 0; s < 64; ++s) a += sw[s] * kq[s * 128 + tid]; NL[(size_t)(c * 4 + h) * 128 + tid] = a; }
            }
        }
        GRID_BAR(2);
    }

    if (IN(3)) for (int rep_ = 0; rep_ < NREP(3); ++rep_) {
        PHASE_IDS
        if (rep_) xcd_barrier(bar, tid);
#ifndef R_SCAN
#define R_SCAN 1
#endif
        for (int prv_ = 0; prv_ < 1 + PR_VF; ++prv_)
        for (int id = bx; id < 512; id += G) {
            const int h = id >> 7, rt = (id & 127) >> 2, ct = id & 3;
            mini_gemm64(lds, WCO_T + (size_t)(rt * 64) * D + h * 512, D, KC + (size_t)(ct * 64) * 4096 + 2048 + h * 512, 4096u, 4, VF + (size_t)(rt * 64) * 1024 + h * 256 + ct * 64, 1024u, wave, lane);
        }
        for (int prv_ = 0; prv_ < 1 + PR_VF; ++prv_)
        for (int id = bx; id < 512; id += G) {
            const int h = id >> 7, kt = (id & 127) >> 2, mt = id & 3;
            mini_gemm64(lds, KC + (size_t)(mt * 64) * 4096 + h * 512, 4096u, WCQ_T + (size_t)(kt * 64) * D + h * 512, D, 4, MF + (size_t)(h * 256 + mt * 64) * D + kt * 64, D, wave, lane);
        }
        for (int rscan_ = 0; rscan_ < R_SCAN; ++rscan_) {
            LAS float* am = (LAS float*)lds;
            LAS float* sm = am + 512;
            LAS float* gl = am + 1024;
            __syncthreads();
            gl[tid] = GATES[GT_G + tid]; gl[512 + tid] = GATES[GT_MLOC + tid];
            __syncthreads();
            if (tid < 4) { float m = 0.f;
#pragma unroll 1
                for (int k = 0; k < NCH; ++k) { const float g = gl[k * 4 + tid], ml = gl[512 + k * 4 + tid]; const float mn = fmaxf(g + m, ml);
                    am[tid * 128 + k] = __expf(g + m - mn); sm[tid * 128 + k] = __expf(ml - mn); if (bx == 0) GATES[GT_MPREV + k * 4 + tid] = m; m = mn; } }
            __syncthreads();
            for (int e = bx * 512 + tid; e < 4 * 32768; e += G * 512) { const int h = e >> 15, rem = e & 32767; float C = 0.f;
#pragma unroll 1
                for (int kb = 0; kb < NCH; kb += 32) { float l[32];
#pragma unroll
                    for (int i = 0; i < 32; ++i) l[i] = __builtin_nontemporal_load(LST + (size_t)((kb + i) * 4 + h) * 32768 + rem);
#pragma unroll
                    for (int i = 0; i < 32; ++i) { const int k = kb + i; CST[(size_t)(k * 4 + h) * 32768 + rem] = (bf16)f2bf(C); C = am[h * 128 + k] * C + sm[h * 128 + k] * l[i]; } } }
            if (bx == 0) { const int h = tid >> 7, dk = tid & 127; float n = 0.f;
#pragma unroll 1
                for (int kb = 0; kb < NCH; kb += 16) { float l[16];
#pragma unroll
                    for (int i = 0; i < 16; ++i) l[i] = NL[(size_t)((kb + i) * 4 + h) * 128 + dk];
#pragma unroll
                    for (int i = 0; i < 16; ++i) { const int k = kb + i; NST[(size_t)(k * 4 + h) * 128 + dk] = n; n = am[h * 128 + k] * n + sm[h * 128 + k] * l[i]; } } }
            __syncthreads();
        }
        {
            const int r32 = lane & 31, hh = lane >> 5;
#pragma unroll 1
            for (int ui_ = 0; ui_ * G < 1144; ++ui_) {
                const int L = ui_ * G + ((ui_ & 1) ? (G - 1 - bx) : bx); if (L >= 1144) continue;
                int sl = 0, g;
                if (L < 912) { int rem = L;
#pragma unroll 1
                    while (rem >= 226 - 32 * sl) { rem -= 226 - 32 * sl; ++sl; }
                    g = 32 * sl + 30 + rem; }
                else { int q = L - 912, r, j; if (q < 176) { r = 15 - q / 16; j = q % 16; sl = j >> 1; } else { q -= 176; r = 4 - q / 14; j = q % 14; sl = 1 + (j >> 1); }
                    g = 2 * (r - 1 + 16 * sl) + (j & 1); }
                const int c = g >> 1, tq0 = g * 32 + wave * 4, N = 64 * (c + 1);
                const int jb = sl * 32, je = (N >> 5) < jb + 32 ? (N >> 5) : jb + 32;
                if (N <= 256) continue;
                unsigned short* rowb = (c < 127 ? (unsigned short*)A_->out + (size_t)2048 * c * (c + 1) : (unsigned short*)(ws + WS_SC127)) + (size_t)(tq0 & 63) * N + jb * 32;
                LAS unsigned short* stg = (LAS unsigned short*)(lds + wave * 8192);
                bf16x8 af[4]; float wq[16];
                { const bf16* qp = QI + (size_t)(tq0 + (r32 >> 3)) * 512 + (r32 & 7) * 64 + 8 * hh;
#pragma unroll
                  for (int ks = 0; ks < 4; ++ks) af[ks] = *(const bf16x8*)(qp + ks * 16);
#pragma unroll
                  for (int qq = 0; qq < 4; ++qq)
#pragma unroll
                      for (int i = 0; i < 4; ++i) wq[qq * 4 + i] = SMALL[(size_t)(tq0 + qq) * 256 + 64 + 4 * hh + i] * 0.04419417382415922f; }
#define IDX_GROUP(gi_) do { const int tile_ = jb + (gi_) * 8 + wave; if (tile_ < je) { _Pragma("unroll") for (int i4 = 0; i4 < 4; ++i4) { const int row_ = i4 * 8 + (lane >> 3); \
                        const bf16* gsrc_ = KIDXN + (size_t)(tile_ * 32 + row_) * 64 + (((lane & 7) ^ (row_ & 7)) * 8); \
                        const unsigned ldst_ = __builtin_amdgcn_readfirstlane((unsigned)(size_t)lds + 65536u + (unsigned)(((gi_) & 1) * 32768 + wave * 4096 + i4 * 1024)); unsigned keep_; \
                        asm volatile("s_mov_b32 %0, m0\n\ts_mov_b32 m0, %2\n\ts_nop 0\n\tglobal_load_lds_dwordx4 %1, off\n\ts_mov_b32 m0, %0" : "=&s"(keep_) : "v"(gsrc_), "s"(ldst_) : "memory"); } } } while (0)
#define IDX_LOAD(buf, gi_, tl_) do { const LAS unsigned char* kt_ = lds + 65536 + ((gi_) & 1) * 32768 + (tl_) * 4096 + r32 * 128; \
                    _Pragma("unroll") for (int ks = 0; ks < 4; ++ks) buf[ks] = *(const LAS bf16x8*)(kt_ + (((ks * 2 + hh) ^ (r32 & 7)) * 16)); } while (0)
#define RELU_(x_) __int_as_float(max(__float_as_int(x_), 0))
#define IDX_TILE(buf, jj) do { const int s0 = (jj) * 32; f32x16 acc; _Pragma("unroll") for (int i = 0; i < 16; ++i) acc[i] = 0.f; \
                        _Pragma("unroll") for (int ks = 0; ks < 4; ++ks) acc = __builtin_amdgcn_mfma_f32_32x32x16_bf16(af[ks], buf[ks], acc, 0, 0, 0); \
                        if (PR_MFMA) { f32x16 acc2; _Pragma("unroll") for (int i = 0; i < 16; ++i) acc2[i] = 0.f; _Pragma("unroll") for (int ks = 0; ks < 4; ++ks) acc2 = __builtin_amdgcn_mfma_f32_32x32x16_bf16(af[ks], buf[ks], acc2, 0, 0, 0); asm volatile("" :: "v"(acc2)); } \
                        if (PR_EPI) { f32x16 a3 = acc; asm volatile("" : "+v"(a3)); float p3[4]; _Pragma("unroll") for (int qq = 0; qq < 4; ++qq) p3[qq] = (wq[qq * 4] * fmaxf(a3[qq * 4], 0.f) + wq[qq * 4 + 1] * fmaxf(a3[qq * 4 + 1], 0.f)) + (wq[qq * 4 + 2] * fmaxf(a3[qq * 4 + 2], 0.f) + wq[qq * 4 + 3] * fmaxf(a3[qq * 4 + 3], 0.f)); \
                            _Pragma("unroll") for (int qq = 0; qq < 4; ++qq) p3[qq] += __shfl_xor(p3[qq], 32); asm volatile("" :: "v"(p3[0]), "v"(p3[1]), "v"(p3[2]), "v"(p3[3])); } \
                        float part[4]; \
                          \
                        _Pragma("unroll") for (int qq = 0; qq < 4; ++qq) part[qq] = (wq[qq * 4] * RELU_(acc[qq * 4]) + wq[qq * 4 + 1] * RELU_(acc[qq * 4 + 1])) + (wq[qq * 4 + 2] * RELU_(acc[qq * 4 + 2]) + wq[qq * 4 + 3] * RELU_(acc[qq * 4 + 3])); \
                        const auto s02_ = __builtin_amdgcn_permlane32_swap(__float_as_uint(part[0]), __float_as_uint(part[2]), false, false), s13_ = __builtin_amdgcn_permlane32_swap(__float_as_uint(part[1]), __float_as_uint(part[3]), false, false); \
                          \
                        const float v0 = __uint_as_float(s02_[0]) + __uint_as_float(s02_[1]), v1 = __uint_as_float(s13_[0]) + __uint_as_float(s13_[1]); \
                        unsigned u0 = __builtin_bit_cast(unsigned short, (_Float16)v0), u1 = __builtin_bit_cast(unsigned short, (_Float16)v1); \
                        u0 = (u0 == 0x8000u) ? 0u : u0; u1 = (u1 == 0x8000u) ? 0u : u1; \
                        stg[(2 * hh) * 1024 + s0 - jb * 32 + r32] = (unsigned short)((u0 & 0x8000u) ? ~u0 : (u0 | 0x8000u)); \
                        stg[(2 * hh + 1) * 1024 + s0 - jb * 32 + r32] = (unsigned short)((u1 & 0x8000u) ? ~u1 : (u1 | 0x8000u)); } while (0)
                { const int ngrp = (je - jb + 7) >> 3;
                  __syncthreads();
                  IDX_GROUP(0);
#pragma unroll 1
                  for (int gi = 0; gi < ngrp; ++gi) {
                      asm volatile("s_waitcnt vmcnt(0)" ::: "memory");
                      __syncthreads();
                      if (gi + 1 < ngrp) IDX_GROUP(gi + 1);
#pragma unroll 2
                      for (int tl = 0; tl < 8; ++tl) { const int jt = jb + gi * 8 + tl; if (jt < je) { bf16x8 kbf[4]; IDX_LOAD(kbf, gi, tl); IDX_TILE(kbf, jt); } }
                  } }
#undef IDX_GROUP
#undef IDX_LOAD
#undef IDX_TILE
                LDS_WAIT(); asm volatile("" ::: "memory");
                { const int nk = (je - jb) * 32, np = nk >> 3;
                  for (int i = lane; i < 4 * np; i += 64) { const int qq = i / np, p = i - qq * np; *(u32x4*)(rowb + (size_t)qq * N + p * 8) = *(const LAS u32x4*)(stg + qq * 1024 + p * 8); } }
                LDS_WAIT(); asm volatile("" ::: "memory");
            }
        }
        GRID_BAR(3);
    }
    if (IN(4)) for (int rep_ = 0; rep_ < NREP(4); ++rep_) {
        PHASE_IDS
        if (rep_) xcd_barrier(bar, tid);
        {
            LAS int* hist = (LAS int*)(lds + MISC_OFF + 4096) + wave * 256;
            LAS int* sel = (LAS int*)(lds + MISC_OFF + 12288) + wave * 256;
            const int r16 = lane & 15, g4 = lane >> 4;
            __syncthreads();
#pragma unroll 1
            for (int ui_ = 0; ui_ * G < T / 8; ++ui_) {
                const int uu = ui_ * G + ((ui_ & 1) ? (G - 1 - bx) : bx); if (uu >= T / 8) continue;
                const int t0 = uu * 8, t = t0 + wave, c = t0 >> 6, N = (c + 1) * 64, ng = N >> 6;
                {
                        if (N > 256) {
                            const unsigned short* rb = (c < 127 ? (const unsigned short*)A_->out + (size_t)2048 * c * (c + 1) : (const unsigned short*)(ws + WS_SC127)) + (size_t)(t & 63) * N;
                            unsigned kr[128];
#pragma unroll
                            for (int b8 = 0; b8 < 16; ++b8) {
#pragma unroll
                                for (int i = 0; i < 8; ++i) kr[b8 * 8 + i] = 0u;
                                if (b8 * 8 < ng) { const bool ok = b8 * 512 + lane * 8 < N;
                                    u32x4 v = __builtin_nontemporal_load((const GAS u32x4*)(rb + (ok ? b8 * 512 + lane * 8 : 0))); if (!ok) v = (u32x4){0u, 0u, 0u, 0u};
                                    kr[b8 * 8 + 0] = v.x & 0xffffu; kr[b8 * 8 + 1] = v.x >> 16; kr[b8 * 8 + 2] = v.y & 0xffffu; kr[b8 * 8 + 3] = v.y >> 16;
                                    kr[b8 * 8 + 4] = v.z & 0xffffu; kr[b8 * 8 + 5] = v.z >> 16; kr[b8 * 8 + 6] = v.w & 0xffffu; kr[b8 * 8 + 7] = v.w >> 16; } }
                            int krem = 256; unsigned prefix = 0u;
#pragma unroll 1
                            for (int ps = 0; ps < 2; ++ps) { const int shift = 8 - 8 * ps;
                                hist[lane] = 0; hist[64 + lane] = 0; hist[128 + lane] = 0; hist[192 + lane] = 0;
#pragma unroll
                                for (int b8 = 0; b8 < 16; ++b8) { if (b8 * 8 < ng) {
#pragma unroll
                                    for (int i = 0; i < 8; ++i) { const unsigned k = kr[b8 * 8 + i]; const bool mt = (k != 0u) && (ps == 0 || (k >> 8) == prefix);
                                        if (mt) __hip_atomic_fetch_add(hist + (int)((k >> shift) & 255u), 1, __ATOMIC_RELAXED, __HIP_MEMORY_SCOPE_WORKGROUP); } } }
                                const int h0 = hist[4 * lane], h1 = hist[4 * lane + 1], h2 = hist[4 * lane + 2], h3 = hist[4 * lane + 3];
                                int sfx = h0 + h1 + h2 + h3;
#pragma unroll
                                for (int o = 1; o < 64; o <<= 1) { const int v = __shfl_down(sfx, o); if (lane + o < 64) sfx += v; }
                                const unsigned long long mge = __ballot(sfx >= krem);
                                const int ls = 63 - __builtin_clzll(mge);
                                const int above_l = (ls < 63) ? __builtin_amdgcn_readlane(sfx, (ls + 1) & 63) : 0;
                                const int b1 = __builtin_amdgcn_readlane(h1, ls), b2 = __builtin_amdgcn_readlane(h2, ls), b3 = __builtin_amdgcn_readlane(h3, ls);
                                int dg, above;
                                if (above_l + b3 >= krem) { dg = 3; above = above_l; } else if (above_l + b3 + b2 >= krem) { dg = 2; above = above_l + b3; }
                                else if (above_l + b3 + b2 + b1 >= krem) { dg = 1; above = above_l + b3 + b2; } else { dg = 0; above = above_l + b3 + b2 + b1; }
                                krem -= above; prefix = (prefix << 8) | (unsigned)(4 * ls + dg); }
                            const unsigned thr = prefix;
                            int cg = 0; const int thi = (int)thr;
#pragma unroll
                            for (int b8 = 0; b8 < 16; ++b8) { if (b8 * 8 < ng) {
#pragma unroll
                                for (int i = 0; i < 8; ++i) { const int k = (int)kr[b8 * 8 + i]; cg += (int)((unsigned)(thi - k) >> 31); } } }
#pragma unroll
                            for (int o = 1; o < 64; o <<= 1) cg += __shfl_xor(cg, o);
                            const int ngt = __builtin_amdgcn_readfirstlane(cg), need = 256 - ngt;
                            int pg = 0, pe = 0; const unsigned long long ltm = (1ull << lane) - 1ull;
                            const int dump = (int)(((LAS int*)(lds + MISC_OFF + 20480) + wave * 64 + lane) - sel);
#pragma unroll
                            for (int b8 = 0; b8 < 16; ++b8) { if (b8 * 8 < ng) {
#pragma unroll
                                for (int i = 0; i < 8; ++i) { const unsigned k = kr[b8 * 8 + i]; const int sidx = b8 * 512 + lane * 8 + i; const bool gt = k > thr, eq = k == thr;
                                    const unsigned long long mg = __ballot(gt), me = __ballot(eq);
                                    const int pos = (int)__builtin_amdgcn_mbcnt_hi((unsigned)(mg >> 32), __builtin_amdgcn_mbcnt_lo((unsigned)mg, (unsigned)pg));
                                    sel[gt ? pos : dump] = sidx; pg += __popcll(mg);
                                    if (me) { const int r = pe + __popcll(me & ltm); if (eq && r < need) sel[ngt + r] = sidx; pe += __popcll(me); } } } }
                        } else {
#pragma unroll
                            for (int i = 0; i < 4; ++i) sel[i * 64 + lane] = i * 64 + lane;
                        }
                        LDS_WAIT(); asm volatile("" ::: "memory");
                }
                {
                        LAS unsigned char* cb = lds + wave * 16384;
                        const int nch = (N > 256 ? 256 : N) >> 5;
                        bf16x8 qf[8];
                        { const bf16* qp = QABS + (size_t)t * 2048 + (r16 & 7) * 256 + 8 * g4;
#pragma unroll
                          for (int ks = 0; ks < 8; ++ks) qf[ks] = *(const bf16x8*)(qp + ks * 32); }
                        f32x4 O[16];
#pragma unroll
                        for (int i = 0; i < 16; ++i) O[i] = (f32x4){0.f, 0.f, 0.f, 0.f};
                        float mrun = -3.0e38f, lrun = 0.f;
                        const int tq = r16 >> 2, tp = r16 & 3;
#pragma unroll 1
                        for (int ch = 0; ch < nch; ++ch) { const int slot0 = ch * 32;
#pragma unroll
                            for (int k = 0; k < 16; ++k) { const int im = k >> 3, row = (k & 7) * 4 + g4; const int lc = r16 ^ (((row & 3) << 2) | ((row >> 2) & 3)); const int key = sel[slot0 + row];
                                __builtin_amdgcn_global_load_lds((const unsigned*)(CKVN + (size_t)key * 256 + im * 128 + lc * 8), (LAS unsigned*)(cb + im * 8192 + (k & 7) * 1024), 16, 0, 0); }
                            asm volatile("s_waitcnt vmcnt(0)" ::: "memory");
                            const LAS unsigned char* cbc = cb;
                            f32x4 s0 = (f32x4){0.f, 0.f, 0.f, 0.f}, s1 = s0;
#pragma unroll
                            for (int ks = 0; ks < 8; ++ks) { const int im = ks >> 2, lc = 4 * (ks & 3) + g4;
                                const int ra = r16, rb = 16 + r16;
                                const bf16x8 k0 = *(const LAS bf16x8*)(cbc + im * 8192 + 256 * ra + 16 * (lc ^ (((ra & 3) << 2) | ((ra >> 2) & 3))));
                                const bf16x8 k1 = *(const LAS bf16x8*)(cbc + im * 8192 + 256 * rb + 16 * (lc ^ (((rb & 3) << 2) | ((rb >> 2) & 3))));
                                s0 = __builtin_amdgcn_mfma_f32_16x16x32_bf16(k0, qf[ks], s0, 0, 0, 0); s1 = __builtin_amdgcn_mfma_f32_16x16x32_bf16(k1, qf[ks], s1, 0, 0, 0);
                                if ((ks & 1) == 1) __builtin_amdgcn_sched_barrier(0); }
                            float mx = fmaxf(fmaxf(fmaxf(s0[0], s0[1]), fmaxf(s0[2], s0[3])), fmaxf(fmaxf(s1[0], s1[1]), fmaxf(s1[2], s1[3])));
                            mx = fmaxf(mx, __shfl_xor(mx, 16)); mx = fmaxf(mx, __shfl_xor(mx, 32));
                            const float mnew = fmaxf(mrun, mx), alpha = __expf(mrun - mnew); mrun = mnew;
                            float p[8]; float ls = 0.f;
#pragma unroll
                            for (int i = 0; i < 4; ++i) { p[i] = __expf(s0[i] - mnew); p[4 + i] = __expf(s1[i] - mnew); ls += p[i] + p[4 + i]; }
                            ls += __shfl_xor(ls, 16); ls += __shfl_xor(ls, 32);
                            lrun = lrun * alpha + ls;
                            u32x4 pw; pw.x = pk2(p[0], p[1]); pw.y = pk2(p[2], p[3]); pw.z = pk2(p[4], p[5]); pw.w = pk2(p[6], p[7]);
                            const bf16x8 pf = __builtin_bit_cast(bf16x8, pw);
#pragma unroll
                            for (int i = 0; i < 16; ++i) O[i] = O[i] * alpha;
                            const unsigned cbase = (unsigned)(size_t)cbc + 256u * (4 * g4 + tq) + 8u * (tp & 1);
#pragma unroll
                            for (int cq = 0; cq < 4; ++cq) {
                                u32x2 va[4], vb[4]; unsigned ad[4];
#pragma unroll
                                for (int j = 0; j < 4; ++j) { const int ct = cq * 4 + j; ad[j] = cbase + (unsigned)((ct >> 3) * 8192) + 16u * ((2 * (ct & 7) + (tp >> 1)) ^ ((tq << 2) | g4)); }
                                asm volatile("ds_read_b64_tr_b16 %0, %8\n\tds_read_b64_tr_b16 %1, %8 offset:4096\n\tds_read_b64_tr_b16 %2, %9\n\tds_read_b64_tr_b16 %3, %9 offset:4096\n\t"
                                             "ds_read_b64_tr_b16 %4, %10\n\tds_read_b64_tr_b16 %5, %10 offset:4096\n\tds_read_b64_tr_b16 %6, %11\n\tds_read_b64_tr_b16 %7, %11 offset:4096\n\ts_waitcnt lgkmcnt(0)"
                                             : "=&v"(va[0]), "=&v"(vb[0]), "=&v"(va[1]), "=&v"(vb[1]), "=&v"(va[2]), "=&v"(vb[2]), "=&v"(va[3]), "=&v"(vb[3])
                                             : "v"(ad[0]), "v"(ad[1]), "v"(ad[2]), "v"(ad[3]) : "memory");
#pragma unroll
                                for (int j = 0; j < 4; ++j) { u32x4 vv; vv.x = va[j].x; vv.y = va[j].y; vv.z = vb[j].x; vv.w = vb[j].y;
                                    O[cq * 4 + j] = __builtin_amdgcn_mfma_f32_16x16x32_bf16(__builtin_bit_cast(bf16x8, vv), pf, O[cq * 4 + j], 0, 0, 0); } }
                        }
                        const float inv = 1.f / lrun;
                        if (r16 < 8) {
#pragma unroll
                            for (int i = 0; i < 16; ++i) { u32x2 w; w.x = pk2(O[i][0] * inv, O[i][1] * inv); w.y = pk2(O[i][2] * inv, O[i][3] * inv); __builtin_nontemporal_store(w, (u32x2*)(MIXIN + (size_t)t * KMIX + r16 * 256 + i * 16 + 4 * g4)); } }
                }
            }
        }
        __syncthreads();
    }

    if (IN(4)) for (int rep_ = 0; rep_ < NREP(4); ++rep_) {
        PHASE_IDS
        if (rep_) xcd_barrier(bar, tid);
        LAS float* Sf = (LAS float*)lds;
        LAS bf16* Sb = (LAS bf16*)(lds + 16640);
        LAS float* ms = (LAS float*)(lds + 25856);
        LAS float* ssq = (LAS float*)(lds + 27904);
        const float* mlg = A_->in[I_ML_NORM_G];
        const int r32 = lane & 31, hh = lane >> 5;
        for (int uu = bx; uu < NCH * 4; uu += G) {
            const int c = uu >> 2, h = uu & 3, t0 = c * CH;
            __syncthreads();
            if (tid < 64) { const float b = GATES[GT_B + (size_t)(t0 + tid) * 4 + h], li = GATES[GT_LI + (size_t)(t0 + tid) * 4 + h]; ms[tid] = b; ms[64 + tid] = li - b; }
            if (tid < 128) ms[384 + tid] = NST[(size_t)(c * 4 + h) * 128 + tid];
            __syncthreads();
            float mt = 0.f;
            if (wave == 0) { const float mprev = GATES[GT_MPREV + c * 4 + h]; float pm = ms[64 + lane];
#pragma unroll
                for (int o = 1; o < 64; o <<= 1) { const float v = __shfl_up(pm, o); if (lane >= o) pm = fmaxf(pm, v); }
                const float mm = fmaxf(mprev, pm); mt = ms[lane] + mm; ms[128 + lane] = -mm; ms[192 + lane] = __expf(mprev - mm);
                float qn = 0.f; const bf16* qr = QCM + (size_t)(t0 + lane) * 512 + h * 128; u32x4 qq[16];
#pragma unroll
                for (int k8 = 0; k8 < 16; ++k8) qq[k8] = *(const u32x4*)(qr + k8 * 8);
#pragma unroll
                for (int k8 = 0; k8 < 16; ++k8) { const LAS float* np = ms + 384 + k8 * 8;
                    qn += (bf2f(qq[k8].x & 0xffffu) * np[0] + bf2f(qq[k8].x >> 16) * np[1]) + (bf2f(qq[k8].y & 0xffffu) * np[2] + bf2f(qq[k8].y >> 16) * np[3]) + (bf2f(qq[k8].z & 0xffffu) * np[4] + bf2f(qq[k8].z >> 16) * np[5]) + (bf2f(qq[k8].w & 0xffffu) * np[6] + bf2f(qq[k8].w >> 16) * np[7]); }
                ms[320 + lane] = qn; }
            __syncthreads();
            if (wave < 4) {
                const int tm = wave >> 1, tn = wave & 1;
                f32x16 acc;
#pragma unroll
                for (int i = 0; i < 16; ++i) acc[i] = 0.f;
                if (tn <= tm) { const bf16* qr = QCM + (size_t)(t0 + tm * 32 + r32) * 512 + h * 128 + 8 * hh; const bf16* kr = KCM + (size_t)(t0 + tn * 32 + r32) * 512 + h * 128 + 8 * hh;
#pragma unroll
                    for (int ks = 0; ks < 8; ++ks) acc = __builtin_amdgcn_mfma_f32_32x32x16_bf16(*(const bf16x8*)(qr + ks * 16), *(const bf16x8*)(kr + ks * 16), acc, 0, 0, 0); }
                const int sidx = tn * 32 + r32; const float us = ms[64 + sidx];
#pragma unroll
                for (int i = 0; i < 16; ++i) { const int t = tm * 32 + (i & 3) + 8 * (i >> 2) + 4 * hh; const float v = (sidx <= t) ? acc[i] * __expf(ms[128 + t] + us) : 0.f; Sf[t * 65 + sidx] = v; Sb[t * 72 + sidx] = (bf16)f2bf(v); }
            }
            __syncthreads();
            if (tid < 64) { float rs = 0.f;
#pragma unroll 4
                for (int s2 = 0; s2 < 64; ++s2) rs += Sf[tid * 65 + s2];
                const float dn = ms[192 + tid] * ms[320 + tid] + rs; ms[256 + tid] = fmaxf(fabsf(dn), __expf(-mt)); }
            f32x16 a1[2], a2[2];
#pragma unroll
            for (int tt = 0; tt < 2; ++tt)
#pragma unroll
                for (int i = 0; i < 16; ++i) { a1[tt][i] = 0.f; a2[tt][i] = 0.f; }
            { const bf16* cr = CST + ((size_t)(c * 4 + h) * 256 + wave * 32 + r32) * 128 + 8 * hh; const bf16* q0 = QCM + (size_t)(t0 + r32) * 512 + h * 128 + 8 * hh; const bf16* q1 = q0 + (size_t)32 * 512;
#pragma unroll
              for (int ks = 0; ks < 8; ++ks) { const bf16x8 cf = *(const bf16x8*)(cr + ks * 16); a1[0] = __builtin_amdgcn_mfma_f32_32x32x16_bf16(cf, *(const bf16x8*)(q0 + ks * 16), a1[0], 0, 0, 0); a1[1] = __builtin_amdgcn_mfma_f32_32x32x16_bf16(cf, *(const bf16x8*)(q1 + ks * 16), a1[1], 0, 0, 0); }
              const bf16* vr = VTM + ((size_t)(c * 4 + h) * 256 + wave * 32 + r32) * 64 + 8 * hh;
#pragma unroll
              for (int ks = 0; ks < 4; ++ks) { const bf16x8 vf = *(const bf16x8*)(vr + ks * 16); a2[0] = __builtin_amdgcn_mfma_f32_32x32x16_bf16(vf, *(const LAS bf16x8*)(Sb + r32 * 72 + ks * 16 + 8 * hh), a2[0], 0, 0, 0); a2[1] = __builtin_amdgcn_mfma_f32_32x32x16_bf16(vf, *(const LAS bf16x8*)(Sb + (32 + r32) * 72 + ks * 16 + 8 * hh), a2[1], 0, 0, 0); } }
            __syncthreads();
#pragma unroll
            for (int tt = 0; tt < 2; ++tt) { const int t = tt * 32 + r32; const float ai = ms[192 + t], idn = 1.f / ms[256 + t]; float p = 0.f;
#pragma unroll
                for (int i = 0; i < 16; ++i) { const float v = (ai * a1[tt][i] + a2[tt][i]) * idn; a1[tt][i] = v; p += v * v; }
                p += __shfl_xor(p, 32); if (hh == 0) ssq[wave * 64 + t] = p; }
            __syncthreads();
#pragma unroll
            for (int tt = 0; tt < 2; ++tt) { const int t = tt * 32 + r32; float sq = 0.f;
#pragma unroll
                for (int w2 = 0; w2 < 8; ++w2) sq += ssq[w2 * 64 + t];
                const float r = rsqrtf(sq * (1.f / 256.f) + EPS);
#pragma unroll
                for (int rq = 0; rq < 4; ++rq) { const int dv0 = h * 256 + wave * 32 + 8 * rq + 4 * hh; const f32x4 g = *(const f32x4*)(mlg + dv0); const u32x2 ob = *(const u32x2*)(MO + (size_t)(t0 + t) * 1024 + dv0);
                    const float o0 = bf2f(ob.x & 0xffffu), o1 = bf2f(ob.x >> 16), o2 = bf2f(ob.y & 0xffffu), o3 = bf2f(ob.y >> 16);
                    u32x2 w; w.x = pk2(a1[tt][4 * rq] * r * g[0] / (1.f + __expf(-o0)), a1[tt][4 * rq + 1] * r * g[1] / (1.f + __expf(-o1))); w.y = pk2(a1[tt][4 * rq + 2] * r * g[2] / (1.f + __expf(-o2)), a1[tt][4 * rq + 3] * r * g[3] / (1.f + __expf(-o3)));
                    *(u32x2*)(MIXIN + (size_t)(t0 + t) * KMIX + 2048 + dv0) = w; } }
        }
        GRID_BAR(4);
    }

    if (IN(6)) for (int rep_ = 0; rep_ < NREP(6); ++rep_) {
        PHASE_IDS
        if (rep_) xcd_barrier(bar, tid);
        pg8::DenseOrder S; S.init(T, D, KMIX, KMIX, G, bx);
        pg8::EpiResidT<false> E{A_->in[I_X], X1B, SS2};
        pg8::gemm_phase(tid, lds, MIXIN, WOUT_T, KMIX, S, E);
        GRID_BAR(6);
    }
    if (IN(7)) for (int rep_ = 0; rep_ < NREP(7); ++rep_) {
        PHASE_IDS
        if (rep_) xcd_barrier(bar, tid);
        pg8::DenseOrder S; S.init(T, 1024, D, D, G, bx);
        pg8::EpiSoftmax E{PB, SS2};
        pg8::gemm_phase(tid, lds, X1B, MF, D, S, E);
        GRID_BAR(7);
    }
    if (IN(10)) for (int rep_ = 0; rep_ < NREP(10); ++rep_) {
        PHASE_IDS
        if (rep_) xcd_barrier(bar, tid);
        pg8::DenseOrder S; S.init(T, D, 1024, 1024, G, bx);
        pg8::EpiResidT<true> E{X1B, X2B, nullptr};
        pg8::gemm_phase(tid, lds, PB, VF, 1024, S, E);
        GRID_BAR(10);
    }
    if (IN(11)) for (int rep_ = 0; rep_ < NREP(11); ++rep_) {
        PHASE_IDS
        if (rep_) xcd_barrier(bar, tid);
        LAS float* part = (LAS float*)lds;
        LAS float* ssp = (LAS float*)(lds + 24576);
        LAS int* eb = (LAS int*)(lds + 24576 + 512);
        const int r16 = lane & 15, g4 = lane >> 4;
        for (int uu = bx; uu < T / 32; uu += G) {
            const int t0 = uu * 32; const int tt = wave & 1, ksl = wave >> 1;
            __syncthreads();
            {
                f32x4 acc[3];
#pragma unroll
                for (int i = 0; i < 3; ++i) acc[i] = (f32x4){0.f, 0.f, 0.f, 0.f};
                float ssq = 0.f;
                const bf16* xr = X2B + (size_t)(t0 + tt * 16 + r16) * D + ksl * 512 + 8 * g4;
                const bf16* wh = WRH + (size_t)r16 * D + ksl * 512 + 8 * g4; const bf16* wl = WRL + (size_t)r16 * D + ksl * 512 + 8 * g4;
#pragma unroll 4
                for (int ks = 0; ks < 16; ++ks) { const u32x4 xa = *(const u32x4*)(xr + ks * 32);
                    { const float f0 = bf2f(xa.x & 0xffffu), f1 = bf2f(xa.x >> 16), f2 = bf2f(xa.y & 0xffffu), f3 = bf2f(xa.y >> 16), f4 = bf2f(xa.z & 0xffffu), f5 = bf2f(xa.z >> 16), f6 = bf2f(xa.w & 0xffffu), f7 = bf2f(xa.w >> 16);
                      ssq += ((f0 * f0 + f1 * f1) + (f2 * f2 + f3 * f3)) + ((f4 * f4 + f5 * f5) + (f6 * f6 + f7 * f7)); }
                    const bf16x8 Ah = __builtin_bit_cast(bf16x8, xa);
#pragma unroll
                    for (int nt = 0; nt < 3; ++nt) { const bf16x8 Bh = *(const bf16x8*)(wh + (size_t)nt * 16 * D + ks * 32), Bl = *(const bf16x8*)(wl + (size_t)nt * 16 * D + ks * 32);
                        acc[nt] = __builtin_amdgcn_mfma_f32_16x16x32_bf16(Ah, Bh, acc[nt], 0, 0, 0); acc[nt] = __builtin_amdgcn_mfma_f32_16x16x32_bf16(Ah, Bl, acc[nt], 0, 0, 0); } }
#pragma unroll
                for (int nt = 0; nt < 3; ++nt)
#pragma unroll
                    for (int i = 0; i < 4; ++i) part[(ksl * 32 + tt * 16 + 4 * g4 + i) * 48 + nt * 16 + r16] = acc[nt][i];
                ssq += __shfl_xor(ssq, 16); ssq += __shfl_xor(ssq, 32);
                if (g4 == 0) ssp[ksl * 32 + tt * 16 + r16] = ssq;
            }
            __syncthreads();
            int e1 = 0, e2 = 0;
            if (tid < 32) { const int t = t0 + tid; const float rstd = rsqrtf((ssp[tid] + ssp[32 + tid] + ssp[64 + tid] + ssp[96 + tid]) * (1.f / D) + EPS);
                const LAS float* p0 = part + tid * 48;
#define LG(o) ((p0[(o)] + p0[32 * 48 + (o)] + p0[64 * 48 + (o)] + p0[96 * 48 + (o)]) * rstd)
                int gs = 0; float gmax = LG(0) + A_->in[I_B_GROUP][0]; float gv[4]; gv[0] = gmax;
#pragma unroll
                for (int i = 1; i < 4; ++i) { gv[i] = LG(i) + A_->in[I_B_GROUP][i]; if (gv[i] > gmax) { gmax = gv[i]; gs = i; } }
                float gsum = 0.f;
#pragma unroll
                for (int i = 0; i < 4; ++i) gsum += __expf(gv[i] - gmax);
                const float pg = 1.f / gsum;
                int i1 = 0, i2 = 0; float v1 = -3.0e38f, v2 = -3.0e38f;
#pragma unroll 1
                for (int i = 0; i < 8; ++i) { const float ev = LG(4 + gs * 8 + i) + A_->in[I_B_ROUTER][gs * 8 + i];
                    if (ev > v1) { v2 = v1; i2 = i1; v1 = ev; i1 = i; } else if (ev > v2) { v2 = ev; i2 = i; } }
#undef LG
                const float p2 = __expf(v2 - v1); const float g1 = pg / (1.f + p2), g2 = pg * p2 / (1.f + p2);
                e1 = gs * 8 + i1; e2 = gs * 8 + i2;
                eb[2 * tid] = e1; eb[2 * tid + 1] = e2;
                TOKW[2 * t] = g1; TOKW[2 * t + 1] = g2; RSTD3[t] = rstd; }
            __syncthreads();
            LAS int* ebase = eb + 64;
            if (tid >= 64 && tid < 96) { const int e = tid - 64; int c = 0;
#pragma unroll 1
                for (int a2 = 0; a2 < 64; ++a2) c += (eb[a2] == e) ? 1 : 0;
                ebase[e] = c ? atomicAdd(CNT + e, c) : 0; }
            __syncthreads();
            if (tid < 64) { const int e = eb[tid]; int rk = 0;
#pragma unroll 1
                for (int a2 = 0; a2 < tid; ++a2) rk += (eb[a2] == e) ? 1 : 0;
                const int slot = ebase[e] + rk; LIST[e * T + slot] = t0 + (tid >> 1); TOKE[2 * t0 + tid] = e * T + slot; }
        }
        GRID_BAR(11);
    }
    volatile LAS int* cnl = (volatile LAS int*)(MISC + 64); volatile LAS int* prel = (volatile LAS int*)(MISC + 128); volatile LAS int* tbl = (volatile LAS int*)(MISC + 192);
    volatile LAS int* mtl = (volatile LAS int*)(MISC + 256); volatile LAS int* tlr = (volatile LAS int*)(MISC + 288); volatile LAS int* tpre = (volatile LAS int*)(MISC + 320); volatile LAS int* fll = (volatile LAS int*)(MISC + 384);
    constexpr int MOE_TAIL = 96;
#define MOE_TABLES(ncol) do { __syncthreads(); if (tid < 64) { const int e = tid & 31; const int c = __hip_atomic_load(CNT + e, __ATOMIC_RELAXED, __HIP_MEMORY_SCOPE_AGENT);     \
        const int full = c >> 8, mt = (c + 255) >> 8; int p = mt * (ncol), tb = mt; \
        _Pragma("unroll") for (int d_ = 1; d_ < 32; d_ <<= 1) { const int q_ = __shfl_up(p, d_), r_ = __shfl_up(tb, d_); if (e >= d_) { p += q_; tb += r_; } } \
        if (tid < 32) { cnl[e] = c; prel[e] = p - mt * (ncol); tbl[e] = tb - mt; mtl[e] = mt; tlr[e] = 0; tpre[e] = 0; fll[e] = full; if (e == 31) { prel[32] = p; tbl[32] = tb; tpre[32] = 0; } } } __syncthreads(); } while (0)
#define MOE_GU(Lb, Le, nbk, cc) do { pg8::MoeOrder S{tbl, cnl, LIST, 4, (Lb), (Le), (nbk), (cc), (unsigned)D * 2u, (size_t)1024 * D * 2, (unsigned)D * 2u, 1}; \
        pg8::EpiSwiGLU E{ACT, LIST, RSTD3, cnl}; pg8::gemm_phase(tid, lds, X2B, WGU_T, D, S, E); } while (0)
#define MOE_DN(Lb, Le, nbk, cc) do { pg8::MoeOrder S{tbl, cnl, LIST, 8, (Lb), (Le), (nbk), (cc), (unsigned)DEXP * 2u, (size_t)D * DEXP * 2, (unsigned)DEXP * 2u, 0}; \
        pg8::EpiBf16 E{Y, D}; pg8::gemm_phase(tid, lds, ACT, WDN_T, DEXP, S, E); } while (0)
    if (IN(13)) for (int rep_ = 0; rep_ < NREP(13); ++rep_) {
        PHASE_IDS
        if (rep_) xcd_barrier(bar, tid);
        MOE_TABLES(4);
        const int U1 = tbl[32] * 4;
        MOE_GU(0, U1 < G ? U1 : G, G, bx);
        GRID_BAR(13);
    }
    if (IN(14)) for (int rep_ = 0; rep_ < NREP(14); ++rep_) {
        PHASE_IDS
        if (rep_) xcd_barrier(bar, tid);
        MOE_TABLES(4);
        const int RT = tbl[32], U1 = RT * 4; const int nb0 = U1 > G ? ((U1 - G) < G ? (U1 - G) : G) : 0; const int rta = (U1 < G ? U1 : G) >> 2;
        if (bx < nb0) MOE_GU(G, U1, nb0, bx);
        else MOE_DN(0, rta * 8, G - nb0, bx - nb0);
        GRID_BAR(14);
    }
    if (IN(15)) for (int rep_ = 0; rep_ < NREP(15); ++rep_) {
        PHASE_IDS
        if (rep_) xcd_barrier(bar, tid);
        MOE_TABLES(8);
        const int RT = tbl[32], U1 = RT * 4; const int rta = (U1 < G ? U1 : G) >> 2;
        MOE_DN(rta * 8, RT * 8, G, bx);
        GRID_BAR(15);
    }
    if (IN(16)) for (int rep_ = 0; rep_ < NREP(16); ++rep_) {
        PHASE_IDS
        if (rep_) xcd_barrier(bar, tid);
        MOE_TABLES(1);
        const float* fg = A_->in[I_FINAL_G];
        int a0n = 0, a1n = 0; float w0n = 0.f, w1n = 0.f;
        if (gw < T) { a0n = TOKE[2 * gw]; a1n = TOKE[2 * gw + 1]; w0n = TOKW[2 * gw]; w1n = TOKW[2 * gw + 1]; }
#pragma unroll 1
        for (int t = gw; t < T; t += NGW) {
            const int a0 = a0n, a1 = a1n; const float w0 = w0n, w1 = w1n;
            { const int tn = t + NGW; if (tn < T) { a0n = TOKE[2 * tn]; a1n = TOKE[2 * tn + 1]; w0n = TOKW[2 * tn]; w1n = TOKW[2 * tn + 1]; } }
            const size_t r0 = (size_t)tbl[a0 / T] * 256 + (a0 % T), r1 = (size_t)tbl[a1 / T] * 256 + (a1 % T);
            const u32x2* xr = (const u32x2*)(X2B + (size_t)t * D) + lane; f32x4* xo = (rep_ == NREP(16) - 1) ? (f32x4*)(A_->out + (size_t)t * D) + lane : (f32x4*)((float*)(ws + WS_X1B) + (size_t)t * D) + lane; const u32x2* y0 = (const u32x2*)(Y + r0 * D) + lane; const u32x2* y1 = (const u32x2*)(Y + r1 * D) + lane;
            f32x4 v[8]; float s = 0.f;
#pragma unroll
            for (int j = 0; j < 8; ++j) { const u32x2 xq = xr[64 * j]; v[j] = (f32x4){bf2f(xq.x & 0xffffu), bf2f(xq.x >> 16), bf2f(xq.y & 0xffffu), bf2f(xq.y >> 16)}; const u32x2 p = y0[64 * j], q = y1[64 * j];
                v[j][0] += w0 * bf2f(p.x & 0xffffu) + w1 * bf2f(q.x & 0xffffu); v[j][1] += w0 * bf2f(p.x >> 16) + w1 * bf2f(q.x >> 16);
                v[j][2] += w0 * bf2f(p.y & 0xffffu) + w1 * bf2f(q.y & 0xffffu); v[j][3] += w0 * bf2f(p.y >> 16) + w1 * bf2f(q.y >> 16);
                s += (v[j][0] * v[j][0] + v[j][1] * v[j][1]) + (v[j][2] * v[j][2] + v[j][3] * v[j][3]); }
            const float r = rsqrtf(wave_sum(s) * (1.f / D) + EPS);
#pragma unroll
            for (int j = 0; j < 8; ++j) { const f32x4 g = ((const f32x4*)fg)[lane + 64 * j]; xo[64 * j] = (f32x4){v[j][0] * r * g[0], v[j][1] * r * g[1], v[j][2] * r * g[2], v[j][3] * r * g[3]}; }
        }
    }
#undef IN
#undef BOTH
#undef GRID_BAR
}

extern "C" void kernel_launch(void* const* d_in, const int* in_sizes, int n_in, void* d_out, int out_size, void* d_ws, size_t ws_size, hipStream_t stream) {
    static int grid = 0;
    if (grid == 0) {
        if (n_in != 27 || out_size != T * D || ws_size < WS_END) { fprintf(stderr, "kernel_launch: unexpected problem (n_in %d out %d ws %zu)\n", n_in, out_size, ws_size); grid = -1; return; }
        int dev = 0, cus = 0, per_cu = 0;
        if (hipGetDevice(&dev) != hipSuccess || hipDeviceGetAttribute(&cus, hipDeviceAttributeMultiprocessorCount, dev) != hipSuccess) { grid = -1; return; }
        if (hipFuncSetAttribute((const void*)mega, hipFuncAttributeMaxDynamicSharedMemorySize, LDS_BYTES) != hipSuccess) { fprintf(stderr, "kernel_launch: hipFuncSetAttribute failed\n"); grid = -1; return; }
        if (hipOccupancyMaxActiveBlocksPerMultiprocessor(&per_cu, (const void*)mega, 512, LDS_BYTES) != hipSuccess || per_cu < 1) fprintf(stderr, "kernel_launch: occupancy query reports %d\n", per_cu);
        (void)hipGetLastError();
        grid = cus;
    }
    if (grid < 0) return;
    if (hipMemsetAsync((char*)d_ws + WS_CTL, 0, CTL_ZERO_BYTES, stream) != hipSuccess) return;
    Args a{};
    for (int i = 0; i < 27; ++i) a.in[i] = (const float*)d_in[i];
    a.out = (float*)d_out; a.ws = (unsigned char*)d_ws;
    if (MK_N_LAUNCHES == 1) { a.ph_lo = 0; a.ph_hi = NPHASE; hipLaunchKernelGGL(mega, dim3(grid), dim3(512), LDS_BYTES, stream, a); }
    else { for (int p = 0; p < NPHASE; ++p) { a.ph_lo = p; a.ph_hi = p + 1; hipLaunchKernelGGL(mega, dim3(grid), dim3(512), LDS_BYTES, stream, a); } }
}
```

```cpp
#include <hip/hip_runtime.h>
#include <cstdio>
#include <cstdint>

#ifndef MK_N_LAUNCHES
#define MK_N_LAUNCHES 1
#endif

#define GAS __attribute__((address_space(1)))
#define LAS __attribute__((address_space(3)))
typedef unsigned short bf16;
typedef short bf16x8 __attribute__((ext_vector_type(8)));
typedef float f32x4 __attribute__((ext_vector_type(4)));
typedef float f32x2 __attribute__((ext_vector_type(2)));
typedef float f32x16 __attribute__((ext_vector_type(16)));
typedef unsigned u32x4 __attribute__((ext_vector_type(4)));
typedef unsigned u32x2 __attribute__((ext_vector_type(2)));

constexpr int T = 8192, D = 2048, NMEM = 256;
constexpr int D_IN = 4944;
constexpr int NPROJ = 6144;
constexpr int KMIX = 3072;
constexpr int NCH = 128, CH = 64;
constexpr int NEXP = 32, DEXP = 512;
constexpr float EPS = 1e-6f;
constexpr int NPHASE = 17;

constexpr size_t MiB = 1u << 20;
constexpr size_t WS_CTL = 0, CTL_ZERO_BYTES = 256 * 1024;
constexpr size_t WS_WOUT_T = 1 * MiB;
constexpr size_t WS_WCQ_T = 13 * MiB;
constexpr size_t WS_WCKV_T = 21 * MiB;
constexpr size_t WS_WCO_T = 37 * MiB;
constexpr size_t WS_WGU_T = 45 * MiB;
constexpr size_t WS_WDN_T = 173 * MiB;
constexpr size_t WS_WIN_T = 237 * MiB;
constexpr size_t WS_H1 = 261 * MiB;
constexpr size_t WS_MIXIN = 237 * MiB;
constexpr size_t WS_SC127 = 285 * MiB;
constexpr size_t WS_MEMN = 293 * MiB;
constexpr size_t WS_KC = 294 * MiB;
constexpr size_t WS_VT = 295 * MiB;
constexpr size_t WS_GATES = 296 * MiB;
constexpr size_t WS_WR = 297 * MiB;
constexpr size_t WS_QABS = 298 * MiB;
constexpr size_t WS_CKVRAW = 330 * MiB;
constexpr size_t WS_QI = 338 * MiB;
constexpr size_t WS_SMALL = 346 * MiB;
constexpr size_t WS_MQKRAW = 354 * MiB;
constexpr size_t WS_MV = 386 * MiB;
constexpr size_t WS_MO = 402 * MiB;
constexpr size_t WS_CKVN = 418 * MiB;
constexpr size_t WS_KIDXN = 422 * MiB;
constexpr size_t WS_QCM = 423 * MiB;
constexpr size_t WS_KCM = 431 * MiB;
constexpr size_t WS_LST = 439 * MiB;
constexpr size_t WS_NL = 503 * MiB;
constexpr size_t WS_CST = 504 * MiB;
constexpr size_t WS_VTM = 536 * MiB;
constexpr size_t WS_X1B = 298 * MiB;
constexpr size_t WS_QC = 330 * MiB;
constexpr size_t WS_OC = 362 * MiB;
constexpr size_t WS_X2B = 394 * MiB;
constexpr size_t WS_LIST = 426 * MiB;
constexpr size_t WS_TOK = 427 * MiB;
constexpr size_t WS_ACT = 428 * MiB;
constexpr size_t WS_Y = 452 * MiB;
constexpr size_t WS_END = 552 * MiB;
constexpr int GT_B = 0;
constexpr int GT_LI = T * 4;
constexpr int GT_G = 2 * T * 4;
constexpr int GT_MLOC = GT_G + 512;
constexpr int GT_MPREV = GT_MLOC + 512;
constexpr int CW_BAR = 4096;
constexpr int CW_CNT = 8192;
constexpr int CW_SS2 = 16384;
static_assert((CW_SS2 + T) * 4 <= (int)CTL_ZERO_BYTES, "ctl");

constexpr int RING_BYTES = 131072;
constexpr int MISC_OFF = RING_BYTES;
constexpr int LDS_BYTES = 159744;

__device__ __forceinline__ float bf2f(unsigned b) { return __uint_as_float(b << 16); }
__device__ __forceinline__ unsigned f2bf(float f) { unsigned u = __float_as_uint(f); return (u + 0x7fffu + ((u >> 16) & 1u)) >> 16; }
__device__ __forceinline__ unsigned pk2(float lo, float hi) { return f2bf(lo) | (f2bf(hi) << 16); }
__device__ __forceinline__ float wave_sum(float v) {
#pragma unroll
    for (int o = 1; o < 64; o <<= 1) v += __shfl_xor(v, o);
    return v;
}
__device__ __forceinline__ float wave_max(float v) {
#pragma unroll
    for (int o = 1; o < 64; o <<= 1) v = fmaxf(v, __shfl_xor(v, o));
    return v;
}
#define LDS_WAIT() asm volatile("s_waitcnt lgkmcnt(0)" ::: "memory")

#define XB_TMO      128
#define XB_XCNT(j)  (256  + 64 * (j))
#define XB_XSUB(j)  (1280 + 64 * (j))
#define XB_XGEN(j)  (2304 + 64 * (j))
#define XB_TOP      3328
#define XB_TOPGEN   3392
#define XCD_BAR_WORDS 3456
#define XB_SPIN_CAP (1u << 18)
__device__ __forceinline__ unsigned xb_ld(unsigned* p)              { return __hip_atomic_load(p, __ATOMIC_RELAXED, __HIP_MEMORY_SCOPE_AGENT); }
__device__ __forceinline__ unsigned xb_add(unsigned* p, unsigned v) { return __hip_atomic_fetch_add(p, v, __ATOMIC_RELAXED, __HIP_MEMORY_SCOPE_AGENT); }
__device__ __forceinline__ unsigned xb_xcc_id() { return (unsigned)__builtin_amdgcn_s_getreg((3 << 11) | 20) & 0xFu; }
#define XB_SPIN(cond, bar) do { unsigned _sp = 0; while (cond) { __builtin_amdgcn_s_sleep(1); \
    if ((++_sp & 255u) == 0u) { if (xb_ld(&(bar)[XB_TMO])) break; if (_sp > XB_SPIN_CAP) { atomicAdd(&(bar)[XB_TMO], 1u); break; } } } } while (0)
struct XcdBarrier { unsigned* bar; unsigned x; volatile LAS unsigned* st; };
__device__ __forceinline__ XcdBarrier xcd_barrier_post(unsigned* bar, volatile LAS unsigned* st) {
    XcdBarrier b; b.bar = bar; b.x = xb_xcc_id(); b.st = st;
    if (threadIdx.x == 0) (void)xb_add(&bar[XB_XCNT(b.x)], 1u);
    return b;
}
__device__ __forceinline__ void xcd_barrier_complete(unsigned* bar, unsigned x, unsigned& nloc, unsigned& nx) {
    const unsigned G = gridDim.x * gridDim.y * gridDim.z;
    unsigned sum, cnt, mine, sp = 0u;
    for (;;) {
        sum = 0u; cnt = 0u; mine = 0u;
#pragma unroll
        for (unsigned j = 0; j < 16; ++j) { const unsigned c = xb_ld(&bar[XB_XCNT(j)]); sum += c; cnt += (c > 0u) ? 1u : 0u; mine = (j == x) ? c : mine; }
        if (sum == G) break;
        __builtin_amdgcn_s_sleep(1);
        if ((++sp & 255u) == 0u) { if (xb_ld(&bar[XB_TMO])) break; if (sp > XB_SPIN_CAP) { atomicAdd(&bar[XB_TMO], 1u); break; } }
    }
    nloc = mine > 0u ? mine : 1u; nx = cnt > 0u ? cnt : 1u;
}
__device__ __forceinline__ void xcd_barrier(const XcdBarrier& b, const int tid_) {
    asm volatile("s_waitcnt vmcnt(0)" ::: "memory");
    __syncthreads();
    if (tid_ == 0) {
        unsigned* bar = b.bar;
        __builtin_amdgcn_s_waitcnt(0);
        unsigned nloc = b.st[0], nx = b.st[1];
        if (nloc == 0u) { xcd_barrier_complete(bar, b.x, nloc, nx); b.st[0] = nloc; b.st[1] = nx; }
        const unsigned old = xb_add(&bar[XB_XSUB(b.x)], 1u);
        const unsigned gen = old / nloc;
        if (old + 1u == (gen + 1u) * nloc) {
            __builtin_amdgcn_fence(__ATOMIC_RELEASE, "agent");
            asm volatile("s_waitcnt vmcnt(0)" ::: "memory");
            const unsigned og = xb_add(&bar[XB_TOP], 1u);
            const unsigned tg = og / nx;
            if (og + 1u == (tg + 1u) * nx) xb_add(&bar[XB_TOPGEN], 1u);
            else XB_SPIN(xb_ld(&bar[XB_TOPGEN]) == tg, bar);
            __builtin_amdgcn_fence(__ATOMIC_ACQUIRE, "agent");
            xb_add(&bar[XB_XGEN(b.x)], 1u);
            asm volatile("s_waitcnt vmcnt(0)" ::: "memory");
        } else {
            XB_SPIN(xb_ld(&bar[XB_XGEN(b.x)]) == gen, bar);
            __builtin_amdgcn_fence(__ATOMIC_ACQUIRE, "agent");
            asm volatile("s_waitcnt vmcnt(0)" ::: "memory");
        }
    }
    __syncthreads();
}

namespace pg8 {
constexpr int BM = 256, BK = 64, HALF = 128, HTB = HALF * BK * 2, STAGE_BYTES = 8 * HTB, NXCD = 8, WGM = 8;
__host__ __device__ __forceinline__ int lds_byte(int r, int c) { const int st = (r >> 4) * 2 + (c >> 5), rr = r & 15, cc = c & 31, ob = rr * 64 + cc * 2; return st * 1024 + (ob ^ (((ob >> 9) & 1) << 5)); }
__host__ __device__ __forceinline__ void stage_rc(int b, int& R, int& C) { const int st = b / 1024, sb = b % 1024, swz = sb ^ (((sb >> 9) & 1) << 5); R = (st >> 1) * 16 + swz / 64; C = (st & 1) * 32 + (swz % 64) / 2; }

struct Unit { int pm, pn, e, rt; };

struct DenseOrder {
    static constexpr bool GATHER = false;
    int nM, nN, nwg, G, c; unsigned lda_bytes; unsigned kb;
    __device__ void init(int M, int N, int K, int lda, int G_, int c_) { nM = M / BM; nN = N / BM; nwg = nM * nN; G = G_; c = c_; lda_bytes = (unsigned)lda * 2u; kb = (unsigned)K * 2u; }
    __device__ bool next(int i, Unit& u) const {
        if (c < 0) return false;
        const long L = (long)i * G + c; if (L >= nwg) return false;
        int wgid = (int)L; { const int q = nwg / NXCD, r = nwg % NXCD, xcd = wgid % NXCD, off = wgid / NXCD; wgid = (xcd < r ? xcd * (q + 1) : r * (q + 1) + (xcd - r) * q) + off; }
        const int nig = WGM * nN, gid = wgid / nig, fm = gid * WGM, gsz = (nM - fm) < WGM ? (nM - fm) : WGM;
        u.pm = fm + ((wgid % nig) % gsz); u.pn = (wgid % nig) / gsz; u.e = 0; u.rt = 0; return true;
    }
    __device__ __forceinline__ unsigned a_row(const Unit& u, int r) const { return (unsigned)(u.pm * BM + r) * lda_bytes; }
    __device__ __forceinline__ size_t b_off(const Unit& u) const { return (size_t)u.pn * BM * kb; }
};

#define PG8_SA(b, h) (((b) * 2 + (h)) * HTB)
#define PG8_SB(b, h) ((4 + (b) * 2 + (h)) * HTB)
#define PG8_STAGEB(bufoff, gbase) do { _Pragma("unroll") for (int _i = 0; _i < 2; ++_i) \
        __builtin_amdgcn_global_load_lds((const unsigned*)((const char*)(gbase) + voffB[_i]), (LAS unsigned*)(lds + (bufoff) + ldsw + _i * 8192), 16, 0, 0); } while (0)
#define PG8_GLDS(src, dstoff) __builtin_amdgcn_global_load_lds((const unsigned*)(src), (LAS unsigned*)(lds + (dstoff)), 16, 0, 0)
#define PG8_STAGEA(bufoff, kbyte, h, NXT) do { if constexpr (Sched::GATHER) { const unsigned _o0 = (NXT) ? ((h) ? n10 : n00) : ((h) ? c10 : c00), _o1 = (NXT) ? ((h) ? n11 : n01) : ((h) ? c11 : c01); \
            PG8_GLDS(Ab + (kbyte) + _o0, (bufoff) + ldsw); PG8_GLDS(Ab + (kbyte) + _o1, (bufoff) + ldsw + 8192); } \
        else { const char* _b = ((NXT) ? nA : cA) + (kbyte) + ((h) ? hstepA : (size_t)0); PG8_GLDS(_b + voffA[0], (bufoff) + ldsw); PG8_GLDS(_b + voffA[1], (bufoff) + ldsw + 8192); } } while (0)
#define PG8_LDA(dst, b, h) do { _Pragma("unroll") for (int m = 0; m < 4; ++m) _Pragma("unroll") for (int k = 0; k < 2; ++k) dst[m][k] = *(const LAS bf16x8*)(lds + PG8_SA(b, h) + aoff + m * 2048 + k * 1024); } while (0)
#define PG8_LDB(dst, b, h) do { _Pragma("unroll") for (int n = 0; n < 2; ++n) _Pragma("unroll") for (int k = 0; k < 2; ++k) dst[n][k] = *(const LAS bf16x8*)(lds + PG8_SB(b, h) + boff + n * 2048 + k * 1024); } while (0)
#define PG8_MMA(ai, bj, At, Bt) do { __builtin_amdgcn_s_setprio(1); _Pragma("unroll") for (int m = 0; m < 4; ++m) _Pragma("unroll") for (int n = 0; n < 2; ++n) _Pragma("unroll") for (int k = 0; k < 2; ++k) \
        acc[ai][bj][m][n] = __builtin_amdgcn_mfma_f32_16x16x32_bf16(Bt[n][k], At[m][k], acc[ai][bj][m][n], 0, 0, 0); __builtin_amdgcn_s_setprio(0); } while (0)
#define PG8_WAIT_V(n) asm volatile("s_waitcnt vmcnt(" #n ")" ::: "memory")
#define PG8_WAIT_L(n) asm volatile("s_waitcnt lgkmcnt(" #n ")" ::: "memory")
#define PG8_BAR __builtin_amdgcn_s_barrier()
#define PG8_SCHED __builtin_amdgcn_sched_barrier(0)

template <class Epi, class Sched>
__device__ __forceinline__ void gemm_phase(const int tid_in, LAS unsigned char* lds, const bf16* A, const bf16* Bt, const int K, const Sched& S, const Epi& E) {
    int tid = tid_in; asm volatile("" : "+v"(tid));
    const int wid = __builtin_amdgcn_readfirstlane(tid >> 6), lane = tid & 63, wr = wid >> 2, wc = wid & 3, fr = lane & 15, fq = lane >> 4;
    int Kop_ = K; asm volatile("" : "+s"(Kop_));
    const int nt = Kop_ / BK;
    int sR[2], sC2[2]; unsigned voffB[2];
#pragma unroll
    for (int i = 0; i < 2; ++i) { int R, C; stage_rc(tid * 16 + i * 8192, R, C); sR[i] = R; sC2[i] = C * 2; voffB[i] = (unsigned)R * S.kb + (unsigned)C * 2u; }
    const unsigned kstep = (unsigned)(BK * 2);
    const size_t hstepB = (size_t)HALF * S.kb;
    const unsigned ldsw = (unsigned)wid * 1024u;
    const int aoff = lds_byte(wr * 64 + fr, fq * 8), boff = lds_byte(wc * 32 + fr, fq * 8);
    Unit cur, nxt; int ui = 0;
    if (!S.next(0, cur)) return;
    f32x4 acc[2][2][4][2];
#pragma unroll
    for (int a = 0; a < 2; ++a)
#pragma unroll
        for (int b = 0; b < 2; ++b)
#pragma unroll
            for (int m = 0; m < 4; ++m)
#pragma unroll
                for (int n = 0; n < 2; ++n) acc[a][b][m][n] = (f32x4){0.f, 0.f, 0.f, 0.f};
    bf16x8 At[4][2], B0[2][2], B1[2][2];
    const char* Ab = (const char*)A;
    unsigned c00 = 0, c01 = 0, c10 = 0, c11 = 0, n00 = 0, n01 = 0, n10 = 0, n11 = 0; unsigned voffA[2] = {0u, 0u}; const char* cA = Ab; const char* nA = Ab; size_t hstepA = 0;
    if constexpr (Sched::GATHER) { c00 = S.a_row(cur, sR[0]) + sC2[0]; c01 = S.a_row(cur, sR[1]) + sC2[1]; c10 = S.a_row(cur, 128 + sR[0]) + sC2[0]; c11 = S.a_row(cur, 128 + sR[1]) + sC2[1]; }
    else { voffA[0] = (unsigned)sR[0] * S.lda_bytes + sC2[0]; voffA[1] = (unsigned)sR[1] * S.lda_bytes + sC2[1]; hstepA = (size_t)HALF * S.lda_bytes; cA = Ab + (size_t)S.a_row(cur, 0); }
    const char* cB = (const char*)Bt + S.b_off(cur);
    PG8_STAGEB(PG8_SB(0, 0), cB); PG8_STAGEA(PG8_SA(0, 0), 0u, 0, false); PG8_STAGEB(PG8_SB(0, 1), cB + hstepB); PG8_STAGEA(PG8_SA(0, 1), 0u, 1, false);
    if (wr == 1) PG8_BAR;
    PG8_WAIT_V(4); PG8_BAR;
    PG8_STAGEB(PG8_SB(1, 0), cB + kstep); PG8_STAGEA(PG8_SA(1, 0), kstep, 0, false); PG8_STAGEB(PG8_SB(1, 1), cB + hstepB + kstep);
    PG8_WAIT_V(6); PG8_BAR;
    for (;;) {
        const bool has_next = S.next(ui + 1, nxt);
        const char* nB = cB;
        if constexpr (Sched::GATHER) { n00 = c00; n01 = c01; n10 = c10; n11 = c11; } else nA = cA;
        if (has_next) { nB = (const char*)Bt + S.b_off(nxt);
            if constexpr (Sched::GATHER) { n00 = S.a_row(nxt, sR[0]) + sC2[0]; n01 = S.a_row(nxt, sR[1]) + sC2[1]; n10 = S.a_row(nxt, 128 + sR[0]) + sC2[0]; n11 = S.a_row(nxt, 128 + sR[1]) + sC2[1]; }
            else nA = Ab + (size_t)S.a_row(nxt, 0); }
        for (int t = 0; t < nt; t += 2) {
            const bool last = (t == nt - 2);
            const unsigned k1 = (unsigned)(t + 1) * kstep;
            const unsigned k2 = last ? 0u : (unsigned)(t + 2) * kstep, k3 = k2 + kstep;
            const char* b2 = last ? nB : cB + (size_t)(t + 2) * kstep; const char* b3 = b2 + kstep;
            PG8_LDB(B0, 0, 0); PG8_SCHED; PG8_LDA(At, 0, 0); PG8_STAGEA(PG8_SA(1, 1), k1, 1, false);
            PG8_WAIT_L(8); PG8_BAR; PG8_WAIT_L(0); PG8_MMA(0, 0, At, B0); PG8_BAR; PG8_SCHED;
            PG8_LDB(B1, 0, 1); PG8_STAGEB(PG8_SB(0, 0), b2);
            PG8_BAR; PG8_WAIT_L(0); PG8_MMA(0, 1, At, B1); PG8_BAR;
            PG8_LDA(At, 0, 1); PG8_STAGEA(PG8_SA(0, 0), k2, 0, last);
            PG8_BAR; PG8_WAIT_L(0); PG8_MMA(1, 0, At, B0); PG8_BAR; PG8_SCHED;
            PG8_STAGEB(PG8_SB(0, 1), b2 + hstepB);
            PG8_WAIT_V(6); PG8_BAR; PG8_MMA(1, 1, At, B1); PG8_BAR;
            PG8_LDB(B0, 1, 0); PG8_SCHED; PG8_LDA(At, 1, 0); PG8_STAGEA(PG8_SA(0, 1), k2, 1, last);
            PG8_WAIT_L(8); PG8_BAR; PG8_WAIT_L(0); PG8_MMA(0, 0, At, B0); PG8_BAR; PG8_SCHED;
            PG8_LDB(B1, 1, 1); PG8_STAGEB(PG8_SB(1, 0), b3);
            PG8_BAR; PG8_WAIT_L(0); PG8_MMA(0, 1, At, B1); PG8_BAR;
            PG8_LDA(At, 1, 1); PG8_STAGEA(PG8_SA(1, 0), k3, 0, last);
            PG8_BAR; PG8_WAIT_L(0); PG8_MMA(1, 0, At, B0); PG8_BAR; PG8_SCHED;
            PG8_STAGEB(PG8_SB(1, 1), b3 + hstepB);
            PG8_WAIT_V(6); PG8_BAR; PG8_MMA(1, 1, At, B1); PG8_BAR;
        }
        if constexpr (!Epi::AFTER_DRAIN) E(acc, cur, wr, wc, fr, fq);
        if (!has_next) break;
#pragma unroll
        for (int a = 0; a < 2; ++a)
#pragma unroll
            for (int b = 0; b < 2; ++b)
#pragma unroll
                for (int m = 0; m < 4; ++m)
#pragma unroll
                    for (int n = 0; n < 2; ++n) acc[a][b][m][n] = (f32x4){0.f, 0.f, 0.f, 0.f};
        cur = nxt; if constexpr (Sched::GATHER) { c00 = n00; c01 = n01; c10 = n10; c11 = n11; } else cA = nA; cB = nB; ++ui;
    }
    PG8_WAIT_V(0);
    if (wr == 0) PG8_BAR;
    PG8_BAR;
    if constexpr (Epi::AFTER_DRAIN) E.fused(acc, cur, wr, wc, fr, fq, lds, wid, lane);
}

__device__ __forceinline__ void store_tile_f32(const f32x4 (&acc)[2][2][4][2], float* dst, int ld, int row0, int col0) {
#pragma unroll
    for (int ai = 0; ai < 2; ++ai)
#pragma unroll
        for (int m = 0; m < 4; ++m) { float* rowp = dst + (size_t)(row0 + ai * HALF + m * 16) * ld + col0;
#pragma unroll
            for (int bj = 0; bj < 2; ++bj)
#pragma unroll
                for (int n = 0; n < 2; ++n) *(f32x4*)(rowp + bj * HALF + n * 16) = acc[ai][bj][m][n]; }
}
__device__ __forceinline__ void store_tile_bf16(const f32x4 (&acc)[2][2][4][2], bf16* dst, int ld, int row0, int col0) {
#pragma unroll
    for (int ai = 0; ai < 2; ++ai)
#pragma unroll
        for (int m = 0; m < 4; ++m) { bf16* rowp = dst + (size_t)(row0 + ai * HALF + m * 16) * ld + col0;
#pragma unroll
            for (int bj = 0; bj < 2; ++bj)
#pragma unroll
                for (int n = 0; n < 2; ++n) { const f32x4 v = acc[ai][bj][m][n]; u32x2 w; w.x = pk2(v[0], v[1]); w.y = pk2(v[2], v[3]); *(u32x2*)(rowp + bj * HALF + n * 16) = w; } }
}
struct EpiBf16 {
    static constexpr bool AFTER_DRAIN = false;
    bf16* dst; int ld;
    __device__ __forceinline__ void operator()(const f32x4 (&acc)[2][2][4][2], const Unit& u, int wr, int wc, int fr, int fq) const {
        store_tile_bf16(acc, dst, ld, u.pm * BM + wr * 64 + fr, u.pn * BM + wc * 32 + 4 * fq);
    }
};
struct EpiProj {
    static constexpr bool AFTER_DRAIN = false;
    bf16* qabs; float* ckvraw; bf16* qi; float* small; float* mqkraw; bf16* mv; bf16* mo;
    __device__ __forceinline__ void operator()(const f32x4 (&acc)[2][2][4][2], const Unit& u, int wr, int wc, int fr, int fq) const {
        const int row0 = u.pm * BM + wr * 64 + fr, cl = wc * 32 + 4 * fq, pn = u.pn;
        if (pn < 8) store_tile_bf16(acc, qabs, 2048, row0, pn * 256 + cl);
        else if (pn == 8) store_tile_f32(acc, ckvraw, 256, row0, cl);
        else if (pn < 11) store_tile_bf16(acc, qi, 512, row0, (pn - 9) * 256 + cl);
        else if (pn == 11) store_tile_f32(acc, small, 256, row0, cl);
        else if (pn < 16) store_tile_f32(acc, mqkraw, 1024, row0, (pn - 12) * 256 + cl);
        else if (pn < 20) store_tile_bf16(acc, mv, 1024, row0, (pn - 16) * 256 + cl);
        else store_tile_bf16(acc, mo, 1024, row0, (pn - 20) * 256 + cl);
    }
};
template <bool BASE_BF16>
struct EpiResidT {
    static constexpr bool AFTER_DRAIN = false;
    const void* base; bf16* xb; float* ss;
    __device__ __forceinline__ void operator()(const f32x4 (&acc)[2][2][4][2], const Unit& u, int wr, int wc, int fr, int fq) const {
        const int row0 = u.pm * BM + wr * 64 + fr, col0 = u.pn * BM + wc * 32 + 4 * fq;
#pragma unroll
        for (int ai = 0; ai < 2; ++ai)
#pragma unroll
            for (int m = 0; m < 4; ++m) { const int row = row0 + ai * HALF + m * 16; const size_t off = (size_t)row * D + col0; float s = 0.f;
#pragma unroll
                for (int bj = 0; bj < 2; ++bj)
#pragma unroll
                    for (int n = 0; n < 2; ++n) { f32x4 b;
                        if constexpr (BASE_BF16) { const u32x2 p = *(const u32x2*)((const bf16*)base + off + bj * HALF + n * 16); b = (f32x4){bf2f(p.x & 0xffffu), bf2f(p.x >> 16), bf2f(p.y & 0xffffu), bf2f(p.y >> 16)}; }
                        else b = *(const f32x4*)((const float*)base + off + bj * HALF + n * 16);
                        const f32x4 v = b + acc[ai][bj][m][n];
                        u32x2 w; w.x = pk2(v[0], v[1]); w.y = pk2(v[2], v[3]); *(u32x2*)(xb + off + bj * HALF + n * 16) = w;
                        s += (v[0] * v[0] + v[1] * v[1]) + (v[2] * v[2] + v[3] * v[3]); }
                if (ss) { s += __shfl_xor(s, 16); s += __shfl_xor(s, 32); if (fq == 0) atomicAdd(ss + row, s); } }
    }
};
struct EpiCq {
    static constexpr bool AFTER_DRAIN = false;
    bf16* dst; const float* ss; float scale;
    __device__ __forceinline__ void operator()(const f32x4 (&acc)[2][2][4][2], const Unit& u, int wr, int wc, int fr, int fq) const {
        const int row0 = u.pm * BM + wr * 64 + fr, col0 = u.pn * BM + wc * 32 + 4 * fq;
#pragma unroll
        for (int ai = 0; ai < 2; ++ai)
#pragma unroll
            for (int m = 0; m < 4; ++m) { const int row = row0 + ai * HALF + m * 16; const float r = rsqrtf(ss[row] * (1.0f / D) + EPS) * scale; bf16* rowp = dst + (size_t)row * D + col0;
#pragma unroll
                for (int bj = 0; bj < 2; ++bj)
#pragma unroll
                    for (int n = 0; n < 2; ++n) { const f32x4 v = acc[ai][bj][m][n] * r; u32x2 w; w.x = pk2(v[0], v[1]); w.y = pk2(v[2], v[3]); *(u32x2*)(rowp + bj * HALF + n * 16) = w; } }
    }
};
struct XsOrder {
    static constexpr bool GATHER = false;
    int G, c; unsigned lda_bytes, kb;
    __device__ bool next(int i, Unit& u) const { const int L = i * G + c; if (i > 0 || L >= 128) return false; u.pm = L >> 2; u.pn = L & 3; u.e = 0; u.rt = 0; return true; }
    __device__ __forceinline__ unsigned a_row(const Unit& u, int r) const { return (unsigned)(u.pm * BM + r) * lda_bytes + (unsigned)u.pn * 1024u; }
    __device__ __forceinline__ size_t b_off(const Unit& u) const { return (size_t)u.pn * 1024; }
};
struct XoOrder {
    static constexpr bool GATHER = false;
    int G, c; unsigned lda_bytes, kb;
    __device__ bool next(int i, Unit& u) const { const int L = i * G + c; if (L >= 256) return false; u.pm = L >> 3; u.pn = L & 7; u.e = 0; u.rt = 0; return true; }
    __device__ __forceinline__ unsigned a_row(const Unit& u, int r) const { return (unsigned)(u.pm * BM + r) * lda_bytes + (unsigned)(u.pn >> 1) * 512u; }
    __device__ __forceinline__ size_t b_off(const Unit& u) const { return (size_t)u.pn * BM * kb; }
};
struct EpiSoftmax {
    static constexpr bool AFTER_DRAIN = true;
    bf16* P; const float* ss;
    __device__ __forceinline__ void fused(f32x4 (&acc)[2][2][4][2], const Unit& u, int wr, int wc, int fr, int fq, LAS unsigned char* lds, int wid, int lane) const {
        LAS float* Pm = (LAS float*)lds; LAS float* Ps = (LAS float*)(lds + 4096);
#pragma unroll
        for (int ai = 0; ai < 2; ++ai)
#pragma unroll
            for (int m = 0; m < 4; ++m) { float mx = -3.0e38f; const float rs = rsqrtf(ss[u.pm * BM + ai * HALF + wr * 64 + m * 16 + fr] * (1.0f / D) + EPS);
#pragma unroll
                for (int bj = 0; bj < 2; ++bj)
#pragma unroll
                    for (int n = 0; n < 2; ++n) { const f32x4 v = acc[ai][bj][m][n] * rs; acc[ai][bj][m][n] = v; mx = fmaxf(mx, fmaxf(fmaxf(v[0], v[1]), fmaxf(v[2], v[3]))); }
                mx = fmaxf(mx, __shfl_xor(mx, 16)); mx = fmaxf(mx, __shfl_xor(mx, 32));
                if (fq == 0) Pm[(ai * HALF + wr * 64 + m * 16 + fr) * 4 + wc] = mx; }
        asm volatile("s_waitcnt lgkmcnt(0)" ::: "memory"); __builtin_amdgcn_s_barrier(); asm volatile("" ::: "memory");
#pragma unroll
        for (int ai = 0; ai < 2; ++ai)
#pragma unroll
            for (int m = 0; m < 4; ++m) { const int r = ai * HALF + wr * 64 + m * 16 + fr; const f32x4 pm4 = *(const LAS f32x4*)(Pm + r * 4); const float mx = fmaxf(fmaxf(pm4[0], pm4[1]), fmaxf(pm4[2], pm4[3])); float sm = 0.f;
#pragma unroll
                for (int bj = 0; bj < 2; ++bj)
#pragma unroll
                    for (int n = 0; n < 2; ++n) { f32x4 v = acc[ai][bj][m][n];
#pragma unroll
                        for (int j = 0; j < 4; ++j) { v[j] = __expf(v[j] - mx); sm += v[j]; }
                        acc[ai][bj][m][n] = v; }
                sm += __shfl_xor(sm, 16); sm += __shfl_xor(sm, 32);
                if (fq == 0) Ps[r * 4 + wc] = sm; }
        asm volatile("s_waitcnt lgkmcnt(0)" ::: "memory"); __builtin_amdgcn_s_barrier(); asm volatile("" ::: "memory");
#pragma unroll
        for (int ai = 0; ai < 2; ++ai)
#pragma unroll
            for (int m = 0; m < 4; ++m) { const int r = ai * HALF + wr * 64 + m * 16 + fr; const f32x4 ps4 = *(const LAS f32x4*)(Ps + r * 4); const float inv = 1.f / ((ps4[0] + ps4[1]) + (ps4[2] + ps4[3]));
                bf16* rowp = P + (size_t)(u.pm * BM + r) * 1024 + u.pn * 256 + wc * 32 + 4 * fq;
#pragma unroll
                for (int bj = 0; bj < 2; ++bj)
#pragma unroll
                    for (int n = 0; n < 2; ++n) { const f32x4 v = acc[ai][bj][m][n] * inv; u32x2 w; w.x = pk2(v[0], v[1]); w.y = pk2(v[2], v[3]); *(u32x2*)(rowp + bj * HALF + n * 16) = w; } }
    }
};
struct MoeOrder {
    static constexpr bool GATHER = true;
    const volatile LAS int* tb; const volatile LAS int* cn; const int* list; int ncol; int Lbeg, Lend, nb, c; unsigned a_ld_bytes; size_t b_exp_bytes; unsigned kb; int gather;
    __device__ bool next(int i, Unit& u) const {
        if (c < 0 || nb <= 0) return false;
        const int L = Lbeg + i * nb + c; if (L >= Lend) return false;
        const int g = L / ncol; int e = 0;
#pragma unroll 1
        for (int j = 1; j < 32; ++j) if (g >= tb[j]) e = j;
        u.e = e; u.rt = g - tb[e]; u.pn = L - g * ncol; u.pm = g; return true;
    }
    __device__ __forceinline__ unsigned a_row(const Unit& u, int r) const {
        if (gather) { int idx = u.rt * 256 + r; const int cnt = cn[u.e]; idx = idx < cnt ? idx : cnt - 1; const int tok = list[u.e * T + idx]; return (unsigned)tok * a_ld_bytes; }
        return (unsigned)(u.pm * 256 + r) * a_ld_bytes;
    }
    __device__ __forceinline__ size_t b_off(const Unit& u) const { return (size_t)u.e * b_exp_bytes + (size_t)u.pn * BM * kb; }
};
struct EpiSwiGLU {
    static constexpr bool AFTER_DRAIN = false;
    bf16* act; const int* list; const float* rstd; const volatile LAS int* cn;
    __device__ __forceinline__ void operator()(const f32x4 (&acc)[2][2][4][2], const Unit& u, int wr, int wc, int fr, int fq) const {
        const int cnt = cn[u.e];
#pragma unroll
        for (int ai = 0; ai < 2; ++ai)
#pragma unroll
            for (int m = 0; m < 4; ++m) { const int rl = ai * HALF + wr * 64 + m * 16 + fr; int idx = u.rt * 256 + rl; idx = idx < cnt ? idx : cnt - 1; const float r = rstd[list[u.e * T + idx]];
                bf16* rowp = act + (size_t)(u.pm * 256 + rl) * DEXP + u.pn * 128 + wc * 32 + 4 * fq;
#pragma unroll
                for (int n = 0; n < 2; ++n) { const f32x4 g = acc[ai][0][m][n] * r, uu = acc[ai][1][m][n] * r; f32x4 a;
#pragma unroll
                    for (int j = 0; j < 4; ++j) a[j] = g[j] / (1.0f + __expf(-g[j])) * uu[j];
                    u32x2 w; w.x = pk2(a[0], a[1]); w.y = pk2(a[2], a[3]); *(u32x2*)(rowp + n * 16) = w; } }
    }
};
}

struct Args { const float* in[27]; float* out; unsigned char* ws; int ph_lo, ph_hi; };
enum { I_X = 0, I_MEM, I_NORM_MIX_G, I_W_IN, I_KV_NORM_G, I_KIDX_NORM_G, I_W_UK, I_W_UV, I_CONV_W, I_CONV_B, I_GATE_B, I_ML_NORM_G, I_W_OUT, I_NORM_X_G, I_MEM_NORM_G,
       I_W_CQ, I_W_CKV, I_W_CO, I_NORM_FFN_G, I_W_GROUP, I_B_GROUP, I_W_ROUTER, I_B_ROUTER, I_W_GATE, I_W_UP, I_W_DOWN, I_FINAL_G };

__device__ __forceinline__ void tr_item(const float* W, size_t ldw, int k0, int n0, const float* kscale, bf16* WT, size_t ldt, int drow0, int dcol0, LAS float* scr, int lane) {
#pragma unroll 8
    for (int i = 0; i < 32; ++i) { const int kk = 2 * i + (lane >> 5); float v = W[(size_t)(k0 + kk) * ldw + n0 + (lane & 31)]; if (kscale) v *= kscale[k0 + kk]; scr[kk * 33 + (lane & 31)] = v; }
    LDS_WAIT(); asm volatile("" ::: "memory");
    const int c = lane & 7;
#pragma unroll
    for (int j = 0; j < 4; ++j) { const int n = (lane >> 3) + 8 * j; const LAS float* s = scr + (8 * c) * 33 + n;
        u32x4 o; o.x = pk2(s[0 * 33], s[1 * 33]); o.y = pk2(s[2 * 33], s[3 * 33]); o.z = pk2(s[4 * 33], s[5 * 33]); o.w = pk2(s[6 * 33], s[7 * 33]);
        *(u32x4*)(WT + (size_t)(drow0 + n0 + n) * ldt + dcol0 + k0 + 8 * c) = o; }
    LDS_WAIT(); asm volatile("" ::: "memory");
}
__device__ __forceinline__ void tr_item64(const float* W, size_t ldw, int k0, int n0, const float* kscale, bf16* WT, size_t ldt, int drow0, int dcol0, LAS unsigned char* scr, int lane) {
    const int nq = lane & 15, kq = lane >> 4;
    const float* src = W + (size_t)(k0 + 2 * kq) * ldw + n0 + 4 * nq;
    f32x4 a[8], b[8];
#pragma unroll
    for (int i = 0; i < 8; ++i) { a[i] = __builtin_nontemporal_load((const f32x4*)(src + (size_t)(8 * i) * ldw)); b[i] = __builtin_nontemporal_load((const f32x4*)(src + (size_t)(8 * i + 1) * ldw)); }
#pragma unroll
    for (int i = 0; i < 8; ++i) { float sa = 1.f, sb = 1.f; if (kscale) { sa = kscale[k0 + 8 * i + 2 * kq]; sb = kscale[k0 + 8 * i + 2 * kq + 1]; }
#pragma unroll
        for (int j = 0; j < 4; ++j) { const int n = 4 * nq + j; *(LAS unsigned*)(scr + n * 128 + 16 * (i ^ (nq & 7)) + 4 * kq) = pk2(a[i][j] * sa, b[i][j] * sb); } }
    LDS_WAIT(); asm volatile("" ::: "memory");
#pragma unroll
    for (int m = 0; m < 8; ++m) { const int n = (lane >> 3) + 8 * m, c = lane & 7; const u32x4 v = *(const LAS u32x4*)(scr + n * 128 + 16 * (c ^ ((n >> 2) & 7)));
        __builtin_nontemporal_store(v, (u32x4*)(WT + (size_t)(drow0 + n0 + n) * ldt + dcol0 + k0 + 8 * c)); }
    LDS_WAIT(); asm volatile("" ::: "memory");
}
__device__ __forceinline__ void cv_item64(const float* W, size_t ldw, int k0, int n0, const float* kscale, float scale, bf16* O, size_t ldo, int lane) {
    const int c4 = (lane & 15) * 4, rr = lane >> 4;
    f32x4 v[16];
#pragma unroll
    for (int i = 0; i < 16; ++i) v[i] = __builtin_nontemporal_load((const f32x4*)(W + (size_t)(k0 + i * 4 + rr) * ldw + n0 + c4));
#pragma unroll
    for (int i = 0; i < 16; ++i) { const float g = kscale[k0 + i * 4 + rr] * scale; u32x2 w; w.x = pk2(v[i][0] * g, v[i][1] * g); w.y = pk2(v[i][2] * g, v[i][3] * g);
        *(u32x2*)(O + (size_t)(k0 + i * 4 + rr) * ldo + n0 + c4) = w; }
}
__device__ __forceinline__ void rms_row_to_bf16(const float* xrow, const float* g, bf16* orow, int lane) {
    const f32x4* xr = (const f32x4*)xrow + lane; const f32x4* gr = (const f32x4*)g + lane;
    f32x4 v[8]; float s = 0.f;
#pragma unroll
    for (int j = 0; j < 8; ++j) { v[j] = xr[64 * j]; s += (v[j][0] * v[j][0] + v[j][1] * v[j][1]) + (v[j][2] * v[j][2] + v[j][3] * v[j][3]); }
    const float r = rsqrtf(wave_sum(s) * (1.f / D) + EPS);
    u32x2* o8 = (u32x2*)orow + lane;
#pragma unroll
    for (int j = 0; j < 8; ++j) { const f32x4 gg = gr[64 * j]; u32x2 w; w.x = pk2(v[j][0] * r * gg[0], v[j][1] * r * gg[1]); w.y = pk2(v[j][2] * r * gg[2], v[j][3] * r * gg[3]); o8[64 * j] = w; }
}

__device__ __forceinline__ void mini_gemm64(LAS unsigned char* lds, const bf16* Ap, const unsigned lda, const bf16* Bp, const unsigned ldb, const int nch, bf16* o, const unsigned ldo, const int wave, const int lane) {
    const int r32 = lane & 31, hh = lane >> 5; const int tm = wave & 1, tn = (wave >> 1) & 1, kh = wave >> 2;
#define KV_DMA(kc_) do { _Pragma("unroll") for (int i4 = 0; i4 < 4; ++i4) { const int ii = wave * 4 + i4; const int isb = ii >> 4, row_ = (ii & 15) * 4 + (lane >> 4); \
        const bf16* gsrc_ = (isb ? Bp + (size_t)row_ * ldb : Ap + (size_t)row_ * lda) + (kc_) * 128 + (((lane & 15) ^ (row_ & 15)) * 8); \
        const unsigned ldst_ = __builtin_amdgcn_readfirstlane((unsigned)(size_t)lds + (unsigned)(((kc_) & 3) * 32768 + isb * 16384 + (ii & 15) * 1024)); unsigned keep_; \
        asm volatile("s_mov_b32 %0, m0\n\ts_mov_b32 m0, %2\n\ts_nop 0\n\tglobal_load_lds_dwordx4 %1, off\n\ts_mov_b32 m0, %0" : "=&s"(keep_) : "v"(gsrc_), "s"(ldst_) : "memory"); } } while (0)
    f32x16 acc;
#pragma unroll
    for (int i = 0; i < 16; ++i) acc[i] = 0.f;
    asm volatile("s_waitcnt vmcnt(0)" ::: "memory");
    __syncthreads();
    KV_DMA(0); if (nch > 1) KV_DMA(1); if (nch > 2) KV_DMA(2);
#pragma unroll 1
    for (int kc = 0; kc < nch; ++kc) {
        const int ahead = nch - 1 - kc;
        if (ahead >= 2) asm volatile("s_waitcnt vmcnt(8)" ::: "memory"); else if (ahead == 1) asm volatile("s_waitcnt vmcnt(4)" ::: "memory"); else asm volatile("s_waitcnt vmcnt(0)" ::: "memory");
        __syncthreads();
        if (kc + 3 < nch) KV_DMA(kc + 3);
        const LAS unsigned char* ba = lds + (kc & 3) * 32768 + (tm * 32 + r32) * 256; const LAS unsigned char* bb = lds + (kc & 3) * 32768 + 16384 + (tn * 32 + r32) * 256;
#pragma unroll
        for (int k4 = 0; k4 < 4; ++k4) { const int ch = (kh * 4 + k4) * 2 + hh;
            const bf16x8 af = *(const LAS bf16x8*)(ba + ((ch ^ (r32 & 15)) * 16)), bfr = *(const LAS bf16x8*)(bb + ((ch ^ (r32 & 15)) * 16));
            acc = __builtin_amdgcn_mfma_f32_32x32x16_bf16(af, bfr, acc, 0, 0, 0); }
    }
#undef KV_DMA
    __syncthreads();
    LAS float* xb = (LAS float*)lds + (wave & 3) * 1024;
    if (kh == 1) {
#pragma unroll
        for (int i = 0; i < 16; ++i) xb[i * 64 + lane] = acc[i]; }
    __syncthreads();
    if (kh == 0) { bf16* op = o + (size_t)(tm * 32 + 4 * hh) * ldo + tn * 32 + r32;
#pragma unroll
        for (int i = 0; i < 16; ++i) op[(size_t)((i & 3) + 8 * (i >> 2)) * ldo] = (bf16)f2bf(acc[i] + xb[i * 64 + lane]); }
}

__global__ void __launch_bounds__(512, 2) mega(Args args) {
    extern __shared__ __attribute__((aligned(16))) unsigned char lds_raw[];
    LAS unsigned char* lds = (LAS unsigned char*)lds_raw;
    volatile LAS unsigned* MISC = (volatile LAS unsigned*)(lds + MISC_OFF);
    const int tid0 = threadIdx.x;
    const int wave0_ = __builtin_amdgcn_readfirstlane(tid0 >> 6);
    const int G = gridDim.x, bx = blockIdx.x;
#define PHASE_IDS const Args* A_ = (const Args*)__builtin_amdgcn_kernarg_segment_ptr(); asm volatile("" : "+s"(A_)); int tid; asm volatile("v_mbcnt_lo_u32_b32 %0, -1, 0\n\tv_mbcnt_hi_u32_b32 %0, -1, %0" : "=v"(tid)); tid += wave0_ * 64; asm volatile("" : "+v"(tid)); const int lane = tid & 63, wave = __builtin_amdgcn_readfirstlane(tid >> 6); const int gw = bx * 8 + wave, NGW = G * 8; (void)lane; (void)gw; (void)NGW;
    const Args* A_ = (const Args*)__builtin_amdgcn_kernarg_segment_ptr();
    unsigned char* ws = args.ws;
    unsigned* ctl = (unsigned*)(ws + WS_CTL);
    const int lo = args.ph_lo, hi = args.ph_hi;
    for (int u = tid0; u < 1024; u += 512) MISC[u] = 0u;
    __syncthreads();
    XcdBarrier bar; bar.bar = ctl + CW_BAR; bar.x = 0; bar.st = MISC;
    if (hi - lo > 1) bar = xcd_barrier_post(ctl + CW_BAR, MISC);
#ifndef PH_MASK
#define PH_MASK 0x1ffff
#endif
#define IN(k) ((((PH_MASK) >> (k)) & 1) && lo <= (k) && (k) < hi)
#ifndef REP_MASK
#define REP_MASK 0
#endif
#define NREP(k) (1 + (((REP_MASK) >> (k)) & 1))
#ifndef PR_MFMA
#define PR_MFMA 0
#endif
#ifndef PR_EPI
#define PR_EPI 0
#endif
#ifndef PR_GA
#define PR_GA 0
#endif
#ifndef PR_VF
#define PR_VF 0
#endif
#ifndef PR_KV
#define PR_KV 0
#endif
#ifndef PR_ML
#define PR_ML 0
#endif
#ifndef PR_TR
#define PR_TR 0
#endif
#ifndef PR_WP
#define PR_WP 0
#endif
#ifndef PR_H1
#define PR_H1 0
#endif
#ifndef PR_QK
#define PR_QK 0
#endif
#ifndef PR_PV
#define PR_PV 0
#endif
#define BOTH(k) (IN(k) && IN((k) + 1))
#define GRID_BAR(k) do { if (BOTH(k) && rep_ == NREP(k) - 1) xcd_barrier(bar, tid); } while (0)

#define WOUT_T ((bf16*)(ws + WS_WOUT_T))
#define WCQ_T ((bf16*)(ws + WS_WCQ_T))
#define WCKV_T ((bf16*)(ws + WS_WCKV_T))
#define WCO_T ((bf16*)(ws + WS_WCO_T))
#define WGU_T ((bf16*)(ws + WS_WGU_T))
#define WDN_T ((bf16*)(ws + WS_WDN_T))
#define WIN_T ((bf16*)(ws + WS_WIN_T))
#define H1 ((bf16*)(ws + WS_H1))
#define MIXIN ((bf16*)(ws + WS_MIXIN))
#define MEMN ((bf16*)(ws + WS_MEMN))
#define KC ((bf16*)(ws + WS_KC))
#define MF ((bf16*)(ws + WS_WCKV_T + 4 * MiB))
#define VF ((bf16*)(ws + WS_WCKV_T))
#define VT ((bf16*)(ws + WS_VT))
#define GATES ((float*)(ws + WS_GATES))
#define QABS ((bf16*)(ws + WS_QABS))
#define CKVRAW ((float*)(ws + WS_CKVRAW))
#define QI ((bf16*)(ws + WS_QI))
#define SMALL ((float*)(ws + WS_SMALL))
#define MQKRAW ((float*)(ws + WS_MQKRAW))
#define MV ((bf16*)(ws + WS_MV))
#define MO ((bf16*)(ws + WS_MO))
#define CKVN ((bf16*)(ws + WS_CKVN))
#define KIDXN ((bf16*)(ws + WS_KIDXN))
#define QCM ((bf16*)(ws + WS_QCM))
#define KCM ((bf16*)(ws + WS_KCM))
#define LST ((float*)(ws + WS_LST))
#define NL ((float*)(ws + WS_NL))
#define NST (NL + NCH * 4 * 128)
#define CST ((bf16*)(ws + WS_CST))
#define VTM ((bf16*)(ws + WS_VTM))
#define PB ((bf16*)(ws + WS_VTM))
#define X1B ((bf16*)(ws + WS_X1B))
#define QC ((bf16*)(ws + WS_QC))
#define OC ((bf16*)(ws + WS_OC))
#define X2B ((bf16*)(ws + WS_X2B))
#define LIST ((int*)(ws + WS_LIST))
#define TOKE ((int*)(ws + WS_TOK))
#define TOKW ((float*)(ws + WS_TOK) + 2 * T)
#define RSTD3 ((float*)(ws + WS_TOK) + 4 * T)
#define ACT ((bf16*)(ws + WS_ACT))
#define Y ((bf16*)(ws + WS_Y))
#define WRH ((bf16*)(ws + WS_WR))
#define WRL (WRH + 48 * D)
#define BCNT ((int*)(ws + WS_TOK) + 8 * T)
#define TOKR ((int*)(ws + WS_TOK) + 6 * T)
#define SS2 ((float*)(ctl + CW_SS2))
#define CNT ((int*)(ctl + CW_CNT))

    if (IN(0)) for (int rep_ = 0; rep_ < NREP(0); ++rep_) {
        PHASE_IDS
        if (rep_) xcd_barrier(bar, tid);
        LAS float* scr = (LAS float*)(lds + wave * 16384);
        const float* w_in = A_->in[I_W_IN]; const float* w_out = A_->in[I_W_OUT];
        constexpr int J_CKV = 32 * 4, J_QI = 32 * 8, J_KI = 32 * 1, J_MQK = 32 * 16, J_MV = 32 * 16, J_MO = 32 * 16, J_WO = 16 * 32, J_CQ = 32 * 32, J_CKVW = 32 * 64, J_CO = 32 * 32,
                      J_G = 32 * 256, J_U = 32 * 256, J_D = 32 * 256;
        constexpr int NITEMS = J_CKV + J_QI + J_KI + J_MQK + J_MV + J_MO + J_WO + J_CQ + J_CKVW + J_CO + J_G + J_U;
        LAS unsigned char* scr8 = (LAS unsigned char*)scr;
        for (int prt_ = 0; prt_ < 1 + PR_TR; ++prt_)
        for (int it = gw; it < NITEMS; it += NGW) {
            int r = it;
            if (r < J_CKV) { tr_item64(w_in + 1024, D_IN, 64 * (r / 4), 64 * (r % 4), nullptr, WIN_T, D, 2048, 0, scr8, lane); continue; } r -= J_CKV;
            if (r < J_QI) { tr_item64(w_in + 1280, D_IN, 64 * (r / 8), 64 * (r % 8), nullptr, WIN_T, D, 2304, 0, scr8, lane); continue; } r -= J_QI;
            if (r < J_KI) { tr_item64(w_in + 1792, D_IN, 64 * r, 0, nullptr, WIN_T, D, 2816, 0, scr8, lane); continue; } r -= J_KI;
            if (r < J_MQK) { tr_item64(w_in + 1864, D_IN, 64 * (r / 16), 64 * (r % 16), nullptr, WIN_T, D, 3072, 0, scr8, lane); continue; } r -= J_MQK;
            if (r < J_MV) { tr_item64(w_in + 2888, D_IN, 64 * (r / 16), 64 * (r % 16), nullptr, WIN_T, D, 4096, 0, scr8, lane); continue; } r -= J_MV;
            if (r < J_MO) { tr_item64(w_in + 3920, D_IN, 64 * (r / 16), 64 * (r % 16), nullptr, WIN_T, D, 5120, 0, scr8, lane); continue; } r -= J_MO;
            if (r < J_WO) { tr_item64(w_out + (size_t)1024 * D, D, 64 * (r / 32), 64 * (r % 32), nullptr, WOUT_T, KMIX, 0, 2048, scr8, lane); continue; } r -= J_WO;
            if (r < J_CQ) { cv_item64(A_->in[I_W_CQ], D, 64 * (r / 32), 64 * (r % 32), A_->in[I_NORM_X_G], 0.04419417382415922f, WCQ_T, D, lane); continue; } r -= J_CQ;
            if (r < J_CKVW) { tr_item64(A_->in[I_W_CKV], 2 * D, 64 * (r / 64), 64 * (r % 64), nullptr, WCKV_T, D, 0, 0, scr8, lane); continue; } r -= J_CKVW;
            if (r < J_CO) { tr_item64(A_->in[I_W_CO], D, 64 * (r / 32), 64 * (r % 32), nullptr, WCO_T, D, 0, 0, scr8, lane); continue; } r -= J_CO;
            if (r < J_G) { const int e = r / 256, q = r % 256, kb = q / 8, nb = q % 8;
                tr_item64(A_->in[I_W_GATE] + (size_t)e * D * DEXP, DEXP, 64 * kb, 64 * nb, A_->in[I_NORM_FFN_G], WGU_T + (size_t)e * 1024 * D, D, (nb / 2) * 128, 0, scr8, lane); continue; } r -= J_G;
            if (r < J_U) { const int e = r / 256, q = r % 256, kb = q / 8, nb = q % 8;
                tr_item64(A_->in[I_W_UP] + (size_t)e * D * DEXP, DEXP, 64 * kb, 64 * nb, A_->in[I_NORM_FFN_G], WGU_T + (size_t)e * 1024 * D, D, (nb / 2) * 128 + 128, 0, scr8, lane); continue; }
        }
        for (int i = bx * 512 + tid; i < 192 * D; i += G * 512) { const int r = i / D, k = i % D; float v = 0.f;
            if (r < 8) v = w_in[(size_t)k * D_IN + 1856 + r]; else if (r < 16) v = w_in[(size_t)k * D_IN + 3912 + (r - 8)];
            WIN_T[(size_t)(2880 + r) * D + k] = (bf16)f2bf(v); }
        for (int i = bx * 512 + tid; i < 48 * D; i += G * 512) { const int o = i / D, k = i % D; float v = 0.f;
            if (o < 4) v = A_->in[I_W_GROUP][(size_t)k * 4 + o] * A_->in[I_NORM_FFN_G][k]; else if (o < 36) v = A_->in[I_W_ROUTER][(size_t)k * 32 + (o - 4)] * A_->in[I_NORM_FFN_G][k];
            const unsigned hb = f2bf(v); WRH[i] = (bf16)hb; WRL[i] = (bf16)f2bf(v - bf2f(hb)); }
        {
            const int r32 = lane & 31, hh = lane >> 5;
            const float* w_uk = A_->in[I_W_UK]; const float* w_uv = A_->in[I_W_UV];
#define CVT8(dst, pa, pb) do { const f32x4 x_ = (pa), y_ = (pb); u32x4 w_; w_.x = pk2(x_[0], x_[1]); w_.y = pk2(x_[2], x_[3]); w_.z = pk2(y_[0], y_[1]); w_.w = pk2(y_[2], y_[3]); dst = __builtin_bit_cast(bf16x8, w_); } while (0)
            for (int prw_ = 0; prw_ < 1 + PR_WP; ++prw_)
            for (int it = gw; it < 4096; it += NGW) {
                const bool isq = it < 2048; const int r = it & 2047, h = r >> 8, rt = (r >> 2) & 63, cg = r & 3;
                if (isq) {
                    const int ct = (r >> 5) & 7, kg = r & 31;
                    bf16x8 af[8];
                    { const float* ap = w_uk + (size_t)((ct * 32 + r32) * 8 + h) * 128 + 8 * hh;
#pragma unroll
                      for (int ks = 0; ks < 8; ++ks) CVT8(af[ks], *(const f32x4*)(ap + ks * 16), *(const f32x4*)(ap + ks * 16 + 4)); }
#pragma unroll 1
                    for (int kt = 0; kt < 2; ++kt) { const int k0 = kg * 64 + kt * 32; const float* bp = w_in + (size_t)(k0 + r32) * D_IN + h * 128 + 8 * hh;
                        f32x16 acc;
#pragma unroll
                        for (int i = 0; i < 16; ++i) acc[i] = 0.f;
#pragma unroll
                        for (int ks = 0; ks < 8; ++ks) { bf16x8 bfr; CVT8(bfr, *(const f32x4*)(bp + ks * 16), *(const f32x4*)(bp + ks * 16 + 4)); acc = __builtin_amdgcn_mfma_f32_32x32x16_bf16(af[ks], bfr, acc, 0, 0, 0); }
                        bf16* o = WIN_T + (size_t)(h * 256 + ct * 32 + 4 * hh) * D + k0 + r32;
#pragma unroll
                        for (int i = 0; i < 16; ++i) o[(size_t)((i & 3) + 8 * (i >> 2)) * D] = (bf16)f2bf(acc[i] * 0.08838834764831845f); }
                } else {
                    const float* pj[8];
#pragma unroll
                    for (int j = 0; j < 8; ++j) pj[j] = w_out + (size_t)(h * 128 + 8 * hh + j) * D + rt * 32 + r32;
                    const float* bp0 = w_uv + (size_t)((cg * 64 + r32) * 8 + h) * 128 + 8 * hh; const float* bp1 = bp0 + (size_t)32 * 8 * 128;
                    f32x16 acc0, acc1;
#pragma unroll
                    for (int i = 0; i < 16; ++i) { acc0[i] = 0.f; acc1[i] = 0.f; }
#pragma unroll 2
                    for (int ks = 0; ks < 8; ++ks) { u32x4 w_; w_.x = pk2(*pj[0], *pj[1]); w_.y = pk2(*pj[2], *pj[3]); w_.z = pk2(*pj[4], *pj[5]); w_.w = pk2(*pj[6], *pj[7]); const bf16x8 afr = __builtin_bit_cast(bf16x8, w_);
#pragma unroll
                        for (int j = 0; j < 8; ++j) pj[j] += (size_t)16 * D;
                        bf16x8 b0, b1; CVT8(b0, *(const f32x4*)(bp0 + ks * 16), *(const f32x4*)(bp0 + ks * 16 + 4)); CVT8(b1, *(const f32x4*)(bp1 + ks * 16), *(const f32x4*)(bp1 + ks * 16 + 4));
                        acc0 = __builtin_amdgcn_mfma_f32_32x32x16_bf16(afr, b0, acc0, 0, 0, 0); acc1 = __builtin_amdgcn_mfma_f32_32x32x16_bf16(afr, b1, acc1, 0, 0, 0); }
                    bf16* o = WOUT_T + (size_t)(rt * 32 + 4 * hh) * KMIX + h * 256 + cg * 64 + r32;
#pragma unroll
                    for (int i = 0; i < 16; ++i) { o[(size_t)((i & 3) + 8 * (i >> 2)) * KMIX] = (bf16)f2bf(acc0[i]); o[(size_t)((i & 3) + 8 * (i >> 2)) * KMIX + 32] = (bf16)f2bf(acc1[i]); }
                }
            }
#undef CVT8
        }
        for (int prh_ = 0; prh_ < 1 + PR_H1; ++prh_)
        for (int m = gw; m < T; m += NGW) rms_row_to_bf16(A_->in[I_X] + (size_t)m * D, A_->in[I_NORM_MIX_G], H1 + (size_t)m * D, lane);
        for (int m = gw; m < NMEM; m += NGW) rms_row_to_bf16(A_->in[I_MEM] + (size_t)m * D, A_->in[I_MEM_NORM_G], MEMN + (size_t)m * D, lane);
        GRID_BAR(0);
    }

    if (IN(1)) for (int rep_ = 0; rep_ < NREP(1); ++rep_) {
        PHASE_IDS
        if (rep_) xcd_barrier(bar, tid);
        pg8::DenseOrder S; S.init(T, NPROJ, D, D, G, bx);
        pg8::EpiProj E{QABS, CKVRAW, QI, SMALL, MQKRAW, MV, MO};
        pg8::gemm_phase(tid, lds, H1, WIN_T, D, S, E);
        GRID_BAR(1);
    }

    if (IN(2)) for (int rep_ = 0; rep_ < NREP(2); ++rep_) {
        PHASE_IDS
        if (rep_) xcd_barrier(bar, tid);
#ifndef P2_SUB
#define P2_SUB 15
#endif
        if (P2_SUB & 1) {
            for (int prk_ = 0; prk_ < 1 + PR_KV; ++prk_)
            for (int id = bx; id < 256; id += G) {
                const int rt = id & 3, ct = id >> 2;
                mini_gemm64(lds, MEMN + (size_t)(rt * 64) * D, D, WCKV_T + (size_t)(ct * 64) * D, D, 16, KC + (size_t)(rt * 64) * 4096 + ct * 64, 4096u, wave, lane);
            }
        }
        __syncthreads();
        if (P2_SUB & 4) for (int t = gw; t < T; t += NGW) {
            const f32x4 v = ((const f32x4*)(CKVRAW + (size_t)t * 256))[lane];
            const float r = rsqrtf(wave_sum((v[0] * v[0] + v[1] * v[1]) + (v[2] * v[2] + v[3] * v[3])) * (1.f / 256.f) + EPS);
            const f32x4 g = ((const f32x4*)A_->in[I_KV_NORM_G])[lane];
            u32x2 w; w.x = pk2(v[0] * r * g[0], v[1] * r * g[1]); w.y = pk2(v[2] * r * g[2], v[3] * r * g[3]);
            ((u32x2*)(CKVN + (size_t)t * 256))[lane] = w;
            const float kv = SMALL[(size_t)t * 256 + lane];
            const float rk = rsqrtf(wave_sum(kv * kv) * (1.f / 64.f) + EPS);
            KIDXN[(size_t)t * 64 + lane] = (bf16)f2bf(kv * rk * A_->in[I_KIDX_NORM_G][lane]);
        }
        if (P2_SUB & 8) {
            LAS float* kq = (LAS float*)lds;
            LAS bf16* KWT = (LAS bf16*)(lds + 32768);
            LAS bf16* VTl = (LAS bf16*)(lds + 51200);
            LAS float* sw = (LAS float*)(lds + 98304);
            const float* conv_w = A_->in[I_CONV_W]; const float* conv_b = A_->in[I_CONV_B]; const float* gate_b = A_->in[I_GATE_B];
            const int r32 = lane & 31, hh = lane >> 5;
            for (int prm_ = 0; prm_ < 1 + PR_ML; ++prm_)
            for (int uu = bx; uu < NCH * 4; uu += G) {
                const int c = uu >> 2, h = uu & 3, t0 = c * CH;
                __syncthreads();
                if (wave == 0) {
                    const int t = t0 + lane; const float li = SMALL[(size_t)t * 256 + 72 + h] + gate_b[h]; const float mf = SMALL[(size_t)t * 256 + 76 + h] + gate_b[4 + h];
                    float bsc = fminf(mf, 0.f) - log1pf(__expf(-fabsf(mf)));
#pragma unroll
                    for (int o = 1; o < 64; o <<= 1) { const float v = __shfl_up(bsc, o); if (lane >= o) bsc += v; }
                    const float g = __shfl(bsc, 63); const float dec = g - bsc + li; const float mx = wave_max(dec);
                    sw[lane] = __expf(dec - mx); sw[128 + lane] = li; sw[192 + lane] = bsc;
                    GATES[GT_B + (size_t)t * 4 + h] = bsc; GATES[GT_LI + (size_t)t * 4 + h] = li;
                    if (lane == 0) { GATES[GT_G + c * 4 + h] = g; GATES[GT_MLOC + c * 4 + h] = mx; } }
                __syncthreads();
                { const int ch = tid & 255, th = tid >> 8; const int src = ch < 128 ? h * 128 + ch : 512 + h * 128 + (ch - 128);
                  const float cw0 = conv_w[src], cw1 = conv_w[1024 + src], cw2 = conv_w[2048 + src], cw3 = conv_w[3072 + src], cbias = conv_b[src];
                  const int tb = t0 + th * 32 - 3; float xr[35];
#pragma unroll
                  for (int i = 0; i < 35; ++i) xr[i] = (tb + i >= 0) ? MQKRAW[(size_t)(tb + i) * 1024 + src] : 0.f;
#pragma unroll
                  for (int i = 0; i < 32; ++i) { const int s_ = th * 32 + i, t = t0 + s_; float y = cbias + ((cw0 * xr[i] + cw1 * xr[i + 1]) + (cw2 * xr[i + 2] + cw3 * xr[i + 3]));
                      y = y / (1.f + __expf(-y));
                      if (ch < 128) QCM[(size_t)t * 512 + h * 128 + ch] = (bf16)f2bf(y * 0.08838834764831845f);
                      else { const unsigned kb = f2bf(y); KCM[(size_t)t * 512 + h * 128 + (ch - 128)] = (bf16)kb; const float kf = bf2f(kb); kq[s_ * 128 + (ch - 128)] = kf; KWT[(ch - 128) * 72 + s_] = (bf16)f2bf(sw[s_] * kf); } } }
#pragma unroll 1
                for (int e = tid; e < 64 * 32; e += 512) { const int s = e & 63, c8 = e >> 6; const u32x4 vv = *(const u32x4*)(MV + (size_t)(t0 + s) * 1024 + h * 256 + c8 * 8);
                    LAS bf16* d = VTl + (c8 * 8) * 72 + s;
                    d[0] = (bf16)(vv.x & 0xffffu); d[72] = (bf16)(vv.x >> 16); d[144] = (bf16)(vv.y & 0xffffu); d[216] = (bf16)(vv.y >> 16);
                    d[288] = (bf16)(vv.z & 0xffffu); d[360] = (bf16)(vv.z >> 16); d[432] = (bf16)(vv.w & 0xffffu); d[504] = (bf16)(vv.w >> 16); }
                __syncthreads();
#pragma unroll 1
                for (int e = tid; e < 256 * 8; e += 512) { const int dv = e >> 3, ch = e & 7; *(u32x4*)(VTM + ((size_t)(c * 4 + h) * 256 + dv) * 64 + ch * 8) = *(const LAS u32x4*)(VTl + dv * 72 + ch * 8); }
                {
                    bf16x8 af[4];
#pragma unroll
                    for (int ks = 0; ks < 4; ++ks) af[ks] = *(const LAS bf16x8*)(VTl + (wave * 32 + r32) * 72 + ks * 16 + 8 * hh);
#pragma unroll 1
                    for (int j = 0; j < 4; ++j) { f32x16 acc;
#pragma unroll
                        for (int i = 0; i < 16; ++i) acc[i] = 0.f;
#pragma unroll
                        for (int ks = 0; ks < 4; ++ks) { const bf16x8 bfr = *(const LAS bf16x8*)(KWT + (j * 32 + r32) * 72 + ks * 16 + 8 * hh); acc = __builtin_amdgcn_mfma_f32_32x32x16_bf16(af[ks], bfr, acc, 0, 0, 0); }
                        float* o = LST + ((size_t)(c * 4 + h) * 256 + wave * 32 + 4 * hh) * 128 + j * 32 + r32;
#pragma unroll
                        for (int i = 0; i < 16; ++i) o[(size_t)((i & 3) + 8 * (i >> 2)) * 128] = acc[i]; }
                }
                if (tid < 128) { float a = 0.f;
#pragma unroll 4
                    for (int s = 0; s < 64; ++s) a += sw[s] * kq[s * 128 + tid]; NL[(size_t)(c * 4 + h) * 128 + tid] = a; }
            }
        }
        GRID_BAR(2);
    }

    if (IN(3)) for (int rep_ = 0; rep_ < NREP(3); ++rep_) {
        PHASE_IDS
        if (rep_) xcd_barrier(bar, tid);
#ifndef R_SCAN
#define R_SCAN 1
#endif
        for (int prv_ = 0; prv_ < 1 + PR_VF; ++prv_)
        for (int id = bx; id < 512; id += G) {
            const int h = id >> 7, rt = (id & 127) >> 2, ct = id & 3;
            mini_gemm64(lds, WCO_T + (size_t)(rt * 64) * D + h * 512, D, KC + (size_t)(ct * 64) * 4096 + 2048 + h * 512, 4096u, 4, VF + (size_t)(rt * 64) * 1024 + h * 256 + ct * 64, 1024u, wave, lane);
        }
        for (int prv_ = 0; prv_ < 1 + PR_VF; ++prv_)
        for (int id = bx; id < 512; id += G) {
            const int h = id >> 7, kt = (id & 127) >> 2, mt = id & 3;
            mini_gemm64(lds, KC + (size_t)(mt * 64) * 4096 + h * 512, 4096u, WCQ_T + (size_t)(kt * 64) * D + h * 512, D, 4, MF + (size_t)(h * 256 + mt * 64) * D + kt * 64, D, wave, lane);
        }
        for (int rscan_ = 0; rscan_ < R_SCAN; ++rscan_) {
            LAS float* am = (LAS float*)lds;
            LAS float* sm = am + 512;
            LAS float* gl = am + 1024;
            __syncthreads();
            gl[tid] = GATES[GT_G + tid]; gl[512 + tid] = GATES[GT_MLOC + tid];
            __syncthreads();
            if (tid < 4) { float m = 0.f;
#pragma unroll 1
                for (int k = 0; k < NCH; ++k) { const float g = gl[k * 4 + tid], ml = gl[512 + k * 4 + tid]; const float mn = fmaxf(g + m, ml);
                    am[tid * 128 + k] = __expf(g + m - mn); sm[tid * 128 + k] = __expf(ml - mn); if (bx == 0) GATES[GT_MPREV + k * 4 + tid] = m; m = mn; } }
            __syncthreads();
            for (int e = bx * 512 + tid; e < 4 * 32768; e += G * 512) { const int h = e >> 15, rem = e & 32767; float C = 0.f;
#pragma unroll 1
                for (int kb = 0; kb < NCH; kb += 32) { float l[32];
#pragma unroll
                    for (int i = 0; i < 32; ++i) l[i] = __builtin_nontemporal_load(LST + (size_t)((kb + i) * 4 + h) * 32768 + rem);
#pragma unroll
                    for (int i = 0; i < 32; ++i) { const int k = kb + i; CST[(size_t)(k * 4 + h) * 32768 + rem] = (bf16)f2bf(C); C = am[h * 128 + k] * C + sm[h * 128 + k] * l[i]; } } }
            if (bx == 0) { const int h = tid >> 7, dk = tid & 127; float n = 0.f;
#pragma unroll 1
                for (int kb = 0; kb < NCH; kb += 16) { float l[16];
#pragma unroll
                    for (int i = 0; i < 16; ++i) l[i] = NL[(size_t)((kb + i) * 4 + h) * 128 + dk];
#pragma unroll
                    for (int i = 0; i < 16; ++i) { const int k = kb + i; NST[(size_t)(k * 4 + h) * 128 + dk] = n; n = am[h * 128 + k] * n + sm[h * 128 + k] * l[i]; } } }
            __syncthreads();
        }
        {
            const int r32 = lane & 31, hh = lane >> 5;
#pragma unroll 1
            for (int ui_ = 0; ui_ * G < 1144; ++ui_) {
                const int L = ui_ * G + ((ui_ & 1) ? (G - 1 - bx) : bx); if (L >= 1144) continue;
                int sl = 0, g;
                if (L < 912) { int rem = L;
#pragma unroll 1
                    while (rem >= 226 - 32 * sl) { rem -= 226 - 32 * sl; ++sl; }
                    g = 32 * sl + 30 + rem; }
                else { int q = L - 912, r, j; if (q < 176) { r = 15 - q / 16; j = q % 16; sl = j >> 1; } else { q -= 176; r = 4 - q / 14; j = q % 14; sl = 1 + (j >> 1); }
                    g = 2 * (r - 1 + 16 * sl) + (j & 1); }
                const int c = g >> 1, tq0 = g * 32 + wave * 4, N = 64 * (c + 1);
                const int jb = sl * 32, je = (N >> 5) < jb + 32 ? (N >> 5) : jb + 32;
                if (N <= 256) continue;
                unsigned short* rowb = (c < 127 ? (unsigned short*)A_->out + (size_t)2048 * c * (c + 1) : (unsigned short*)(ws + WS_SC127)) + (size_t)(tq0 & 63) * N + jb * 32;
                LAS unsigned short* stg = (LAS unsigned short*)(lds + wave * 8192);
                bf16x8 af[4]; float wq[16];
                { const bf16* qp = QI + (size_t)(tq0 + (r32 >> 3)) * 512 + (r32 & 7) * 64 + 8 * hh;
#pragma unroll
                  for (int ks = 0; ks < 4; ++ks) af[ks] = *(const bf16x8*)(qp + ks * 16);
#pragma unroll
                  for (int qq = 0; qq < 4; ++qq)
#pragma unroll
                      for (int i = 0; i < 4; ++i) wq[qq * 4 + i] = SMALL[(size_t)(tq0 + qq) * 256 + 64 + 4 * hh + i] * 0.04419417382415922f; }
#define IDX_GROUP(gi_) do { const int tile_ = jb + (gi_) * 8 + wave; if (tile_ < je) { _Pragma("unroll") for (int i4 = 0; i4 < 4; ++i4) { const int row_ = i4 * 8 + (lane >> 3); \
                        const bf16* gsrc_ = KIDXN + (size_t)(tile_ * 32 + row_) * 64 + (((lane & 7) ^ (row_ & 7)) * 8); \
                        const unsigned ldst_ = __builtin_amdgcn_readfirstlane((unsigned)(size_t)lds + 65536u + (unsigned)(((gi_) & 1) * 32768 + wave * 4096 + i4 * 1024)); unsigned keep_; \
                        asm volatile("s_mov_b32 %0, m0\n\ts_mov_b32 m0, %2\n\ts_nop 0\n\tglobal_load_lds_dwordx4 %1, off\n\ts_mov_b32 m0, %0" : "=&s"(keep_) : "v"(gsrc_), "s"(ldst_) : "memory"); } } } while (0)
#define IDX_LOAD(buf, gi_, tl_) do { const LAS unsigned char* kt_ = lds + 65536 + ((gi_) & 1) * 32768 + (tl_) * 4096 + r32 * 128; \
                    _Pragma("unroll") for (int ks = 0; ks < 4; ++ks) buf[ks] = *(const LAS bf16x8*)(kt_ + (((ks * 2 + hh) ^ (r32 & 7)) * 16)); } while (0)
#define RELU_(x_) __int_as_float(max(__float_as_int(x_), 0))
#define IDX_TILE(buf, jj) do { const int s0 = (jj) * 32; f32x16 acc; _Pragma("unroll") for (int i = 0; i < 16; ++i) acc[i] = 0.f; \
                        _Pragma("unroll") for (int ks = 0; ks < 4; ++ks) acc = __builtin_amdgcn_mfma_f32_32x32x16_bf16(af[ks], buf[ks], acc, 0, 0, 0); \
                        if (PR_MFMA) { f32x16 acc2; _Pragma("unroll") for (int i = 0; i < 16; ++i) acc2[i] = 0.f; _Pragma("unroll") for (int ks = 0; ks < 4; ++ks) acc2 = __builtin_amdgcn_mfma_f32_32x32x16_bf16(af[ks], buf[ks], acc2, 0, 0, 0); asm volatile("" :: "v"(acc2)); } \
                        if (PR_EPI) { f32x16 a3 = acc; asm volatile("" : "+v"(a3)); float p3[4]; _Pragma("unroll") for (int qq = 0; qq < 4; ++qq) p3[qq] = (wq[qq * 4] * fmaxf(a3[qq * 4], 0.f) + wq[qq * 4 + 1] * fmaxf(a3[qq * 4 + 1], 0.f)) + (wq[qq * 4 + 2] * fmaxf(a3[qq * 4 + 2], 0.f) + wq[qq * 4 + 3] * fmaxf(a3[qq * 4 + 3], 0.f)); \
                            _Pragma("unroll") for (int qq = 0; qq < 4; ++qq) p3[qq] += __shfl_xor(p3[qq], 32); asm volatile("" :: "v"(p3[0]), "v"(p3[1]), "v"(p3[2]), "v"(p3[3])); } \
                        float part[4]; \
                          \
                        _Pragma("unroll") for (int qq = 0; qq < 4; ++qq) part[qq] = (wq[qq * 4] * RELU_(acc[qq * 4]) + wq[qq * 4 + 1] * RELU_(acc[qq * 4 + 1])) + (wq[qq * 4 + 2] * RELU_(acc[qq * 4 + 2]) + wq[qq * 4 + 3] * RELU_(acc[qq * 4 + 3])); \
                        const auto s02_ = __builtin_amdgcn_permlane32_swap(__float_as_uint(part[0]), __float_as_uint(part[2]), false, false), s13_ = __builtin_amdgcn_permlane32_swap(__float_as_uint(part[1]), __float_as_uint(part[3]), false, false); \
                          \
                        const float v0 = __uint_as_float(s02_[0]) + __uint_as_float(s02_[1]), v1 = __uint_as_float(s13_[0]) + __uint_as_float(s13_[1]); \
                        unsigned u0 = __builtin_bit_cast(unsigned short, (_Float16)v0), u1 = __builtin_bit_cast(unsigned short, (_Float16)v1); \
                        u0 = (u0 == 0x8000u) ? 0u : u0; u1 = (u1 == 0x8000u) ? 0u : u1; \
                        stg[(2 * hh) * 1024 + s0 - jb * 32 + r32] = (unsigned short)((u0 & 0x8000u) ? ~u0 : (u0 | 0x8000u)); \
                        stg[(2 * hh + 1) * 1024 + s0 - jb * 32 + r32] = (unsigned short)((u1 & 0x8000u) ? ~u1 : (u1 | 0x8000u)); } while (0)
                { const int ngrp = (je - jb + 7) >> 3;
                  __syncthreads();
                  IDX_GROUP(0);
#pragma unroll 1
                  for (int gi = 0; gi < ngrp; ++gi) {
                      asm volatile("s_waitcnt vmcnt(0)" ::: "memory");
                      __syncthreads();
                      if (gi + 1 < ngrp) IDX_GROUP(gi + 1);
#pragma unroll 2
                      for (int tl = 0; tl < 8; ++tl) { const int jt = jb + gi * 8 + tl; if (jt < je) { bf16x8 kbf[4]; IDX_LOAD(kbf, gi, tl); IDX_TILE(kbf, jt); } }
                  } }
#undef IDX_GROUP
#undef IDX_LOAD
#undef IDX_TILE
                LDS_WAIT(); asm volatile("" ::: "memory");
                { const int nk = (je - jb) * 32, np = nk >> 3;
                  for (int i = lane; i < 4 * np; i += 64) { const int qq = i / np, p = i - qq * np; *(u32x4*)(rowb + (size_t)qq * N + p * 8) = *(const LAS u32x4*)(stg + qq * 1024 + p * 8); } }
                LDS_WAIT(); asm volatile("" ::: "memory");
            }
        }
        GRID_BAR(3);
    }
    if (IN(4)) for (int rep_ = 0; rep_ < NREP(4); ++rep_) {
        PHASE_IDS
        if (rep_) xcd_barrier(bar, tid);
        {
            LAS int* hist = (LAS int*)(lds + MISC_OFF + 4096) + wave * 256;
            LAS int* sel = (LAS int*)(lds + MISC_OFF + 12288) + wave * 256;
            const int r16 = lane & 15, g4 = lane >> 4;
            __syncthreads();
#pragma unroll 1
            for (int ui_ = 0; ui_ * G < T / 8; ++ui_) {
                const int uu = ui_ * G + ((ui_ & 1) ? (G - 1 - bx) : bx); if (uu >= T / 8) continue;
                const int t0 = uu * 8, t = t0 + wave, c = t0 >> 6, N = (c + 1) * 64, ng = N >> 6;
                {
                        if (N > 256) {
                            const unsigned short* rb = (c < 127 ? (const unsigned short*)A_->out + (size_t)2048 * c * (c + 1) : (const unsigned short*)(ws + WS_SC127)) + (size_t)(t & 63) * N;
                            unsigned kr[128];
#pragma unroll
                            for (int b8 = 0; b8 < 16; ++b8) {
#pragma unroll
                                for (int i = 0; i < 8; ++i) kr[b8 * 8 + i] = 0u;
                                if (b8 * 8 < ng) { const bool ok = b8 * 512 + lane * 8 < N;
                                    u32x4 v = __builtin_nontemporal_load((const GAS u32x4*)(rb + (ok ? b8 * 512 + lane * 8 : 0))); if (!ok) v = (u32x4){0u, 0u, 0u, 0u};
                                    kr[b8 * 8 + 0] = v.x & 0xffffu; kr[b8 * 8 + 1] = v.x >> 16; kr[b8 * 8 + 2] = v.y & 0xffffu; kr[b8 * 8 + 3] = v.y >> 16;
                                    kr[b8 * 8 + 4] = v.z & 0xffffu; kr[b8 * 8 + 5] = v.z >> 16; kr[b8 * 8 + 6] = v.w & 0xffffu; kr[b8 * 8 + 7] = v.w >> 16; } }
                            int krem = 256; unsigned prefix = 0u;
#pragma unroll 1
                            for (int ps = 0; ps < 2; ++ps) { const int shift = 8 - 8 * ps;
                                hist[lane] = 0; hist[64 + lane] = 0; hist[128 + lane] = 0; hist[192 + lane] = 0;
#pragma unroll
                                for (int b8 = 0; b8 < 16; ++b8) { if (b8 * 8 < ng) {
#pragma unroll
                                    for (int i = 0; i < 8; ++i) { const unsigned k = kr[b8 * 8 + i]; const bool mt = (k != 0u) && (ps == 0 || (k >> 8) == prefix);
                                        if (mt) __hip_atomic_fetch_add(hist + (int)((k >> shift) & 255u), 1, __ATOMIC_RELAXED, __HIP_MEMORY_SCOPE_WORKGROUP); } } }
                                const int h0 = hist[4 * lane], h1 = hist[4 * lane + 1], h2 = hist[4 * lane + 2], h3 = hist[4 * lane + 3];
                                int sfx = h0 + h1 + h2 + h3;
#pragma unroll
                                for (int o = 1; o < 64; o <<= 1) { const int v = __shfl_down(sfx, o); if (lane + o < 64) sfx += v; }
                                const unsigned long long mge = __ballot(sfx >= krem);
                                const int ls = 63 - __builtin_clzll(mge);
                                const int above_l = (ls < 63) ? __builtin_amdgcn_readlane(sfx, (ls + 1) & 63) : 0;
                                const int b1 = __builtin_amdgcn_readlane(h1, ls), b2 = __builtin_amdgcn_readlane(h2, ls), b3 = __builtin_amdgcn_readlane(h3, ls);
                                int dg, above;
                                if (above_l + b3 >= krem) { dg = 3; above = above_l; } else if (above_l + b3 + b2 >= krem) { dg = 2; above = above_l + b3; }
                                else if (above_l + b3 + b2 + b1 >= krem) { dg = 1; above = above_l + b3 + b2; } else { dg = 0; above = above_l + b3 + b2 + b1; }
                                krem -= above; prefix = (prefix << 8) | (unsigned)(4 * ls + dg); }
                            const unsigned thr = prefix;
                            int cg = 0; const int thi = (int)thr;
#pragma unroll
                            for (int b8 = 0; b8 < 16; ++b8) { if (b8 * 8 < ng) {
#pragma unroll
                                for (int i = 0; i < 8; ++i) { const int k = (int)kr[b8 * 8 + i]; cg += (int)((unsigned)(thi - k) >> 31); } } }
#pragma unroll
                            for (int o = 1; o < 64; o <<= 1) cg += __shfl_xor(cg, o);
                            const int ngt = __builtin_amdgcn_readfirstlane(cg), need = 256 - ngt;
                            int pg = 0, pe = 0; const unsigned long long ltm = (1ull << lane) - 1ull;
                            const int dump = (int)(((LAS int*)(lds + MISC_OFF + 20480) + wave * 64 + lane) - sel);
#pragma unroll
                            for (int b8 = 0; b8 < 16; ++b8) { if (b8 * 8 < ng) {
#pragma unroll
                                for (int i = 0; i < 8; ++i) { const unsigned k = kr[b8 * 8 + i]; const int sidx = b8 * 512 + lane * 8 + i; const bool gt = k > thr, eq = k == thr;
                                    const unsigned long long mg = __ballot(gt), me = __ballot(eq);
                                    const int pos = (int)__builtin_amdgcn_mbcnt_hi((unsigned)(mg >> 32), __builtin_amdgcn_mbcnt_lo((unsigned)mg, (unsigned)pg));
                                    sel[gt ? pos : dump] = sidx; pg += __popcll(mg);
                                    if (me) { const int r = pe + __popcll(me & ltm); if (eq && r < need) sel[ngt + r] = sidx; pe += __popcll(me); } } } }
                        } else {
#pragma unroll
                            for (int i = 0; i < 4; ++i) sel[i * 64 + lane] = i * 64 + lane;
                        }
                        LDS_WAIT(); asm volatile("" ::: "memory");
                }
                {
                        LAS unsigned char* cb = lds + wave * 16384;
                        const int nch = (N > 256 ? 256 : N) >> 5;
                        bf16x8 qf[8];
                        { const bf16* qp = QABS + (size_t)t * 2048 + (r16 & 7) * 256 + 8 * g4;
#pragma unroll
                          for (int ks = 0; ks < 8; ++ks) qf[ks] = *(const bf16x8*)(qp + ks * 32); }
                        f32x4 O[16];
#pragma unroll
                        for (int i = 0; i < 16; ++i) O[i] = (f32x4){0.f, 0.f, 0.f, 0.f};
                        float mrun = -3.0e38f, lrun = 0.f;
                        const int tq = r16 >> 2, tp = r16 & 3;
#pragma unroll 1
                        for (int ch = 0; ch < nch; ++ch) { const int slot0 = ch * 32;
#pragma unroll
                            for (int k = 0; k < 16; ++k) { const int im = k >> 3, row = (k & 7) * 4 + g4; const int lc = r16 ^ (((row & 3) << 2) | ((row >> 2) & 3)); const int key = sel[slot0 + row];
                                __builtin_amdgcn_global_load_lds((const unsigned*)(CKVN + (size_t)key * 256 + im * 128 + lc * 8), (LAS unsigned*)(cb + im * 8192 + (k & 7) * 1024), 16, 0, 0); }
                            asm volatile("s_waitcnt vmcnt(0)" ::: "memory");
                            const LAS unsigned char* cbc = cb;
                            f32x4 s0 = (f32x4){0.f, 0.f, 0.f, 0.f}, s1 = s0;
#pragma unroll
                            for (int ks = 0; ks < 8; ++ks) { const int im = ks >> 2, lc = 4 * (ks & 3) + g4;
                                const int ra = r16, rb = 16 + r16;
                                const bf16x8 k0 = *(const LAS bf16x8*)(cbc + im * 8192 + 256 * ra + 16 * (lc ^ (((ra & 3) << 2) | ((ra >> 2) & 3))));
                                const bf16x8 k1 = *(const LAS bf16x8*)(cbc + im * 8192 + 256 * rb + 16 * (lc ^ (((rb & 3) << 2) | ((rb >> 2) & 3))));
                                s0 = __builtin_amdgcn_mfma_f32_16x16x32_bf16(k0, qf[ks], s0, 0, 0, 0); s1 = __builtin_amdgcn_mfma_f32_16x16x32_bf16(k1, qf[ks], s1, 0, 0, 0);
                                if ((ks & 1) == 1) __builtin_amdgcn_sched_barrier(0); }
                            float mx = fmaxf(fmaxf(fmaxf(s0[0], s0[1]), fmaxf(s0[2], s0[3])), fmaxf(fmaxf(s1[0], s1[1]), fmaxf(s1[2], s1[3])));
                            mx = fmaxf(mx, __shfl_xor(mx, 16)); mx = fmaxf(mx, __shfl_xor(mx, 32));
                            const float mnew = fmaxf(mrun, mx), alpha = __expf(mrun - mnew); mrun = mnew;
                            float p[8]; float ls = 0.f;
#pragma unroll
                            for (int i = 0; i < 4; ++i) { p[i] = __expf(s0[i] - mnew); p[4 + i] = __expf(s1[i] - mnew); ls += p[i] + p[4 + i]; }
                            ls += __shfl_xor(ls, 16); ls += __shfl_xor(ls, 32);
                            lrun = lrun * alpha + ls;
                            u32x4 pw; pw.x = pk2(p[0], p[1]); pw.y = pk2(p[2], p[3]); pw.z = pk2(p[4], p[5]); pw.w = pk2(p[6], p[7]);
                            const bf16x8 pf = __builtin_bit_cast(bf16x8, pw);
#pragma unroll
                            for (int i = 0; i < 16; ++i) O[i] = O[i] * alpha;
                            const unsigned cbase = (unsigned)(size_t)cbc + 256u * (4 * g4 + tq) + 8u * (tp & 1);
#pragma unroll
                            for (int cq = 0; cq < 4; ++cq) {
                                u32x2 va[4], vb[4]; unsigned ad[4];
#pragma unroll
                                for (int j = 0; j < 4; ++j) { const int ct = cq * 4 + j; ad[j] = cbase + (unsigned)((ct >> 3) * 8192) + 16u * ((2 * (ct & 7) + (tp >> 1)) ^ ((tq << 2) | g4)); }
                                asm volatile("ds_read_b64_tr_b16 %0, %8\n\tds_read_b64_tr_b16 %1, %8 offset:4096\n\tds_read_b64_tr_b16 %2, %9\n\tds_read_b64_tr_b16 %3, %9 offset:4096\n\t"
                                             "ds_read_b64_tr_b16 %4, %10\n\tds_read_b64_tr_b16 %5, %10 offset:4096\n\tds_read_b64_tr_b16 %6, %11\n\tds_read_b64_tr_b16 %7, %11 offset:4096\n\ts_waitcnt lgkmcnt(0)"
                                             : "=&v"(va[0]), "=&v"(vb[0]), "=&v"(va[1]), "=&v"(vb[1]), "=&v"(va[2]), "=&v"(vb[2]), "=&v"(va[3]), "=&v"(vb[3])
                                             : "v"(ad[0]), "v"(ad[1]), "v"(ad[2]), "v"(ad[3]) : "memory");
#pragma unroll
                                for (int j = 0; j < 4; ++j) { u32x4 vv; vv.x = va[j].x; vv.y = va[j].y; vv.z = vb[j].x; vv.w = vb[j].y;
                                    O[cq * 4 + j] = __builtin_amdgcn_mfma_f32_16x16x32_bf16(__builtin_bit_cast(bf16x8, vv), pf, O[cq * 4 + j], 0, 0, 0); } }
                        }
                        const float inv = 1.f / lrun;
                        if (r16 < 8) {
#pragma unroll
                            for (int i = 0; i < 16; ++i) { u32x2 w; w.x = pk2(O[i][0] * inv, O[i][1] * inv); w.y = pk2(O[i][2] * inv, O[i][3] * inv); __builtin_nontemporal_store(w, (u32x2*)(MIXIN + (size_t)t * KMIX + r16 * 256 + i * 16 + 4 * g4)); } }
                }
            }
        }
        __syncthreads();
    }

    if (IN(4)) for (int rep_ = 0; rep_ < NREP(4); ++rep_) {
        PHASE_IDS
        if (rep_) xcd_barrier(bar, tid);
        LAS float* Sf = (LAS float*)lds;
        LAS bf16* Sb = (LAS bf16*)(lds + 16640);
        LAS float* ms = (LAS float*)(lds + 25856);
        LAS float* ssq = (LAS float*)(lds + 27904);
        const float* mlg = A_->in[I_ML_NORM_G];
        const int r32 = lane & 31, hh = lane >> 5;
        for (int uu = bx; uu < NCH * 4; uu += G) {
            const int c = uu >> 2, h = uu & 3, t0 = c * CH;
            __syncthreads();
            if (tid < 64) { const float b = GATES[GT_B + (size_t)(t0 + tid) * 4 + h], li = GATES[GT_LI + (size_t)(t0 + tid) * 4 + h]; ms[tid] = b; ms[64 + tid] = li - b; }
            if (tid < 128) ms[384 + tid] = NST[(size_t)(c * 4 + h) * 128 + tid];
            __syncthreads();
            float mt = 0.f;
            if (wave == 0) { const float mprev = GATES[GT_MPREV + c * 4 + h]; float pm = ms[64 + lane];
#pragma unroll
                for (int o = 1; o < 64; o <<= 1) { const float v = __shfl_up(pm, o); if (lane >= o) pm = fmaxf(pm, v); }
                const float mm = fmaxf(mprev, pm); mt = ms[lane] + mm; ms[128 + lane] = -mm; ms[192 + lane] = __expf(mprev - mm);
                float qn = 0.f; const bf16* qr = QCM + (size_t)(t0 + lane) * 512 + h * 128; u32x4 qq[16];
#pragma unroll
                for (int k8 = 0; k8 < 16; ++k8) qq[k8] = *(const u32x4*)(qr + k8 * 8);
#pragma unroll
                for (int k8 = 0; k8 < 16; ++k8) { const LAS float* np = ms + 384 + k8 * 8;
                    qn += (bf2f(qq[k8].x & 0xffffu) * np[0] + bf2f(qq[k8].x >> 16) * np[1]) + (bf2f(qq[k8].y & 0xffffu) * np[2] + bf2f(qq[k8].y >> 16) * np[3]) + (bf2f(qq[k8].z & 0xffffu) * np[4] + bf2f(qq[k8].z >> 16) * np[5]) + (bf2f(qq[k8].w & 0xffffu) * np[6] + bf2f(qq[k8].w >> 16) * np[7]); }
                ms[320 + lane] = qn; }
            __syncthreads();
            if (wave < 4) {
                const int tm = wave >> 1, tn = wave & 1;
                f32x16 acc;
#pragma unroll
                for (int i = 0; i < 16; ++i) acc[i] = 0.f;
                if (tn <= tm) { const bf16* qr = QCM + (size_t)(t0 + tm * 32 + r32) * 512 + h * 128 + 8 * hh; const bf16* kr = KCM + (size_t)(t0 + tn * 32 + r32) * 512 + h * 128 + 8 * hh;
#pragma unroll
                    for (int ks = 0; ks < 8; ++ks) acc = __builtin_amdgcn_mfma_f32_32x32x16_bf16(*(const bf16x8*)(qr + ks * 16), *(const bf16x8*)(kr + ks * 16), acc, 0, 0, 0); }
                const int sidx = tn * 32 + r32; const float us = ms[64 + sidx];
#pragma unroll
                for (int i = 0; i < 16; ++i) { const int t = tm * 32 + (i & 3) + 8 * (i >> 2) + 4 * hh; const float v = (sidx <= t) ? acc[i] * __expf(ms[128 + t] + us) : 0.f; Sf[t * 65 + sidx] = v; Sb[t * 72 + sidx] = (bf16)f2bf(v); }
            }
            __syncthreads();
            if (tid < 64) { float rs = 0.f;
#pragma unroll 4
                for (int s2 = 0; s2 < 64; ++s2) rs += Sf[tid * 65 + s2];
                const float dn = ms[192 + tid] * ms[320 + tid] + rs; ms[256 + tid] = fmaxf(fabsf(dn), __expf(-mt)); }
            f32x16 a1[2], a2[2];
#pragma unroll
            for (int tt = 0; tt < 2; ++tt)
#pragma unroll
                for (int i = 0; i < 16; ++i) { a1[tt][i] = 0.f; a2[tt][i] = 0.f; }
            { const bf16* cr = CST + ((size_t)(c * 4 + h) * 256 + wave * 32 + r32) * 128 + 8 * hh; const bf16* q0 = QCM + (size_t)(t0 + r32) * 512 + h * 128 + 8 * hh; const bf16* q1 = q0 + (size_t)32 * 512;
#pragma unroll
              for (int ks = 0; ks < 8; ++ks) { const bf16x8 cf = *(const bf16x8*)(cr + ks * 16); a1[0] = __builtin_amdgcn_mfma_f32_32x32x16_bf16(cf, *(const bf16x8*)(q0 + ks * 16), a1[0], 0, 0, 0); a1[1] = __builtin_amdgcn_mfma_f32_32x32x16_bf16(cf, *(const bf16x8*)(q1 + ks * 16), a1[1], 0, 0, 0); }
              const bf16* vr = VTM + ((size_t)(c * 4 + h) * 256 + wave * 32 + r32) * 64 + 8 * hh;
#pragma unroll
              for (int ks = 0; ks < 4; ++ks) { const bf16x8 vf = *(const bf16x8*)(vr + ks * 16); a2[0] = __builtin_amdgcn_mfma_f32_32x32x16_bf16(vf, *(const LAS bf16x8*)(Sb + r32 * 72 + ks * 16 + 8 * hh), a2[0], 0, 0, 0); a2[1] = __builtin_amdgcn_mfma_f32_32x32x16_bf16(vf, *(const LAS bf16x8*)(Sb + (32 + r32) * 72 + ks * 16 + 8 * hh), a2[1], 0, 0, 0); } }
            __syncthreads();
#pragma unroll
            for (int tt = 0; tt < 2; ++tt) { const int t = tt * 32 + r32; const float ai = ms[192 + t], idn = 1.f / ms[256 + t]; float p = 0.f;
#pragma unroll
                for (int i = 0; i < 16; ++i) { const float v = (ai * a1[tt][i] + a2[tt][i]) * idn; a1[tt][i] = v; p += v * v; }
                p += __shfl_xor(p, 32); if (hh == 0) ssq[wave * 64 + t] = p; }
            __syncthreads();
#pragma unroll
            for (int tt = 0; tt < 2; ++tt) { const int t = tt * 32 + r32; float sq = 0.f;
#pragma unroll
                for (int w2 = 0; w2 < 8; ++w2) sq += ssq[w2 * 64 + t];
                const float r = rsqrtf(sq * (1.f / 256.f) + EPS);
#pragma unroll
                for (int rq = 0; rq < 4; ++rq) { const int dv0 = h * 256 + wave * 32 + 8 * rq + 4 * hh; const f32x4 g = *(const f32x4*)(mlg + dv0); const u32x2 ob = *(const u32x2*)(MO + (size_t)(t0 + t) * 1024 + dv0);
                    const float o0 = bf2f(ob.x & 0xffffu), o1 = bf2f(ob.x >> 16), o2 = bf2f(ob.y & 0xffffu), o3 = bf2f(ob.y >> 16);
                    u32x2 w; w.x = pk2(a1[tt][4 * rq] * r * g[0] / (1.f + __expf(-o0)), a1[tt][4 * rq + 1] * r * g[1] / (1.f + __expf(-o1))); w.y = pk2(a1[tt][4 * rq + 2] * r * g[2] / (1.f + __expf(-o2)), a1[tt][4 * rq + 3] * r * g[3] / (1.f + __expf(-o3)));
                    *(u32x2*)(MIXIN + (size_t)(t0 + t) * KMIX + 2048 + dv0) = w; } }
        }
        GRID_BAR(4);
    }

    if (IN(6)) for (int rep_ = 0; rep_ < NREP(6); ++rep_) {
        PHASE_IDS
        if (rep_) xcd_barrier(bar, tid);
        pg8::DenseOrder S; S.init(T, D, KMIX, KMIX, G, bx);
        pg8::EpiResidT<false> E{A_->in[I_X], X1B, SS2};
        pg8::gemm_phase(tid, lds, MIXIN, WOUT_T, KMIX, S, E);
        GRID_BAR(6);
    }
    if (IN(7)) for (int rep_ = 0; rep_ < NREP(7); ++rep_) {
        PHASE_IDS
        if (rep_) xcd_barrier(bar, tid);
        pg8::DenseOrder S; S.init(T, 1024, D, D, G, bx);
        pg8::EpiSoftmax E{PB, SS2};
        pg8::gemm_phase(tid, lds, X1B, MF, D, S, E);
        { const int nidle = G > 128 ? G - 128 : G, ib = G > 128 ? bx - 128 : bx;
          if (ib >= 0) { LAS unsigned char* scr8 = lds + wave * 16384; __syncthreads();
              for (int r = ib * 8 + wave; r < 32 * 256; r += nidle * 8) { const int e = r / 256, q = r % 256, kb = q / 32, nb = q % 32;
                  tr_item64(A_->in[I_W_DOWN] + (size_t)e * DEXP * D, D, 64 * kb, 64 * nb, nullptr, WDN_T + (size_t)e * D * DEXP, DEXP, 0, 0, scr8, lane); } } }
        GRID_BAR(7);
    }
    if (IN(10)) for (int rep_ = 0; rep_ < NREP(10); ++rep_) {
        PHASE_IDS
        if (rep_) xcd_barrier(bar, tid);
        pg8::DenseOrder S; S.init(T, D, 1024, 1024, G, bx);
        pg8::EpiResidT<true> E{X1B, X2B, nullptr};
        pg8::gemm_phase(tid, lds, PB, VF, 1024, S, E);
        GRID_BAR(10);
    }
    if (IN(11)) for (int rep_ = 0; rep_ < NREP(11); ++rep_) {
        PHASE_IDS
        if (rep_) xcd_barrier(bar, tid);
        LAS float* part = (LAS float*)lds;
        LAS float* ssp = (LAS float*)(lds + 24576);
        LAS int* eb = (LAS int*)(lds + 24576 + 512);
        const int r16 = lane & 15, g4 = lane >> 4;
        for (int uu = bx; uu < T / 32; uu += G) {
            const int t0 = uu * 32; const int tt = wave & 1, ksl = wave >> 1;
            __syncthreads();
            {
                f32x4 acc[3];
#pragma unroll
                for (int i = 0; i < 3; ++i) acc[i] = (f32x4){0.f, 0.f, 0.f, 0.f};
                float ssq = 0.f;
                const bf16* xr = X2B + (size_t)(t0 + tt * 16 + r16) * D + ksl * 512 + 8 * g4;
                const bf16* wh = WRH + (size_t)r16 * D + ksl * 512 + 8 * g4; const bf16* wl = WRL + (size_t)r16 * D + ksl * 512 + 8 * g4;
#pragma unroll 4
                for (int ks = 0; ks < 16; ++ks) { const u32x4 xa = *(const u32x4*)(xr + ks * 32);
                    { const float f0 = bf2f(xa.x & 0xffffu), f1 = bf2f(xa.x >> 16), f2 = bf2f(xa.y & 0xffffu), f3 = bf2f(xa.y >> 16), f4 = bf2f(xa.z & 0xffffu), f5 = bf2f(xa.z >> 16), f6 = bf2f(xa.w & 0xffffu), f7 = bf2f(xa.w >> 16);
                      ssq += ((f0 * f0 + f1 * f1) + (f2 * f2 + f3 * f3)) + ((f4 * f4 + f5 * f5) + (f6 * f6 + f7 * f7)); }
                    const bf16x8 Ah = __builtin_bit_cast(bf16x8, xa);
#pragma unroll
                    for (int nt = 0; nt < 3; ++nt) { const bf16x8 Bh = *(const bf16x8*)(wh + (size_t)nt * 16 * D + ks * 32), Bl = *(const bf16x8*)(wl + (size_t)nt * 16 * D + ks * 32);
                        acc[nt] = __builtin_amdgcn_mfma_f32_16x16x32_bf16(Ah, Bh, acc[nt], 0, 0, 0); acc[nt] = __builtin_amdgcn_mfma_f32_16x16x32_bf16(Ah, Bl, acc[nt], 0, 0, 0); } }
#pragma unroll
                for (int nt = 0; nt < 3; ++nt)
#pragma unroll
                    for (int i = 0; i < 4; ++i) part[(ksl * 32 + tt * 16 + 4 * g4 + i) * 48 + nt * 16 + r16] = acc[nt][i];
                ssq += __shfl_xor(ssq, 16); ssq += __shfl_xor(ssq, 32);
                if (g4 == 0) ssp[ksl * 32 + tt * 16 + r16] = ssq;
            }
            __syncthreads();
            int e1 = 0, e2 = 0;
            if (tid < 32) { const int t = t0 + tid; const float rstd = rsqrtf((ssp[tid] + ssp[32 + tid] + ssp[64 + tid] + ssp[96 + tid]) * (1.f / D) + EPS);
                const LAS float* p0 = part + tid * 48;
#define LG(o) ((p0[(o)] + p0[32 * 48 + (o)] + p0[64 * 48 + (o)] + p0[96 * 48 + (o)]) * rstd)
                int gs = 0; float gmax = LG(0) + A_->in[I_B_GROUP][0]; float gv[4]; gv[0] = gmax;
#pragma unroll
                for (int i = 1; i < 4; ++i) { gv[i] = LG(i) + A_->in[I_B_GROUP][i]; if (gv[i] > gmax) { gmax = gv[i]; gs = i; } }
                float gsum = 0.f;
#pragma unroll
                for (int i = 0; i < 4; ++i) gsum += __expf(gv[i] - gmax);
                const float pg = 1.f / gsum;
                int i1 = 0, i2 = 0; float v1 = -3.0e38f, v2 = -3.0e38f;
#pragma unroll 1
                for (int i = 0; i < 8; ++i) { const float ev = LG(4 + gs * 8 + i) + A_->in[I_B_ROUTER][gs * 8 + i];
                    if (ev > v1) { v2 = v1; i2 = i1; v1 = ev; i1 = i; } else if (ev > v2) { v2 = ev; i2 = i; } }
#undef LG
                const float p2 = __expf(v2 - v1); const float g1 = pg / (1.f + p2), g2 = pg * p2 / (1.f + p2);
                e1 = gs * 8 + i1; e2 = gs * 8 + i2;
                eb[2 * tid] = e1; eb[2 * tid + 1] = e2;
                TOKW[2 * t] = g1; TOKW[2 * t + 1] = g2; RSTD3[t] = rstd; }
            __syncthreads();
            LAS int* ebase = eb + 64;
            if (tid >= 64 && tid < 96) { const int e = tid - 64; int c = 0;
#pragma unroll 1
                for (int a2 = 0; a2 < 64; ++a2) c += (eb[a2] == e) ? 1 : 0;
                ebase[e] = c ? atomicAdd(CNT + e, c) : 0; }
            __syncthreads();
            if (tid < 64) { const int e = eb[tid]; int rk = 0;
#pragma unroll 1
                for (int a2 = 0; a2 < tid; ++a2) rk += (eb[a2] == e) ? 1 : 0;
                const int slot = ebase[e] + rk; LIST[e * T + slot] = t0 + (tid >> 1); TOKE[2 * t0 + tid] = e * T + slot; }
        }
        GRID_BAR(11);
    }
    volatile LAS int* cnl = (volatile LAS int*)(MISC + 64); volatile LAS int* prel = (volatile LAS int*)(MISC + 128); volatile LAS int* tbl = (volatile LAS int*)(MISC + 192);
    volatile LAS int* mtl = (volatile LAS int*)(MISC + 256); volatile LAS int* tlr = (volatile LAS int*)(MISC + 288); volatile LAS int* tpre = (volatile LAS int*)(MISC + 320); volatile LAS int* fll = (volatile LAS int*)(MISC + 384);
    constexpr int MOE_TAIL = 96;
#define MOE_TABLES(ncol) do { __syncthreads(); if (tid < 64) { const int e = tid & 31; const int c = __hip_atomic_load(CNT + e, __ATOMIC_RELAXED, __HIP_MEMORY_SCOPE_AGENT);     \
        const int full = c >> 8, mt = (c + 255) >> 8; int p = mt * (ncol), tb = mt; \
        _Pragma("unroll") for (int d_ = 1; d_ < 32; d_ <<= 1) { const int q_ = __shfl_up(p, d_), r_ = __shfl_up(tb, d_); if (e >= d_) { p += q_; tb += r_; } } \
        if (tid < 32) { cnl[e] = c; prel[e] = p - mt * (ncol); tbl[e] = tb - mt; mtl[e] = mt; tlr[e] = 0; tpre[e] = 0; fll[e] = full; if (e == 31) { prel[32] = p; tbl[32] = tb; tpre[32] = 0; } } } __syncthreads(); } while (0)
#define MOE_GU(Lb, Le, nbk, cc) do { pg8::MoeOrder S{tbl, cnl, LIST, 4, (Lb), (Le), (nbk), (cc), (unsigned)D * 2u, (size_t)1024 * D * 2, (unsigned)D * 2u, 1}; \
        pg8::EpiSwiGLU E{ACT, LIST, RSTD3, cnl}; pg8::gemm_phase(tid, lds, X2B, WGU_T, D, S, E); } while (0)
#define MOE_DN(Lb, Le, nbk, cc) do { pg8::MoeOrder S{tbl, cnl, LIST, 8, (Lb), (Le), (nbk), (cc), (unsigned)DEXP * 2u, (size_t)D * DEXP * 2, (unsigned)DEXP * 2u, 0}; \
        pg8::EpiBf16 E{Y, D}; pg8::gemm_phase(tid, lds, ACT, WDN_T, DEXP, S, E); } while (0)
    if (IN(13)) for (int rep_ = 0; rep_ < NREP(13); ++rep_) {
        PHASE_IDS
        if (rep_) xcd_barrier(bar, tid);
        MOE_TABLES(4);
        const int U1 = tbl[32] * 4;
        MOE_GU(0, U1 < G ? U1 : G, G, bx);
        GRID_BAR(13);
    }
    if (IN(14)) for (int rep_ = 0; rep_ < NREP(14); ++rep_) {
        PHASE_IDS
        if (rep_) xcd_barrier(bar, tid);
        MOE_TABLES(4);
        const int RT = tbl[32], U1 = RT * 4; const int nb0 = U1 > G ? ((U1 - G) < G ? (U1 - G) : G) : 0; const int rta = (U1 < G ? U1 : G) >> 2;
        if (bx < nb0) MOE_GU(G, U1, nb0, bx);
        else MOE_DN(0, rta * 8, G - nb0, bx - nb0);
        GRID_BAR(14);
    }
    if (IN(15)) for (int rep_ = 0; rep_ < NREP(15); ++rep_) {
        PHASE_IDS
        if (rep_) xcd_barrier(bar, tid);
        MOE_TABLES(8);
        const int RT = tbl[32], U1 = RT * 4; const int rta = (U1 < G ? U1 : G) >> 2;
        MOE_DN(rta * 8, RT * 8, G, bx);
        GRID_BAR(15);
    }
    if (IN(16)) for (int rep_ = 0; rep_ < NREP(16); ++rep_) {
        PHASE_IDS
        if (rep_) xcd_barrier(bar, tid);
        MOE_TABLES(1);
        const float* fg = A_->in[I_FINAL_G];
        int a0n = 0, a1n = 0; float w0n = 0.f, w1n = 0.f;
        if (gw < T) { a0n = TOKE[2 * gw]; a1n = TOKE[2 * gw + 1]; w0n = TOKW[2 * gw]; w1n = TOKW[2 * gw + 1]; }
#pragma unroll 1
        for (int t = gw; t < T; t += NGW) {
            const int a0 = a0n, a1 = a1n; const float w0 = w0n, w1 = w1n;
            { const int tn = t + NGW; if (tn < T) { a0n = TOKE[2 * tn]; a1n = TOKE[2 * tn + 1]; w0n = TOKW[2 * tn]; w1n = TOKW[2 * tn + 1]; } }
            const size_t r0 = (size_t)tbl[a0 / T] * 256 + (a0 % T), r1 = (size_t)tbl[a1 / T] * 256 + (a1 % T);
            const u32x2* xr = (const u32x2*)(X2B + (size_t)t * D) + lane; f32x4* xo = (rep_ == NREP(16) - 1) ? (f32x4*)(A_->out + (size_t)t * D) + lane : (f32x4*)((float*)(ws + WS_X1B) + (size_t)t * D) + lane; const u32x2* y0 = (const u32x2*)(Y + r0 * D) + lane; const u32x2* y1 = (const u32x2*)(Y + r1 * D) + lane;
            f32x4 v[8]; float s = 0.f;
#pragma unroll
            for (int j = 0; j < 8; ++j) { const u32x2 xq = xr[64 * j]; v[j] = (f32x4){bf2f(xq.x & 0xffffu), bf2f(xq.x >> 16), bf2f(xq.y & 0xffffu), bf2f(xq.y >> 16)}; const u32x2 p = y0[64 * j], q = y1[64 * j];
                v[j][0] += w0 * bf2f(p.x & 0xffffu) + w1 * bf2f(q.x & 0xffffu); v[j][1] += w0 * bf2f(p.x >> 16) + w1 * bf2f(q.x >> 16);
                v[j][2] += w0 * bf2f(p.y & 0xffffu) + w1 * bf2f(q.y & 0xffffu); v[j][3] += w0 * bf2f(p.y >> 16) + w1 * bf2f(q.y >> 16);
                s += (v[j][0] * v[j][0] + v[j][1] * v[j][1]) + (v[j][2] * v[j][2] + v[j][3] * v[j][3]); }
            const float r = rsqrtf(wave_sum(s) * (1.f / D) + EPS);
#pragma unroll
            for (int j = 0; j < 8; ++j) { const f32x4 g = ((const f32x4*)fg)[lane + 64 * j]; xo[64 * j] = (f32x4){v[j][0] * r * g[0], v[j][1] * r * g[1], v[j][2] * r * g[2], v[j][3] * r * g[3]}; }
        }
    }
#undef IN
#undef BOTH
#undef GRID_BAR
}

extern "C" void kernel_launch(void* const* d_in, const int* in_sizes, int n_in, void* d_out, int out_size, void* d_ws, size_t ws_size, hipStream_t stream) {
    static int grid = 0;
    if (grid == 0) {
        if (n_in != 27 || out_size != T * D || ws_size < WS_END) { fprintf(stderr, "kernel_launch: unexpected problem (n_in %d out %d ws %zu)\n", n_in, out_size, ws_size); grid = -1; return; }
        int dev = 0, cus = 0, per_cu = 0;
        if (hipGetDevice(&dev) != hipSuccess || hipDeviceGetAttribute(&cus, hipDeviceAttributeMultiprocessorCount, dev) != hipSuccess) { grid = -1; return; }
        if (hipFuncSetAttribute((const void*)mega, hipFuncAttributeMaxDynamicSharedMemorySize, LDS_BYTES) != hipSuccess) { fprintf(stderr, "kernel_launch: hipFuncSetAttribute failed\n"); grid = -1; return; }
        if (hipOccupancyMaxActiveBlocksPerMultiprocessor(&per_cu, (const void*)mega, 512, LDS_BYTES) != hipSuccess || per_cu < 1) fprintf(stderr, "kernel_launch: occupancy query reports %d\n", per_cu);
        (void)hipGetLastError();
        grid = cus;
    }
    if (grid < 0) return;
    if (hipMemsetAsync((char*)d_ws + WS_CTL, 0, CTL_ZERO_BYTES, stream) != hipSuccess) return;
    Args a{};
    for (int i = 0; i < 27; ++i) a.in[i] = (const float*)d_in[i];
    a.out = (float*)d_out; a.ws = (unsigned char*)d_ws;
    if (MK_N_LAUNCHES == 1) { a.ph_lo = 0; a.ph_hi = NPHASE; hipLaunchKernelGGL(mega, dim3(grid), dim3(512), LDS_BYTES, stream, a); }
    else { for (int p = 0; p < NPHASE; ++p) { a.ph_lo = p; a.ph_hi = p + 1; hipLaunchKernelGGL(mega, dim3(grid), dim3(512), LDS_BYTES, stream, a); } }
}
```

```cpp
#include <hip/hip_runtime.h>
#include <cstdio>
#include <cstdint>

#ifndef MK_N_LAUNCHES
#define MK_N_LAUNCHES 1
#endif

#define GAS __attribute__((address_space(1)))
#define LAS __attribute__((address_space(3)))
typedef unsigned short bf16;
typedef short bf16x8 __attribute__((ext_vector_type(8)));
typedef float f32x4 __attribute__((ext_vector_type(4)));
typedef float f32x2 __attribute__((ext_vector_type(2)));
typedef float f32x16 __attribute__((ext_vector_type(16)));
typedef unsigned u32x4 __attribute__((ext_vector_type(4)));
typedef unsigned u32x2 __attribute__((ext_vector_type(2)));

constexpr int T = 8192, D = 2048, NMEM = 256;
constexpr int D_IN = 4944;
constexpr int NPROJ = 6144;
constexpr int KMIX = 3072;
constexpr int NCH = 128, CH = 64;
constexpr int NEXP = 32, DEXP = 512;
constexpr float EPS = 1e-6f;
constexpr int NPHASE = 17;

constexpr size_t MiB = 1u << 20;
constexpr size_t WS_CTL = 0, CTL_ZERO_BYTES = 256 * 1024;
constexpr size_t WS_WOUT_T = 1 * MiB;
constexpr size_t WS_WCQ_T = 13 * MiB;
constexpr size_t WS_WCKV_T = 21 * MiB;
constexpr size_t WS_WCO_T = 37 * MiB;
constexpr size_t WS_WGU_T = 45 * MiB;
constexpr size_t WS_WDN_T = 173 * MiB;
constexpr size_t WS_WIN_T = 237 * MiB;
constexpr size_t WS_H1 = 261 * MiB;
constexpr size_t WS_MIXIN = 237 * MiB;
constexpr size_t WS_SC127 = 285 * MiB;
constexpr size_t WS_MEMN = 293 * MiB;
constexpr size_t WS_KC = 294 * MiB;
constexpr size_t WS_VT = 295 * MiB;
constexpr size_t WS_GATES = 296 * MiB;
constexpr size_t WS_WR = 297 * MiB;
constexpr size_t WS_QABS = 298 * MiB;
constexpr size_t WS_CKVRAW = 330 * MiB;
constexpr size_t WS_QI = 338 * MiB;
constexpr size_t WS_SMALL = 346 * MiB;
constexpr size_t WS_MQKRAW = 354 * MiB;
constexpr size_t WS_MV = 386 * MiB;
constexpr size_t WS_MO = 402 * MiB;
constexpr size_t WS_CKVN = 418 * MiB;
constexpr size_t WS_KIDXN = 422 * MiB;
constexpr size_t WS_QCM = 423 * MiB;
constexpr size_t WS_KCM = 431 * MiB;
constexpr size_t WS_LST = 439 * MiB;
constexpr size_t WS_NL = 503 * MiB;
constexpr size_t WS_CST = 504 * MiB;
constexpr size_t WS_VTM = 536 * MiB;
constexpr size_t WS_X1B = 298 * MiB;
constexpr size_t WS_QC = 330 * MiB;
constexpr size_t WS_OC = 362 * MiB;
constexpr size_t WS_X2B = 394 * MiB;
constexpr size_t WS_LIST = 426 * MiB;
constexpr size_t WS_TOK = 427 * MiB;
constexpr size_t WS_ACT = 428 * MiB;
constexpr size_t WS_Y = 452 * MiB;
constexpr size_t WS_END = 552 * MiB;
constexpr int GT_B = 0;
constexpr int GT_LI = T * 4;
constexpr int GT_G = 2 * T * 4;
constexpr int GT_MLOC = GT_G + 512;
constexpr int GT_MPREV = GT_MLOC + 512;
constexpr int CW_BAR = 4096;
constexpr int CW_CNT = 8192;
constexpr int CW_SS2 = 16384;
static_assert((CW_SS2 + T) * 4 <= (int)CTL_ZERO_BYTES, "ctl");

constexpr int RING_BYTES = 131072;
constexpr int MISC_OFF = RING_BYTES;
constexpr int LDS_BYTES = 159744;

__device__ __forceinline__ float bf2f(unsigned b) { return __uint_as_float(b << 16); }
typedef __bf16 hwbf16x2 __attribute__((ext_vector_type(2)));
__device__ __forceinline__ unsigned pk2(float lo, float hi) { f32x2 v; v.x = lo; v.y = hi; return __builtin_bit_cast(unsigned, __builtin_convertvector(v, hwbf16x2)); }
__device__ __forceinline__ unsigned f2bf(float f) { return pk2(f, 0.f) & 0xffffu; }
__device__ __forceinline__ float wave_sum(float v) {
#pragma unroll
    for (int o = 1; o < 64; o <<= 1) v += __shfl_xor(v, o);
    return v;
}
__device__ __forceinline__ float wave_max(float v) {
#pragma unroll
    for (int o = 1; o < 64; o <<= 1) v = fmaxf(v, __shfl_xor(v, o));
    return v;
}
#define LDS_WAIT() asm volatile("s_waitcnt lgkmcnt(0)" ::: "memory")

#define XB_TMO      128
#define XB_XCNT(j)  (256  + 64 * (j))
#define XB_XSUB(j)  (1280 + 64 * (j))
#define XB_XGEN(j)  (2304 + 64 * (j))
#define XB_TOP      3328
#define XB_TOPGEN   3392
#define XCD_BAR_WORDS 3456
#define XB_SPIN_CAP (1u << 18)
__device__ __forceinline__ unsigned xb_ld(unsigned* p)              { return __hip_atomic_load(p, __ATOMIC_RELAXED, __HIP_MEMORY_SCOPE_AGENT); }
__device__ __forceinline__ unsigned xb_add(unsigned* p, unsigned v) { return __hip_atomic_fetch_add(p, v, __ATOMIC_RELAXED, __HIP_MEMORY_SCOPE_AGENT); }
__device__ __forceinline__ unsigned xb_xcc_id() { return (unsigned)__builtin_amdgcn_s_getreg((3 << 11) | 20) & 0xFu; }
#define XB_SPIN(cond, bar) do { unsigned _sp = 0; while (cond) { __builtin_amdgcn_s_sleep(1); \
    if ((++_sp & 255u) == 0u) { if (xb_ld(&(bar)[XB_TMO])) break; if (_sp > XB_SPIN_CAP) { atomicAdd(&(bar)[XB_TMO], 1u); break; } } } } while (0)
struct XcdBarrier { unsigned* bar; unsigned x; volatile LAS unsigned* st; };
__device__ __forceinline__ XcdBarrier xcd_barrier_post(unsigned* bar, volatile LAS unsigned* st) {
    XcdBarrier b; b.bar = bar; b.x = xb_xcc_id(); b.st = st;
    if (threadIdx.x == 0) (void)xb_add(&bar[XB_XCNT(b.x)], 1u);
    return b;
}
__device__ __forceinline__ void xcd_barrier_complete(unsigned* bar, unsigned x, unsigned& nloc, unsigned& nx) {
    const unsigned G = gridDim.x * gridDim.y * gridDim.z;
    unsigned sum, cnt, mine, sp = 0u;
    for (;;) {
        sum = 0u; cnt = 0u; mine = 0u;
#pragma unroll
        for (unsigned j = 0; j < 16; ++j) { const unsigned c = xb_ld(&bar[XB_XCNT(j)]); sum += c; cnt += (c > 0u) ? 1u : 0u; mine = (j == x) ? c : mine; }
        if (sum == G) break;
        __builtin_amdgcn_s_sleep(1);
        if ((++sp & 255u) == 0u) { if (xb_ld(&bar[XB_TMO])) break; if (sp > XB_SPIN_CAP) { atomicAdd(&bar[XB_TMO], 1u); break; } }
    }
    nloc = mine > 0u ? mine : 1u; nx = cnt > 0u ? cnt : 1u;
}
__device__ __forceinline__ void xcd_barrier(const XcdBarrier& b, const int tid_) {
    asm volatile("s_waitcnt vmcnt(0)" ::: "memory");
    __syncthreads();
    if (tid_ == 0) {
        unsigned* bar = b.bar;
        __builtin_amdgcn_s_waitcnt(0);
        unsigned nloc = b.st[0], nx = b.st[1];
        if (nloc == 0u) { xcd_barrier_complete(bar, b.x, nloc, nx); b.st[0] = nloc; b.st[1] = nx; }
        const unsigned old = xb_add(&bar[XB_XSUB(b.x)], 1u);
        const unsigned gen = old / nloc;
        if (old + 1u == (gen + 1u) * nloc) {
            __builtin_amdgcn_fence(__ATOMIC_RELEASE, "agent");
            asm volatile("s_waitcnt vmcnt(0)" ::: "memory");
            const unsigned og = xb_add(&bar[XB_TOP], 1u);
            const unsigned tg = og / nx;
            if (og + 1u == (tg + 1u) * nx) xb_add(&bar[XB_TOPGEN], 1u);
            else XB_SPIN(xb_ld(&bar[XB_TOPGEN]) == tg, bar);
            __builtin_amdgcn_fence(__ATOMIC_ACQUIRE, "agent");
            xb_add(&bar[XB_XGEN(b.x)], 1u);
            asm volatile("s_waitcnt vmcnt(0)" ::: "memory");
        } else {
            XB_SPIN(xb_ld(&bar[XB_XGEN(b.x)]) == gen, bar);
            __builtin_amdgcn_fence(__ATOMIC_ACQUIRE, "agent");
            asm volatile("s_waitcnt vmcnt(0)" ::: "memory");
        }
    }
    __syncthreads();
}

namespace pg8 {
constexpr int BM = 256, BK = 64, HALF = 128, HTB = HALF * BK * 2, STAGE_BYTES = 8 * HTB, NXCD = 8, WGM = 8;
__host__ __device__ __forceinline__ int lds_byte(int r, int c) { const int st = (r >> 4) * 2 + (c >> 5), rr = r & 15, cc = c & 31, ob = rr * 64 + cc * 2; return st * 1024 + (ob ^ (((ob >> 9) & 1) << 5)); }
__host__ __device__ __forceinline__ void stage_rc(int b, int& R, int& C) { const int st = b / 1024, sb = b % 1024, swz = sb ^ (((sb >> 9) & 1) << 5); R = (st >> 1) * 16 + swz / 64; C = (st & 1) * 32 + (swz % 64) / 2; }

struct Unit { int pm, pn, e, rt; };

struct DenseOrder {
    static constexpr bool GATHER = false;
    int nM, nN, nwg, G, c; unsigned lda_bytes; unsigned kb;
    __device__ void init(int M, int N, int K, int lda, int G_, int c_) { nM = M / BM; nN = N / BM; nwg = nM * nN; G = G_; c = c_; lda_bytes = (unsigned)lda * 2u; kb = (unsigned)K * 2u; }
    __device__ bool next(int i, Unit& u) const {
        if (c < 0) return false;
        const long L = (long)i * G + c; if (L >= nwg) return false;
        int wgid = (int)L; { const int q = nwg / NXCD, r = nwg % NXCD, xcd = wgid % NXCD, off = wgid / NXCD; wgid = (xcd < r ? xcd * (q + 1) : r * (q + 1) + (xcd - r) * q) + off; }
        const int nig = WGM * nN, gid = wgid / nig, fm = gid * WGM, gsz = (nM - fm) < WGM ? (nM - fm) : WGM;
        u.pm = fm + ((wgid % nig) % gsz); u.pn = (wgid % nig) / gsz; u.e = 0; u.rt = 0; return true;
    }
    __device__ __forceinline__ unsigned a_row(const Unit& u, int r) const { return (unsigned)(u.pm * BM + r) * lda_bytes; }
    __device__ __forceinline__ size_t b_off(const Unit& u) const { return (size_t)u.pn * BM * kb; }
};

#define PG8_SA(b, h) (((b) * 2 + (h)) * HTB)
#define PG8_SB(b, h) ((4 + (b) * 2 + (h)) * HTB)
#define PG8_STAGEB(bufoff, gbase) do { _Pragma("unroll") for (int _i = 0; _i < 2; ++_i) \
        __builtin_amdgcn_global_load_lds((const unsigned*)((const char*)(gbase) + voffB[_i]), (LAS unsigned*)(lds + (bufoff) + ldsw + _i * 8192), 16, 0, 0); } while (0)
#define PG8_GLDS(src, dstoff) __builtin_amdgcn_global_load_lds((const unsigned*)(src), (LAS unsigned*)(lds + (dstoff)), 16, 0, 0)
#define PG8_STAGEA(bufoff, kbyte, h, NXT) do { if constexpr (Sched::GATHER) { const unsigned _o0 = (NXT) ? ((h) ? n10 : n00) : ((h) ? c10 : c00), _o1 = (NXT) ? ((h) ? n11 : n01) : ((h) ? c11 : c01); \
            PG8_GLDS(Ab + (kbyte) + _o0, (bufoff) + ldsw); PG8_GLDS(Ab + (kbyte) + _o1, (bufoff) + ldsw + 8192); } \
        else { const char* _b = ((NXT) ? nA : cA) + (kbyte) + ((h) ? hstepA : (size_t)0); PG8_GLDS(_b + voffA[0], (bufoff) + ldsw); PG8_GLDS(_b + voffA[1], (bufoff) + ldsw + 8192); } } while (0)
#define PG8_LDA(dst, b, h) do { _Pragma("unroll") for (int m = 0; m < 4; ++m) _Pragma("unroll") for (int k = 0; k < 2; ++k) dst[m][k] = *(const LAS bf16x8*)(lds + PG8_SA(b, h) + aoff + m * 2048 + k * 1024); } while (0)
#define PG8_LDB(dst, b, h) do { _Pragma("unroll") for (int n = 0; n < 2; ++n) _Pragma("unroll") for (int k = 0; k < 2; ++k) dst[n][k] = *(const LAS bf16x8*)(lds + PG8_SB(b, h) + boff + n * 2048 + k * 1024); } while (0)
#define PG8_MMA(ai, bj, At, Bt) do { __builtin_amdgcn_s_setprio(1); _Pragma("unroll") for (int m = 0; m < 4; ++m) _Pragma("unroll") for (int n = 0; n < 2; ++n) _Pragma("unroll") for (int k = 0; k < 2; ++k) \
        acc[ai][bj][m][n] = __builtin_amdgcn_mfma_f32_16x16x32_bf16(Bt[n][k], At[m][k], acc[ai][bj][m][n], 0, 0, 0); __builtin_amdgcn_s_setprio(0); } while (0)
#define PG8_WAIT_V(n) asm volatile("s_waitcnt vmcnt(" #n ")" ::: "memory")
#define PG8_WAIT_L(n) asm volatile("s_waitcnt lgkmcnt(" #n ")" ::: "memory")
#define PG8_BAR __builtin_amdgcn_s_barrier()
#define PG8_SCHED __builtin_amdgcn_sched_barrier(0)

template <class Epi, class Sched>
__device__ __forceinline__ void gemm_phase(const int tid_in, LAS unsigned char* lds, const bf16* A, const bf16* Bt, const int K, const Sched& S, const Epi& E) {
    int tid = tid_in; asm volatile("" : "+v"(tid));
    const int wid = __builtin_amdgcn_readfirstlane(tid >> 6), lane = tid & 63, wr = wid >> 2, wc = wid & 3, fr = lane & 15, fq = lane >> 4;
    int Kop_ = K; asm volatile("" : "+s"(Kop_));
    const int nt = Kop_ / BK;
    int sR[2], sC2[2]; unsigned voffB[2];
#pragma unroll
    for (int i = 0; i < 2; ++i) { int R, C; stage_rc(tid * 16 + i * 8192, R, C); sR[i] = R; sC2[i] = C * 2; voffB[i] = (unsigned)R * S.kb + (unsigned)C * 2u; }
    const unsigned kstep = (unsigned)(BK * 2);
    const size_t hstepB = (size_t)HALF * S.kb;
    const unsigned ldsw = (unsigned)wid * 1024u;
    const int aoff = lds_byte(wr * 64 + fr, fq * 8), boff = lds_byte(wc * 32 + fr, fq * 8);
    Unit cur, nxt; int ui = 0;
    if (!S.next(0, cur)) return;
    f32x4 acc[2][2][4][2];
#pragma unroll
    for (int a = 0; a < 2; ++a)
#pragma unroll
        for (int b = 0; b < 2; ++b)
#pragma unroll
            for (int m = 0; m < 4; ++m)
#pragma unroll
                for (int n = 0; n < 2; ++n) acc[a][b][m][n] = (f32x4){0.f, 0.f, 0.f, 0.f};
    bf16x8 At[4][2], B0[2][2], B1[2][2];
    const char* Ab = (const char*)A;
    unsigned c00 = 0, c01 = 0, c10 = 0, c11 = 0, n00 = 0, n01 = 0, n10 = 0, n11 = 0; unsigned voffA[2] = {0u, 0u}; const char* cA = Ab; const char* nA = Ab; size_t hstepA = 0;
    if constexpr (Sched::GATHER) { c00 = S.a_row(cur, sR[0]) + sC2[0]; c01 = S.a_row(cur, sR[1]) + sC2[1]; c10 = S.a_row(cur, 128 + sR[0]) + sC2[0]; c11 = S.a_row(cur, 128 + sR[1]) + sC2[1]; }
    else { voffA[0] = (unsigned)sR[0] * S.lda_bytes + sC2[0]; voffA[1] = (unsigned)sR[1] * S.lda_bytes + sC2[1]; hstepA = (size_t)HALF * S.lda_bytes; cA = Ab + (size_t)S.a_row(cur, 0); }
    const char* cB = (const char*)Bt + S.b_off(cur);
    PG8_STAGEB(PG8_SB(0, 0), cB); PG8_STAGEA(PG8_SA(0, 0), 0u, 0, false); PG8_STAGEB(PG8_SB(0, 1), cB + hstepB); PG8_STAGEA(PG8_SA(0, 1), 0u, 1, false);
    if (wr == 1) PG8_BAR;
    PG8_WAIT_V(4); PG8_BAR;
    PG8_STAGEB(PG8_SB(1, 0), cB + kstep); PG8_STAGEA(PG8_SA(1, 0), kstep, 0, false); PG8_STAGEB(PG8_SB(1, 1), cB + hstepB + kstep);
    PG8_WAIT_V(6); PG8_BAR;
    for (;;) {
        const bool has_next = S.next(ui + 1, nxt);
        const char* nB = cB;
        if constexpr (Sched::GATHER) { n00 = c00; n01 = c01; n10 = c10; n11 = c11; } else nA = cA;
        if (has_next) { nB = (const char*)Bt + S.b_off(nxt);
            if constexpr (Sched::GATHER) { n00 = S.a_row(nxt, sR[0]) + sC2[0]; n01 = S.a_row(nxt, sR[1]) + sC2[1]; n10 = S.a_row(nxt, 128 + sR[0]) + sC2[0]; n11 = S.a_row(nxt, 128 + sR[1]) + sC2[1]; }
            else nA = Ab + (size_t)S.a_row(nxt, 0); }
        for (int t = 0; t < nt; t += 2) {
            const bool last = (t == nt - 2);
            const unsigned k1 = (unsigned)(t + 1) * kstep;
            const unsigned k2 = last ? 0u : (unsigned)(t + 2) * kstep, k3 = k2 + kstep;
            const char* b2 = last ? nB : cB + (size_t)(t + 2) * kstep; const char* b3 = b2 + kstep;
            PG8_LDB(B0, 0, 0); PG8_SCHED; PG8_LDA(At, 0, 0); PG8_STAGEA(PG8_SA(1, 1), k1, 1, false);
            PG8_WAIT_L(8); PG8_BAR; PG8_WAIT_L(0); PG8_MMA(0, 0, At, B0); PG8_BAR; PG8_SCHED;
            PG8_LDB(B1, 0, 1); PG8_STAGEB(PG8_SB(0, 0), b2);
            PG8_BAR; PG8_WAIT_L(0); PG8_MMA(0, 1, At, B1); PG8_BAR;
            PG8_LDA(At, 0, 1); PG8_STAGEA(PG8_SA(0, 0), k2, 0, last);
            PG8_BAR; PG8_WAIT_L(0); PG8_MMA(1, 0, At, B0); PG8_BAR; PG8_SCHED;
            PG8_STAGEB(PG8_SB(0, 1), b2 + hstepB);
            PG8_WAIT_V(6); PG8_BAR; PG8_MMA(1, 1, At, B1); PG8_BAR;
            PG8_LDB(B0, 1, 0); PG8_SCHED; PG8_LDA(At, 1, 0); PG8_STAGEA(PG8_SA(0, 1), k2, 1, last);
            PG8_WAIT_L(8); PG8_BAR; PG8_WAIT_L(0); PG8_MMA(0, 0, At, B0); PG8_BAR; PG8_SCHED;
            PG8_LDB(B1, 1, 1); PG8_STAGEB(PG8_SB(1, 0), b3);
            PG8_BAR; PG8_WAIT_L(0); PG8_MMA(0, 1, At, B1); PG8_BAR;
            PG8_LDA(At, 1, 1); PG8_STAGEA(PG8_SA(1, 0), k3, 0, last);
            PG8_BAR; PG8_WAIT_L(0); PG8_MMA(1, 0, At, B0); PG8_BAR; PG8_SCHED;
            PG8_STAGEB(PG8_SB(1, 1), b3 + hstepB);
            PG8_WAIT_V(6); PG8_BAR; PG8_MMA(1, 1, At, B1); PG8_BAR;
        }
        if constexpr (!Epi::AFTER_DRAIN) E(acc, cur, wr, wc, fr, fq);
        if (!has_next) break;
#pragma unroll
        for (int a = 0; a < 2; ++a)
#pragma unroll
            for (int b = 0; b < 2; ++b)
#pragma unroll
                for (int m = 0; m < 4; ++m)
#pragma unroll
                    for (int n = 0; n < 2; ++n) acc[a][b][m][n] = (f32x4){0.f, 0.f, 0.f, 0.f};
        cur = nxt; if constexpr (Sched::GATHER) { c00 = n00; c01 = n01; c10 = n10; c11 = n11; } else cA = nA; cB = nB; ++ui;
    }
    PG8_WAIT_V(0);
    if (wr == 0) PG8_BAR;
    PG8_BAR;
    if constexpr (Epi::AFTER_DRAIN) E.fused(acc, cur, wr, wc, fr, fq, lds, wid, lane);
}

__device__ __forceinline__ void store_tile_f32(const f32x4 (&acc)[2][2][4][2], float* dst, int ld, int row0, int col0) {
#pragma unroll
    for (int ai = 0; ai < 2; ++ai)
#pragma unroll
        for (int m = 0; m < 4; ++m) { float* rowp = dst + (size_t)(row0 + ai * HALF + m * 16) * ld + col0;
#pragma unroll
            for (int bj = 0; bj < 2; ++bj)
#pragma unroll
                for (int n = 0; n < 2; ++n) *(f32x4*)(rowp + bj * HALF + n * 16) = acc[ai][bj][m][n]; }
}
__device__ __forceinline__ void store_tile_bf16(const f32x4 (&acc)[2][2][4][2], bf16* dst, int ld, int row0, int col0) {
#pragma unroll
    for (int ai = 0; ai < 2; ++ai)
#pragma unroll
        for (int m = 0; m < 4; ++m) { bf16* rowp = dst + (size_t)(row0 + ai * HALF + m * 16) * ld + col0;
#pragma unroll
            for (int bj = 0; bj < 2; ++bj)
#pragma unroll
                for (int n = 0; n < 2; ++n) { const f32x4 v = acc[ai][bj][m][n]; u32x2 w; w.x = pk2(v[0], v[1]); w.y = pk2(v[2], v[3]); *(u32x2*)(rowp + bj * HALF + n * 16) = w; } }
}
struct EpiBf16 {
    static constexpr bool AFTER_DRAIN = false;
    bf16* dst; int ld;
    __device__ __forceinline__ void operator()(const f32x4 (&acc)[2][2][4][2], const Unit& u, int wr, int wc, int fr, int fq) const {
        store_tile_bf16(acc, dst, ld, u.pm * BM + wr * 64 + fr, u.pn * BM + wc * 32 + 4 * fq);
    }
};
struct EpiProj {
    static constexpr bool AFTER_DRAIN = false;
    bf16* qabs; float* ckvraw; bf16* qi; float* small; float* mqkraw; bf16* mv; bf16* mo;
    __device__ __forceinline__ void operator()(const f32x4 (&acc)[2][2][4][2], const Unit& u, int wr, int wc, int fr, int fq) const {
        const int row0 = u.pm * BM + wr * 64 + fr, cl = wc * 32 + 4 * fq, pn = u.pn;
        if (pn < 8) store_tile_bf16(acc, qabs, 2048, row0, pn * 256 + cl);
        else if (pn == 8) store_tile_f32(acc, ckvraw, 256, row0, cl);
        else if (pn < 11) store_tile_bf16(acc, qi, 512, row0, (pn - 9) * 256 + cl);
        else if (pn == 11) store_tile_f32(acc, small, 256, row0, cl);
        else if (pn < 16) store_tile_f32(acc, mqkraw, 1024, row0, (pn - 12) * 256 + cl);
        else if (pn < 20) store_tile_bf16(acc, mv, 1024, row0, (pn - 16) * 256 + cl);
        else store_tile_bf16(acc, mo, 1024, row0, (pn - 20) * 256 + cl);
    }
};
template <bool BASE_BF16>
struct EpiResidT {
    static constexpr bool AFTER_DRAIN = false;
    const void* base; bf16* xb; float* ss;
    __device__ __forceinline__ void operator()(const f32x4 (&acc)[2][2][4][2], const Unit& u, int wr, int wc, int fr, int fq) const {
        const int row0 = u.pm * BM + wr * 64 + fr, col0 = u.pn * BM + wc * 32 + 4 * fq;
#pragma unroll
        for (int ai = 0; ai < 2; ++ai)
#pragma unroll
            for (int m = 0; m < 4; ++m) { const int row = row0 + ai * HALF + m * 16; const size_t off = (size_t)row * D + col0; float s = 0.f;
#pragma unroll
                for (int bj = 0; bj < 2; ++bj)
#pragma unroll
                    for (int n = 0; n < 2; ++n) { f32x4 b;
                        if constexpr (BASE_BF16) { const u32x2 p = *(const u32x2*)((const bf16*)base + off + bj * HALF + n * 16); b = (f32x4){bf2f(p.x & 0xffffu), bf2f(p.x >> 16), bf2f(p.y & 0xffffu), bf2f(p.y >> 16)}; }
                        else b = *(const f32x4*)((const float*)base + off + bj * HALF + n * 16);
                        const f32x4 v = b + acc[ai][bj][m][n];
                        u32x2 w; w.x = pk2(v[0], v[1]); w.y = pk2(v[2], v[3]); *(u32x2*)(xb + off + bj * HALF + n * 16) = w;
                        s += (v[0] * v[0] + v[1] * v[1]) + (v[2] * v[2] + v[3] * v[3]); }
                if (ss) { s += __shfl_xor(s, 16); s += __shfl_xor(s, 32); if (fq == 0) atomicAdd(ss + row, s); } }
    }
};
struct EpiCq {
    static constexpr bool AFTER_DRAIN = false;
    bf16* dst; const float* ss; float scale;
    __device__ __forceinline__ void operator()(const f32x4 (&acc)[2][2][4][2], const Unit& u, int wr, int wc, int fr, int fq) const {
        const int row0 = u.pm * BM + wr * 64 + fr, col0 = u.pn * BM + wc * 32 + 4 * fq;
#pragma unroll
        for (int ai = 0; ai < 2; ++ai)
#pragma unroll
            for (int m = 0; m < 4; ++m) { const int row = row0 + ai * HALF + m * 16; const float r = rsqrtf(ss[row] * (1.0f / D) + EPS) * scale; bf16* rowp = dst + (size_t)row * D + col0;
#pragma unroll
                for (int bj = 0; bj < 2; ++bj)
#pragma unroll
                    for (int n = 0; n < 2; ++n) { const f32x4 v = acc[ai][bj][m][n] * r; u32x2 w; w.x = pk2(v[0], v[1]); w.y = pk2(v[2], v[3]); *(u32x2*)(rowp + bj * HALF + n * 16) = w; } }
    }
};
struct XsOrder {
    static constexpr bool GATHER = false;
    int G, c; unsigned lda_bytes, kb;
    __device__ bool next(int i, Unit& u) const { const int L = i * G + c; if (i > 0 || L >= 128) return false; u.pm = L >> 2; u.pn = L & 3; u.e = 0; u.rt = 0; return true; }
    __device__ __forceinline__ unsigned a_row(const Unit& u, int r) const { return (unsigned)(u.pm * BM + r) * lda_bytes + (unsigned)u.pn * 1024u; }
    __device__ __forceinline__ size_t b_off(const Unit& u) const { return (size_t)u.pn * 1024; }
};
struct XoOrder {
    static constexpr bool GATHER = false;
    int G, c; unsigned lda_bytes, kb;
    __device__ bool next(int i, Unit& u) const { const int L = i * G + c; if (L >= 256) return false; u.pm = L >> 3; u.pn = L & 7; u.e = 0; u.rt = 0; return true; }
    __device__ __forceinline__ unsigned a_row(const Unit& u, int r) const { return (unsigned)(u.pm * BM + r) * lda_bytes + (unsigned)(u.pn >> 1) * 512u; }
    __device__ __forceinline__ size_t b_off(const Unit& u) const { return (size_t)u.pn * BM * kb; }
};
struct EpiSoftmax {
    static constexpr bool AFTER_DRAIN = true;
    bf16* P; const float* ss;
    __device__ __forceinline__ void fused(f32x4 (&acc)[2][2][4][2], const Unit& u, int wr, int wc, int fr, int fq, LAS unsigned char* lds, int wid, int lane) const {
        LAS float* Pm = (LAS float*)lds; LAS float* Ps = (LAS float*)(lds + 4096);
#pragma unroll
        for (int ai = 0; ai < 2; ++ai)
#pragma unroll
            for (int m = 0; m < 4; ++m) { float mx = -3.0e38f; const float rs = rsqrtf(ss[u.pm * BM + ai * HALF + wr * 64 + m * 16 + fr] * (1.0f / D) + EPS);
#pragma unroll
                for (int bj = 0; bj < 2; ++bj)
#pragma unroll
                    for (int n = 0; n < 2; ++n) { const f32x4 v = acc[ai][bj][m][n] * rs; acc[ai][bj][m][n] = v; mx = fmaxf(mx, fmaxf(fmaxf(v[0], v[1]), fmaxf(v[2], v[3]))); }
                mx = fmaxf(mx, __shfl_xor(mx, 16)); mx = fmaxf(mx, __shfl_xor(mx, 32));
                if (fq == 0) Pm[(ai * HALF + wr * 64 + m * 16 + fr) * 4 + wc] = mx; }
        asm volatile("s_waitcnt lgkmcnt(0)" ::: "memory"); __builtin_amdgcn_s_barrier(); asm volatile("" ::: "memory");
#pragma unroll
        for (int ai = 0; ai < 2; ++ai)
#pragma unroll
            for (int m = 0; m < 4; ++m) { const int r = ai * HALF + wr * 64 + m * 16 + fr; const f32x4 pm4 = *(const LAS f32x4*)(Pm + r * 4); const float mx = fmaxf(fmaxf(pm4[0], pm4[1]), fmaxf(pm4[2], pm4[3])); float sm = 0.f;
#pragma unroll
                for (int bj = 0; bj < 2; ++bj)
#pragma unroll
                    for (int n = 0; n < 2; ++n) { f32x4 v = acc[ai][bj][m][n];
#pragma unroll
                        for (int j = 0; j < 4; ++j) { v[j] = __expf(v[j] - mx); sm += v[j]; }
                        acc[ai][bj][m][n] = v; }
                sm += __shfl_xor(sm, 16); sm += __shfl_xor(sm, 32);
                if (fq == 0) Ps[r * 4 + wc] = sm; }
        asm volatile("s_waitcnt lgkmcnt(0)" ::: "memory"); __builtin_amdgcn_s_barrier(); asm volatile("" ::: "memory");
#pragma unroll
        for (int ai = 0; ai < 2; ++ai)
#pragma unroll
            for (int m = 0; m < 4; ++m) { const int r = ai * HALF + wr * 64 + m * 16 + fr; const f32x4 ps4 = *(const LAS f32x4*)(Ps + r * 4); const float inv = 1.f / ((ps4[0] + ps4[1]) + (ps4[2] + ps4[3]));
                bf16* rowp = P + (size_t)(u.pm * BM + r) * 1024 + u.pn * 256 + wc * 32 + 4 * fq;
#pragma unroll
                for (int bj = 0; bj < 2; ++bj)
#pragma unroll
                    for (int n = 0; n < 2; ++n) { const f32x4 v = acc[ai][bj][m][n] * inv; u32x2 w; w.x = pk2(v[0], v[1]); w.y = pk2(v[2], v[3]); *(u32x2*)(rowp + bj * HALF + n * 16) = w; } }
    }
};
struct MoeOrder {
    static constexpr bool GATHER = true;
    const volatile LAS int* tb; const volatile LAS int* cn; const int* list; int ncol; int Lbeg, Lend, nb, c; unsigned a_ld_bytes; size_t b_exp_bytes; unsigned kb; int gather;
    __device__ bool next(int i, Unit& u) const {
        if (c < 0 || nb <= 0) return false;
        const int L = Lbeg + i * nb + c; if (L >= Lend) return false;
        const int g = L / ncol; int e = 0;
#pragma unroll 1
        for (int j = 1; j < 32; ++j) if (g >= tb[j]) e = j;
        u.e = e; u.rt = g - tb[e]; u.pn = L - g * ncol; u.pm = g; return true;
    }
    __device__ __forceinline__ unsigned a_row(const Unit& u, int r) const {
        if (gather) { int idx = u.rt * 256 + r; const int cnt = cn[u.e]; idx = idx < cnt ? idx : cnt - 1; const int tok = list[u.e * T + idx]; return (unsigned)tok * a_ld_bytes; }
        return (unsigned)(u.pm * 256 + r) * a_ld_bytes;
    }
    __device__ __forceinline__ size_t b_off(const Unit& u) const { return (size_t)u.e * b_exp_bytes + (size_t)u.pn * BM * kb; }
};
struct EpiSwiGLU {
    static constexpr bool AFTER_DRAIN = false;
    bf16* act; const int* list; const float* rstd; const volatile LAS int* cn;
    __device__ __forceinline__ void operator()(const f32x4 (&acc)[2][2][4][2], const Unit& u, int wr, int wc, int fr, int fq) const {
        const int cnt = cn[u.e];
#pragma unroll
        for (int ai = 0; ai < 2; ++ai)
#pragma unroll
            for (int m = 0; m < 4; ++m) { const int rl = ai * HALF + wr * 64 + m * 16 + fr; int idx = u.rt * 256 + rl; idx = idx < cnt ? idx : cnt - 1; const float r = rstd[list[u.e * T + idx]];
                bf16* rowp = act + (size_t)(u.pm * 256 + rl) * DEXP + u.pn * 128 + wc * 32 + 4 * fq;
#pragma unroll
                for (int n = 0; n < 2; ++n) { const f32x4 g = acc[ai][0][m][n] * r, uu = acc[ai][1][m][n] * r; f32x4 a;
#pragma unroll
                    for (int j = 0; j < 4; ++j) a[j] = g[j] / (1.0f + __expf(-g[j])) * uu[j];
                    u32x2 w; w.x = pk2(a[0], a[1]); w.y = pk2(a[2], a[3]); *(u32x2*)(rowp + n * 16) = w; } }
    }
};
}

struct Args { const float* in[27]; float* out; unsigned char* ws; int ph_lo, ph_hi; };
enum { I_X = 0, I_MEM, I_NORM_MIX_G, I_W_IN, I_KV_NORM_G, I_KIDX_NORM_G, I_W_UK, I_W_UV, I_CONV_W, I_CONV_B, I_GATE_B, I_ML_NORM_G, I_W_OUT, I_NORM_X_G, I_MEM_NORM_G,
       I_W_CQ, I_W_CKV, I_W_CO, I_NORM_FFN_G, I_W_GROUP, I_B_GROUP, I_W_ROUTER, I_B_ROUTER, I_W_GATE, I_W_UP, I_W_DOWN, I_FINAL_G };

__device__ __forceinline__ void tr_item(const float* W, size_t ldw, int k0, int n0, const float* kscale, bf16* WT, size_t ldt, int drow0, int dcol0, LAS float* scr, int lane) {
#pragma unroll 8
    for (int i = 0; i < 32; ++i) { const int kk = 2 * i + (lane >> 5); float v = W[(size_t)(k0 + kk) * ldw + n0 + (lane & 31)]; if (kscale) v *= kscale[k0 + kk]; scr[kk * 33 + (lane & 31)] = v; }
    LDS_WAIT(); asm volatile("" ::: "memory");
    const int c = lane & 7;
#pragma unroll
    for (int j = 0; j < 4; ++j) { const int n = (lane >> 3) + 8 * j; const LAS float* s = scr + (8 * c) * 33 + n;
        u32x4 o; o.x = pk2(s[0 * 33], s[1 * 33]); o.y = pk2(s[2 * 33], s[3 * 33]); o.z = pk2(s[4 * 33], s[5 * 33]); o.w = pk2(s[6 * 33], s[7 * 33]);
        *(u32x4*)(WT + (size_t)(drow0 + n0 + n) * ldt + dcol0 + k0 + 8 * c) = o; }
    LDS_WAIT(); asm volatile("" ::: "memory");
}
__device__ __forceinline__ void tr_load64(const float* W, size_t ldw, int k0, int n0, f32x4 (&a)[8], f32x4 (&b)[8], int lane) {
    const int nq = lane & 15, kq = lane >> 4;
    const float* src = W + (size_t)(k0 + 2 * kq) * ldw + n0 + 4 * nq;
#pragma unroll
    for (int i = 0; i < 8; ++i) { a[i] = __builtin_nontemporal_load((const f32x4*)(src + (size_t)(8 * i) * ldw)); b[i] = __builtin_nontemporal_load((const f32x4*)(src + (size_t)(8 * i + 1) * ldw)); }
}
__device__ __forceinline__ void tr_finish64(const f32x4 (&a)[8], const f32x4 (&b)[8], int k0, int n0, const float* kscale, bf16* WT, size_t ldt, int drow0, int dcol0, LAS unsigned char* scr, int lane) {
    const int nq = lane & 15, kq = lane >> 4;
#pragma unroll
    for (int i = 0; i < 8; ++i) { float sa = 1.f, sb = 1.f; if (kscale) { sa = kscale[k0 + 8 * i + 2 * kq]; sb = kscale[k0 + 8 * i + 2 * kq + 1]; }
#pragma unroll
        for (int j = 0; j < 4; ++j) { const int n = 4 * nq + j; *(LAS unsigned*)(scr + n * 128 + 16 * (i ^ (nq & 7)) + 4 * kq) = pk2(a[i][j] * sa, b[i][j] * sb); } }
    LDS_WAIT(); asm volatile("" ::: "memory");
#pragma unroll
    for (int m = 0; m < 8; ++m) { const int n = (lane >> 3) + 8 * m, c = lane & 7; const u32x4 v = *(const LAS u32x4*)(scr + n * 128 + 16 * (c ^ ((n >> 2) & 7)));
        __builtin_nontemporal_store(v, (u32x4*)(WT + (size_t)(drow0 + n0 + n) * ldt + dcol0 + k0 + 8 * c)); }
    LDS_WAIT(); asm volatile("" ::: "memory");
}
__device__ __forceinline__ void tr_scales64(const float* kscale, int k0, float (&sc)[16], int lane) { const int kq = lane >> 4;
#pragma unroll
    for (int i = 0; i < 8; ++i) { sc[2 * i] = kscale[k0 + 8 * i + 2 * kq]; sc[2 * i + 1] = kscale[k0 + 8 * i + 2 * kq + 1]; } }
__device__ __forceinline__ void tr_finish64s(const f32x4 (&a)[8], const f32x4 (&b)[8], const float (&sc)[16], int k0, int n0, bf16* WT, size_t ldt, int drow0, int dcol0, LAS unsigned char* scr, int lane) {
    const int nq = lane & 15, kq = lane >> 4;
#pragma unroll
    for (int i = 0; i < 8; ++i) {
#pragma unroll
        for (int j = 0; j < 4; ++j) { const int n = 4 * nq + j; *(LAS unsigned*)(scr + n * 128 + 16 * (i ^ (nq & 7)) + 4 * kq) = pk2(a[i][j] * sc[2 * i], b[i][j] * sc[2 * i + 1]); } }
    LDS_WAIT(); asm volatile("" ::: "memory");
#pragma unroll
    for (int m = 0; m < 8; ++m) { const int n = (lane >> 3) + 8 * m, c = lane & 7; const u32x4 v = *(const LAS u32x4*)(scr + n * 128 + 16 * (c ^ ((n >> 2) & 7)));
        __builtin_nontemporal_store(v, (u32x4*)(WT + (size_t)(drow0 + n0 + n) * ldt + dcol0 + k0 + 8 * c)); }
    LDS_WAIT(); asm volatile("" ::: "memory");
}
__device__ __forceinline__ void tr_item64(const float* W, size_t ldw, int k0, int n0, const float* kscale, bf16* WT, size_t ldt, int drow0, int dcol0, LAS unsigned char* scr, int lane) {
    f32x4 a[8], b[8];
    tr_load64(W, ldw, k0, n0, a, b, lane);
    tr_finish64(a, b, k0, n0, kscale, WT, ldt, drow0, dcol0, scr, lane);
}
__device__ __forceinline__ void cv_item64(const float* W, size_t ldw, int k0, int n0, const float* kscale, float scale, bf16* O, size_t ldo, int lane) {
    const int c4 = (lane & 15) * 4, rr = lane >> 4;
    f32x4 v[16];
#pragma unroll
    for (int i = 0; i < 16; ++i) v[i] = __builtin_nontemporal_load((const f32x4*)(W + (size_t)(k0 + i * 4 + rr) * ldw + n0 + c4));
#pragma unroll
    for (int i = 0; i < 16; ++i) { const float g = kscale[k0 + i * 4 + rr] * scale; u32x2 w; w.x = pk2(v[i][0] * g, v[i][1] * g); w.y = pk2(v[i][2] * g, v[i][3] * g);
        *(u32x2*)(O + (size_t)(k0 + i * 4 + rr) * ldo + n0 + c4) = w; }
}
__device__ __forceinline__ void rms_row_to_bf16(const float* xrow, const float* g, bf16* orow, int lane) {
    const f32x4* xr = (const f32x4*)xrow + lane; const f32x4* gr = (const f32x4*)g + lane;
    f32x4 v[8]; float s = 0.f;
#pragma unroll
    for (int j = 0; j < 8; ++j) { v[j] = xr[64 * j]; s += (v[j][0] * v[j][0] + v[j][1] * v[j][1]) + (v[j][2] * v[j][2] + v[j][3] * v[j][3]); }
    const float r = rsqrtf(wave_sum(s) * (1.f / D) + EPS);
    u32x2* o8 = (u32x2*)orow + lane;
#pragma unroll
    for (int j = 0; j < 8; ++j) { const f32x4 gg = gr[64 * j]; u32x2 w; w.x = pk2(v[j][0] * r * gg[0], v[j][1] * r * gg[1]); w.y = pk2(v[j][2] * r * gg[2], v[j][3] * r * gg[3]); o8[64 * j] = w; }
}

__device__ __forceinline__ void mini_gemm64(LAS unsigned char* lds, const bf16* Ap, const unsigned lda, const bf16* Bp, const unsigned ldb, const int nch, bf16* o, const unsigned ldo, const int wave, const int lane) {
    const int r32 = lane & 31, hh = lane >> 5; const int tm = wave & 1, tn = (wave >> 1) & 1, kh = wave >> 2;
#define KV_DMA(kc_) do { _Pragma("unroll") for (int i4 = 0; i4 < 4; ++i4) { const int ii = wave * 4 + i4; const int isb = ii >> 4, row_ = (ii & 15) * 4 + (lane >> 4); \
        const bf16* gsrc_ = (isb ? Bp + (size_t)row_ * ldb : Ap + (size_t)row_ * lda) + (kc_) * 128 + (((lane & 15) ^ (row_ & 15)) * 8); \
        const unsigned ldst_ = __builtin_amdgcn_readfirstlane((unsigned)(size_t)lds + (unsigned)(((kc_) & 3) * 32768 + isb * 16384 + (ii & 15) * 1024)); unsigned keep_; \
        asm volatile("s_mov_b32 %0, m0\n\ts_mov_b32 m0, %2\n\ts_nop 0\n\tglobal_load_lds_dwordx4 %1, off\n\ts_mov_b32 m0, %0" : "=&s"(keep_) : "v"(gsrc_), "s"(ldst_) : "memory"); } } while (0)
    f32x16 acc;
#pragma unroll
    for (int i = 0; i < 16; ++i) acc[i] = 0.f;
    asm volatile("s_waitcnt vmcnt(0)" ::: "memory");
    __syncthreads();
    KV_DMA(0); if (nch > 1) KV_DMA(1); if (nch > 2) KV_DMA(2);
#pragma unroll 1
    for (int kc = 0; kc < nch; ++kc) {
        const int ahead = nch - 1 - kc;
        if (ahead >= 2) asm volatile("s_waitcnt vmcnt(8)" ::: "memory"); else if (ahead == 1) asm volatile("s_waitcnt vmcnt(4)" ::: "memory"); else asm volatile("s_waitcnt vmcnt(0)" ::: "memory");
        __syncthreads();
        if (kc + 3 < nch) KV_DMA(kc + 3);
        const LAS unsigned char* ba = lds + (kc & 3) * 32768 + (tm * 32 + r32) * 256; const LAS unsigned char* bb = lds + (kc & 3) * 32768 + 16384 + (tn * 32 + r32) * 256;
#pragma unroll
        for (int k4 = 0; k4 < 4; ++k4) { const int ch = (kh * 4 + k4) * 2 + hh;
            const bf16x8 af = *(const LAS bf16x8*)(ba + ((ch ^ (r32 & 15)) * 16)), bfr = *(const LAS bf16x8*)(bb + ((ch ^ (r32 & 15)) * 16));
            acc = __builtin_amdgcn_mfma_f32_32x32x16_bf16(af, bfr, acc, 0, 0, 0); }
    }
#undef KV_DMA
    __syncthreads();
    LAS float* xb = (LAS float*)lds + (wave & 3) * 1024;
    if (kh == 1) {
#pragma unroll
        for (int i = 0; i < 16; ++i) xb[i * 64 + lane] = acc[i]; }
    __syncthreads();
    if (kh == 0) { bf16* op = o + (size_t)(tm * 32 + 4 * hh) * ldo + tn * 32 + r32;
#pragma unroll
        for (int i = 0; i < 16; ++i) op[(size_t)((i & 3) + 8 * (i >> 2)) * ldo] = (bf16)f2bf(acc[i] + xb[i * 64 + lane]); }
}

__global__ void __launch_bounds__(512, 2) mega(Args args) {
    extern __shared__ __attribute__((aligned(16))) unsigned char lds_raw[];
    LAS unsigned char* lds = (LAS unsigned char*)lds_raw;
    volatile LAS unsigned* MISC = (volatile LAS unsigned*)(lds + MISC_OFF);
    const int tid0 = threadIdx.x;
    const int wave0_ = __builtin_amdgcn_readfirstlane(tid0 >> 6);
    const int G = gridDim.x, bx = blockIdx.x;
#define PHASE_IDS const Args* A_ = (const Args*)__builtin_amdgcn_kernarg_segment_ptr(); asm volatile("" : "+s"(A_)); int tid; asm volatile("v_mbcnt_lo_u32_b32 %0, -1, 0\n\tv_mbcnt_hi_u32_b32 %0, -1, %0" : "=v"(tid)); tid += wave0_ * 64; asm volatile("" : "+v"(tid)); const int lane = tid & 63, wave = __builtin_amdgcn_readfirstlane(tid >> 6); const int gw = bx * 8 + wave, NGW = G * 8; (void)lane; (void)gw; (void)NGW;
    const Args* A_ = (const Args*)__builtin_amdgcn_kernarg_segment_ptr();
    unsigned char* ws = args.ws;
    unsigned* ctl = (unsigned*)(ws + WS_CTL);
    const int lo = args.ph_lo, hi = args.ph_hi;
    for (int u = tid0; u < 1024; u += 512) MISC[u] = 0u;
    __syncthreads();
    XcdBarrier bar; bar.bar = ctl + CW_BAR; bar.x = 0; bar.st = MISC;
    if (hi - lo > 1) bar = xcd_barrier_post(ctl + CW_BAR, MISC);
#ifndef PH_MASK
#define PH_MASK 0x1ffff
#endif
#define IN(k) ((((PH_MASK) >> (k)) & 1) && lo <= (k) && (k) < hi)
#ifndef REP_MASK
#define REP_MASK 0
#endif
#define NREP(k) (1 + (((REP_MASK) >> (k)) & 1))
#ifndef PR_MFMA
#define PR_MFMA 0
#endif
#ifndef PR_EPI
#define PR_EPI 0
#endif
#ifndef PR_GA
#define PR_GA 0
#endif
#ifndef PR_VF
#define PR_VF 0
#endif
#ifndef PR_KV
#define PR_KV 0
#endif
#ifndef PR_ML
#define PR_ML 0
#endif
#ifndef PR_TR
#define PR_TR 0
#endif
#ifndef PR_WP
#define PR_WP 0
#endif
#ifndef PR_H1
#define PR_H1 0
#endif
#ifndef PR_QK
#define PR_QK 0
#endif
#ifndef PR_PV
#define PR_PV 0
#endif
#define BOTH(k) (IN(k) && IN((k) + 1))
#define GRID_BAR(k) do { if (BOTH(k) && rep_ == NREP(k) - 1) xcd_barrier(bar, tid); } while (0)

#define WOUT_T ((bf16*)(ws + WS_WOUT_T))
#define WCQ_T ((bf16*)(ws + WS_WCQ_T))
#define WCKV_T ((bf16*)(ws + WS_WCKV_T))
#define WCO_T ((bf16*)(ws + WS_WCO_T))
#define WGU_T ((bf16*)(ws + WS_WGU_T))
#define WDN_T ((bf16*)(ws + WS_WDN_T))
#define WIN_T ((bf16*)(ws + WS_WIN_T))
#define H1 ((bf16*)(ws + WS_H1))
#define MIXIN ((bf16*)(ws + WS_MIXIN))
#define MEMN ((bf16*)(ws + WS_MEMN))
#define KC ((bf16*)(ws + WS_KC))
#define MF ((bf16*)(ws + WS_WCKV_T + 4 * MiB))
#define VF ((bf16*)(ws + WS_WCKV_T))
#define VT ((bf16*)(ws + WS_VT))
#define GATES ((float*)(ws + WS_GATES))
#define QABS ((bf16*)(ws + WS_QABS))
#define CKVRAW ((float*)(ws + WS_CKVRAW))
#define QI ((bf16*)(ws + WS_QI))
#define SMALL ((float*)(ws + WS_SMALL))
#define MQKRAW ((float*)(ws + WS_MQKRAW))
#define MV ((bf16*)(ws + WS_MV))
#define MO ((bf16*)(ws + WS_MO))
#define CKVN ((bf16*)(ws + WS_CKVN))
#define KIDXN ((bf16*)(ws + WS_KIDXN))
#define QCM ((bf16*)(ws + WS_QCM))
#define KCM ((bf16*)(ws + WS_KCM))
#define LST ((float*)(ws + WS_LST))
#define NL ((float*)(ws + WS_NL))
#define NST (NL + NCH * 4 * 128)
#define CST ((bf16*)(ws + WS_CST))
#define VTM ((bf16*)(ws + WS_VTM))
#define PB ((bf16*)(ws + WS_VTM))
#define X1B ((bf16*)(ws + WS_X1B))
#define QC ((bf16*)(ws + WS_QC))
#define OC ((bf16*)(ws + WS_OC))
#define X2B ((bf16*)(ws + WS_X2B))
#define LIST ((int*)(ws + WS_LIST))
#define TOKE ((int*)(ws + WS_TOK))
#define TOKW ((float*)(ws + WS_TOK) + 2 * T)
#define RSTD3 ((float*)(ws + WS_TOK) + 4 * T)
#define ACT ((bf16*)(ws + WS_ACT))
#define Y ((bf16*)(ws + WS_Y))
#define WRH ((bf16*)(ws + WS_WR))
#define WRL (WRH + 48 * D)
#define BCNT ((int*)(ws + WS_TOK) + 8 * T)
#define TOKR ((int*)(ws + WS_TOK) + 6 * T)
#define SS2 ((float*)(ctl + CW_SS2))
#define CNT ((int*)(ctl + CW_CNT))

    if (IN(0)) for (int rep_ = 0; rep_ < NREP(0); ++rep_) {
        PHASE_IDS
        if (rep_) xcd_barrier(bar, tid);
        LAS float* scr = (LAS float*)(lds + wave * 16384);
        const float* w_in = A_->in[I_W_IN]; const float* w_out = A_->in[I_W_OUT];
        constexpr int J_CKV = 32 * 4, J_QI = 32 * 8, J_KI = 32 * 1, J_MQK = 32 * 16, J_MV = 32 * 16, J_MO = 32 * 16, J_WO = 16 * 32, J_CQ = 32 * 32, J_CKVW = 32 * 64, J_CO = 32 * 32,
                      J_G = 32 * 256, J_U = 32 * 256, J_D = 32 * 256;
        constexpr int NITEMS = J_CKV + J_QI + J_KI + J_MQK + J_MV + J_MO + J_WO + J_CQ + J_CKVW + J_CO + J_U;
        LAS unsigned char* scr8 = (LAS unsigned char*)scr;
        for (int prt_ = 0; prt_ < 1 + PR_TR; ++prt_)
        for (int it = gw; it < NITEMS; it += NGW) {
            int r = it;
            if (r < J_CKV) { tr_item64(w_in + 1024, D_IN, 64 * (r / 4), 64 * (r % 4), nullptr, WIN_T, D, 2048, 0, scr8, lane); continue; } r -= J_CKV;
            if (r < J_QI) { tr_item64(w_in + 1280, D_IN, 64 * (r / 8), 64 * (r % 8), nullptr, WIN_T, D, 2304, 0, scr8, lane); continue; } r -= J_QI;
            if (r < J_KI) { tr_item64(w_in + 1792, D_IN, 64 * r, 0, nullptr, WIN_T, D, 2816, 0, scr8, lane); continue; } r -= J_KI;
            if (r < J_MQK) { tr_item64(w_in + 1864, D_IN, 64 * (r / 16), 64 * (r % 16), nullptr, WIN_T, D, 3072, 0, scr8, lane); continue; } r -= J_MQK;
            if (r < J_MV) { tr_item64(w_in + 2888, D_IN, 64 * (r / 16), 64 * (r % 16), nullptr, WIN_T, D, 4096, 0, scr8, lane); continue; } r -= J_MV;
            if (r < J_MO) { tr_item64(w_in + 3920, D_IN, 64 * (r / 16), 64 * (r % 16), nullptr, WIN_T, D, 5120, 0, scr8, lane); continue; } r -= J_MO;
            if (r < J_WO) { tr_item64(w_out + (size_t)1024 * D, D, 64 * (r / 32), 64 * (r % 32), nullptr, WOUT_T, KMIX, 0, 2048, scr8, lane); continue; } r -= J_WO;
            if (r < J_CQ) { cv_item64(A_->in[I_W_CQ], D, 64 * (r / 32), 64 * (r % 32), A_->in[I_NORM_X_G], 0.04419417382415922f, WCQ_T, D, lane); continue; } r -= J_CQ;
            if (r < J_CKVW) { tr_item64(A_->in[I_W_CKV], 2 * D, 64 * (r / 64), 64 * (r % 64), nullptr, WCKV_T, D, 0, 0, scr8, lane); continue; } r -= J_CKVW;
            if (r < J_CO) { tr_item64(A_->in[I_W_CO], D, 64 * (r / 32), 64 * (r % 32), nullptr, WCO_T, D, 0, 0, scr8, lane); continue; } r -= J_CO;
            if (r < J_U) { const int e = r / 256, q = r % 256, kb = q / 8, nb = q % 8;
                tr_item64(A_->in[I_W_UP] + (size_t)e * D * DEXP, DEXP, 64 * kb, 64 * nb, A_->in[I_NORM_FFN_G], WGU_T + (size_t)e * 1024 * D, D, (nb / 2) * 128 + 128, 0, scr8, lane); continue; }
        }
        for (int i = bx * 512 + tid; i < 192 * D; i += G * 512) { const int r = i / D, k = i % D; float v = 0.f;
            if (r < 8) v = w_in[(size_t)k * D_IN + 1856 + r]; else if (r < 16) v = w_in[(size_t)k * D_IN + 3912 + (r - 8)];
            WIN_T[(size_t)(2880 + r) * D + k] = (bf16)f2bf(v); }
        for (int i = bx * 512 + tid; i < 48 * D; i += G * 512) { const int o = i / D, k = i % D; float v = 0.f;
            if (o < 4) v = A_->in[I_W_GROUP][(size_t)k * 4 + o] * A_->in[I_NORM_FFN_G][k]; else if (o < 36) v = A_->in[I_W_ROUTER][(size_t)k * 32 + (o - 4)] * A_->in[I_NORM_FFN_G][k];
            const unsigned hb = f2bf(v); WRH[i] = (bf16)hb; WRL[i] = (bf16)f2bf(v - bf2f(hb)); }
        {
            const int r32 = lane & 31, hh = lane >> 5;
            const float* w_uk = A_->in[I_W_UK]; const float* w_uv = A_->in[I_W_UV];
#define CVT8(dst, pa, pb) do { const f32x4 x_ = (pa), y_ = (pb); u32x4 w_; w_.x = pk2(x_[0], x_[1]); w_.y = pk2(x_[2], x_[3]); w_.z = pk2(y_[0], y_[1]); w_.w = pk2(y_[2], y_[3]); dst = __builtin_bit_cast(bf16x8, w_); } while (0)
            for (int prw_ = 0; prw_ < 1 + PR_WP; ++prw_)
            for (int it = gw; it < 4096; it += NGW) {
                const bool isq = it < 2048; const int r = it & 2047, h = r >> 8, rt = (r >> 2) & 63, cg = r & 3;
                if (isq) {
                    const int ct = (r >> 5) & 7, kg = r & 31;
                    bf16x8 af[8];
                    { const float* ap = w_uk + (size_t)((ct * 32 + r32) * 8 + h) * 128 + 8 * hh;
#pragma unroll
                      for (int ks = 0; ks < 8; ++ks) CVT8(af[ks], *(const f32x4*)(ap + ks * 16), *(const f32x4*)(ap + ks * 16 + 4)); }
#pragma unroll 1
                    for (int kt = 0; kt < 2; ++kt) { const int k0 = kg * 64 + kt * 32; const float* bp = w_in + (size_t)(k0 + r32) * D_IN + h * 128 + 8 * hh;
                        f32x16 acc;
#pragma unroll
                        for (int i = 0; i < 16; ++i) acc[i] = 0.f;
#pragma unroll
                        for (int ks = 0; ks < 8; ++ks) { bf16x8 bfr; CVT8(bfr, *(const f32x4*)(bp + ks * 16), *(const f32x4*)(bp + ks * 16 + 4)); acc = __builtin_amdgcn_mfma_f32_32x32x16_bf16(af[ks], bfr, acc, 0, 0, 0); }
                        bf16* o = WIN_T + (size_t)(h * 256 + ct * 32 + 4 * hh) * D + k0 + r32;
#pragma unroll
                        for (int i = 0; i < 16; ++i) o[(size_t)((i & 3) + 8 * (i >> 2)) * D] = (bf16)f2bf(acc[i] * 0.08838834764831845f); }
                } else {
                    const float* pj[8];
#pragma unroll
                    for (int j = 0; j < 8; ++j) pj[j] = w_out + (size_t)(h * 128 + 8 * hh + j) * D + rt * 32 + r32;
                    const float* bp0 = w_uv + (size_t)((cg * 64 + r32) * 8 + h) * 128 + 8 * hh; const float* bp1 = bp0 + (size_t)32 * 8 * 128;
                    f32x16 acc0, acc1;
#pragma unroll
                    for (int i = 0; i < 16; ++i) { acc0[i] = 0.f; acc1[i] = 0.f; }
#pragma unroll 2
                    for (int ks = 0; ks < 8; ++ks) { u32x4 w_; w_.x = pk2(*pj[0], *pj[1]); w_.y = pk2(*pj[2], *pj[3]); w_.z = pk2(*pj[4], *pj[5]); w_.w = pk2(*pj[6], *pj[7]); const bf16x8 afr = __builtin_bit_cast(bf16x8, w_);
#pragma unroll
                        for (int j = 0; j < 8; ++j) pj[j] += (size_t)16 * D;
                        bf16x8 b0, b1; CVT8(b0, *(const f32x4*)(bp0 + ks * 16), *(const f32x4*)(bp0 + ks * 16 + 4)); CVT8(b1, *(const f32x4*)(bp1 + ks * 16), *(const f32x4*)(bp1 + ks * 16 + 4));
                        acc0 = __builtin_amdgcn_mfma_f32_32x32x16_bf16(afr, b0, acc0, 0, 0, 0); acc1 = __builtin_amdgcn_mfma_f32_32x32x16_bf16(afr, b1, acc1, 0, 0, 0); }
                    bf16* o = WOUT_T + (size_t)(rt * 32 + 4 * hh) * KMIX + h * 256 + cg * 64 + r32;
#pragma unroll
                    for (int i = 0; i < 16; ++i) { o[(size_t)((i & 3) + 8 * (i >> 2)) * KMIX] = (bf16)f2bf(acc0[i]); o[(size_t)((i & 3) + 8 * (i >> 2)) * KMIX + 32] = (bf16)f2bf(acc1[i]); }
                }
            }
#undef CVT8
        }
        for (int prh_ = 0; prh_ < 1 + PR_H1; ++prh_)
        for (int m = gw; m < T; m += NGW) rms_row_to_bf16(A_->in[I_X] + (size_t)m * D, A_->in[I_NORM_MIX_G], H1 + (size_t)m * D, lane);
        for (int m = gw; m < NMEM; m += NGW) rms_row_to_bf16(A_->in[I_MEM] + (size_t)m * D, A_->in[I_MEM_NORM_G], MEMN + (size_t)m * D, lane);
        GRID_BAR(0);
    }

    if (IN(1)) for (int rep_ = 0; rep_ < NREP(1); ++rep_) {
        PHASE_IDS
        if (rep_) xcd_barrier(bar, tid);
        pg8::DenseOrder S; S.init(T, NPROJ, D, D, G, bx);
        pg8::EpiProj E{QABS, CKVRAW, QI, SMALL, MQKRAW, MV, MO};
        pg8::gemm_phase(tid, lds, H1, WIN_T, D, S, E);
        GRID_BAR(1);
    }

    if (IN(2)) for (int rep_ = 0; rep_ < NREP(2); ++rep_) {
        PHASE_IDS
        if (rep_) xcd_barrier(bar, tid);
#ifndef P2_SUB
#define P2_SUB 15
#endif
        if (P2_SUB & 1) {
            for (int prk_ = 0; prk_ < 1 + PR_KV; ++prk_)
            for (int id = bx; id < 256; id += G) {
                const int rt = id & 3, ct = id >> 2;
                mini_gemm64(lds, MEMN + (size_t)(rt * 64) * D, D, WCKV_T + (size_t)(ct * 64) * D, D, 16, KC + (size_t)(rt * 64) * 4096 + ct * 64, 4096u, wave, lane);
            }
        }
        __syncthreads();
        if (P2_SUB & 4) for (int t = gw; t < T; t += NGW) {
            const f32x4 v = ((const f32x4*)(CKVRAW + (size_t)t * 256))[lane];
            const float r = rsqrtf(wave_sum((v[0] * v[0] + v[1] * v[1]) + (v[2] * v[2] + v[3] * v[3])) * (1.f / 256.f) + EPS);
            const f32x4 g = ((const f32x4*)A_->in[I_KV_NORM_G])[lane];
            u32x2 w; w.x = pk2(v[0] * r * g[0], v[1] * r * g[1]); w.y = pk2(v[2] * r * g[2], v[3] * r * g[3]);
            ((u32x2*)(CKVN + (size_t)t * 256))[lane] = w;
            const float kv = SMALL[(size_t)t * 256 + lane];
            const float rk = rsqrtf(wave_sum(kv * kv) * (1.f / 64.f) + EPS);
            KIDXN[(size_t)t * 64 + lane] = (bf16)f2bf(kv * rk * A_->in[I_KIDX_NORM_G][lane]);
        }
        if (P2_SUB & 8) {
            LAS float* kq = (LAS float*)lds;
            LAS bf16* KWT = (LAS bf16*)(lds + 32768);
            LAS bf16* VTl = (LAS bf16*)(lds + 51200);
            LAS float* sw = (LAS float*)(lds + 98304);
            const float* conv_w = A_->in[I_CONV_W]; const float* conv_b = A_->in[I_CONV_B]; const float* gate_b = A_->in[I_GATE_B];
            const int r32 = lane & 31, hh = lane >> 5;
            for (int prm_ = 0; prm_ < 1 + PR_ML; ++prm_)
            for (int uu = bx; uu < NCH * 4; uu += G) {
                const int c = uu >> 2, h = uu & 3, t0 = c * CH;
                __syncthreads();
                if (wave == 0) {
                    const int t = t0 + lane; const float li = SMALL[(size_t)t * 256 + 72 + h] + gate_b[h]; const float mf = SMALL[(size_t)t * 256 + 76 + h] + gate_b[4 + h];
                    float bsc = fminf(mf, 0.f) - log1pf(__expf(-fabsf(mf)));
#pragma unroll
                    for (int o = 1; o < 64; o <<= 1) { const float v = __shfl_up(bsc, o); if (lane >= o) bsc += v; }
                    const float g = __shfl(bsc, 63); const float dec = g - bsc + li; const float mx = wave_max(dec);
                    sw[lane] = __expf(dec - mx); sw[128 + lane] = li; sw[192 + lane] = bsc;
                    GATES[GT_B + (size_t)t * 4 + h] = bsc; GATES[GT_LI + (size_t)t * 4 + h] = li;
                    if (lane == 0) { GATES[GT_G + c * 4 + h] = g; GATES[GT_MLOC + c * 4 + h] = mx; } }
                __syncthreads();
                { const int ch = tid & 255, th = tid >> 8; const int src = ch < 128 ? h * 128 + ch : 512 + h * 128 + (ch - 128);
                  const float cw0 = conv_w[src], cw1 = conv_w[1024 + src], cw2 = conv_w[2048 + src], cw3 = conv_w[3072 + src], cbias = conv_b[src];
                  const int tb = t0 + th * 32 - 3; float xr[35];
#pragma unroll
                  for (int i = 0; i < 35; ++i) xr[i] = (tb + i >= 0) ? MQKRAW[(size_t)(tb + i) * 1024 + src] : 0.f;
#pragma unroll
                  for (int i = 0; i < 32; ++i) { const int s_ = th * 32 + i, t = t0 + s_; float y = cbias + ((cw0 * xr[i] + cw1 * xr[i + 1]) + (cw2 * xr[i + 2] + cw3 * xr[i + 3]));
                      y = y / (1.f + __expf(-y));
                      if (ch < 128) QCM[(size_t)t * 512 + h * 128 + ch] = (bf16)f2bf(y * 0.08838834764831845f);
                      else { const unsigned kb = f2bf(y); KCM[(size_t)t * 512 + h * 128 + (ch - 128)] = (bf16)kb; const float kf = bf2f(kb); kq[s_ * 128 + (ch - 128)] = kf; KWT[(ch - 128) * 72 + s_] = (bf16)f2bf(sw[s_] * kf); } } }
#pragma unroll 1
                for (int e = tid; e < 64 * 32; e += 512) { const int s = e & 63, c8 = e >> 6; const u32x4 vv = *(const u32x4*)(MV + (size_t)(t0 + s) * 1024 + h * 256 + c8 * 8);
                    LAS bf16* d = VTl + (c8 * 8) * 72 + s;
                    d[0] = (bf16)(vv.x & 0xffffu); d[72] = (bf16)(vv.x >> 16); d[144] = (bf16)(vv.y & 0xffffu); d[216] = (bf16)(vv.y >> 16);
                    d[288] = (bf16)(vv.z & 0xffffu); d[360] = (bf16)(vv.z >> 16); d[432] = (bf16)(vv.w & 0xffffu); d[504] = (bf16)(vv.w >> 16); }
                __syncthreads();
#pragma unroll 1
                for (int e = tid; e < 256 * 8; e += 512) { const int dv = e >> 3, ch = e & 7; *(u32x4*)(VTM + ((size_t)(c * 4 + h) * 256 + dv) * 64 + ch * 8) = *(const LAS u32x4*)(VTl + dv * 72 + ch * 8); }
                {
                    bf16x8 af[4];
#pragma unroll
                    for (int ks = 0; ks < 4; ++ks) af[ks] = *(const LAS bf16x8*)(VTl + (wave * 32 + r32) * 72 + ks * 16 + 8 * hh);
#pragma unroll 1
                    for (int j = 0; j < 4; ++j) { f32x16 acc;
#pragma unroll
                        for (int i = 0; i < 16; ++i) acc[i] = 0.f;
#pragma unroll
                        for (int ks = 0; ks < 4; ++ks) { const bf16x8 bfr = *(const LAS bf16x8*)(KWT + (j * 32 + r32) * 72 + ks * 16 + 8 * hh); acc = __builtin_amdgcn_mfma_f32_32x32x16_bf16(af[ks], bfr, acc, 0, 0, 0); }
                        float* o = LST + ((size_t)(c * 4 + h) * 256 + wave * 32 + 4 * hh) * 128 + j * 32 + r32;
#pragma unroll
                        for (int i = 0; i < 16; ++i) o[(size_t)((i & 3) + 8 * (i >> 2)) * 128] = acc[i]; }
                }
                if (tid < 128) { float a = 0.f;
#pragma unroll 4
                    for (int s = 0; s < 64; ++s) a += sw[s] * kq[s * 128 + tid]; NL[(size_t)(c * 4 + h) * 128 + tid] = a; }
            }
        }
        GRID_BAR(2);
    }

    if (IN(3)) for (int rep_ = 0; rep_ < NREP(3); ++rep_) {
        PHASE_IDS
        if (rep_) xcd_barrier(bar, tid);
#ifndef R_SCAN
#define R_SCAN 1
#endif
        for (int prv_ = 0; prv_ < 1 + PR_VF; ++prv_)
        for (int id = bx; id < 512; id += G) {
            const int h = id >> 7, rt = (id & 127) >> 2, ct = id & 3;
            mini_gemm64(lds, WCO_T + (size_t)(rt * 64) * D + h * 512, D, KC + (size_t)(ct * 64) * 4096 + 2048 + h * 512, 4096u, 4, VF + (size_t)(rt * 64) * 1024 + h * 256 + ct * 64, 1024u, wave, lane);
        }
        for (int prv_ = 0; prv_ < 1 + PR_VF; ++prv_)
        for (int id = bx; id < 512; id += G) {
            const int h = id >> 7, kt = (id & 127) >> 2, mt = id & 3;
            mini_gemm64(lds, KC + (size_t)(mt * 64) * 4096 + h * 512, 4096u, WCQ_T + (size_t)(kt * 64) * D + h * 512, D, 4, MF + (size_t)(h * 256 + mt * 64) * D + kt * 64, D, wave, lane);
        }
        for (int rscan_ = 0; rscan_ < R_SCAN; ++rscan_) {
            LAS float* am = (LAS float*)lds;
            LAS float* sm = am + 512;
            LAS float* gl = am + 1024;
            __syncthreads();
            gl[tid] = GATES[GT_G + tid]; gl[512 + tid] = GATES[GT_MLOC + tid];
            __syncthreads();
            if (tid < 4) { float m = 0.f;
#pragma unroll 1
                for (int k = 0; k < NCH; ++k) { const float g = gl[k * 4 + tid], ml = gl[512 + k * 4 + tid]; const float mn = fmaxf(g + m, ml);
                    am[tid * 128 + k] = __expf(g + m - mn); sm[tid * 128 + k] = __expf(ml - mn); if (bx == 0) GATES[GT_MPREV + k * 4 + tid] = m; m = mn; } }
            __syncthreads();
            for (int e = bx * 512 + tid; e < 4 * 32768; e += G * 512) { const int h = e >> 15, rem = e & 32767; float C = 0.f;
#pragma unroll 1
                for (int kb = 0; kb < NCH; kb += 32) { float l[32];
#pragma unroll
                    for (int i = 0; i < 32; ++i) l[i] = __builtin_nontemporal_load(LST + (size_t)((kb + i) * 4 + h) * 32768 + rem);
#pragma unroll
                    for (int i = 0; i < 32; ++i) { const int k = kb + i; CST[(size_t)(k * 4 + h) * 32768 + rem] = (bf16)f2bf(C); C = am[h * 128 + k] * C + sm[h * 128 + k] * l[i]; } } }
            if (bx == 0) { const int h = tid >> 7, dk = tid & 127; float n = 0.f;
#pragma unroll 1
                for (int kb = 0; kb < NCH; kb += 16) { float l[16];
#pragma unroll
                    for (int i = 0; i < 16; ++i) l[i] = NL[(size_t)((kb + i) * 4 + h) * 128 + dk];
#pragma unroll
                    for (int i = 0; i < 16; ++i) { const int k = kb + i; NST[(size_t)(k * 4 + h) * 128 + dk] = n; n = am[h * 128 + k] * n + sm[h * 128 + k] * l[i]; } } }
            __syncthreads();
        }
        {
            const int r32 = lane & 31, hh = lane >> 5;
#pragma unroll 1
            for (int ui_ = 0; ui_ * G < 1144; ++ui_) {
                const int L = ui_ * G + ((ui_ & 1) ? (G - 1 - bx) : bx); if (L >= 1144) continue;
                int sl = 0, g;
                if (L < 912) { int rem = L;
#pragma unroll 1
                    while (rem >= 226 - 32 * sl) { rem -= 226 - 32 * sl; ++sl; }
                    g = 32 * sl + 30 + rem; }
                else { int q = L - 912, r, j; if (q < 176) { r = 15 - q / 16; j = q % 16; sl = j >> 1; } else { q -= 176; r = 4 - q / 14; j = q % 14; sl = 1 + (j >> 1); }
                    g = 2 * (r - 1 + 16 * sl) + (j & 1); }
                const int c = g >> 1, tq0 = g * 32 + wave * 4, N = 64 * (c + 1);
                const int jb = sl * 32, je = (N >> 5) < jb + 32 ? (N >> 5) : jb + 32;
                if (N <= 256) continue;
                unsigned short* rowb = (c < 127 ? (unsigned short*)A_->out + (size_t)2048 * c * (c + 1) : (unsigned short*)(ws + WS_SC127)) + (size_t)(tq0 & 63) * N + jb * 32;
                LAS unsigned short* stg = (LAS unsigned short*)(lds + wave * 8192);
                bf16x8 af[4]; float wq[16];
                { const bf16* qp = QI + (size_t)(tq0 + (r32 >> 3)) * 512 + (r32 & 7) * 64 + 8 * hh;
#pragma unroll
                  for (int ks = 0; ks < 4; ++ks) af[ks] = *(const bf16x8*)(qp + ks * 16);
#pragma unroll
                  for (int qq = 0; qq < 4; ++qq)
#pragma unroll
                      for (int i = 0; i < 4; ++i) wq[qq * 4 + i] = SMALL[(size_t)(tq0 + qq) * 256 + 64 + 4 * hh + i] * 0.04419417382415922f; }
#define IDX_GROUP(gi_) do { const int tile_ = jb + (gi_) * 8 + wave; if (tile_ < je) { _Pragma("unroll") for (int i4 = 0; i4 < 4; ++i4) { const int row_ = i4 * 8 + (lane >> 3); \
                        const bf16* gsrc_ = KIDXN + (size_t)(tile_ * 32 + row_) * 64 + (((lane & 7) ^ (row_ & 7)) * 8); \
                        const unsigned ldst_ = __builtin_amdgcn_readfirstlane((unsigned)(size_t)lds + 65536u + (unsigned)(((gi_) & 1) * 32768 + wave * 4096 + i4 * 1024)); unsigned keep_; \
                        asm volatile("s_mov_b32 %0, m0\n\ts_mov_b32 m0, %2\n\ts_nop 0\n\tglobal_load_lds_dwordx4 %1, off\n\ts_mov_b32 m0, %0" : "=&s"(keep_) : "v"(gsrc_), "s"(ldst_) : "memory"); } } } while (0)
#define IDX_LOAD(buf, gi_, tl_) do { const LAS unsigned char* kt_ = lds + 65536 + ((gi_) & 1) * 32768 + (tl_) * 4096 + r32 * 128; \
                    _Pragma("unroll") for (int ks = 0; ks < 4; ++ks) buf[ks] = *(const LAS bf16x8*)(kt_ + (((ks * 2 + hh) ^ (r32 & 7)) * 16)); } while (0)
#define RELU_(x_) __int_as_float(max(__float_as_int(x_), 0))
#define IDX_TILE(buf, jj) do { const int s0 = (jj) * 32; f32x16 acc; _Pragma("unroll") for (int i = 0; i < 16; ++i) acc[i] = 0.f; \
                        _Pragma("unroll") for (int ks = 0; ks < 4; ++ks) acc = __builtin_amdgcn_mfma_f32_32x32x16_bf16(af[ks], buf[ks], acc, 0, 0, 0); \
                        if (PR_MFMA) { f32x16 acc2; _Pragma("unroll") for (int i = 0; i < 16; ++i) acc2[i] = 0.f; _Pragma("unroll") for (int ks = 0; ks < 4; ++ks) acc2 = __builtin_amdgcn_mfma_f32_32x32x16_bf16(af[ks], buf[ks], acc2, 0, 0, 0); asm volatile("" :: "v"(acc2)); } \
                        if (PR_EPI) { f32x16 a3 = acc; asm volatile("" : "+v"(a3)); float p3[4]; _Pragma("unroll") for (int qq = 0; qq < 4; ++qq) p3[qq] = (wq[qq * 4] * fmaxf(a3[qq * 4], 0.f) + wq[qq * 4 + 1] * fmaxf(a3[qq * 4 + 1], 0.f)) + (wq[qq * 4 + 2] * fmaxf(a3[qq * 4 + 2], 0.f) + wq[qq * 4 + 3] * fmaxf(a3[qq * 4 + 3], 0.f)); \
                            _Pragma("unroll") for (int qq = 0; qq < 4; ++qq) p3[qq] += __shfl_xor(p3[qq], 32); asm volatile("" :: "v"(p3[0]), "v"(p3[1]), "v"(p3[2]), "v"(p3[3])); } \
                        float part[4]; \
                          \
                        _Pragma("unroll") for (int qq = 0; qq < 4; ++qq) part[qq] = (wq[qq * 4] * RELU_(acc[qq * 4]) + wq[qq * 4 + 1] * RELU_(acc[qq * 4 + 1])) + (wq[qq * 4 + 2] * RELU_(acc[qq * 4 + 2]) + wq[qq * 4 + 3] * RELU_(acc[qq * 4 + 3])); \
                        const auto s02_ = __builtin_amdgcn_permlane32_swap(__float_as_uint(part[0]), __float_as_uint(part[2]), false, false), s13_ = __builtin_amdgcn_permlane32_swap(__float_as_uint(part[1]), __float_as_uint(part[3]), false, false); \
                          \
                        const float v0 = __uint_as_float(s02_[0]) + __uint_as_float(s02_[1]), v1 = __uint_as_float(s13_[0]) + __uint_as_float(s13_[1]); \
                        unsigned u0 = __builtin_bit_cast(unsigned short, (_Float16)v0), u1 = __builtin_bit_cast(unsigned short, (_Float16)v1); \
                        u0 = (u0 == 0x8000u) ? 0u : u0; u1 = (u1 == 0x8000u) ? 0u : u1; \
                        stg[(2 * hh) * 1024 + s0 - jb * 32 + r32] = (unsigned short)((u0 & 0x8000u) ? ~u0 : (u0 | 0x8000u)); \
                        stg[(2 * hh + 1) * 1024 + s0 - jb * 32 + r32] = (unsigned short)((u1 & 0x8000u) ? ~u1 : (u1 | 0x8000u)); } while (0)
                { const int ngrp = (je - jb + 7) >> 3;
                  __syncthreads();
                  IDX_GROUP(0);
#pragma unroll 1
                  for (int gi = 0; gi < ngrp; ++gi) {
                      asm volatile("s_waitcnt vmcnt(0)" ::: "memory");
                      __syncthreads();
                      if (gi + 1 < ngrp) IDX_GROUP(gi + 1);
#pragma unroll 2
                      for (int tl = 0; tl < 8; ++tl) { const int jt = jb + gi * 8 + tl; if (jt < je) { bf16x8 kbf[4]; IDX_LOAD(kbf, gi, tl); IDX_TILE(kbf, jt); } }
                  } }
#undef IDX_GROUP
#undef IDX_LOAD
#undef IDX_TILE
                LDS_WAIT(); asm volatile("" ::: "memory");
                { const int nk = (je - jb) * 32, np = nk >> 3;
                  for (int i = lane; i < 4 * np; i += 64) { const int qq = i / np, p = i - qq * np; *(u32x4*)(rowb + (size_t)qq * N + p * 8) = *(const LAS u32x4*)(stg + qq * 1024 + p * 8); } }
                LDS_WAIT(); asm volatile("" ::: "memory");
            }
        }
        GRID_BAR(3);
    }
    if (IN(4)) for (int rep_ = 0; rep_ < NREP(4); ++rep_) {
        PHASE_IDS
        if (rep_) xcd_barrier(bar, tid);
        {
            LAS int* hist = (LAS int*)(lds + MISC_OFF + 4096) + wave * 256;
            LAS int* sel = (LAS int*)(lds + MISC_OFF + 12288) + wave * 256;
            const int r16 = lane & 15, g4 = lane >> 4;
            __syncthreads();
#pragma unroll 1
            for (int ui_ = 0; ui_ * G < T / 8; ++ui_) {
                const int uu = ui_ * G + ((ui_ & 1) ? (G - 1 - bx) : bx); if (uu >= T / 8) continue;
                const int t0 = uu * 8, t = t0 + wave, c = t0 >> 6, N = (c + 1) * 64, ng = N >> 6;
                f32x4 ta[8], tb[8]; float tsc[16]; const int tri = uu * 8 + wave, tre = tri >> 8, trk = (tri & 255) >> 3, trn = tri & 7;
#define TR_FINISH() tr_finish64s(ta, tb, tsc, 64 * trk, 64 * trn, WGU_T + (size_t)tre * 1024 * D, D, (trn / 2) * 128, 0, lds + wave * 16384, lane);
#define TR_ISSUE() do { tr_load64(A_->in[I_W_GATE] + (size_t)tre * D * DEXP, DEXP, 64 * trk, 64 * trn, ta, tb, lane); tr_scales64(A_->in[I_NORM_FFN_G], 64 * trk, tsc, lane); } while (0)
                {
                        if (N > 256) {
                            const unsigned short* rb = (c < 127 ? (const unsigned short*)A_->out + (size_t)2048 * c * (c + 1) : (const unsigned short*)(ws + WS_SC127)) + (size_t)(t & 63) * N;
                            unsigned kraw[64];
#define KR(ri_) (((ri_) & 1) ? (kraw[(ri_) >> 1] >> 16) : (kraw[(ri_) >> 1] & 0xffffu))
#define KR_OPAQUE() do { _Pragma("unroll") for (int i_ = 0; i_ < 64; ++i_) asm volatile("" : "+v"(kraw[i_])); } while (0)
#pragma unroll
                            for (int b8 = 0; b8 < 16; ++b8) {
#pragma unroll
                                for (int i = 0; i < 4; ++i) kraw[b8 * 4 + i] = 0u;
                                if (b8 * 8 < ng) { const bool ok = b8 * 512 + lane * 8 < N;
                                    u32x4 v = __builtin_nontemporal_load((const GAS u32x4*)(rb + (ok ? b8 * 512 + lane * 8 : 0))); if (!ok) v = (u32x4){0u, 0u, 0u, 0u};
                                    kraw[b8 * 4 + 0] = v.x; kraw[b8 * 4 + 1] = v.y; kraw[b8 * 4 + 2] = v.z; kraw[b8 * 4 + 3] = v.w; } }
                            TR_ISSUE();
                            int krem = 256; unsigned prefix = 0u;
#pragma unroll 1
                            for (int ps = 0; ps < 2; ++ps) { const int shift = 8 - 8 * ps;
                                hist[lane] = 0; hist[64 + lane] = 0; hist[128 + lane] = 0; hist[192 + lane] = 0;
                                KR_OPAQUE();
#pragma unroll
                                for (int b8 = 0; b8 < 16; ++b8) { if (b8 * 8 < ng) {
#pragma unroll
                                    for (int i = 0; i < 8; ++i) { const unsigned k = KR(b8 * 8 + i); const bool mt = (k != 0u) && (ps == 0 || (k >> 8) == prefix);
                                        if (mt) __hip_atomic_fetch_add(hist + (int)((k >> shift) & 255u), 1, __ATOMIC_RELAXED, __HIP_MEMORY_SCOPE_WORKGROUP); } } }
                                const int h0 = hist[4 * lane], h1 = hist[4 * lane + 1], h2 = hist[4 * lane + 2], h3 = hist[4 * lane + 3];
                                int sfx = h0 + h1 + h2 + h3;
#pragma unroll
                                for (int o = 1; o < 64; o <<= 1) { const int v = __shfl_down(sfx, o); if (lane + o < 64) sfx += v; }
                                const unsigned long long mge = __ballot(sfx >= krem);
                                const int ls = 63 - __builtin_clzll(mge);
                                const int above_l = (ls < 63) ? __builtin_amdgcn_readlane(sfx, (ls + 1) & 63) : 0;
                                const int b1 = __builtin_amdgcn_readlane(h1, ls), b2 = __builtin_amdgcn_readlane(h2, ls), b3 = __builtin_amdgcn_readlane(h3, ls);
                                int dg, above;
                                if (above_l + b3 >= krem) { dg = 3; above = above_l; } else if (above_l + b3 + b2 >= krem) { dg = 2; above = above_l + b3; }
                                else if (above_l + b3 + b2 + b1 >= krem) { dg = 1; above = above_l + b3 + b2; } else { dg = 0; above = above_l + b3 + b2 + b1; }
                                krem -= above; prefix = (prefix << 8) | (unsigned)(4 * ls + dg); }
                            const unsigned thr = prefix;
                            TR_FINISH();
                            KR_OPAQUE();
                            int cg = 0; const int thi = (int)thr;
#pragma unroll
                            for (int b8 = 0; b8 < 16; ++b8) { if (b8 * 8 < ng) {
#pragma unroll
                                for (int i = 0; i < 8; ++i) { const int k = (int)KR(b8 * 8 + i); cg += (int)((unsigned)(thi - k) >> 31); } } }
#pragma unroll
                            for (int o = 1; o < 64; o <<= 1) cg += __shfl_xor(cg, o);
                            const int ngt = __builtin_amdgcn_readfirstlane(cg), need = 256 - ngt;
                            KR_OPAQUE();
                            int pg = 0, pe = 0; const unsigned long long ltm = (1ull << lane) - 1ull;
                            const int dump = (int)(((LAS int*)(lds + MISC_OFF + 20480) + wave * 64 + lane) - sel);
#pragma unroll
                            for (int b8 = 0; b8 < 16; ++b8) { if (b8 * 8 < ng) {
#pragma unroll
                                for (int i = 0; i < 8; ++i) { const unsigned k = KR(b8 * 8 + i); const int sidx = b8 * 512 + lane * 8 + i; const bool gt = k > thr, eq = k == thr;
                                    const unsigned long long mg = __ballot(gt), me = __ballot(eq);
                                    const int pos = (int)__builtin_amdgcn_mbcnt_hi((unsigned)(mg >> 32), __builtin_amdgcn_mbcnt_lo((unsigned)mg, (unsigned)pg));
                                    sel[gt ? pos : dump] = sidx; pg += __popcll(mg);
                                    if (me) { const int r = pe + __popcll(me & ltm); if (eq && r < need) sel[ngt + r] = sidx; pe += __popcll(me); } } } }
#undef KR
#undef KR_OPAQUE
                        } else {
                            TR_ISSUE();
#pragma unroll
                            for (int i = 0; i < 4; ++i) sel[i * 64 + lane] = i * 64 + lane;
                            TR_FINISH();
                        }
                        LDS_WAIT(); asm volatile("" ::: "memory");
                }
#undef TR_ISSUE
#undef TR_FINISH
                {
                        LAS unsigned char* cb = lds + wave * 16384;
                        const int nch = (N > 256 ? 256 : N) >> 5;
                        bf16x8 qf[8];
                        { const bf16* qp = QABS + (size_t)t * 2048 + (r16 & 7) * 256 + 8 * g4;
#pragma unroll
                          for (int ks = 0; ks < 8; ++ks) qf[ks] = *(const bf16x8*)(qp + ks * 32); }
                        f32x4 O[16];
#pragma unroll
                        for (int i = 0; i < 16; ++i) O[i] = (f32x4){0.f, 0.f, 0.f, 0.f};
                        float mrun = -3.0e38f, lrun = 0.f;
                        const int tq = r16 >> 2, tp = r16 & 3;
#pragma unroll 1
                        for (int ch = 0; ch < nch; ++ch) { const int slot0 = ch * 32;
#pragma unroll
                            for (int k = 0; k < 16; ++k) { const int im = k >> 3, row = (k & 7) * 4 + g4; const int lc = r16 ^ (((row & 3) << 2) | ((row >> 2) & 3)); const int key = sel[slot0 + row];
                                __builtin_amdgcn_global_load_lds((const unsigned*)(CKVN + (size_t)key * 256 + im * 128 + lc * 8), (LAS unsigned*)(cb + im * 8192 + (k & 7) * 1024), 16, 0, 0); }
                            asm volatile("s_waitcnt vmcnt(0)" ::: "memory");
                            const LAS unsigned char* cbc = cb;
                            f32x4 s0 = (f32x4){0.f, 0.f, 0.f, 0.f}, s1 = s0;
#pragma unroll
                            for (int ks = 0; ks < 8; ++ks) { const int im = ks >> 2, lc = 4 * (ks & 3) + g4;
                                const int ra = r16, rb = 16 + r16;
                                const bf16x8 k0 = *(const LAS bf16x8*)(cbc + im * 8192 + 256 * ra + 16 * (lc ^ (((ra & 3) << 2) | ((ra >> 2) & 3))));
                                const bf16x8 k1 = *(const LAS bf16x8*)(cbc + im * 8192 + 256 * rb + 16 * (lc ^ (((rb & 3) << 2) | ((rb >> 2) & 3))));
                                s0 = __builtin_amdgcn_mfma_f32_16x16x32_bf16(k0, qf[ks], s0, 0, 0, 0); s1 = __builtin_amdgcn_mfma_f32_16x16x32_bf16(k1, qf[ks], s1, 0, 0, 0);
                                if ((ks & 1) == 1) __builtin_amdgcn_sched_barrier(0); }
                            float mx = fmaxf(fmaxf(fmaxf(s0[0], s0[1]), fmaxf(s0[2], s0[3])), fmaxf(fmaxf(s1[0], s1[1]), fmaxf(s1[2], s1[3])));
                            mx = fmaxf(mx, __shfl_xor(mx, 16)); mx = fmaxf(mx, __shfl_xor(mx, 32));
                            const float mnew = fmaxf(mrun, mx), alpha = __expf(mrun - mnew); mrun = mnew;
                            float p[8]; float ls = 0.f;
#pragma unroll
                            for (int i = 0; i < 4; ++i) { p[i] = __expf(s0[i] - mnew); p[4 + i] = __expf(s1[i] - mnew); ls += p[i] + p[4 + i]; }
                            ls += __shfl_xor(ls, 16); ls += __shfl_xor(ls, 32);
                            lrun = lrun * alpha + ls;
                            u32x4 pw; pw.x = pk2(p[0], p[1]); pw.y = pk2(p[2], p[3]); pw.z = pk2(p[4], p[5]); pw.w = pk2(p[6], p[7]);
                            const bf16x8 pf = __builtin_bit_cast(bf16x8, pw);
#pragma unroll
                            for (int i = 0; i < 16; ++i) O[i] = O[i] * alpha;
                            const unsigned cbase = (unsigned)(size_t)cbc + 256u * (4 * g4 + tq) + 8u * (tp & 1);
#pragma unroll
                            for (int cq = 0; cq < 4; ++cq) {
                                u32x2 va[4], vb[4]; unsigned ad[4];
#pragma unroll
                                for (int j = 0; j < 4; ++j) { const int ct = cq * 4 + j; ad[j] = cbase + (unsigned)((ct >> 3) * 8192) + 16u * ((2 * (ct & 7) + (tp >> 1)) ^ ((tq << 2) | g4)); }
                                asm volatile("ds_read_b64_tr_b16 %0, %8\n\tds_read_b64_tr_b16 %1, %8 offset:4096\n\tds_read_b64_tr_b16 %2, %9\n\tds_read_b64_tr_b16 %3, %9 offset:4096\n\t"
                                             "ds_read_b64_tr_b16 %4, %10\n\tds_read_b64_tr_b16 %5, %10 offset:4096\n\tds_read_b64_tr_b16 %6, %11\n\tds_read_b64_tr_b16 %7, %11 offset:4096\n\ts_waitcnt lgkmcnt(0)"
                                             : "=&v"(va[0]), "=&v"(vb[0]), "=&v"(va[1]), "=&v"(vb[1]), "=&v"(va[2]), "=&v"(vb[2]), "=&v"(va[3]), "=&v"(vb[3])
                                             : "v"(ad[0]), "v"(ad[1]), "v"(ad[2]), "v"(ad[3]) : "memory");
#pragma unroll
                                for (int j = 0; j < 4; ++j) { u32x4 vv; vv.x = va[j].x; vv.y = va[j].y; vv.z = vb[j].x; vv.w = vb[j].y;
                                    O[cq * 4 + j] = __builtin_amdgcn_mfma_f32_16x16x32_bf16(__builtin_bit_cast(bf16x8, vv), pf, O[cq * 4 + j], 0, 0, 0); } }
                        }
                        const float inv = 1.f / lrun;
                        if (r16 < 8) {
#pragma unroll
                            for (int i = 0; i < 16; ++i) { u32x2 w; w.x = pk2(O[i][0] * inv, O[i][1] * inv); w.y = pk2(O[i][2] * inv, O[i][3] * inv); __builtin_nontemporal_store(w, (u32x2*)(MIXIN + (size_t)t * KMIX + r16 * 256 + i * 16 + 4 * g4)); } }
                }
            }
        }
        __syncthreads();
    }

    if (IN(4)) for (int rep_ = 0; rep_ < NREP(4); ++rep_) {
        PHASE_IDS
        if (rep_) xcd_barrier(bar, tid);
        LAS float* Sf = (LAS float*)lds;
        LAS bf16* Sb = (LAS bf16*)(lds + 16640);
        LAS float* ms = (LAS float*)(lds + 25856);
        LAS float* ssq = (LAS float*)(lds + 27904);
        const float* mlg = A_->in[I_ML_NORM_G];
        const int r32 = lane & 31, hh = lane >> 5;
        for (int uu = bx; uu < NCH * 4; uu += G) {
            const int c = uu >> 2, h = uu & 3, t0 = c * CH;
            __syncthreads();
            if (tid < 64) { const float b = GATES[GT_B + (size_t)(t0 + tid) * 4 + h], li = GATES[GT_LI + (size_t)(t0 + tid) * 4 + h]; ms[tid] = b; ms[64 + tid] = li - b; }
            if (tid < 128) ms[384 + tid] = NST[(size_t)(c * 4 + h) * 128 + tid];
            __syncthreads();
            float mt = 0.f;
            if (wave == 0) { const float mprev = GATES[GT_MPREV + c * 4 + h]; float pm = ms[64 + lane];
#pragma unroll
                for (int o = 1; o < 64; o <<= 1) { const float v = __shfl_up(pm, o); if (lane >= o) pm = fmaxf(pm, v); }
                const float mm = fmaxf(mprev, pm); mt = ms[lane] + mm; ms[128 + lane] = -mm; ms[192 + lane] = __expf(mprev - mm);
                float qn = 0.f; const bf16* qr = QCM + (size_t)(t0 + lane) * 512 + h * 128; u32x4 qq[16];
#pragma unroll
                for (int k8 = 0; k8 < 16; ++k8) qq[k8] = *(const u32x4*)(qr + k8 * 8);
#pragma unroll
                for (int k8 = 0; k8 < 16; ++k8) { const LAS float* np = ms + 384 + k8 * 8;
                    qn += (bf2f(qq[k8].x & 0xffffu) * np[0] + bf2f(qq[k8].x >> 16) * np[1]) + (bf2f(qq[k8].y & 0xffffu) * np[2] + bf2f(qq[k8].y >> 16) * np[3]) + (bf2f(qq[k8].z & 0xffffu) * np[4] + bf2f(qq[k8].z >> 16) * np[5]) + (bf2f(qq[k8].w & 0xffffu) * np[6] + bf2f(qq[k8].w >> 16) * np[7]); }
                ms[320 + lane] = qn; }
            __syncthreads();
            if (wave < 4) {
                const int tm = wave >> 1, tn = wave & 1;
                f32x16 acc;
#pragma unroll
                for (int i = 0; i < 16; ++i) acc[i] = 0.f;
                if (tn <= tm) { const bf16* qr = QCM + (size_t)(t0 + tm * 32 + r32) * 512 + h * 128 + 8 * hh; const bf16* kr = KCM + (size_t)(t0 + tn * 32 + r32) * 512 + h * 128 + 8 * hh;
#pragma unroll
                    for (int ks = 0; ks < 8; ++ks) acc = __builtin_amdgcn_mfma_f32_32x32x16_bf16(*(const bf16x8*)(qr + ks * 16), *(const bf16x8*)(kr + ks * 16), acc, 0, 0, 0); }
                const int sidx = tn * 32 + r32; const float us = ms[64 + sidx];
#pragma unroll
                for (int i = 0; i < 16; ++i) { const int t = tm * 32 + (i & 3) + 8 * (i >> 2) + 4 * hh; const float v = (sidx <= t) ? acc[i] * __expf(ms[128 + t] + us) : 0.f; Sf[t * 65 + sidx] = v; Sb[t * 72 + sidx] = (bf16)f2bf(v); }
            }
            __syncthreads();
            if (tid < 64) { float rs = 0.f;
#pragma unroll 4
                for (int s2 = 0; s2 < 64; ++s2) rs += Sf[tid * 65 + s2];
                const float dn = ms[192 + tid] * ms[320 + tid] + rs; ms[256 + tid] = fmaxf(fabsf(dn), __expf(-mt)); }
            f32x16 a1[2], a2[2];
#pragma unroll
            for (int tt = 0; tt < 2; ++tt)
#pragma unroll
                for (int i = 0; i < 16; ++i) { a1[tt][i] = 0.f; a2[tt][i] = 0.f; }
            { const bf16* cr = CST + ((size_t)(c * 4 + h) * 256 + wave * 32 + r32) * 128 + 8 * hh; const bf16* q0 = QCM + (size_t)(t0 + r32) * 512 + h * 128 + 8 * hh; const bf16* q1 = q0 + (size_t)32 * 512;
#pragma unroll
              for (int ks = 0; ks < 8; ++ks) { const bf16x8 cf = *(const bf16x8*)(cr + ks * 16); a1[0] = __builtin_amdgcn_mfma_f32_32x32x16_bf16(cf, *(const bf16x8*)(q0 + ks * 16), a1[0], 0, 0, 0); a1[1] = __builtin_amdgcn_mfma_f32_32x32x16_bf16(cf, *(const bf16x8*)(q1 + ks * 16), a1[1], 0, 0, 0); }
              const bf16* vr = VTM + ((size_t)(c * 4 + h) * 256 + wave * 32 + r32) * 64 + 8 * hh;
#pragma unroll
              for (int ks = 0; ks < 4; ++ks) { const bf16x8 vf = *(const bf16x8*)(vr + ks * 16); a2[0] = __builtin_amdgcn_mfma_f32_32x32x16_bf16(vf, *(const LAS bf16x8*)(Sb + r32 * 72 + ks * 16 + 8 * hh), a2[0], 0, 0, 0); a2[1] = __builtin_amdgcn_mfma_f32_32x32x16_bf16(vf, *(const LAS bf16x8*)(Sb + (32 + r32) * 72 + ks * 16 + 8 * hh), a2[1], 0, 0, 0); } }
            __syncthreads();
#pragma unroll
            for (int tt = 0; tt < 2; ++tt) { const int t = tt * 32 + r32; const float ai = ms[192 + t], idn = 1.f / ms[256 + t]; float p = 0.f;
#pragma unroll
                for (int i = 0; i < 16; ++i) { const float v = (ai * a1[tt][i] + a2[tt][i]) * idn; a1[tt][i] = v; p += v * v; }
                p += __shfl_xor(p, 32); if (hh == 0) ssq[wave * 64 + t] = p; }
            __syncthreads();
#pragma unroll
            for (int tt = 0; tt < 2; ++tt) { const int t = tt * 32 + r32; float sq = 0.f;
#pragma unroll
                for (int w2 = 0; w2 < 8; ++w2) sq += ssq[w2 * 64 + t];
                const float r = rsqrtf(sq * (1.f / 256.f) + EPS);
#pragma unroll
                for (int rq = 0; rq < 4; ++rq) { const int dv0 = h * 256 + wave * 32 + 8 * rq + 4 * hh; const f32x4 g = *(const f32x4*)(mlg + dv0); const u32x2 ob = *(const u32x2*)(MO + (size_t)(t0 + t) * 1024 + dv0);
                    const float o0 = bf2f(ob.x & 0xffffu), o1 = bf2f(ob.x >> 16), o2 = bf2f(ob.y & 0xffffu), o3 = bf2f(ob.y >> 16);
                    u32x2 w; w.x = pk2(a1[tt][4 * rq] * r * g[0] / (1.f + __expf(-o0)), a1[tt][4 * rq + 1] * r * g[1] / (1.f + __expf(-o1))); w.y = pk2(a1[tt][4 * rq + 2] * r * g[2] / (1.f + __expf(-o2)), a1[tt][4 * rq + 3] * r * g[3] / (1.f + __expf(-o3)));
                    *(u32x2*)(MIXIN + (size_t)(t0 + t) * KMIX + 2048 + dv0) = w; } }
        }
        GRID_BAR(4);
    }

    if (IN(6)) for (int rep_ = 0; rep_ < NREP(6); ++rep_) {
        PHASE_IDS
        if (rep_) xcd_barrier(bar, tid);
        pg8::DenseOrder S; S.init(T, D, KMIX, KMIX, G, bx);
        pg8::EpiResidT<false> E{A_->in[I_X], X1B, SS2};
        pg8::gemm_phase(tid, lds, MIXIN, WOUT_T, KMIX, S, E);
        GRID_BAR(6);
    }
    if (IN(7)) for (int rep_ = 0; rep_ < NREP(7); ++rep_) {
        PHASE_IDS
        if (rep_) xcd_barrier(bar, tid);
        pg8::DenseOrder S; S.init(T, 1024, D, D, G, bx);
        pg8::EpiSoftmax E{PB, SS2};
        pg8::gemm_phase(tid, lds, X1B, MF, D, S, E);
        { const int nidle = G > 128 ? G - 128 : G, ib = G > 128 ? bx - 128 : bx;
          if (ib >= 0) { LAS unsigned char* scr8 = lds + wave * 16384; __syncthreads();
              for (int r = ib * 8 + wave; r < 32 * 256; r += nidle * 8) { const int e = r / 256, q = r % 256, kb = q / 32, nb = q % 32;
                  tr_item64(A_->in[I_W_DOWN] + (size_t)e * DEXP * D, D, 64 * kb, 64 * nb, nullptr, WDN_T + (size_t)e * D * DEXP, DEXP, 0, 0, scr8, lane); } } }
        GRID_BAR(7);
    }
    if (IN(10)) for (int rep_ = 0; rep_ < NREP(10); ++rep_) {
        PHASE_IDS
        if (rep_) xcd_barrier(bar, tid);
        pg8::DenseOrder S; S.init(T, D, 1024, 1024, G, bx);
        pg8::EpiResidT<true> E{X1B, X2B, nullptr};
        pg8::gemm_phase(tid, lds, PB, VF, 1024, S, E);
        GRID_BAR(10);
    }
    if (IN(11)) for (int rep_ = 0; rep_ < NREP(11); ++rep_) {
        PHASE_IDS
        if (rep_) xcd_barrier(bar, tid);
        LAS float* part = (LAS float*)lds;
        LAS float* ssp = (LAS float*)(lds + 24576);
        LAS int* eb = (LAS int*)(lds + 24576 + 512);
        const int r16 = lane & 15, g4 = lane >> 4;
        for (int uu = bx; uu < T / 32; uu += G) {
            const int t0 = uu * 32; const int tt = wave & 1, ksl = wave >> 1;
            __syncthreads();
            {
                f32x4 acc[3];
#pragma unroll
                for (int i = 0; i < 3; ++i) acc[i] = (f32x4){0.f, 0.f, 0.f, 0.f};
                float ssq = 0.f;
                const bf16* xr = X2B + (size_t)(t0 + tt * 16 + r16) * D + ksl * 512 + 8 * g4;
                const bf16* wh = WRH + (size_t)r16 * D + ksl * 512 + 8 * g4; const bf16* wl = WRL + (size_t)r16 * D + ksl * 512 + 8 * g4;
#pragma unroll 4
                for (int ks = 0; ks < 16; ++ks) { const u32x4 xa = *(const u32x4*)(xr + ks * 32);
                    { const float f0 = bf2f(xa.x & 0xffffu), f1 = bf2f(xa.x >> 16), f2 = bf2f(xa.y & 0xffffu), f3 = bf2f(xa.y >> 16), f4 = bf2f(xa.z & 0xffffu), f5 = bf2f(xa.z >> 16), f6 = bf2f(xa.w & 0xffffu), f7 = bf2f(xa.w >> 16);
                      ssq += ((f0 * f0 + f1 * f1) + (f2 * f2 + f3 * f3)) + ((f4 * f4 + f5 * f5) + (f6 * f6 + f7 * f7)); }
                    const bf16x8 Ah = __builtin_bit_cast(bf16x8, xa);
#pragma unroll
                    for (int nt = 0; nt < 3; ++nt) { const bf16x8 Bh = *(const bf16x8*)(wh + (size_t)nt * 16 * D + ks * 32), Bl = *(const bf16x8*)(wl + (size_t)nt * 16 * D + ks * 32);
                        acc[nt] = __builtin_amdgcn_mfma_f32_16x16x32_bf16(Ah, Bh, acc[nt], 0, 0, 0); acc[nt] = __builtin_amdgcn_mfma_f32_16x16x32_bf16(Ah, Bl, acc[nt], 0, 0, 0); } }
#pragma unroll
                for (int nt = 0; nt < 3; ++nt)
#pragma unroll
                    for (int i = 0; i < 4; ++i) part[(ksl * 32 + tt * 16 + 4 * g4 + i) * 48 + nt * 16 + r16] = acc[nt][i];
                ssq += __shfl_xor(ssq, 16); ssq += __shfl_xor(ssq, 32);
                if (g4 == 0) ssp[ksl * 32 + tt * 16 + r16] = ssq;
            }
            __syncthreads();
            int e1 = 0, e2 = 0;
            if (tid < 32) { const int t = t0 + tid; const float rstd = rsqrtf((ssp[tid] + ssp[32 + tid] + ssp[64 + tid] + ssp[96 + tid]) * (1.f / D) + EPS);
                const LAS float* p0 = part + tid * 48;
#define LG(o) ((p0[(o)] + p0[32 * 48 + (o)] + p0[64 * 48 + (o)] + p0[96 * 48 + (o)]) * rstd)
                int gs = 0; float gmax = LG(0) + A_->in[I_B_GROUP][0]; float gv[4]; gv[0] = gmax;
#pragma unroll
                for (int i = 1; i < 4; ++i) { gv[i] = LG(i) + A_->in[I_B_GROUP][i]; if (gv[i] > gmax) { gmax = gv[i]; gs = i; } }
                float gsum = 0.f;
#pragma unroll
                for (int i = 0; i < 4; ++i) gsum += __expf(gv[i] - gmax);
                const float pg = 1.f / gsum;
                int i1 = 0, i2 = 0; float v1 = -3.0e38f, v2 = -3.0e38f;
#pragma unroll 1
                for (int i = 0; i < 8; ++i) { const float ev = LG(4 + gs * 8 + i) + A_->in[I_B_ROUTER][gs * 8 + i];
                    if (ev > v1) { v2 = v1; i2 = i1; v1 = ev; i1 = i; } else if (ev > v2) { v2 = ev; i2 = i; } }
#undef LG
                const float p2 = __expf(v2 - v1); const float g1 = pg / (1.f + p2), g2 = pg * p2 / (1.f + p2);
                e1 = gs * 8 + i1; e2 = gs * 8 + i2;
                eb[2 * tid] = e1; eb[2 * tid + 1] = e2;
                TOKW[2 * t] = g1; TOKW[2 * t + 1] = g2; RSTD3[t] = rstd; }
            __syncthreads();
            LAS int* ebase = eb + 64;
            if (tid >= 64 && tid < 96) { const int e = tid - 64; int c = 0;
#pragma unroll 1
                for (int a2 = 0; a2 < 64; ++a2) c += (eb[a2] == e) ? 1 : 0;
                ebase[e] = c ? atomicAdd(CNT + e, c) : 0; }
            __syncthreads();
            if (tid < 64) { const int e = eb[tid]; int rk = 0;
#pragma unroll 1
                for (int a2 = 0; a2 < tid; ++a2) rk += (eb[a2] == e) ? 1 : 0;
                const int slot = ebase[e] + rk; LIST[e * T + slot] = t0 + (tid >> 1); TOKE[2 * t0 + tid] = e * T + slot; }
        }
        GRID_BAR(11);
    }
    volatile LAS int* cnl = (volatile LAS int*)(MISC + 64); volatile LAS int* prel = (volatile LAS int*)(MISC + 128); volatile LAS int* tbl = (volatile LAS int*)(MISC + 192);
    volatile LAS int* mtl = (volatile LAS int*)(MISC + 256); volatile LAS int* tlr = (volatile LAS int*)(MISC + 288); volatile LAS int* tpre = (volatile LAS int*)(MISC + 320); volatile LAS int* fll = (volatile LAS int*)(MISC + 384);
    constexpr int MOE_TAIL = 96;
#define MOE_TABLES(ncol) do { __syncthreads(); if (tid < 64) { const int e = tid & 31; const int c = __hip_atomic_load(CNT + e, __ATOMIC_RELAXED, __HIP_MEMORY_SCOPE_AGENT);     \
        const int full = c >> 8, mt = (c + 255) >> 8; int p = mt * (ncol), tb = mt; \
        _Pragma("unroll") for (int d_ = 1; d_ < 32; d_ <<= 1) { const int q_ = __shfl_up(p, d_), r_ = __shfl_up(tb, d_); if (e >= d_) { p += q_; tb += r_; } } \
        if (tid < 32) { cnl[e] = c; prel[e] = p - mt * (ncol); tbl[e] = tb - mt; mtl[e] = mt; tlr[e] = 0; tpre[e] = 0; fll[e] = full; if (e == 31) { prel[32] = p; tbl[32] = tb; tpre[32] = 0; } } } __syncthreads(); } while (0)
#define MOE_GU(Lb, Le, nbk, cc) do { pg8::MoeOrder S{tbl, cnl, LIST, 4, (Lb), (Le), (nbk), (cc), (unsigned)D * 2u, (size_t)1024 * D * 2, (unsigned)D * 2u, 1}; \
        pg8::EpiSwiGLU E{ACT, LIST, RSTD3, cnl}; pg8::gemm_phase(tid, lds, X2B, WGU_T, D, S, E); } while (0)
#define MOE_DN(Lb, Le, nbk, cc) do { pg8::MoeOrder S{tbl, cnl, LIST, 8, (Lb), (Le), (nbk), (cc), (unsigned)DEXP * 2u, (size_t)D * DEXP * 2, (unsigned)DEXP * 2u, 0}; \
        pg8::EpiBf16 E{Y, D}; pg8::gemm_phase(tid, lds, ACT, WDN_T, DEXP, S, E); } while (0)
    if (IN(13)) for (int rep_ = 0; rep_ < NREP(13); ++rep_) {
        PHASE_IDS
        if (rep_) xcd_barrier(bar, tid);
        MOE_TABLES(4);
        const int U1 = tbl[32] * 4;
        MOE_GU(0, U1 < G ? U1 : G, G, bx);
        GRID_BAR(13);
    }
    if (IN(14)) for (int rep_ = 0; rep_ < NREP(14); ++rep_) {
        PHASE_IDS
        if (rep_) xcd_barrier(bar, tid);
        MOE_TABLES(4);
        const int RT = tbl[32], U1 = RT * 4; const int nb0 = U1 > G ? ((U1 - G) < G ? (U1 - G) : G) : 0; const int rta = (U1 < G ? U1 : G) >> 2;
        if (bx < nb0) MOE_GU(G, U1, nb0, bx);
        else MOE_DN(0, rta * 8, G - nb0, bx - nb0);
        GRID_BAR(14);
    }
    if (IN(15)) for (int rep_ = 0; rep_ < NREP(15); ++rep_) {
        PHASE_IDS
        if (rep_) xcd_barrier(bar, tid);
        MOE_TABLES(8);
        const int RT = tbl[32], U1 = RT * 4; const int rta = (U1 < G ? U1 : G) >> 2;
        MOE_DN(rta * 8, RT * 8, G, bx);
        GRID_BAR(15);
    }
    if (IN(16)) for (int rep_ = 0; rep_ < NREP(16); ++rep_) {
        PHASE_IDS
        if (rep_) xcd_barrier(bar, tid);
        MOE_TABLES(1);
        const float* fg = A_->in[I_FINAL_G];
        int a0n = 0, a1n = 0; float w0n = 0.f, w1n = 0.f;
        if (gw < T) { a0n = TOKE[2 * gw]; a1n = TOKE[2 * gw + 1]; w0n = TOKW[2 * gw]; w1n = TOKW[2 * gw + 1]; }
#pragma unroll 1
        for (int t = gw; t < T; t += NGW) {
            const int a0 = a0n, a1 = a1n; const float w0 = w0n, w1 = w1n;
            { const int tn = t + NGW; if (tn < T) { a0n = TOKE[2 * tn]; a1n = TOKE[2 * tn + 1]; w0n = TOKW[2 * tn]; w1n = TOKW[2 * tn + 1]; } }
            const size_t r0 = (size_t)tbl[a0 / T] * 256 + (a0 % T), r1 = (size_t)tbl[a1 / T] * 256 + (a1 % T);
            const u32x2* xr = (const u32x2*)(X2B + (size_t)t * D) + lane; f32x4* xo = (rep_ == NREP(16) - 1) ? (f32x4*)(A_->out + (size_t)t * D) + lane : (f32x4*)((float*)(ws + WS_X1B) + (size_t)t * D) + lane; const u32x2* y0 = (const u32x2*)(Y + r0 * D) + lane; const u32x2* y1 = (const u32x2*)(Y + r1 * D) + lane;
            f32x4 v[8]; float s = 0.f;
#pragma unroll
            for (int j = 0; j < 8; ++j) { const u32x2 xq = xr[64 * j]; v[j] = (f32x4){bf2f(xq.x & 0xffffu), bf2f(xq.x >> 16), bf2f(xq.y & 0xffffu), bf2f(xq.y >> 16)}; const u32x2 p = y0[64 * j], q = y1[64 * j];
                v[j][0] += w0 * bf2f(p.x & 0xffffu) + w1 * bf2f(q.x & 0xffffu); v[j][1] += w0 * bf2f(p.x >> 16) + w1 * bf2f(q.x >> 16);
                v[j][2] += w0 * bf2f(p.y & 0xffffu) + w1 * bf2f(q.y & 0xffffu); v[j][3] += w0 * bf2f(p.y >> 16) + w1 * bf2f(q.y >> 16);
                s += (v[j][0] * v[j][0] + v[j][1] * v[j][1]) + (v[j][2] * v[j][2] + v[j][3] * v[j][3]); }
            const float r = rsqrtf(wave_sum(s) * (1.f / D) + EPS);
#pragma unroll
            for (int j = 0; j < 8; ++j) { const f32x4 g = ((const f32x4*)fg)[lane + 64 * j]; xo[64 * j] = (f32x4){v[j][0] * r * g[0], v[j][1] * r * g[1], v[j][2] * r * g[2], v[j][3] * r * g[3]}; }
        }
    }
#undef IN
#undef BOTH
#undef GRID_BAR
}

extern "C" void kernel_launch(void* const* d_in, const int* in_sizes, int n_in, void* d_out, int out_size, void* d_ws, size_t ws_size, hipStream_t stream) {
    static int grid = 0;
    if (grid == 0) {
        if (n_in != 27 || out_size != T * D || ws_size < WS_END) { fprintf(stderr, "kernel_launch: unexpected problem (n_in %d out %d ws %zu)\n", n_in, out_size, ws_size); grid = -1; return; }
        int dev = 0, cus = 0, per_cu = 0;
        if (hipGetDevice(&dev) != hipSuccess || hipDeviceGetAttribute(&cus, hipDeviceAttributeMultiprocessorCount, dev) != hipSuccess) { grid = -1; return; }
        if (hipFuncSetAttribute((const void*)mega, hipFuncAttributeMaxDynamicSharedMemorySize, LDS_BYTES) != hipSuccess) { fprintf(stderr, "kernel_launch: hipFuncSetAttribute failed\n"); grid = -1; return; }
        if (hipOccupancyMaxActiveBlocksPerMultiprocessor(&per_cu, (const void*)mega, 512, LDS_BYTES) != hipSuccess || per_cu < 1) fprintf(stderr, "kernel_launch: occupancy query reports %d\n", per_cu);
        (void)hipGetLastError();
        grid = cus;
    }
    if (grid < 0) return;
    if (hipMemsetAsync((char*)d_ws + WS_CTL, 0, CTL_ZERO_BYTES, stream) != hipSuccess) return;
    Args a{};
    for (int i = 0; i < 27; ++i) a.in[i] = (const float*)d_in[i];
    a.out = (float*)d_out; a.ws = (unsigned char*)d_ws;
    if (MK_N_LAUNCHES == 1) { a.ph_lo = 0; a.ph_hi = NPHASE; hipLaunchKernelGGL(mega, dim3(grid), dim3(512), LDS_BYTES, stream, a); }
    else { for (int p = 0; p < NPHASE; ++p) { a.ph_lo = p; a.ph_hi = p + 1; hipLaunchKernelGGL(mega, dim3(grid), dim3(512), LDS_BYTES, stream, a); } }
}
```

```cpp
#include <hip/hip_runtime.h>
#include <cstdio>
#include <cstdint>

#ifndef MK_N_LAUNCHES
#define MK_N_LAUNCHES 1
#endif

#define GAS __attribute__((address_space(1)))
#define LAS __attribute__((address_space(3)))
typedef unsigned short bf16;
typedef short bf16x8 __attribute__((ext_vector_type(8)));
typedef float f32x4 __attribute__((ext_vector_type(4)));
typedef float f32x2 __attribute__((ext_vector_type(2)));
typedef float f32x16 __attribute__((ext_vector_type(16)));
typedef unsigned u32x4 __attribute__((ext_vector_type(4)));
typedef unsigned u32x2 __attribute__((ext_vector_type(2)));

constexpr int T = 8192, D = 2048, NMEM = 256;
constexpr int D_IN = 4944;
constexpr int NPROJ = 6144;
constexpr int KMIX = 3072;
constexpr int NCH = 128, CH = 64;
constexpr int NEXP = 32, DEXP = 512;
constexpr float EPS = 1e-6f;
constexpr int NPHASE = 17;

constexpr size_t MiB = 1u << 20;
constexpr size_t WS_CTL = 0, CTL_ZERO_BYTES = 256 * 1024;
constexpr size_t WS_WOUT_T = 1 * MiB;
constexpr size_t WS_WCQ_T = 13 * MiB;
constexpr size_t WS_WCKV_T = 21 * MiB;
constexpr size_t WS_WCO_T = 37 * MiB;
constexpr size_t WS_WGU_T = 45 * MiB;
constexpr size_t WS_WDN_T = 173 * MiB;
constexpr size_t WS_WIN_T = 237 * MiB;
constexpr size_t WS_H1 = 261 * MiB;
constexpr size_t WS_MIXIN = 237 * MiB;
constexpr size_t WS_SC127 = 285 * MiB;
constexpr size_t WS_MEMN = 293 * MiB;
constexpr size_t WS_KC = 294 * MiB;
constexpr size_t WS_VT = 295 * MiB;
constexpr size_t WS_GATES = 296 * MiB;
constexpr size_t WS_WR = 297 * MiB;
constexpr size_t WS_QABS = 298 * MiB;
constexpr size_t WS_CKVRAW = 330 * MiB;
constexpr size_t WS_QI = 338 * MiB;
constexpr size_t WS_SMALL = 346 * MiB;
constexpr size_t WS_MQKRAW = 354 * MiB;
constexpr size_t WS_MV = 386 * MiB;
constexpr size_t WS_MO = 402 * MiB;
constexpr size_t WS_CKVN = 418 * MiB;
constexpr size_t WS_KIDXN = 422 * MiB;
constexpr size_t WS_QCM = 423 * MiB;
constexpr size_t WS_KCM = 431 * MiB;
constexpr size_t WS_LST = 439 * MiB;
constexpr size_t WS_NL = 503 * MiB;
constexpr size_t WS_CST = 504 * MiB;
constexpr size_t WS_VTM = 536 * MiB;
constexpr size_t WS_X1B = 298 * MiB;
constexpr size_t WS_QC = 330 * MiB;
constexpr size_t WS_OC = 362 * MiB;
constexpr size_t WS_X2B = 394 * MiB;
constexpr size_t WS_LIST = 426 * MiB;
constexpr size_t WS_TOK = 427 * MiB;
constexpr size_t WS_ACT = 428 * MiB;
constexpr size_t WS_Y = 452 * MiB;
constexpr size_t WS_END = 552 * MiB;
constexpr int GT_B = 0;
constexpr int GT_LI = T * 4;
constexpr int GT_G = 2 * T * 4;
constexpr int GT_MLOC = GT_G + 512;
constexpr int GT_MPREV = GT_MLOC + 512;
constexpr int CW_BAR = 4096;
constexpr int CW_CNT = 8192;
constexpr int CW_SS2 = 16384;
static_assert((CW_SS2 + T) * 4 <= (int)CTL_ZERO_BYTES, "ctl");

constexpr int RING_BYTES = 131072;
constexpr int MISC_OFF = RING_BYTES;
constexpr int LDS_BYTES = 159744;

__device__ __forceinline__ float bf2f(unsigned b) { return __uint_as_float(b << 16); }
typedef __bf16 hwbf16x2 __attribute__((ext_vector_type(2)));
__device__ __forceinline__ unsigned pk2(float lo, float hi) { f32x2 v; v.x = lo; v.y = hi; return __builtin_bit_cast(unsigned, __builtin_convertvector(v, hwbf16x2)); }
__device__ __forceinline__ unsigned f2bf(float f) { return pk2(f, 0.f) & 0xffffu; }
__device__ __forceinline__ float wave_sum(float v) {
#pragma unroll
    for (int o = 1; o < 64; o <<= 1) v += __shfl_xor(v, o);
    return v;
}
__device__ __forceinline__ float wave_max(float v) {
#pragma unroll
    for (int o = 1; o < 64; o <<= 1) v = fmaxf(v, __shfl_xor(v, o));
    return v;
}
#define LDS_WAIT() asm volatile("s_waitcnt lgkmcnt(0)" ::: "memory")

#define XB_TMO      128
#define XB_XCNT(j)  (256  + 64 * (j))
#define XB_XSUB(j)  (1280 + 64 * (j))
#define XB_XGEN(j)  (2304 + 64 * (j))
#define XB_TOP      3328
#define XB_TOPGEN   3392
#define XCD_BAR_WORDS 3456
#define XB_SPIN_CAP (1u << 18)
__device__ __forceinline__ unsigned xb_ld(unsigned* p)              { return __hip_atomic_load(p, __ATOMIC_RELAXED, __HIP_MEMORY_SCOPE_AGENT); }
__device__ __forceinline__ unsigned xb_add(unsigned* p, unsigned v) { return __hip_atomic_fetch_add(p, v, __ATOMIC_RELAXED, __HIP_MEMORY_SCOPE_AGENT); }
__device__ __forceinline__ unsigned xb_xcc_id() { return (unsigned)__builtin_amdgcn_s_getreg((3 << 11) | 20) & 0xFu; }
#define XB_SPIN(cond, bar) do { unsigned _sp = 0; while (cond) { __builtin_amdgcn_s_sleep(1); \
    if ((++_sp & 255u) == 0u) { if (xb_ld(&(bar)[XB_TMO])) break; if (_sp > XB_SPIN_CAP) { atomicAdd(&(bar)[XB_TMO], 1u); break; } } } } while (0)
struct XcdBarrier { unsigned* bar; unsigned x; volatile LAS unsigned* st; };
__device__ __forceinline__ XcdBarrier xcd_barrier_post(unsigned* bar, volatile LAS unsigned* st) {
    XcdBarrier b; b.bar = bar; b.x = xb_xcc_id(); b.st = st;
    if (threadIdx.x == 0) (void)xb_add(&bar[XB_XCNT(b.x)], 1u);
    return b;
}
__device__ __forceinline__ void xcd_barrier_complete(unsigned* bar, unsigned x, unsigned& nloc, unsigned& nx) {
    const unsigned G = gridDim.x * gridDim.y * gridDim.z;
    unsigned sum, cnt, mine, sp = 0u;
    for (;;) {
        sum = 0u; cnt = 0u; mine = 0u;
#pragma unroll
        for (unsigned j = 0; j < 16; ++j) { const unsigned c = xb_ld(&bar[XB_XCNT(j)]); sum += c; cnt += (c > 0u) ? 1u : 0u; mine = (j == x) ? c : mine; }
        if (sum == G) break;
        __builtin_amdgcn_s_sleep(1);
        if ((++sp & 255u) == 0u) { if (xb_ld(&bar[XB_TMO])) break; if (sp > XB_SPIN_CAP) { atomicAdd(&bar[XB_TMO], 1u); break; } }
    }
    nloc = mine > 0u ? mine : 1u; nx = cnt > 0u ? cnt : 1u;
}
__device__ __forceinline__ void xcd_barrier(const XcdBarrier& b, const int tid_) {
    asm volatile("s_waitcnt vmcnt(0)" ::: "memory");
    __syncthreads();
    if (tid_ == 0) {
        unsigned* bar = b.bar;
        __builtin_amdgcn_s_waitcnt(0);
        unsigned nloc = b.st[0], nx = b.st[1];
        if (nloc == 0u) { xcd_barrier_complete(bar, b.x, nloc, nx); b.st[0] = nloc; b.st[1] = nx; }
        const unsigned old = xb_add(&bar[XB_XSUB(b.x)], 1u);
        const unsigned gen = old / nloc;
        if (old + 1u == (gen + 1u) * nloc) {
            __builtin_amdgcn_fence(__ATOMIC_RELEASE, "agent");
            asm volatile("s_waitcnt vmcnt(0)" ::: "memory");
            const unsigned og = xb_add(&bar[XB_TOP], 1u);
            const unsigned tg = og / nx;
            if (og + 1u == (tg + 1u) * nx) xb_add(&bar[XB_TOPGEN], 1u);
            else XB_SPIN(xb_ld(&bar[XB_TOPGEN]) == tg, bar);
            __builtin_amdgcn_fence(__ATOMIC_ACQUIRE, "agent");
            xb_add(&bar[XB_XGEN(b.x)], 1u);
            asm volatile("s_waitcnt vmcnt(0)" ::: "memory");
        } else {
            XB_SPIN(xb_ld(&bar[XB_XGEN(b.x)]) == gen, bar);
            __builtin_amdgcn_fence(__ATOMIC_ACQUIRE, "agent");
            asm volatile("s_waitcnt vmcnt(0)" ::: "memory");
        }
    }
    __syncthreads();
}

namespace pg8 {
constexpr int BM = 256, BK = 64, HALF = 128, HTB = HALF * BK * 2, STAGE_BYTES = 8 * HTB, NXCD = 8, WGM = 8;
__host__ __device__ __forceinline__ int lds_byte(int r, int c) { const int st = (r >> 4) * 2 + (c >> 5), rr = r & 15, cc = c & 31, ob = rr * 64 + cc * 2; return st * 1024 + (ob ^ (((ob >> 9) & 1) << 5)); }
__host__ __device__ __forceinline__ void stage_rc(int b, int& R, int& C) { const int st = b / 1024, sb = b % 1024, swz = sb ^ (((sb >> 9) & 1) << 5); R = (st >> 1) * 16 + swz / 64; C = (st & 1) * 32 + (swz % 64) / 2; }

struct Unit { int pm, pn, e, rt; };

struct DenseOrder {
    static constexpr bool GATHER = false;
    int nM, nN, nwg, G, c; unsigned lda_bytes; unsigned kb;
    __device__ void init(int M, int N, int K, int lda, int G_, int c_) { nM = M / BM; nN = N / BM; nwg = nM * nN; G = G_; c = c_; lda_bytes = (unsigned)lda * 2u; kb = (unsigned)K * 2u; }
    __device__ bool next(int i, Unit& u) const {
        if (c < 0) return false;
        const long L = (long)i * G + c; if (L >= nwg) return false;
        int wgid = (int)L; { const int q = nwg / NXCD, r = nwg % NXCD, xcd = wgid % NXCD, off = wgid / NXCD; wgid = (xcd < r ? xcd * (q + 1) : r * (q + 1) + (xcd - r) * q) + off; }
        const int nig = WGM * nN, gid = wgid / nig, fm = gid * WGM, gsz = (nM - fm) < WGM ? (nM - fm) : WGM;
        u.pm = fm + ((wgid % nig) % gsz); u.pn = (wgid % nig) / gsz; u.e = 0; u.rt = 0; return true;
    }
    __device__ __forceinline__ unsigned a_row(const Unit& u, int r) const { return (unsigned)(u.pm * BM + r) * lda_bytes; }
    __device__ __forceinline__ size_t b_off(const Unit& u) const { return (size_t)u.pn * BM * kb; }
};

#define PG8_SA(b, h) (((b) * 2 + (h)) * HTB)
#define PG8_SB(b, h) ((4 + (b) * 2 + (h)) * HTB)
#define PG8_STAGEB(bufoff, gbase) do { _Pragma("unroll") for (int _i = 0; _i < 2; ++_i) \
        __builtin_amdgcn_global_load_lds((const unsigned*)((const char*)(gbase) + voffB[_i]), (LAS unsigned*)(lds + (bufoff) + ldsw + _i * 8192), 16, 0, 0); } while (0)
#define PG8_GLDS(src, dstoff) __builtin_amdgcn_global_load_lds((const unsigned*)(src), (LAS unsigned*)(lds + (dstoff)), 16, 0, 0)
#define PG8_STAGEA(bufoff, kbyte, h, NXT) do { if constexpr (Sched::GATHER) { const unsigned _o0 = (NXT) ? ((h) ? n10 : n00) : ((h) ? c10 : c00), _o1 = (NXT) ? ((h) ? n11 : n01) : ((h) ? c11 : c01); \
            PG8_GLDS(Ab + (kbyte) + _o0, (bufoff) + ldsw); PG8_GLDS(Ab + (kbyte) + _o1, (bufoff) + ldsw + 8192); } \
        else { const char* _b = ((NXT) ? nA : cA) + (kbyte) + ((h) ? hstepA : (size_t)0); PG8_GLDS(_b + voffA[0], (bufoff) + ldsw); PG8_GLDS(_b + voffA[1], (bufoff) + ldsw + 8192); } } while (0)
#define PG8_LDA(dst, b, h) do { _Pragma("unroll") for (int m = 0; m < 4; ++m) _Pragma("unroll") for (int k = 0; k < 2; ++k) dst[m][k] = *(const LAS bf16x8*)(lds + PG8_SA(b, h) + aoff + m * 2048 + k * 1024); } while (0)
#define PG8_LDB(dst, b, h) do { _Pragma("unroll") for (int n = 0; n < 2; ++n) _Pragma("unroll") for (int k = 0; k < 2; ++k) dst[n][k] = *(const LAS bf16x8*)(lds + PG8_SB(b, h) + boff + n * 2048 + k * 1024); } while (0)
#define PG8_MMA(ai, bj, At, Bt) do { __builtin_amdgcn_s_setprio(1); _Pragma("unroll") for (int m = 0; m < 4; ++m) _Pragma("unroll") for (int n = 0; n < 2; ++n) _Pragma("unroll") for (int k = 0; k < 2; ++k) \
        acc[ai][bj][m][n] = __builtin_amdgcn_mfma_f32_16x16x32_bf16(Bt[n][k], At[m][k], acc[ai][bj][m][n], 0, 0, 0); __builtin_amdgcn_s_setprio(0); } while (0)
#define PG8_WAIT_V(n) asm volatile("s_waitcnt vmcnt(" #n ")" ::: "memory")
#define PG8_WAIT_L(n) asm volatile("s_waitcnt lgkmcnt(" #n ")" ::: "memory")
#define PG8_BAR __builtin_amdgcn_s_barrier()
#define PG8_SCHED __builtin_amdgcn_sched_barrier(0)

template <class Epi, class Sched>
__device__ __forceinline__ void gemm_phase(const int tid_in, LAS unsigned char* lds, const bf16* A, const bf16* Bt, const int K, const Sched& S, const Epi& E) {
    int tid = tid_in; asm volatile("" : "+v"(tid));
    const int wid = __builtin_amdgcn_readfirstlane(tid >> 6), lane = tid & 63, wr = wid >> 2, wc = wid & 3, fr = lane & 15, fq = lane >> 4;
    int Kop_ = K; asm volatile("" : "+s"(Kop_));
    const int nt = Kop_ / BK;
    int sR[2], sC2[2]; unsigned voffB[2];
#pragma unroll
    for (int i = 0; i < 2; ++i) { int R, C; stage_rc(tid * 16 + i * 8192, R, C); sR[i] = R; sC2[i] = C * 2; voffB[i] = (unsigned)R * S.kb + (unsigned)C * 2u; }
    const unsigned kstep = (unsigned)(BK * 2);
    const size_t hstepB = (size_t)HALF * S.kb;
    const unsigned ldsw = (unsigned)wid * 1024u;
    const int aoff = lds_byte(wr * 64 + fr, fq * 8), boff = lds_byte(wc * 32 + fr, fq * 8);
    Unit cur, nxt; int ui = 0;
    if (!S.next(0, cur)) return;
    f32x4 acc[2][2][4][2];
#pragma unroll
    for (int a = 0; a < 2; ++a)
#pragma unroll
        for (int b = 0; b < 2; ++b)
#pragma unroll
            for (int m = 0; m < 4; ++m)
#pragma unroll
                for (int n = 0; n < 2; ++n) acc[a][b][m][n] = (f32x4){0.f, 0.f, 0.f, 0.f};
    bf16x8 At[4][2], B0[2][2], B1[2][2];
    const char* Ab = (const char*)A;
    unsigned c00 = 0, c01 = 0, c10 = 0, c11 = 0, n00 = 0, n01 = 0, n10 = 0, n11 = 0; unsigned voffA[2] = {0u, 0u}; const char* cA = Ab; const char* nA = Ab; size_t hstepA = 0;
    if constexpr (Sched::GATHER) { c00 = S.a_row(cur, sR[0]) + sC2[0]; c01 = S.a_row(cur, sR[1]) + sC2[1]; c10 = S.a_row(cur, 128 + sR[0]) + sC2[0]; c11 = S.a_row(cur, 128 + sR[1]) + sC2[1]; }
    else { voffA[0] = (unsigned)sR[0] * S.lda_bytes + sC2[0]; voffA[1] = (unsigned)sR[1] * S.lda_bytes + sC2[1]; hstepA = (size_t)HALF * S.lda_bytes; cA = Ab + (size_t)S.a_row(cur, 0); }
    const char* cB = (const char*)Bt + S.b_off(cur);
    PG8_STAGEB(PG8_SB(0, 0), cB); PG8_STAGEA(PG8_SA(0, 0), 0u, 0, false); PG8_STAGEB(PG8_SB(0, 1), cB + hstepB); PG8_STAGEA(PG8_SA(0, 1), 0u, 1, false);
    if (wr == 1) PG8_BAR;
    PG8_WAIT_V(4); PG8_BAR;
    PG8_STAGEB(PG8_SB(1, 0), cB + kstep); PG8_STAGEA(PG8_SA(1, 0), kstep, 0, false); PG8_STAGEB(PG8_SB(1, 1), cB + hstepB + kstep);
    PG8_WAIT_V(6); PG8_BAR;
    for (;;) {
        const bool has_next = S.next(ui + 1, nxt);
        const char* nB = cB;
        if constexpr (Sched::GATHER) { n00 = c00; n01 = c01; n10 = c10; n11 = c11; } else nA = cA;
        if (has_next) { nB = (const char*)Bt + S.b_off(nxt);
            if constexpr (Sched::GATHER) { n00 = S.a_row(nxt, sR[0]) + sC2[0]; n01 = S.a_row(nxt, sR[1]) + sC2[1]; n10 = S.a_row(nxt, 128 + sR[0]) + sC2[0]; n11 = S.a_row(nxt, 128 + sR[1]) + sC2[1]; }
            else nA = Ab + (size_t)S.a_row(nxt, 0); }
        for (int t = 0; t < nt; t += 2) {
            const bool last = (t == nt - 2);
            const unsigned k1 = (unsigned)(t + 1) * kstep;
            const unsigned k2 = last ? 0u : (unsigned)(t + 2) * kstep, k3 = k2 + kstep;
            const char* b2 = last ? nB : cB + (size_t)(t + 2) * kstep; const char* b3 = b2 + kstep;
            PG8_LDB(B0, 0, 0); PG8_SCHED; PG8_LDA(At, 0, 0); PG8_STAGEA(PG8_SA(1, 1), k1, 1, false);
            PG8_WAIT_L(8); PG8_BAR; PG8_WAIT_L(0); PG8_MMA(0, 0, At, B0); PG8_BAR; PG8_SCHED;
            PG8_LDB(B1, 0, 1); PG8_STAGEB(PG8_SB(0, 0), b2);
            PG8_BAR; PG8_WAIT_L(0); PG8_MMA(0, 1, At, B1); PG8_BAR;
            PG8_LDA(At, 0, 1); PG8_STAGEA(PG8_SA(0, 0), k2, 0, last);
            PG8_BAR; PG8_WAIT_L(0); PG8_MMA(1, 0, At, B0); PG8_BAR; PG8_SCHED;
            PG8_STAGEB(PG8_SB(0, 1), b2 + hstepB);
            PG8_WAIT_V(6); PG8_BAR; PG8_MMA(1, 1, At, B1); PG8_BAR;
            PG8_LDB(B0, 1, 0); PG8_SCHED; PG8_LDA(At, 1, 0); PG8_STAGEA(PG8_SA(0, 1), k2, 1, last);
            PG8_WAIT_L(8); PG8_BAR; PG8_WAIT_L(0); PG8_MMA(0, 0, At, B0); PG8_BAR; PG8_SCHED;
            PG8_LDB(B1, 1, 1); PG8_STAGEB(PG8_SB(1, 0), b3);
            PG8_BAR; PG8_WAIT_L(0); PG8_MMA(0, 1, At, B1); PG8_BAR;
            PG8_LDA(At, 1, 1); PG8_STAGEA(PG8_SA(1, 0), k3, 0, last);
            PG8_BAR; PG8_WAIT_L(0); PG8_MMA(1, 0, At, B0); PG8_BAR; PG8_SCHED;
            PG8_STAGEB(PG8_SB(1, 1), b3 + hstepB);
            PG8_WAIT_V(6); PG8_BAR; PG8_MMA(1, 1, At, B1); PG8_BAR;
        }
        if constexpr (!Epi::AFTER_DRAIN) E(acc, cur, wr, wc, fr, fq);
        if (!has_next) break;
#pragma unroll
        for (int a = 0; a < 2; ++a)
#pragma unroll
            for (int b = 0; b < 2; ++b)
#pragma unroll
                for (int m = 0; m < 4; ++m)
#pragma unroll
                    for (int n = 0; n < 2; ++n) acc[a][b][m][n] = (f32x4){0.f, 0.f, 0.f, 0.f};
        cur = nxt; if constexpr (Sched::GATHER) { c00 = n00; c01 = n01; c10 = n10; c11 = n11; } else cA = nA; cB = nB; ++ui;
    }
    PG8_WAIT_V(0);
    if (wr == 0) PG8_BAR;
    PG8_BAR;
    if constexpr (Epi::AFTER_DRAIN) E.fused(acc, cur, wr, wc, fr, fq, lds, wid, lane);
}

__device__ __forceinline__ void store_tile_f32(const f32x4 (&acc)[2][2][4][2], float* dst, int ld, int row0, int col0) {
#pragma unroll
    for (int ai = 0; ai < 2; ++ai)
#pragma unroll
        for (int m = 0; m < 4; ++m) { float* rowp = dst + (size_t)(row0 + ai * HALF + m * 16) * ld + col0;
#pragma unroll
            for (int bj = 0; bj < 2; ++bj)
#pragma unroll
                for (int n = 0; n < 2; ++n) *(f32x4*)(rowp + bj * HALF + n * 16) = acc[ai][bj][m][n]; }
}
__device__ __forceinline__ void store_tile_bf16(const f32x4 (&acc)[2][2][4][2], bf16* dst, int ld, int row0, int col0) {
#pragma unroll
    for (int ai = 0; ai < 2; ++ai)
#pragma unroll
        for (int m = 0; m < 4; ++m) { bf16* rowp = dst + (size_t)(row0 + ai * HALF + m * 16) * ld + col0;
#pragma unroll
            for (int bj = 0; bj < 2; ++bj)
#pragma unroll
                for (int n = 0; n < 2; ++n) { const f32x4 v = acc[ai][bj][m][n]; u32x2 w; w.x = pk2(v[0], v[1]); w.y = pk2(v[2], v[3]); *(u32x2*)(rowp + bj * HALF + n * 16) = w; } }
}
struct EpiBf16 {
    static constexpr bool AFTER_DRAIN = false;
    bf16* dst; int ld;
    __device__ __forceinline__ void operator()(const f32x4 (&acc)[2][2][4][2], const Unit& u, int wr, int wc, int fr, int fq) const {
        store_tile_bf16(acc, dst, ld, u.pm * BM + wr * 64 + fr, u.pn * BM + wc * 32 + 4 * fq);
    }
};
struct EpiProj {
    static constexpr bool AFTER_DRAIN = false;
    bf16* qabs; float* ckvraw; bf16* qi; float* small; float* mqkraw; bf16* mv; bf16* mo;
    __device__ __forceinline__ void operator()(const f32x4 (&acc)[2][2][4][2], const Unit& u, int wr, int wc, int fr, int fq) const {
        const int row0 = u.pm * BM + wr * 64 + fr, cl = wc * 32 + 4 * fq, pn = u.pn;
        if (pn < 8) store_tile_bf16(acc, qabs, 2048, row0, pn * 256 + cl);
        else if (pn == 8) store_tile_f32(acc, ckvraw, 256, row0, cl);
        else if (pn < 11) store_tile_bf16(acc, qi, 512, row0, (pn - 9) * 256 + cl);
        else if (pn == 11) store_tile_f32(acc, small, 256, row0, cl);
        else if (pn < 16) store_tile_f32(acc, mqkraw, 1024, row0, (pn - 12) * 256 + cl);
        else if (pn < 20) store_tile_bf16(acc, mv, 1024, row0, (pn - 16) * 256 + cl);
        else store_tile_bf16(acc, mo, 1024, row0, (pn - 20) * 256 + cl);
    }
};
template <bool BASE_BF16>
struct EpiResidT {
    static constexpr bool AFTER_DRAIN = false;
    const void* base; bf16* xb; float* ss;
    __device__ __forceinline__ void operator()(const f32x4 (&acc)[2][2][4][2], const Unit& u, int wr, int wc, int fr, int fq) const {
        const int row0 = u.pm * BM + wr * 64 + fr, col0 = u.pn * BM + wc * 32 + 4 * fq;
#pragma unroll
        for (int ai = 0; ai < 2; ++ai)
#pragma unroll
            for (int m = 0; m < 4; ++m) { const int row = row0 + ai * HALF + m * 16; const size_t off = (size_t)row * D + col0; float s = 0.f;
#pragma unroll
                for (int bj = 0; bj < 2; ++bj)
#pragma unroll
                    for (int n = 0; n < 2; ++n) { f32x4 b;
                        if constexpr (BASE_BF16) { const u32x2 p = *(const u32x2*)((const bf16*)base + off + bj * HALF + n * 16); b = (f32x4){bf2f(p.x & 0xffffu), bf2f(p.x >> 16), bf2f(p.y & 0xffffu), bf2f(p.y >> 16)}; }
                        else b = *(const f32x4*)((const float*)base + off + bj * HALF + n * 16);
                        const f32x4 v = b + acc[ai][bj][m][n];
                        u32x2 w; w.x = pk2(v[0], v[1]); w.y = pk2(v[2], v[3]); *(u32x2*)(xb + off + bj * HALF + n * 16) = w;
                        s += (v[0] * v[0] + v[1] * v[1]) + (v[2] * v[2] + v[3] * v[3]); }
                if (ss) { s += __shfl_xor(s, 16); s += __shfl_xor(s, 32); if (fq == 0) atomicAdd(ss + row, s); } }
    }
};
struct EpiCq {
    static constexpr bool AFTER_DRAIN = false;
    bf16* dst; const float* ss; float scale;
    __device__ __forceinline__ void operator()(const f32x4 (&acc)[2][2][4][2], const Unit& u, int wr, int wc, int fr, int fq) const {
        const int row0 = u.pm * BM + wr * 64 + fr, col0 = u.pn * BM + wc * 32 + 4 * fq;
#pragma unroll
        for (int ai = 0; ai < 2; ++ai)
#pragma unroll
            for (int m = 0; m < 4; ++m) { const int row = row0 + ai * HALF + m * 16; const float r = rsqrtf(ss[row] * (1.0f / D) + EPS) * scale; bf16* rowp = dst + (size_t)row * D + col0;
#pragma unroll
                for (int bj = 0; bj < 2; ++bj)
#pragma unroll
                    for (int n = 0; n < 2; ++n) { const f32x4 v = acc[ai][bj][m][n] * r; u32x2 w; w.x = pk2(v[0], v[1]); w.y = pk2(v[2], v[3]); *(u32x2*)(rowp + bj * HALF + n * 16) = w; } }
    }
};
struct XsOrder {
    static constexpr bool GATHER = false;
    int G, c; unsigned lda_bytes, kb;
    __device__ bool next(int i, Unit& u) const { const int L = i * G + c; if (i > 0 || L >= 128) return false; u.pm = L >> 2; u.pn = L & 3; u.e = 0; u.rt = 0; return true; }
    __device__ __forceinline__ unsigned a_row(const Unit& u, int r) const { return (unsigned)(u.pm * BM + r) * lda_bytes + (unsigned)u.pn * 1024u; }
    __device__ __forceinline__ size_t b_off(const Unit& u) const { return (size_t)u.pn * 1024; }
};
struct XoOrder {
    static constexpr bool GATHER = false;
    int G, c; unsigned lda_bytes, kb;
    __device__ bool next(int i, Unit& u) const { const int L = i * G + c; if (L >= 256) return false; u.pm = L >> 3; u.pn = L & 7; u.e = 0; u.rt = 0; return true; }
    __device__ __forceinline__ unsigned a_row(const Unit& u, int r) const { return (unsigned)(u.pm * BM + r) * lda_bytes + (unsigned)(u.pn >> 1) * 512u; }
    __device__ __forceinline__ size_t b_off(const Unit& u) const { return (size_t)u.pn * BM * kb; }
};
struct EpiSoftmax {
    static constexpr bool AFTER_DRAIN = true;
    bf16* P; const float* ss;
    __device__ __forceinline__ void fused(f32x4 (&acc)[2][2][4][2], const Unit& u, int wr, int wc, int fr, int fq, LAS unsigned char* lds, int wid, int lane) const {
        LAS float* Pm = (LAS float*)lds; LAS float* Ps = (LAS float*)(lds + 4096);
#pragma unroll
        for (int ai = 0; ai < 2; ++ai)
#pragma unroll
            for (int m = 0; m < 4; ++m) { float mx = -3.0e38f; const float rs = rsqrtf(ss[u.pm * BM + ai * HALF + wr * 64 + m * 16 + fr] * (1.0f / D) + EPS);
#pragma unroll
                for (int bj = 0; bj < 2; ++bj)
#pragma unroll
                    for (int n = 0; n < 2; ++n) { const f32x4 v = acc[ai][bj][m][n] * rs; acc[ai][bj][m][n] = v; mx = fmaxf(mx, fmaxf(fmaxf(v[0], v[1]), fmaxf(v[2], v[3]))); }
                mx = fmaxf(mx, __shfl_xor(mx, 16)); mx = fmaxf(mx, __shfl_xor(mx, 32));
                if (fq == 0) Pm[(ai * HALF + wr * 64 + m * 16 + fr) * 4 + wc] = mx; }
        asm volatile("s_waitcnt lgkmcnt(0)" ::: "memory"); __builtin_amdgcn_s_barrier(); asm volatile("" ::: "memory");
#pragma unroll
        for (int ai = 0; ai < 2; ++ai)
#pragma unroll
            for (int m = 0; m < 4; ++m) { const int r = ai * HALF + wr * 64 + m * 16 + fr; const f32x4 pm4 = *(const LAS f32x4*)(Pm + r * 4); const float mx = fmaxf(fmaxf(pm4[0], pm4[1]), fmaxf(pm4[2], pm4[3])); float sm = 0.f;
#pragma unroll
                for (int bj = 0; bj < 2; ++bj)
#pragma unroll
                    for (int n = 0; n < 2; ++n) { f32x4 v = acc[ai][bj][m][n];
#pragma unroll
                        for (int j = 0; j < 4; ++j) { v[j] = __expf(v[j] - mx); sm += v[j]; }
                        acc[ai][bj][m][n] = v; }
                sm += __shfl_xor(sm, 16); sm += __shfl_xor(sm, 32);
                if (fq == 0) Ps[r * 4 + wc] = sm; }
        asm volatile("s_waitcnt lgkmcnt(0)" ::: "memory"); __builtin_amdgcn_s_barrier(); asm volatile("" ::: "memory");
#pragma unroll
        for (int ai = 0; ai < 2; ++ai)
#pragma unroll
            for (int m = 0; m < 4; ++m) { const int r = ai * HALF + wr * 64 + m * 16 + fr; const f32x4 ps4 = *(const LAS f32x4*)(Ps + r * 4); const float inv = 1.f / ((ps4[0] + ps4[1]) + (ps4[2] + ps4[3]));
                bf16* rowp = P + (size_t)(u.pm * BM + r) * 1024 + u.pn * 256 + wc * 32 + 4 * fq;
#pragma unroll
                for (int bj = 0; bj < 2; ++bj)
#pragma unroll
                    for (int n = 0; n < 2; ++n) { const f32x4 v = acc[ai][bj][m][n] * inv; u32x2 w; w.x = pk2(v[0], v[1]); w.y = pk2(v[2], v[3]); *(u32x2*)(rowp + bj * HALF + n * 16) = w; } }
    }
};
struct MoeOrder {
    static constexpr bool GATHER = true;
    const volatile LAS int* tb; const volatile LAS int* cn; const int* list; int ncol; int Lbeg, Lend, nb, c; unsigned a_ld_bytes; size_t b_exp_bytes; unsigned kb; int gather;
    __device__ bool next(int i, Unit& u) const {
        if (c < 0 || nb <= 0) return false;
        const int L = Lbeg + i * nb + c; if (L >= Lend) return false;
        const int g = L / ncol; int e = 0;
#pragma unroll 1
        for (int j = 1; j < 32; ++j) if (g >= tb[j]) e = j;
        u.e = e; u.rt = g - tb[e]; u.pn = L - g * ncol; u.pm = g; return true;
    }
    __device__ __forceinline__ unsigned a_row(const Unit& u, int r) const {
        if (gather) { int idx = u.rt * 256 + r; const int cnt = cn[u.e]; idx = idx < cnt ? idx : cnt - 1; const int tok = list[u.e * T + idx]; return (unsigned)tok * a_ld_bytes; }
        return (unsigned)(u.pm * 256 + r) * a_ld_bytes;
    }
    __device__ __forceinline__ size_t b_off(const Unit& u) const { return (size_t)u.e * b_exp_bytes + (size_t)u.pn * BM * kb; }
};
struct EpiSwiGLU {
    static constexpr bool AFTER_DRAIN = false;
    bf16* act; const int* list; const float* rstd; const volatile LAS int* cn;
    __device__ __forceinline__ void operator()(const f32x4 (&acc)[2][2][4][2], const Unit& u, int wr, int wc, int fr, int fq) const {
        const int cnt = cn[u.e];
#pragma unroll
        for (int ai = 0; ai < 2; ++ai)
#pragma unroll
            for (int m = 0; m < 4; ++m) { const int rl = ai * HALF + wr * 64 + m * 16 + fr; int idx = u.rt * 256 + rl; idx = idx < cnt ? idx : cnt - 1; const float r = rstd[list[u.e * T + idx]];
                bf16* rowp = act + (size_t)(u.pm * 256 + rl) * DEXP + u.pn * 128 + wc * 32 + 4 * fq;
#pragma unroll
                for (int n = 0; n < 2; ++n) { const f32x4 g = acc[ai][0][m][n] * r, uu = acc[ai][1][m][n] * r; f32x4 a;
#pragma unroll
                    for (int j = 0; j < 4; ++j) a[j] = g[j] / (1.0f + __expf(-g[j])) * uu[j];
                    u32x2 w; w.x = pk2(a[0], a[1]); w.y = pk2(a[2], a[3]); *(u32x2*)(rowp + n * 16) = w; } }
    }
};
}

struct Args { const float* in[27]; float* out; unsigned char* ws; int ph_lo, ph_hi; };
enum { I_X = 0, I_MEM, I_NORM_MIX_G, I_W_IN, I_KV_NORM_G, I_KIDX_NORM_G, I_W_UK, I_W_UV, I_CONV_W, I_CONV_B, I_GATE_B, I_ML_NORM_G, I_W_OUT, I_NORM_X_G, I_MEM_NORM_G,
       I_W_CQ, I_W_CKV, I_W_CO, I_NORM_FFN_G, I_W_GROUP, I_B_GROUP, I_W_ROUTER, I_B_ROUTER, I_W_GATE, I_W_UP, I_W_DOWN, I_FINAL_G };

__device__ __forceinline__ void tr_item(const float* W, size_t ldw, int k0, int n0, const float* kscale, bf16* WT, size_t ldt, int drow0, int dcol0, LAS float* scr, int lane) {
#pragma unroll 8
    for (int i = 0; i < 32; ++i) { const int kk = 2 * i + (lane >> 5); float v = W[(size_t)(k0 + kk) * ldw + n0 + (lane & 31)]; if (kscale) v *= kscale[k0 + kk]; scr[kk * 33 + (lane & 31)] = v; }
    LDS_WAIT(); asm volatile("" ::: "memory");
    const int c = lane & 7;
#pragma unroll
    for (int j = 0; j < 4; ++j) { const int n = (lane >> 3) + 8 * j; const LAS float* s = scr + (8 * c) * 33 + n;
        u32x4 o; o.x = pk2(s[0 * 33], s[1 * 33]); o.y = pk2(s[2 * 33], s[3 * 33]); o.z = pk2(s[4 * 33], s[5 * 33]); o.w = pk2(s[6 * 33], s[7 * 33]);
        *(u32x4*)(WT + (size_t)(drow0 + n0 + n) * ldt + dcol0 + k0 + 8 * c) = o; }
    LDS_WAIT(); asm volatile("" ::: "memory");
}
__device__ __forceinline__ void tr_load64(const float* W, size_t ldw, int k0, int n0, f32x4 (&a)[8], f32x4 (&b)[8], int lane) {
    const int nq = lane & 15, kq = lane >> 4;
    const float* src = W + (size_t)(k0 + 2 * kq) * ldw + n0 + 4 * nq;
#pragma unroll
    for (int i = 0; i < 8; ++i) { a[i] = __builtin_nontemporal_load((const f32x4*)(src + (size_t)(8 * i) * ldw)); b[i] = __builtin_nontemporal_load((const f32x4*)(src + (size_t)(8 * i + 1) * ldw)); }
}
__device__ __forceinline__ void tr_finish64(const f32x4 (&a)[8], const f32x4 (&b)[8], int k0, int n0, const float* kscale, bf16* WT, size_t ldt, int drow0, int dcol0, LAS unsigned char* scr, int lane) {
    const int nq = lane & 15, kq = lane >> 4;
#pragma unroll
    for (int i = 0; i < 8; ++i) { float sa = 1.f, sb = 1.f; if (kscale) { sa = kscale[k0 + 8 * i + 2 * kq]; sb = kscale[k0 + 8 * i + 2 * kq + 1]; }
#pragma unroll
        for (int j = 0; j < 4; ++j) { const int n = 4 * nq + j; *(LAS unsigned*)(scr + n * 128 + 16 * (i ^ (nq & 7)) + 4 * kq) = pk2(a[i][j] * sa, b[i][j] * sb); } }
    LDS_WAIT(); asm volatile("" ::: "memory");
#pragma unroll
    for (int m = 0; m < 8; ++m) { const int n = (lane >> 3) + 8 * m, c = lane & 7; const u32x4 v = *(const LAS u32x4*)(scr + n * 128 + 16 * (c ^ ((n >> 2) & 7)));
        __builtin_nontemporal_store(v, (u32x4*)(WT + (size_t)(drow0 + n0 + n) * ldt + dcol0 + k0 + 8 * c)); }
    LDS_WAIT(); asm volatile("" ::: "memory");
}
__device__ __forceinline__ void tr_scales64(const float* kscale, int k0, float (&sc)[16], int lane) { const int kq = lane >> 4;
#pragma unroll
    for (int i = 0; i < 8; ++i) { sc[2 * i] = kscale[k0 + 8 * i + 2 * kq]; sc[2 * i + 1] = kscale[k0 + 8 * i + 2 * kq + 1]; } }
__device__ __forceinline__ void tr_finish64s(const f32x4 (&a)[8], const f32x4 (&b)[8], const float (&sc)[16], int k0, int n0, bf16* WT, size_t ldt, int drow0, int dcol0, LAS unsigned char* scr, int lane) {
    const int nq = lane & 15, kq = lane >> 4;
#pragma unroll
    for (int i = 0; i < 8; ++i) {
#pragma unroll
        for (int j = 0; j < 4; ++j) { const int n = 4 * nq + j; *(LAS unsigned*)(scr + n * 128 + 16 * (i ^ (nq & 7)) + 4 * kq) = pk2(a[i][j] * sc[2 * i], b[i][j] * sc[2 * i + 1]); } }
    LDS_WAIT(); asm volatile("" ::: "memory");
#pragma unroll
    for (int m = 0; m < 8; ++m) { const int n = (lane >> 3) + 8 * m, c = lane & 7; const u32x4 v = *(const LAS u32x4*)(scr + n * 128 + 16 * (c ^ ((n >> 2) & 7)));
        __builtin_nontemporal_store(v, (u32x4*)(WT + (size_t)(drow0 + n0 + n) * ldt + dcol0 + k0 + 8 * c)); }
    LDS_WAIT(); asm volatile("" ::: "memory");
}
__device__ __forceinline__ void tr_item64(const float* W, size_t ldw, int k0, int n0, const float* kscale, bf16* WT, size_t ldt, int drow0, int dcol0, LAS unsigned char* scr, int lane) {
    f32x4 a[8], b[8];
    tr_load64(W, ldw, k0, n0, a, b, lane);
    tr_finish64(a, b, k0, n0, kscale, WT, ldt, drow0, dcol0, scr, lane);
}
__device__ __forceinline__ void cv_item64(const float* W, size_t ldw, int k0, int n0, const float* kscale, float scale, bf16* O, size_t ldo, int lane) {
    const int c4 = (lane & 15) * 4, rr = lane >> 4;
    f32x4 v[16];
#pragma unroll
    for (int i = 0; i < 16; ++i) v[i] = __builtin_nontemporal_load((const f32x4*)(W + (size_t)(k0 + i * 4 + rr) * ldw + n0 + c4));
#pragma unroll
    for (int i = 0; i < 16; ++i) { const float g = kscale[k0 + i * 4 + rr] * scale; u32x2 w; w.x = pk2(v[i][0] * g, v[i][1] * g); w.y = pk2(v[i][2] * g, v[i][3] * g);
        *(u32x2*)(O + (size_t)(k0 + i * 4 + rr) * ldo + n0 + c4) = w; }
}
__device__ __forceinline__ void rms_row_to_bf16(const float* xrow, const float* g, bf16* orow, int lane) {
    const f32x4* xr = (const f32x4*)xrow + lane; const f32x4* gr = (const f32x4*)g + lane;
    f32x4 v[8]; float s = 0.f;
#pragma unroll
    for (int j = 0; j < 8; ++j) { v[j] = xr[64 * j]; s += (v[j][0] * v[j][0] + v[j][1] * v[j][1]) + (v[j][2] * v[j][2] + v[j][3] * v[j][3]); }
    const float r = rsqrtf(wave_sum(s) * (1.f / D) + EPS);
    u32x2* o8 = (u32x2*)orow + lane;
#pragma unroll
    for (int j = 0; j < 8; ++j) { const f32x4 gg = gr[64 * j]; u32x2 w; w.x = pk2(v[j][0] * r * gg[0], v[j][1] * r * gg[1]); w.y = pk2(v[j][2] * r * gg[2], v[j][3] * r * gg[3]); o8[64 * j] = w; }
}

__device__ __forceinline__ void mini_gemm64(LAS unsigned char* lds, const bf16* Ap, const unsigned lda, const bf16* Bp, const unsigned ldb, const int nch, bf16* o, const unsigned ldo, const int wave, const int lane) {
    const int r32 = lane & 31, hh = lane >> 5; const int tm = wave & 1, tn = (wave >> 1) & 1, kh = wave >> 2;
#define KV_DMA(kc_) do { _Pragma("unroll") for (int i4 = 0; i4 < 4; ++i4) { const int ii = wave * 4 + i4; const int isb = ii >> 4, row_ = (ii & 15) * 4 + (lane >> 4); \
        const bf16* gsrc_ = (isb ? Bp + (size_t)row_ * ldb : Ap + (size_t)row_ * lda) + (kc_) * 128 + (((lane & 15) ^ (row_ & 15)) * 8); \
        const unsigned ldst_ = __builtin_amdgcn_readfirstlane((unsigned)(size_t)lds + (unsigned)(((kc_) & 3) * 32768 + isb * 16384 + (ii & 15) * 1024)); unsigned keep_; \
        asm volatile("s_mov_b32 %0, m0\n\ts_mov_b32 m0, %2\n\ts_nop 0\n\tglobal_load_lds_dwordx4 %1, off\n\ts_mov_b32 m0, %0" : "=&s"(keep_) : "v"(gsrc_), "s"(ldst_) : "memory"); } } while (0)
    f32x16 acc;
#pragma unroll
    for (int i = 0; i < 16; ++i) acc[i] = 0.f;
    asm volatile("s_waitcnt vmcnt(0)" ::: "memory");
    __syncthreads();
    KV_DMA(0); if (nch > 1) KV_DMA(1); if (nch > 2) KV_DMA(2);
#pragma unroll 1
    for (int kc = 0; kc < nch; ++kc) {
        const int ahead = nch - 1 - kc;
        if (ahead >= 2) asm volatile("s_waitcnt vmcnt(8)" ::: "memory"); else if (ahead == 1) asm volatile("s_waitcnt vmcnt(4)" ::: "memory"); else asm volatile("s_waitcnt vmcnt(0)" ::: "memory");
        __syncthreads();
        if (kc + 3 < nch) KV_DMA(kc + 3);
        const LAS unsigned char* ba = lds + (kc & 3) * 32768 + (tm * 32 + r32) * 256; const LAS unsigned char* bb = lds + (kc & 3) * 32768 + 16384 + (tn * 32 + r32) * 256;
#pragma unroll
        for (int k4 = 0; k4 < 4; ++k4) { const int ch = (kh * 4 + k4) * 2 + hh;
            const bf16x8 af = *(const LAS bf16x8*)(ba + ((ch ^ (r32 & 15)) * 16)), bfr = *(const LAS bf16x8*)(bb + ((ch ^ (r32 & 15)) * 16));
            acc = __builtin_amdgcn_mfma_f32_32x32x16_bf16(af, bfr, acc, 0, 0, 0); }
    }
#undef KV_DMA
    __syncthreads();
    LAS float* xb = (LAS float*)lds + (wave & 3) * 1024;
    if (kh == 1) {
#pragma unroll
        for (int i = 0; i < 16; ++i) xb[i * 64 + lane] = acc[i]; }
    __syncthreads();
    if (kh == 0) { bf16* op = o + (size_t)(tm * 32 + 4 * hh) * ldo + tn * 32 + r32;
#pragma unroll
        for (int i = 0; i < 16; ++i) op[(size_t)((i & 3) + 8 * (i >> 2)) * ldo] = (bf16)f2bf(acc[i] + xb[i * 64 + lane]); }
}

__global__ void __launch_bounds__(512, 2) mega(Args args) {
    extern __shared__ __attribute__((aligned(16))) unsigned char lds_raw[];
    LAS unsigned char* lds = (LAS unsigned char*)lds_raw;
    volatile LAS unsigned* MISC = (volatile LAS unsigned*)(lds + MISC_OFF);
    const int tid0 = threadIdx.x;
    const int wave0_ = __builtin_amdgcn_readfirstlane(tid0 >> 6);
    const int G = gridDim.x, bx = blockIdx.x;
#define PHASE_IDS const Args* A_ = (const Args*)__builtin_amdgcn_kernarg_segment_ptr(); asm volatile("" : "+s"(A_)); int tid; asm volatile("v_mbcnt_lo_u32_b32 %0, -1, 0\n\tv_mbcnt_hi_u32_b32 %0, -1, %0" : "=v"(tid)); tid += wave0_ * 64; asm volatile("" : "+v"(tid)); const int lane = tid & 63, wave = __builtin_amdgcn_readfirstlane(tid >> 6); const int gw = bx * 8 + wave, NGW = G * 8; (void)lane; (void)gw; (void)NGW;
    const Args* A_ = (const Args*)__builtin_amdgcn_kernarg_segment_ptr();
    unsigned char* ws = args.ws;
    unsigned* ctl = (unsigned*)(ws + WS_CTL);
    const int lo = args.ph_lo, hi = args.ph_hi;
    for (int u = tid0; u < 1024; u += 512) MISC[u] = 0u;
    __syncthreads();
    XcdBarrier bar; bar.bar = ctl + CW_BAR; bar.x = 0; bar.st = MISC;
    if (hi - lo > 1) bar = xcd_barrier_post(ctl + CW_BAR, MISC);
#ifndef PH_MASK
#define PH_MASK 0x1ffff
#endif
#define IN(k) ((((PH_MASK) >> (k)) & 1) && lo <= (k) && (k) < hi)
#ifndef REP_MASK
#define REP_MASK 0
#endif
#define NREP(k) (1 + (((REP_MASK) >> (k)) & 1))
#ifndef PR_MFMA
#define PR_MFMA 0
#endif
#ifndef PR_EPI
#define PR_EPI 0
#endif
#ifndef PR_GA
#define PR_GA 0
#endif
#ifndef PR_VF
#define PR_VF 0
#endif
#ifndef PR_KV
#define PR_KV 0
#endif
#ifndef PR_ML
#define PR_ML 0
#endif
#ifndef PR_TR
#define PR_TR 0
#endif
#ifndef PR_WP
#define PR_WP 0
#endif
#ifndef PR_H1
#define PR_H1 0
#endif
#ifndef PR_QK
#define PR_QK 0
#endif
#ifndef PR_PV
#define PR_PV 0
#endif
#define BOTH(k) (IN(k) && IN((k) + 1))
#define GRID_BAR(k) do { if (BOTH(k) && rep_ == NREP(k) - 1) xcd_barrier(bar, tid); } while (0)

#define WOUT_T ((bf16*)(ws + WS_WOUT_T))
#define WCQ_T ((bf16*)(ws + WS_WCQ_T))
#define WCKV_T ((bf16*)(ws + WS_WCKV_T))
#define WCO_T ((bf16*)(ws + WS_WCO_T))
#define WGU_T ((bf16*)(ws + WS_WGU_T))
#define WDN_T ((bf16*)(ws + WS_WDN_T))
#define WIN_T ((bf16*)(ws + WS_WIN_T))
#define H1 ((bf16*)(ws + WS_H1))
#define MIXIN ((bf16*)(ws + WS_MIXIN))
#define MEMN ((bf16*)(ws + WS_MEMN))
#define KC ((bf16*)(ws + WS_KC))
#define MF ((bf16*)(ws + WS_WCKV_T + 4 * MiB))
#define VF ((bf16*)(ws + WS_WCKV_T))
#define VT ((bf16*)(ws + WS_VT))
#define GATES ((float*)(ws + WS_GATES))
#define QABS ((bf16*)(ws + WS_QABS))
#define CKVRAW ((float*)(ws + WS_CKVRAW))
#define QI ((bf16*)(ws + WS_QI))
#define SMALL ((float*)(ws + WS_SMALL))
#define MQKRAW ((float*)(ws + WS_MQKRAW))
#define MV ((bf16*)(ws + WS_MV))
#define MO ((bf16*)(ws + WS_MO))
#define CKVN ((bf16*)(ws + WS_CKVN))
#define KIDXN ((bf16*)(ws + WS_KIDXN))
#define QCM ((bf16*)(ws + WS_QCM))
#define KCM ((bf16*)(ws + WS_KCM))
#define LST ((float*)(ws + WS_LST))
#define NL ((float*)(ws + WS_NL))
#define NST (NL + NCH * 4 * 128)
#define CST ((bf16*)(ws + WS_CST))
#define VTM ((bf16*)(ws + WS_VTM))
#define PB ((bf16*)(ws + WS_VTM))
#define X1B ((bf16*)(ws + WS_X1B))
#define QC ((bf16*)(ws + WS_QC))
#define OC ((bf16*)(ws + WS_OC))
#define X2B ((bf16*)(ws + WS_X2B))
#define LIST ((int*)(ws + WS_LIST))
#define TOKE ((int*)(ws + WS_TOK))
#define TOKW ((float*)(ws + WS_TOK) + 2 * T)
#define RSTD3 ((float*)(ws + WS_TOK) + 4 * T)
#define ACT ((bf16*)(ws + WS_ACT))
#define Y ((bf16*)(ws + WS_Y))
#define WRH ((bf16*)(ws + WS_WR))
#define WRL (WRH + 48 * D)
#define BCNT ((int*)(ws + WS_TOK) + 8 * T)
#define TOKR ((int*)(ws + WS_TOK) + 6 * T)
#define SS2 ((float*)(ctl + CW_SS2))
#define CNT ((int*)(ctl + CW_CNT))

    if (IN(0)) for (int rep_ = 0; rep_ < NREP(0); ++rep_) {
        PHASE_IDS
        if (rep_) xcd_barrier(bar, tid);
        LAS float* scr = (LAS float*)(lds + wave * 16384);
        const float* w_in = A_->in[I_W_IN]; const float* w_out = A_->in[I_W_OUT];
        constexpr int J_CKV = 32 * 4, J_QI = 32 * 8, J_KI = 32 * 1, J_MQK = 32 * 16, J_MV = 32 * 16, J_MO = 32 * 16, J_WO = 16 * 32, J_CQ = 32 * 32, J_CKVW = 32 * 64, J_CO = 32 * 32,
                      J_G = 32 * 256, J_U = 32 * 256, J_D = 32 * 256;
        constexpr int NITEMS = J_CKV + J_QI + J_KI + J_MQK + J_MV + J_MO + J_WO + J_CQ + J_CKVW + J_CO;
        LAS unsigned char* scr8 = (LAS unsigned char*)scr;
        for (int prt_ = 0; prt_ < 1 + PR_TR; ++prt_)
        for (int it = gw; it < NITEMS; it += NGW) {
            int r = it;
            if (r < J_CKV) { tr_item64(w_in + 1024, D_IN, 64 * (r / 4), 64 * (r % 4), nullptr, WIN_T, D, 2048, 0, scr8, lane); continue; } r -= J_CKV;
            if (r < J_QI) { tr_item64(w_in + 1280, D_IN, 64 * (r / 8), 64 * (r % 8), nullptr, WIN_T, D, 2304, 0, scr8, lane); continue; } r -= J_QI;
            if (r < J_KI) { tr_item64(w_in + 1792, D_IN, 64 * r, 0, nullptr, WIN_T, D, 2816, 0, scr8, lane); continue; } r -= J_KI;
            if (r < J_MQK) { tr_item64(w_in + 1864, D_IN, 64 * (r / 16), 64 * (r % 16), nullptr, WIN_T, D, 3072, 0, scr8, lane); continue; } r -= J_MQK;
            if (r < J_MV) { tr_item64(w_in + 2888, D_IN, 64 * (r / 16), 64 * (r % 16), nullptr, WIN_T, D, 4096, 0, scr8, lane); continue; } r -= J_MV;
            if (r < J_MO) { tr_item64(w_in + 3920, D_IN, 64 * (r / 16), 64 * (r % 16), nullptr, WIN_T, D, 5120, 0, scr8, lane); continue; } r -= J_MO;
            if (r < J_WO) { tr_item64(w_out + (size_t)1024 * D, D, 64 * (r / 32), 64 * (r % 32), nullptr, WOUT_T, KMIX, 0, 2048, scr8, lane); continue; } r -= J_WO;
            if (r < J_CQ) { cv_item64(A_->in[I_W_CQ], D, 64 * (r / 32), 64 * (r % 32), A_->in[I_NORM_X_G], 0.04419417382415922f, WCQ_T, D, lane); continue; } r -= J_CQ;
            if (r < J_CKVW) { tr_item64(A_->in[I_W_CKV], 2 * D, 64 * (r / 64), 64 * (r % 64), nullptr, WCKV_T, D, 0, 0, scr8, lane); continue; } r -= J_CKVW;
            if (r < J_CO) { tr_item64(A_->in[I_W_CO], D, 64 * (r / 32), 64 * (r % 32), nullptr, WCO_T, D, 0, 0, scr8, lane); continue; } r -= J_CO;
            (void)r;
        }
        for (int i = bx * 512 + tid; i < 192 * D; i += G * 512) { const int r = i / D, k = i % D; float v = 0.f;
            if (r < 8) v = w_in[(size_t)k * D_IN + 1856 + r]; else if (r < 16) v = w_in[(size_t)k * D_IN + 3912 + (r - 8)];
            WIN_T[(size_t)(2880 + r) * D + k] = (bf16)f2bf(v); }
        for (int i = bx * 512 + tid; i < 48 * D; i += G * 512) { const int o = i / D, k = i % D; float v = 0.f;
            if (o < 4) v = A_->in[I_W_GROUP][(size_t)k * 4 + o] * A_->in[I_NORM_FFN_G][k]; else if (o < 36) v = A_->in[I_W_ROUTER][(size_t)k * 32 + (o - 4)] * A_->in[I_NORM_FFN_G][k];
            const unsigned hb = f2bf(v); WRH[i] = (bf16)hb; WRL[i] = (bf16)f2bf(v - bf2f(hb)); }
        {
            const int r32 = lane & 31, hh = lane >> 5;
            const float* w_uk = A_->in[I_W_UK]; const float* w_uv = A_->in[I_W_UV];
#define CVT8(dst, pa, pb) do { const f32x4 x_ = (pa), y_ = (pb); u32x4 w_; w_.x = pk2(x_[0], x_[1]); w_.y = pk2(x_[2], x_[3]); w_.z = pk2(y_[0], y_[1]); w_.w = pk2(y_[2], y_[3]); dst = __builtin_bit_cast(bf16x8, w_); } while (0)
            for (int prw_ = 0; prw_ < 1 + PR_WP; ++prw_)
            for (int it = gw; it < 4096; it += NGW) {
                const bool isq = it < 2048; const int r = it & 2047, h = r >> 8, rt = (r >> 2) & 63, cg = r & 3;
                if (isq) {
                    const int ct = (r >> 5) & 7, kg = r & 31;
                    bf16x8 af[8];
                    { const float* ap = w_uk + (size_t)((ct * 32 + r32) * 8 + h) * 128 + 8 * hh;
#pragma unroll
                      for (int ks = 0; ks < 8; ++ks) CVT8(af[ks], *(const f32x4*)(ap + ks * 16), *(const f32x4*)(ap + ks * 16 + 4)); }
#pragma unroll 1
                    for (int kt = 0; kt < 2; ++kt) { const int k0 = kg * 64 + kt * 32; const float* bp = w_in + (size_t)(k0 + r32) * D_IN + h * 128 + 8 * hh;
                        f32x16 acc;
#pragma unroll
                        for (int i = 0; i < 16; ++i) acc[i] = 0.f;
#pragma unroll
                        for (int ks = 0; ks < 8; ++ks) { bf16x8 bfr; CVT8(bfr, *(const f32x4*)(bp + ks * 16), *(const f32x4*)(bp + ks * 16 + 4)); acc = __builtin_amdgcn_mfma_f32_32x32x16_bf16(af[ks], bfr, acc, 0, 0, 0); }
                        bf16* o = WIN_T + (size_t)(h * 256 + ct * 32 + 4 * hh) * D + k0 + r32;
#pragma unroll
                        for (int i = 0; i < 16; ++i) o[(size_t)((i & 3) + 8 * (i >> 2)) * D] = (bf16)f2bf(acc[i] * 0.08838834764831845f); }
                } else {
                    const float* pj[8];
#pragma unroll
                    for (int j = 0; j < 8; ++j) pj[j] = w_out + (size_t)(h * 128 + 8 * hh + j) * D + rt * 32 + r32;
                    const float* bp0 = w_uv + (size_t)((cg * 64 + r32) * 8 + h) * 128 + 8 * hh; const float* bp1 = bp0 + (size_t)32 * 8 * 128;
                    f32x16 acc0, acc1;
#pragma unroll
                    for (int i = 0; i < 16; ++i) { acc0[i] = 0.f; acc1[i] = 0.f; }
#pragma unroll 2
                    for (int ks = 0; ks < 8; ++ks) { u32x4 w_; w_.x = pk2(*pj[0], *pj[1]); w_.y = pk2(*pj[2], *pj[3]); w_.z = pk2(*pj[4], *pj[5]); w_.w = pk2(*pj[6], *pj[7]); const bf16x8 afr = __builtin_bit_cast(bf16x8, w_);
#pragma unroll
                        for (int j = 0; j < 8; ++j) pj[j] += (size_t)16 * D;
                        bf16x8 b0, b1; CVT8(b0, *(const f32x4*)(bp0 + ks * 16), *(const f32x4*)(bp0 + ks * 16 + 4)); CVT8(b1, *(const f32x4*)(bp1 + ks * 16), *(const f32x4*)(bp1 + ks * 16 + 4));
                        acc0 = __builtin_amdgcn_mfma_f32_32x32x16_bf16(afr, b0, acc0, 0, 0, 0); acc1 = __builtin_amdgcn_mfma_f32_32x32x16_bf16(afr, b1, acc1, 0, 0, 0); }
                    bf16* o = WOUT_T + (size_t)(rt * 32 + 4 * hh) * KMIX + h * 256 + cg * 64 + r32;
#pragma unroll
                    for (int i = 0; i < 16; ++i) { o[(size_t)((i & 3) + 8 * (i >> 2)) * KMIX] = (bf16)f2bf(acc0[i]); o[(size_t)((i & 3) + 8 * (i >> 2)) * KMIX + 32] = (bf16)f2bf(acc1[i]); }
                }
            }
#undef CVT8
        }
        for (int prh_ = 0; prh_ < 1 + PR_H1; ++prh_)
        for (int m = gw; m < T; m += NGW) rms_row_to_bf16(A_->in[I_X] + (size_t)m * D, A_->in[I_NORM_MIX_G], H1 + (size_t)m * D, lane);
        for (int m = gw; m < NMEM; m += NGW) rms_row_to_bf16(A_->in[I_MEM] + (size_t)m * D, A_->in[I_MEM_NORM_G], MEMN + (size_t)m * D, lane);
        GRID_BAR(0);
    }

    if (IN(1)) for (int rep_ = 0; rep_ < NREP(1); ++rep_) {
        PHASE_IDS
        if (rep_) xcd_barrier(bar, tid);
        pg8::DenseOrder S; S.init(T, NPROJ, D, D, G, bx);
        pg8::EpiProj E{QABS, CKVRAW, QI, SMALL, MQKRAW, MV, MO};
        pg8::gemm_phase(tid, lds, H1, WIN_T, D, S, E);
        GRID_BAR(1);
    }

    if (IN(2)) for (int rep_ = 0; rep_ < NREP(2); ++rep_) {
        PHASE_IDS
        if (rep_) xcd_barrier(bar, tid);
#ifndef P2_SUB
#define P2_SUB 15
#endif
        if (P2_SUB & 1) {
            for (int prk_ = 0; prk_ < 1 + PR_KV; ++prk_)
            for (int id = bx; id < 256; id += G) {
                const int rt = id & 3, ct = id >> 2;
                mini_gemm64(lds, MEMN + (size_t)(rt * 64) * D, D, WCKV_T + (size_t)(ct * 64) * D, D, 16, KC + (size_t)(rt * 64) * 4096 + ct * 64, 4096u, wave, lane);
            }
        }
        __syncthreads();
        if (P2_SUB & 4) for (int t = gw; t < T; t += NGW) {
            const f32x4 v = ((const f32x4*)(CKVRAW + (size_t)t * 256))[lane];
            const float r = rsqrtf(wave_sum((v[0] * v[0] + v[1] * v[1]) + (v[2] * v[2] + v[3] * v[3])) * (1.f / 256.f) + EPS);
            const f32x4 g = ((const f32x4*)A_->in[I_KV_NORM_G])[lane];
            u32x2 w; w.x = pk2(v[0] * r * g[0], v[1] * r * g[1]); w.y = pk2(v[2] * r * g[2], v[3] * r * g[3]);
            ((u32x2*)(CKVN + (size_t)t * 256))[lane] = w;
            const float kv = SMALL[(size_t)t * 256 + lane];
            const float rk = rsqrtf(wave_sum(kv * kv) * (1.f / 64.f) + EPS);
            KIDXN[(size_t)t * 64 + lane] = (bf16)f2bf(kv * rk * A_->in[I_KIDX_NORM_G][lane]);
        }
        if (P2_SUB & 8) {
            LAS float* kq = (LAS float*)lds;
            LAS bf16* KWT = (LAS bf16*)(lds + 32768);
            LAS bf16* VTl = (LAS bf16*)(lds + 51200);
            LAS float* sw = (LAS float*)(lds + 98304);
            const float* conv_w = A_->in[I_CONV_W]; const float* conv_b = A_->in[I_CONV_B]; const float* gate_b = A_->in[I_GATE_B];
            const int r32 = lane & 31, hh = lane >> 5;
            for (int prm_ = 0; prm_ < 1 + PR_ML; ++prm_)
            for (int uu = bx; uu < NCH * 4; uu += G) {
                const int c = uu >> 2, h = uu & 3, t0 = c * CH;
                __syncthreads();
                if (wave == 0) {
                    const int t = t0 + lane; const float li = SMALL[(size_t)t * 256 + 72 + h] + gate_b[h]; const float mf = SMALL[(size_t)t * 256 + 76 + h] + gate_b[4 + h];
                    float bsc = fminf(mf, 0.f) - log1pf(__expf(-fabsf(mf)));
#pragma unroll
                    for (int o = 1; o < 64; o <<= 1) { const float v = __shfl_up(bsc, o); if (lane >= o) bsc += v; }
                    const float g = __shfl(bsc, 63); const float dec = g - bsc + li; const float mx = wave_max(dec);
                    sw[lane] = __expf(dec - mx); sw[128 + lane] = li; sw[192 + lane] = bsc;
                    GATES[GT_B + (size_t)t * 4 + h] = bsc; GATES[GT_LI + (size_t)t * 4 + h] = li;
                    if (lane == 0) { GATES[GT_G + c * 4 + h] = g; GATES[GT_MLOC + c * 4 + h] = mx; } }
                __syncthreads();
                { const int ch = tid & 255, th = tid >> 8; const int src = ch < 128 ? h * 128 + ch : 512 + h * 128 + (ch - 128);
                  const float cw0 = conv_w[src], cw1 = conv_w[1024 + src], cw2 = conv_w[2048 + src], cw3 = conv_w[3072 + src], cbias = conv_b[src];
                  const int tb = t0 + th * 32 - 3; float xr[35];
#pragma unroll
                  for (int i = 0; i < 35; ++i) xr[i] = (tb + i >= 0) ? MQKRAW[(size_t)(tb + i) * 1024 + src] : 0.f;
#pragma unroll
                  for (int i = 0; i < 32; ++i) { const int s_ = th * 32 + i, t = t0 + s_; float y = cbias + ((cw0 * xr[i] + cw1 * xr[i + 1]) + (cw2 * xr[i + 2] + cw3 * xr[i + 3]));
                      y = y / (1.f + __expf(-y));
                      if (ch < 128) QCM[(size_t)t * 512 + h * 128 + ch] = (bf16)f2bf(y * 0.08838834764831845f);
                      else { const unsigned kb = f2bf(y); KCM[(size_t)t * 512 + h * 128 + (ch - 128)] = (bf16)kb; const float kf = bf2f(kb); kq[s_ * 128 + (ch - 128)] = kf; KWT[(ch - 128) * 72 + s_] = (bf16)f2bf(sw[s_] * kf); } } }
#pragma unroll 1
                for (int e = tid; e < 64 * 32; e += 512) { const int s = e & 63, c8 = e >> 6; const u32x4 vv = *(const u32x4*)(MV + (size_t)(t0 + s) * 1024 + h * 256 + c8 * 8);
                    LAS bf16* d = VTl + (c8 * 8) * 72 + s;
                    d[0] = (bf16)(vv.x & 0xffffu); d[72] = (bf16)(vv.x >> 16); d[144] = (bf16)(vv.y & 0xffffu); d[216] = (bf16)(vv.y >> 16);
                    d[288] = (bf16)(vv.z & 0xffffu); d[360] = (bf16)(vv.z >> 16); d[432] = (bf16)(vv.w & 0xffffu); d[504] = (bf16)(vv.w >> 16); }
                __syncthreads();
#pragma unroll 1
                for (int e = tid; e < 256 * 8; e += 512) { const int dv = e >> 3, ch = e & 7; *(u32x4*)(VTM + ((size_t)(c * 4 + h) * 256 + dv) * 64 + ch * 8) = *(const LAS u32x4*)(VTl + dv * 72 + ch * 8); }
                {
                    bf16x8 af[4];
#pragma unroll
                    for (int ks = 0; ks < 4; ++ks) af[ks] = *(const LAS bf16x8*)(VTl + (wave * 32 + r32) * 72 + ks * 16 + 8 * hh);
#pragma unroll 1
                    for (int j = 0; j < 4; ++j) { f32x16 acc;
#pragma unroll
                        for (int i = 0; i < 16; ++i) acc[i] = 0.f;
#pragma unroll
                        for (int ks = 0; ks < 4; ++ks) { const bf16x8 bfr = *(const LAS bf16x8*)(KWT + (j * 32 + r32) * 72 + ks * 16 + 8 * hh); acc = __builtin_amdgcn_mfma_f32_32x32x16_bf16(af[ks], bfr, acc, 0, 0, 0); }
                        float* o = LST + ((size_t)(c * 4 + h) * 256 + wave * 32 + 4 * hh) * 128 + j * 32 + r32;
#pragma unroll
                        for (int i = 0; i < 16; ++i) o[(size_t)((i & 3) + 8 * (i >> 2)) * 128] = acc[i]; }
                }
                if (tid < 128) { float a = 0.f;
#pragma unroll 4
                    for (int s = 0; s < 64; ++s) a += sw[s] * kq[s * 128 + tid]; NL[(size_t)(c * 4 + h) * 128 + tid] = a; }
            }
        }
        GRID_BAR(2);
    }

    if (IN(3)) for (int rep_ = 0; rep_ < NREP(3); ++rep_) {
        PHASE_IDS
        if (rep_) xcd_barrier(bar, tid);
#ifndef R_SCAN
#define R_SCAN 1
#endif
        for (int prv_ = 0; prv_ < 1 + PR_VF; ++prv_)
        for (int id = bx; id < 512; id += G) {
            const int h = id >> 7, rt = (id & 127) >> 2, ct = id & 3;
            mini_gemm64(lds, WCO_T + (size_t)(rt * 64) * D + h * 512, D, KC + (size_t)(ct * 64) * 4096 + 2048 + h * 512, 4096u, 4, VF + (size_t)(rt * 64) * 1024 + h * 256 + ct * 64, 1024u, wave, lane);
        }
        for (int prv_ = 0; prv_ < 1 + PR_VF; ++prv_)
        for (int id = bx; id < 512; id += G) {
            const int h = id >> 7, kt = (id & 127) >> 2, mt = id & 3;
            mini_gemm64(lds, KC + (size_t)(mt * 64) * 4096 + h * 512, 4096u, WCQ_T + (size_t)(kt * 64) * D + h * 512, D, 4, MF + (size_t)(h * 256 + mt * 64) * D + kt * 64, D, wave, lane);
        }
        for (int rscan_ = 0; rscan_ < R_SCAN; ++rscan_) {
            LAS float* am = (LAS float*)lds;
            LAS float* sm = am + 512;
            LAS float* gl = am + 1024;
            __syncthreads();
            gl[tid] = GATES[GT_G + tid]; gl[512 + tid] = GATES[GT_MLOC + tid];
            __syncthreads();
            if (tid < 4) { float m = 0.f;
#pragma unroll 1
                for (int k = 0; k < NCH; ++k) { const float g = gl[k * 4 + tid], ml = gl[512 + k * 4 + tid]; const float mn = fmaxf(g + m, ml);
                    am[tid * 128 + k] = __expf(g + m - mn); sm[tid * 128 + k] = __expf(ml - mn); if (bx == 0) GATES[GT_MPREV + k * 4 + tid] = m; m = mn; } }
            __syncthreads();
            for (int e = bx * 512 + tid; e < 4 * 32768; e += G * 512) { const int h = e >> 15, rem = e & 32767; float C = 0.f;
#pragma unroll 1
                for (int kb = 0; kb < NCH; kb += 32) { float l[32];
#pragma unroll
                    for (int i = 0; i < 32; ++i) l[i] = __builtin_nontemporal_load(LST + (size_t)((kb + i) * 4 + h) * 32768 + rem);
#pragma unroll
                    for (int i = 0; i < 32; ++i) { const int k = kb + i; CST[(size_t)(k * 4 + h) * 32768 + rem] = (bf16)f2bf(C); C = am[h * 128 + k] * C + sm[h * 128 + k] * l[i]; } } }
            if (bx == 0) { const int h = tid >> 7, dk = tid & 127; float n = 0.f;
#pragma unroll 1
                for (int kb = 0; kb < NCH; kb += 16) { float l[16];
#pragma unroll
                    for (int i = 0; i < 16; ++i) l[i] = NL[(size_t)((kb + i) * 4 + h) * 128 + dk];
#pragma unroll
                    for (int i = 0; i < 16; ++i) { const int k = kb + i; NST[(size_t)(k * 4 + h) * 128 + dk] = n; n = am[h * 128 + k] * n + sm[h * 128 + k] * l[i]; } } }
            __syncthreads();
        }
        {
            const int r32 = lane & 31, hh = lane >> 5;
#pragma unroll 1
            for (int ui_ = 0; ui_ * G < 1144; ++ui_) {
                const int L = ui_ * G + ((ui_ & 1) ? (G - 1 - bx) : bx); if (L >= 1144) continue;
                int sl = 0, g;
                if (L < 912) { int rem = L;
#pragma unroll 1
                    while (rem >= 226 - 32 * sl) { rem -= 226 - 32 * sl; ++sl; }
                    g = 32 * sl + 30 + rem; }
                else { int q = L - 912, r, j; if (q < 176) { r = 15 - q / 16; j = q % 16; sl = j >> 1; } else { q -= 176; r = 4 - q / 14; j = q % 14; sl = 1 + (j >> 1); }
                    g = 2 * (r - 1 + 16 * sl) + (j & 1); }
                const int c = g >> 1, tq0 = g * 32 + wave * 4, N = 64 * (c + 1);
                const int jb = sl * 32, je = (N >> 5) < jb + 32 ? (N >> 5) : jb + 32;
                if (N <= 256) continue;
                unsigned short* rowb = (c < 127 ? (unsigned short*)A_->out + (size_t)2048 * c * (c + 1) : (unsigned short*)(ws + WS_SC127)) + (size_t)(tq0 & 63) * N + jb * 32;
                LAS unsigned short* stg = (LAS unsigned short*)(lds + wave * 8192);
                bf16x8 af[4]; float wq[16];
                { const bf16* qp = QI + (size_t)(tq0 + (r32 >> 3)) * 512 + (r32 & 7) * 64 + 8 * hh;
#pragma unroll
                  for (int ks = 0; ks < 4; ++ks) af[ks] = *(const bf16x8*)(qp + ks * 16);
#pragma unroll
                  for (int qq = 0; qq < 4; ++qq)
#pragma unroll
                      for (int i = 0; i < 4; ++i) wq[qq * 4 + i] = SMALL[(size_t)(tq0 + qq) * 256 + 64 + 4 * hh + i] * 0.04419417382415922f; }
#define IDX_GROUP(gi_) do { const int tile_ = jb + (gi_) * 8 + wave; if (tile_ < je) { _Pragma("unroll") for (int i4 = 0; i4 < 4; ++i4) { const int row_ = i4 * 8 + (lane >> 3); \
                        const bf16* gsrc_ = KIDXN + (size_t)(tile_ * 32 + row_) * 64 + (((lane & 7) ^ (row_ & 7)) * 8); \
                        const unsigned ldst_ = __builtin_amdgcn_readfirstlane((unsigned)(size_t)lds + 65536u + (unsigned)(((gi_) & 1) * 32768 + wave * 4096 + i4 * 1024)); unsigned keep_; \
                        asm volatile("s_mov_b32 %0, m0\n\ts_mov_b32 m0, %2\n\ts_nop 0\n\tglobal_load_lds_dwordx4 %1, off\n\ts_mov_b32 m0, %0" : "=&s"(keep_) : "v"(gsrc_), "s"(ldst_) : "memory"); } } } while (0)
#define IDX_LOAD(buf, gi_, tl_) do { const LAS unsigned char* kt_ = lds + 65536 + ((gi_) & 1) * 32768 + (tl_) * 4096 + r32 * 128; \
                    _Pragma("unroll") for (int ks = 0; ks < 4; ++ks) buf[ks] = *(const LAS bf16x8*)(kt_ + (((ks * 2 + hh) ^ (r32 & 7)) * 16)); } while (0)
#define RELU_(x_) __int_as_float(max(__float_as_int(x_), 0))
#define IDX_TILE(buf, jj) do { const int s0 = (jj) * 32; f32x16 acc; _Pragma("unroll") for (int i = 0; i < 16; ++i) acc[i] = 0.f; \
                        _Pragma("unroll") for (int ks = 0; ks < 4; ++ks) acc = __builtin_amdgcn_mfma_f32_32x32x16_bf16(af[ks], buf[ks], acc, 0, 0, 0); \
                        if (PR_MFMA) { f32x16 acc2; _Pragma("unroll") for (int i = 0; i < 16; ++i) acc2[i] = 0.f; _Pragma("unroll") for (int ks = 0; ks < 4; ++ks) acc2 = __builtin_amdgcn_mfma_f32_32x32x16_bf16(af[ks], buf[ks], acc2, 0, 0, 0); asm volatile("" :: "v"(acc2)); } \
                        if (PR_EPI) { f32x16 a3 = acc; asm volatile("" : "+v"(a3)); float p3[4]; _Pragma("unroll") for (int qq = 0; qq < 4; ++qq) p3[qq] = (wq[qq * 4] * fmaxf(a3[qq * 4], 0.f) + wq[qq * 4 + 1] * fmaxf(a3[qq * 4 + 1], 0.f)) + (wq[qq * 4 + 2] * fmaxf(a3[qq * 4 + 2], 0.f) + wq[qq * 4 + 3] * fmaxf(a3[qq * 4 + 3], 0.f)); \
                            _Pragma("unroll") for (int qq = 0; qq < 4; ++qq) p3[qq] += __shfl_xor(p3[qq], 32); asm volatile("" :: "v"(p3[0]), "v"(p3[1]), "v"(p3[2]), "v"(p3[3])); } \
                        float part[4]; \
                          \
                        _Pragma("unroll") for (int qq = 0; qq < 4; ++qq) part[qq] = (wq[qq * 4] * RELU_(acc[qq * 4]) + wq[qq * 4 + 1] * RELU_(acc[qq * 4 + 1])) + (wq[qq * 4 + 2] * RELU_(acc[qq * 4 + 2]) + wq[qq * 4 + 3] * RELU_(acc[qq * 4 + 3])); \
                        const auto s02_ = __builtin_amdgcn_permlane32_swap(__float_as_uint(part[0]), __float_as_uint(part[2]), false, false), s13_ = __builtin_amdgcn_permlane32_swap(__float_as_uint(part[1]), __float_as_uint(part[3]), false, false); \
                          \
                        const float v0 = __uint_as_float(s02_[0]) + __uint_as_float(s02_[1]), v1 = __uint_as_float(s13_[0]) + __uint_as_float(s13_[1]); \
                        unsigned u0 = __builtin_bit_cast(unsigned short, (_Float16)v0), u1 = __builtin_bit_cast(unsigned short, (_Float16)v1); \
                        u0 = (u0 == 0x8000u) ? 0u : u0; u1 = (u1 == 0x8000u) ? 0u : u1; \
                        stg[(2 * hh) * 1024 + s0 - jb * 32 + r32] = (unsigned short)((u0 & 0x8000u) ? ~u0 : (u0 | 0x8000u)); \
                        stg[(2 * hh + 1) * 1024 + s0 - jb * 32 + r32] = (unsigned short)((u1 & 0x8000u) ? ~u1 : (u1 | 0x8000u)); } while (0)
                { const int ngrp = (je - jb + 7) >> 3;
                  __syncthreads();
                  IDX_GROUP(0);
#pragma unroll 1
                  for (int gi = 0; gi < ngrp; ++gi) {
                      asm volatile("s_waitcnt vmcnt(0)" ::: "memory");
                      __syncthreads();
                      if (gi + 1 < ngrp) IDX_GROUP(gi + 1);
#pragma unroll 2
                      for (int tl = 0; tl < 8; ++tl) { const int jt = jb + gi * 8 + tl; if (jt < je) { bf16x8 kbf[4]; IDX_LOAD(kbf, gi, tl); IDX_TILE(kbf, jt); } }
                  } }
#undef IDX_GROUP
#undef IDX_LOAD
#undef IDX_TILE
                LDS_WAIT(); asm volatile("" ::: "memory");
                { const int nk = (je - jb) * 32, np = nk >> 3;
                  for (int i = lane; i < 4 * np; i += 64) { const int qq = i / np, p = i - qq * np; *(u32x4*)(rowb + (size_t)qq * N + p * 8) = *(const LAS u32x4*)(stg + qq * 1024 + p * 8); } }
                LDS_WAIT(); asm volatile("" ::: "memory");
            }
        }
        GRID_BAR(3);
    }
    if (IN(4)) for (int rep_ = 0; rep_ < NREP(4); ++rep_) {
        PHASE_IDS
        if (rep_) xcd_barrier(bar, tid);
        {
            LAS int* hist = (LAS int*)(lds + MISC_OFF + 4096) + wave * 256;
            LAS int* sel = (LAS int*)(lds + MISC_OFF + 12288) + wave * 256;
            __syncthreads();
#pragma unroll 1
            for (int ui_ = 0; ui_ * G < T / 8; ++ui_) {
                const int uu = ui_ * G + ((ui_ & 1) ? (G - 1 - bx) : bx); if (uu >= T / 8) continue;
                const int t0 = uu * 8, t = t0 + wave, c = t0 >> 6, N = (c + 1) * 64, ng = N >> 6;
                int lo_ = lane; asm volatile("" : "+v"(lo_)); const int r16 = lo_ & 15, g4 = lo_ >> 4;
                f32x4 ta[8], tb[8]; float tsc[16]; const int tri = uu * 8 + wave, tre = tri >> 8, trk = (tri & 255) >> 3, trn = tri & 7;
#define TR_ISSUE_UP() do { tr_load64(A_->in[I_W_UP] + (size_t)tre * D * DEXP, DEXP, 64 * trk, 64 * trn, ta, tb, lane); } while (0)
#define TR_FINISH_UP() tr_finish64s(ta, tb, tsc, 64 * trk, 64 * trn, WGU_T + (size_t)tre * 1024 * D, D, (trn / 2) * 128 + 128, 0, lds + wave * 16384, lane);
#define TR_FINISH() tr_finish64s(ta, tb, tsc, 64 * trk, 64 * trn, WGU_T + (size_t)tre * 1024 * D, D, (trn / 2) * 128, 0, lds + wave * 16384, lane);
#define TR_ISSUE() do { tr_load64(A_->in[I_W_GATE] + (size_t)tre * D * DEXP, DEXP, 64 * trk, 64 * trn, ta, tb, lane); tr_scales64(A_->in[I_NORM_FFN_G], 64 * trk, tsc, lane); } while (0)
                {
                        if (N > 256) {
                            const unsigned short* rb = (c < 127 ? (const unsigned short*)A_->out + (size_t)2048 * c * (c + 1) : (const unsigned short*)(ws + WS_SC127)) + (size_t)(t & 63) * N;
                            unsigned kraw[64];
#define KR(ri_) (((ri_) & 1) ? (kraw[(ri_) >> 1] >> 16) : (kraw[(ri_) >> 1] & 0xffffu))
#define KR_OPAQUE() do { _Pragma("unroll") for (int i_ = 0; i_ < 64; ++i_) asm volatile("" : "+v"(kraw[i_])); } while (0)
#pragma unroll
                            for (int b8 = 0; b8 < 16; ++b8) {
#pragma unroll
                                for (int i = 0; i < 4; ++i) kraw[b8 * 4 + i] = 0u;
                                if (b8 * 8 < ng) { const bool ok = b8 * 512 + lane * 8 < N;
                                    u32x4 v = __builtin_nontemporal_load((const GAS u32x4*)(rb + (ok ? b8 * 512 + lane * 8 : 0))); if (!ok) v = (u32x4){0u, 0u, 0u, 0u};
                                    kraw[b8 * 4 + 0] = v.x; kraw[b8 * 4 + 1] = v.y; kraw[b8 * 4 + 2] = v.z; kraw[b8 * 4 + 3] = v.w; } }
                            TR_ISSUE();
                            int krem = 256; unsigned prefix = 0u;
#pragma unroll 1
                            for (int ps = 0; ps < 2; ++ps) { const int shift = 8 - 8 * ps;
                                hist[lane] = 0; hist[64 + lane] = 0; hist[128 + lane] = 0; hist[192 + lane] = 0;
                                KR_OPAQUE();
#pragma unroll
                                for (int b8 = 0; b8 < 16; ++b8) { if (b8 * 8 < ng) {
#pragma unroll
                                    for (int i = 0; i < 8; ++i) { const unsigned k = KR(b8 * 8 + i); const bool mt = (k != 0u) && (ps == 0 || (k >> 8) == prefix);
                                        if (mt) __hip_atomic_fetch_add(hist + (int)((k >> shift) & 255u), 1, __ATOMIC_RELAXED, __HIP_MEMORY_SCOPE_WORKGROUP); } } }
                                const int h0 = hist[4 * lane], h1 = hist[4 * lane + 1], h2 = hist[4 * lane + 2], h3 = hist[4 * lane + 3];
                                int sfx = h0 + h1 + h2 + h3;
#pragma unroll
                                for (int o = 1; o < 64; o <<= 1) { const int v = __shfl_down(sfx, o); if (lane + o < 64) sfx += v; }
                                const unsigned long long mge = __ballot(sfx >= krem);
                                const int ls = 63 - __builtin_clzll(mge);
                                const int above_l = (ls < 63) ? __builtin_amdgcn_readlane(sfx, (ls + 1) & 63) : 0;
                                const int b1 = __builtin_amdgcn_readlane(h1, ls), b2 = __builtin_amdgcn_readlane(h2, ls), b3 = __builtin_amdgcn_readlane(h3, ls);
                                int dg, above;
                                if (above_l + b3 >= krem) { dg = 3; above = above_l; } else if (above_l + b3 + b2 >= krem) { dg = 2; above = above_l + b3; }
                                else if (above_l + b3 + b2 + b1 >= krem) { dg = 1; above = above_l + b3 + b2; } else { dg = 0; above = above_l + b3 + b2 + b1; }
                                krem -= above; prefix = (prefix << 8) | (unsigned)(4 * ls + dg); }
                            const unsigned thr = prefix;
                            TR_FINISH();
                            TR_ISSUE_UP();
                            KR_OPAQUE();
                            int cg = 0; const int thi = (int)thr;
#pragma unroll
                            for (int b8 = 0; b8 < 16; ++b8) { if (b8 * 8 < ng) {
#pragma unroll
                                for (int i = 0; i < 8; ++i) { const int k = (int)KR(b8 * 8 + i); cg += (int)((unsigned)(thi - k) >> 31); } } }
#pragma unroll
                            for (int o = 1; o < 64; o <<= 1) cg += __shfl_xor(cg, o);
                            const int ngt = __builtin_amdgcn_readfirstlane(cg), need = 256 - ngt;
                            KR_OPAQUE();
                            int pg = 0, pe = 0; const unsigned long long ltm = (1ull << lane) - 1ull;
                            const int dump = (int)(((LAS int*)(lds + MISC_OFF + 20480) + wave * 64 + lane) - sel);
#pragma unroll
                            for (int b8 = 0; b8 < 16; ++b8) { if (b8 * 8 < ng) {
#pragma unroll
                                for (int i = 0; i < 8; ++i) { const unsigned k = KR(b8 * 8 + i); const int sidx = b8 * 512 + lane * 8 + i; const bool gt = k > thr, eq = k == thr;
                                    const unsigned long long mg = __ballot(gt), me = __ballot(eq);
                                    const int pos = (int)__builtin_amdgcn_mbcnt_hi((unsigned)(mg >> 32), __builtin_amdgcn_mbcnt_lo((unsigned)mg, (unsigned)pg));
                                    sel[gt ? pos : dump] = sidx; pg += __popcll(mg);
                                    if (me) { const int r = pe + __popcll(me & ltm); if (eq && r < need) sel[ngt + r] = sidx; pe += __popcll(me); } } } }
#undef KR
#undef KR_OPAQUE
                            TR_FINISH_UP();
                        } else {
                            TR_ISSUE();
#pragma unroll
                            for (int i = 0; i < 4; ++i) sel[i * 64 + lane] = i * 64 + lane;
                            TR_FINISH();
                            TR_ISSUE_UP(); TR_FINISH_UP();
                        }
                        LDS_WAIT(); asm volatile("" ::: "memory");
                }
#undef TR_ISSUE
#undef TR_FINISH
#undef TR_ISSUE_UP
#undef TR_FINISH_UP
                {
                        LAS unsigned char* cb = lds + wave * 16384;
                        const int nch = (N > 256 ? 256 : N) >> 5;
                        bf16x8 qf[8];
                        { const bf16* qp = QABS + (size_t)t * 2048 + (r16 & 7) * 256 + 8 * g4;
#pragma unroll
                          for (int ks = 0; ks < 8; ++ks) qf[ks] = *(const bf16x8*)(qp + ks * 32); }
                        f32x4 O[16];
#pragma unroll
                        for (int i = 0; i < 16; ++i) O[i] = (f32x4){0.f, 0.f, 0.f, 0.f};
                        float mrun = -3.0e38f, lrun = 0.f;
                        const int tq = r16 >> 2, tp = r16 & 3;
#pragma unroll 1
                        for (int ch = 0; ch < nch; ++ch) { const int slot0 = ch * 32;
#pragma unroll
                            for (int k = 0; k < 16; ++k) { const int im = k >> 3, row = (k & 7) * 4 + g4; const int lc = r16 ^ (((row & 3) << 2) | ((row >> 2) & 3)); const int key = sel[slot0 + row];
                                __builtin_amdgcn_global_load_lds((const unsigned*)(CKVN + (size_t)key * 256 + im * 128 + lc * 8), (LAS unsigned*)(cb + im * 8192 + (k & 7) * 1024), 16, 0, 0); }
                            asm volatile("s_waitcnt vmcnt(0)" ::: "memory");
                            const LAS unsigned char* cbc = cb;
                            f32x4 s0 = (f32x4){0.f, 0.f, 0.f, 0.f}, s1 = s0;
#pragma unroll
                            for (int ks = 0; ks < 8; ++ks) { const int im = ks >> 2, lc = 4 * (ks & 3) + g4;
                                const int ra = r16, rb = 16 + r16;
                                const bf16x8 k0 = *(const LAS bf16x8*)(cbc + im * 8192 + 256 * ra + 16 * (lc ^ (((ra & 3) << 2) | ((ra >> 2) & 3))));
                                const bf16x8 k1 = *(const LAS bf16x8*)(cbc + im * 8192 + 256 * rb + 16 * (lc ^ (((rb & 3) << 2) | ((rb >> 2) & 3))));
                                s0 = __builtin_amdgcn_mfma_f32_16x16x32_bf16(k0, qf[ks], s0, 0, 0, 0); s1 = __builtin_amdgcn_mfma_f32_16x16x32_bf16(k1, qf[ks], s1, 0, 0, 0);
                                if ((ks & 1) == 1) __builtin_amdgcn_sched_barrier(0); }
                            float mx = fmaxf(fmaxf(fmaxf(s0[0], s0[1]), fmaxf(s0[2], s0[3])), fmaxf(fmaxf(s1[0], s1[1]), fmaxf(s1[2], s1[3])));
                            mx = fmaxf(mx, __shfl_xor(mx, 16)); mx = fmaxf(mx, __shfl_xor(mx, 32));
                            const float mnew = fmaxf(mrun, mx), alpha = __expf(mrun - mnew); mrun = mnew;
                            float p[8]; float ls = 0.f;
#pragma unroll
                            for (int i = 0; i < 4; ++i) { p[i] = __expf(s0[i] - mnew); p[4 + i] = __expf(s1[i] - mnew); ls += p[i] + p[4 + i]; }
                            ls += __shfl_xor(ls, 16); ls += __shfl_xor(ls, 32);
                            lrun = lrun * alpha + ls;
                            u32x4 pw; pw.x = pk2(p[0], p[1]); pw.y = pk2(p[2], p[3]); pw.z = pk2(p[4], p[5]); pw.w = pk2(p[6], p[7]);
                            const bf16x8 pf = __builtin_bit_cast(bf16x8, pw);
#pragma unroll
                            for (int i = 0; i < 16; ++i) O[i] = O[i] * alpha;
                            const unsigned cbase = (unsigned)(size_t)cbc + 256u * (4 * g4 + tq) + 8u * (tp & 1);
#pragma unroll
                            for (int cq = 0; cq < 4; ++cq) {
                                u32x2 va[4], vb[4]; unsigned ad[4];
#pragma unroll
                                for (int j = 0; j < 4; ++j) { const int ct = cq * 4 + j; ad[j] = cbase + (unsigned)((ct >> 3) * 8192) + 16u * ((2 * (ct & 7) + (tp >> 1)) ^ ((tq << 2) | g4)); }
                                asm volatile("ds_read_b64_tr_b16 %0, %8\n\tds_read_b64_tr_b16 %1, %8 offset:4096\n\tds_read_b64_tr_b16 %2, %9\n\tds_read_b64_tr_b16 %3, %9 offset:4096\n\t"
                                             "ds_read_b64_tr_b16 %4, %10\n\tds_read_b64_tr_b16 %5, %10 offset:4096\n\tds_read_b64_tr_b16 %6, %11\n\tds_read_b64_tr_b16 %7, %11 offset:4096\n\ts_waitcnt lgkmcnt(0)"
                                             : "=&v"(va[0]), "=&v"(vb[0]), "=&v"(va[1]), "=&v"(vb[1]), "=&v"(va[2]), "=&v"(vb[2]), "=&v"(va[3]), "=&v"(vb[3])
                                             : "v"(ad[0]), "v"(ad[1]), "v"(ad[2]), "v"(ad[3]) : "memory");
#pragma unroll
                                for (int j = 0; j < 4; ++j) { u32x4 vv; vv.x = va[j].x; vv.y = va[j].y; vv.z = vb[j].x; vv.w = vb[j].y;
                                    O[cq * 4 + j] = __builtin_amdgcn_mfma_f32_16x16x32_bf16(__builtin_bit_cast(bf16x8, vv), pf, O[cq * 4 + j], 0, 0, 0); } }
                        }
                        const float inv = 1.f / lrun;
                        if (r16 < 8) {
#pragma unroll
                            for (int i = 0; i < 16; ++i) { u32x2 w; w.x = pk2(O[i][0] * inv, O[i][1] * inv); w.y = pk2(O[i][2] * inv, O[i][3] * inv); __builtin_nontemporal_store(w, (u32x2*)(MIXIN + (size_t)t * KMIX + r16 * 256 + i * 16 + 4 * g4)); } }
                }
            }
        }
        __syncthreads();
    }

    if (IN(4)) for (int rep_ = 0; rep_ < NREP(4); ++rep_) {
        PHASE_IDS
        if (rep_) xcd_barrier(bar, tid);
        LAS float* Sf = (LAS float*)lds;
        LAS bf16* Sb = (LAS bf16*)(lds + 16640);
        LAS float* ms = (LAS float*)(lds + 25856);
        LAS float* ssq = (LAS float*)(lds + 27904);
        const float* mlg = A_->in[I_ML_NORM_G];
        const int r32 = lane & 31, hh = lane >> 5;
        for (int uu = bx; uu < NCH * 4; uu += G) {
            const int c = uu >> 2, h = uu & 3, t0 = c * CH;
            __syncthreads();
            if (tid < 64) { const float b = GATES[GT_B + (size_t)(t0 + tid) * 4 + h], li = GATES[GT_LI + (size_t)(t0 + tid) * 4 + h]; ms[tid] = b; ms[64 + tid] = li - b; }
            if (tid < 128) ms[384 + tid] = NST[(size_t)(c * 4 + h) * 128 + tid];
            __syncthreads();
            float mt = 0.f;
            if (wave == 0) { const float mprev = GATES[GT_MPREV + c * 4 + h]; float pm = ms[64 + lane];
#pragma unroll
                for (int o = 1; o < 64; o <<= 1) { const float v = __shfl_up(pm, o); if (lane >= o) pm = fmaxf(pm, v); }
                const float mm = fmaxf(mprev, pm); mt = ms[lane] + mm; ms[128 + lane] = -mm; ms[192 + lane] = __expf(mprev - mm);
                float qn = 0.f; const bf16* qr = QCM + (size_t)(t0 + lane) * 512 + h * 128; u32x4 qq[16];
#pragma unroll
                for (int k8 = 0; k8 < 16; ++k8) qq[k8] = *(const u32x4*)(qr + k8 * 8);
#pragma unroll
                for (int k8 = 0; k8 < 16; ++k8) { const LAS float* np = ms + 384 + k8 * 8;
                    qn += (bf2f(qq[k8].x & 0xffffu) * np[0] + bf2f(qq[k8].x >> 16) * np[1]) + (bf2f(qq[k8].y & 0xffffu) * np[2] + bf2f(qq[k8].y >> 16) * np[3]) + (bf2f(qq[k8].z & 0xffffu) * np[4] + bf2f(qq[k8].z >> 16) * np[5]) + (bf2f(qq[k8].w & 0xffffu) * np[6] + bf2f(qq[k8].w >> 16) * np[7]); }
                ms[320 + lane] = qn; }
            __syncthreads();
            if (wave < 4) {
                const int tm = wave >> 1, tn = wave & 1;
                f32x16 acc;
#pragma unroll
                for (int i = 0; i < 16; ++i) acc[i] = 0.f;
                if (tn <= tm) { const bf16* qr = QCM + (size_t)(t0 + tm * 32 + r32) * 512 + h * 128 + 8 * hh; const bf16* kr = KCM + (size_t)(t0 + tn * 32 + r32) * 512 + h * 128 + 8 * hh;
#pragma unroll
                    for (int ks = 0; ks < 8; ++ks) acc = __builtin_amdgcn_mfma_f32_32x32x16_bf16(*(const bf16x8*)(qr + ks * 16), *(const bf16x8*)(kr + ks * 16), acc, 0, 0, 0); }
                const int sidx = tn * 32 + r32; const float us = ms[64 + sidx];
#pragma unroll
                for (int i = 0; i < 16; ++i) { const int t = tm * 32 + (i & 3) + 8 * (i >> 2) + 4 * hh; const float v = (sidx <= t) ? acc[i] * __expf(ms[128 + t] + us) : 0.f; Sf[t * 65 + sidx] = v; Sb[t * 72 + sidx] = (bf16)f2bf(v); }
            }
            __syncthreads();
            if (tid < 64) { float rs = 0.f;
#pragma unroll 4
                for (int s2 = 0; s2 < 64; ++s2) rs += Sf[tid * 65 + s2];
                const float dn = ms[192 + tid] * ms[320 + tid] + rs; ms[256 + tid] = fmaxf(fabsf(dn), __expf(-mt)); }
            f32x16 a1[2], a2[2];
#pragma unroll
            for (int tt = 0; tt < 2; ++tt)
#pragma unroll
                for (int i = 0; i < 16; ++i) { a1[tt][i] = 0.f; a2[tt][i] = 0.f; }
            { const bf16* cr = CST + ((size_t)(c * 4 + h) * 256 + wave * 32 + r32) * 128 + 8 * hh; const bf16* q0 = QCM + (size_t)(t0 + r32) * 512 + h * 128 + 8 * hh; const bf16* q1 = q0 + (size_t)32 * 512;
#pragma unroll
              for (int ks = 0; ks < 8; ++ks) { const bf16x8 cf = *(const bf16x8*)(cr + ks * 16); a1[0] = __builtin_amdgcn_mfma_f32_32x32x16_bf16(cf, *(const bf16x8*)(q0 + ks * 16), a1[0], 0, 0, 0); a1[1] = __builtin_amdgcn_mfma_f32_32x32x16_bf16(cf, *(const bf16x8*)(q1 + ks * 16), a1[1], 0, 0, 0); }
              const bf16* vr = VTM + ((size_t)(c * 4 + h) * 256 + wave * 32 + r32) * 64 + 8 * hh;
#pragma unroll
              for (int ks = 0; ks < 4; ++ks) { const bf16x8 vf = *(const bf16x8*)(vr + ks * 16); a2[0] = __builtin_amdgcn_mfma_f32_32x32x16_bf16(vf, *(const LAS bf16x8*)(Sb + r32 * 72 + ks * 16 + 8 * hh), a2[0], 0, 0, 0); a2[1] = __builtin_amdgcn_mfma_f32_32x32x16_bf16(vf, *(const LAS bf16x8*)(Sb + (32 + r32) * 72 + ks * 16 + 8 * hh), a2[1], 0, 0, 0); } }
            __syncthreads();
#pragma unroll
            for (int tt = 0; tt < 2; ++tt) { const int t = tt * 32 + r32; const float ai = ms[192 + t], idn = 1.f / ms[256 + t]; float p = 0.f;
#pragma unroll
                for (int i = 0; i < 16; ++i) { const float v = (ai * a1[tt][i] + a2[tt][i]) * idn; a1[tt][i] = v; p += v * v; }
                p += __shfl_xor(p, 32); if (hh == 0) ssq[wave * 64 + t] = p; }
            __syncthreads();
#pragma unroll
            for (int tt = 0; tt < 2; ++tt) { const int t = tt * 32 + r32; float sq = 0.f;
#pragma unroll
                for (int w2 = 0; w2 < 8; ++w2) sq += ssq[w2 * 64 + t];
                const float r = rsqrtf(sq * (1.f / 256.f) + EPS);
#pragma unroll
                for (int rq = 0; rq < 4; ++rq) { const int dv0 = h * 256 + wave * 32 + 8 * rq + 4 * hh; const f32x4 g = *(const f32x4*)(mlg + dv0); const u32x2 ob = *(const u32x2*)(MO + (size_t)(t0 + t) * 1024 + dv0);
                    const float o0 = bf2f(ob.x & 0xffffu), o1 = bf2f(ob.x >> 16), o2 = bf2f(ob.y & 0xffffu), o3 = bf2f(ob.y >> 16);
                    u32x2 w; w.x = pk2(a1[tt][4 * rq] * r * g[0] / (1.f + __expf(-o0)), a1[tt][4 * rq + 1] * r * g[1] / (1.f + __expf(-o1))); w.y = pk2(a1[tt][4 * rq + 2] * r * g[2] / (1.f + __expf(-o2)), a1[tt][4 * rq + 3] * r * g[3] / (1.f + __expf(-o3)));
                    *(u32x2*)(MIXIN + (size_t)(t0 + t) * KMIX + 2048 + dv0) = w; } }
        }
        GRID_BAR(4);
    }

    if (IN(6)) for (int rep_ = 0; rep_ < NREP(6); ++rep_) {
        PHASE_IDS
        if (rep_) xcd_barrier(bar, tid);
        pg8::DenseOrder S; S.init(T, D, KMIX, KMIX, G, bx);
        pg8::EpiResidT<false> E{A_->in[I_X], X1B, SS2};
        pg8::gemm_phase(tid, lds, MIXIN, WOUT_T, KMIX, S, E);
        GRID_BAR(6);
    }
    if (IN(7)) for (int rep_ = 0; rep_ < NREP(7); ++rep_) {
        PHASE_IDS
        if (rep_) xcd_barrier(bar, tid);
        pg8::DenseOrder S; S.init(T, 1024, D, D, G, bx);
        pg8::EpiSoftmax E{PB, SS2};
        pg8::gemm_phase(tid, lds, X1B, MF, D, S, E);
        { const int nidle = G > 128 ? G - 128 : G, ib = G > 128 ? bx - 128 : bx;
          if (ib >= 0) { LAS unsigned char* scr8 = lds + wave * 16384; __syncthreads();
              for (int r = ib * 8 + wave; r < 32 * 256; r += nidle * 8) { const int e = r / 256, q = r % 256, kb = q / 32, nb = q % 32;
                  tr_item64(A_->in[I_W_DOWN] + (size_t)e * DEXP * D, D, 64 * kb, 64 * nb, nullptr, WDN_T + (size_t)e * D * DEXP, DEXP, 0, 0, scr8, lane); } } }
        GRID_BAR(7);
    }
    if (IN(10)) for (int rep_ = 0; rep_ < NREP(10); ++rep_) {
        PHASE_IDS
        if (rep_) xcd_barrier(bar, tid);
        pg8::DenseOrder S; S.init(T, D, 1024, 1024, G, bx);
        pg8::EpiResidT<true> E{X1B, X2B, nullptr};
        pg8::gemm_phase(tid, lds, PB, VF, 1024, S, E);
        GRID_BAR(10);
    }
    if (IN(11)) for (int rep_ = 0; rep_ < NREP(11); ++rep_) {
        PHASE_IDS
        if (rep_) xcd_barrier(bar, tid);
        LAS float* part = (LAS float*)lds;
        LAS float* ssp = (LAS float*)(lds + 24576);
        LAS int* eb = (LAS int*)(lds + 24576 + 512);
        const int r16 = lane & 15, g4 = lane >> 4;
        for (int uu = bx; uu < T / 32; uu += G) {
            const int t0 = uu * 32; const int tt = wave & 1, ksl = wave >> 1;
            __syncthreads();
            {
                f32x4 acc[3];
#pragma unroll
                for (int i = 0; i < 3; ++i) acc[i] = (f32x4){0.f, 0.f, 0.f, 0.f};
                float ssq = 0.f;
                const bf16* xr = X2B + (size_t)(t0 + tt * 16 + r16) * D + ksl * 512 + 8 * g4;
                const bf16* wh = WRH + (size_t)r16 * D + ksl * 512 + 8 * g4; const bf16* wl = WRL + (size_t)r16 * D + ksl * 512 + 8 * g4;
#pragma unroll 4
                for (int ks = 0; ks < 16; ++ks) { const u32x4 xa = *(const u32x4*)(xr + ks * 32);
                    { const float f0 = bf2f(xa.x & 0xffffu), f1 = bf2f(xa.x >> 16), f2 = bf2f(xa.y & 0xffffu), f3 = bf2f(xa.y >> 16), f4 = bf2f(xa.z & 0xffffu), f5 = bf2f(xa.z >> 16), f6 = bf2f(xa.w & 0xffffu), f7 = bf2f(xa.w >> 16);
                      ssq += ((f0 * f0 + f1 * f1) + (f2 * f2 + f3 * f3)) + ((f4 * f4 + f5 * f5) + (f6 * f6 + f7 * f7)); }
                    const bf16x8 Ah = __builtin_bit_cast(bf16x8, xa);
#pragma unroll
                    for (int nt = 0; nt < 3; ++nt) { const bf16x8 Bh = *(const bf16x8*)(wh + (size_t)nt * 16 * D + ks * 32), Bl = *(const bf16x8*)(wl + (size_t)nt * 16 * D + ks * 32);
                        acc[nt] = __builtin_amdgcn_mfma_f32_16x16x32_bf16(Ah, Bh, acc[nt], 0, 0, 0); acc[nt] = __builtin_amdgcn_mfma_f32_16x16x32_bf16(Ah, Bl, acc[nt], 0, 0, 0); } }
#pragma unroll
                for (int nt = 0; nt < 3; ++nt)
#pragma unroll
                    for (int i = 0; i < 4; ++i) part[(ksl * 32 + tt * 16 + 4 * g4 + i) * 48 + nt * 16 + r16] = acc[nt][i];
                ssq += __shfl_xor(ssq, 16); ssq += __shfl_xor(ssq, 32);
                if (g4 == 0) ssp[ksl * 32 + tt * 16 + r16] = ssq;
            }
            __syncthreads();
            int e1 = 0, e2 = 0;
            if (tid < 32) { const int t = t0 + tid; const float rstd = rsqrtf((ssp[tid] + ssp[32 + tid] + ssp[64 + tid] + ssp[96 + tid]) * (1.f / D) + EPS);
                const LAS float* p0 = part + tid * 48;
#define LG(o) ((p0[(o)] + p0[32 * 48 + (o)] + p0[64 * 48 + (o)] + p0[96 * 48 + (o)]) * rstd)
                int gs = 0; float gmax = LG(0) + A_->in[I_B_GROUP][0]; float gv[4]; gv[0] = gmax;
#pragma unroll
                for (int i = 1; i < 4; ++i) { gv[i] = LG(i) + A_->in[I_B_GROUP][i]; if (gv[i] > gmax) { gmax = gv[i]; gs = i; } }
                float gsum = 0.f;
#pragma unroll
                for (int i = 0; i < 4; ++i) gsum += __expf(gv[i] - gmax);
                const float pg = 1.f / gsum;
                int i1 = 0, i2 = 0; float v1 = -3.0e38f, v2 = -3.0e38f;
#pragma unroll 1
                for (int i = 0; i < 8; ++i) { const float ev = LG(4 + gs * 8 + i) + A_->in[I_B_ROUTER][gs * 8 + i];
                    if (ev > v1) { v2 = v1; i2 = i1; v1 = ev; i1 = i; } else if (ev > v2) { v2 = ev; i2 = i; } }
#undef LG
                const float p2 = __expf(v2 - v1); const float g1 = pg / (1.f + p2), g2 = pg * p2 / (1.f + p2);
                e1 = gs * 8 + i1; e2 = gs * 8 + i2;
                eb[2 * tid] = e1; eb[2 * tid + 1] = e2;
                TOKW[2 * t] = g1; TOKW[2 * t + 1] = g2; RSTD3[t] = rstd; }
            __syncthreads();
            LAS int* ebase = eb + 64;
            if (tid >= 64 && tid < 96) { const int e = tid - 64; int c = 0;
#pragma unroll 1
                for (int a2 = 0; a2 < 64; ++a2) c += (eb[a2] == e) ? 1 : 0;
                ebase[e] = c ? atomicAdd(CNT + e, c) : 0; }
            __syncthreads();
            if (tid < 64) { const int e = eb[tid]; int rk = 0;
#pragma unroll 1
                for (int a2 = 0; a2 < tid; ++a2) rk += (eb[a2] == e) ? 1 : 0;
                const int slot = ebase[e] + rk; LIST[e * T + slot] = t0 + (tid >> 1); TOKE[2 * t0 + tid] = e * T + slot; }
        }
        GRID_BAR(11);
    }
    volatile LAS int* cnl = (volatile LAS int*)(MISC + 64); volatile LAS int* prel = (volatile LAS int*)(MISC + 128); volatile LAS int* tbl = (volatile LAS int*)(MISC + 192);
    volatile LAS int* mtl = (volatile LAS int*)(MISC + 256); volatile LAS int* tlr = (volatile LAS int*)(MISC + 288); volatile LAS int* tpre = (volatile LAS int*)(MISC + 320); volatile LAS int* fll = (volatile LAS int*)(MISC + 384);
    constexpr int MOE_TAIL = 96;
#define MOE_TABLES(ncol) do { __syncthreads(); if (tid < 64) { const int e = tid & 31; const int c = __hip_atomic_load(CNT + e, __ATOMIC_RELAXED, __HIP_MEMORY_SCOPE_AGENT);     \
        const int full = c >> 8, mt = (c + 255) >> 8; int p = mt * (ncol), tb = mt; \
        _Pragma("unroll") for (int d_ = 1; d_ < 32; d_ <<= 1) { const int q_ = __shfl_up(p, d_), r_ = __shfl_up(tb, d_); if (e >= d_) { p += q_; tb += r_; } } \
        if (tid < 32) { cnl[e] = c; prel[e] = p - mt * (ncol); tbl[e] = tb - mt; mtl[e] = mt; tlr[e] = 0; tpre[e] = 0; fll[e] = full; if (e == 31) { prel[32] = p; tbl[32] = tb; tpre[32] = 0; } } } __syncthreads(); } while (0)
#define MOE_GU(Lb, Le, nbk, cc) do { pg8::MoeOrder S{tbl, cnl, LIST, 4, (Lb), (Le), (nbk), (cc), (unsigned)D * 2u, (size_t)1024 * D * 2, (unsigned)D * 2u, 1}; \
        pg8::EpiSwiGLU E{ACT, LIST, RSTD3, cnl}; pg8::gemm_phase(tid, lds, X2B, WGU_T, D, S, E); } while (0)
#define MOE_DN(Lb, Le, nbk, cc) do { pg8::MoeOrder S{tbl, cnl, LIST, 8, (Lb), (Le), (nbk), (cc), (unsigned)DEXP * 2u, (size_t)D * DEXP * 2, (unsigned)DEXP * 2u, 0}; \
        pg8::EpiBf16 E{Y, D}; pg8::gemm_phase(tid, lds, ACT, WDN_T, DEXP, S, E); } while (0)
    if (IN(13)) for (int rep_ = 0; rep_ < NREP(13); ++rep_) {
        PHASE_IDS
        if (rep_) xcd_barrier(bar, tid);
        MOE_TABLES(4);
        const int U1 = tbl[32] * 4;
        MOE_GU(0, U1 < G ? U1 : G, G, bx);
        GRID_BAR(13);
    }
    if (IN(14)) for (int rep_ = 0; rep_ < NREP(14); ++rep_) {
        PHASE_IDS
        if (rep_) xcd_barrier(bar, tid);
        MOE_TABLES(4);
        const int RT = tbl[32], U1 = RT * 4; const int nb0 = U1 > G ? ((U1 - G) < G ? (U1 - G) : G) : 0; const int rta = (U1 < G ? U1 : G) >> 2;
        if (bx < nb0) MOE_GU(G, U1, nb0, bx);
        else MOE_DN(0, rta * 8, G - nb0, bx - nb0);
        GRID_BAR(14);
    }
    if (IN(15)) for (int rep_ = 0; rep_ < NREP(15); ++rep_) {
        PHASE_IDS
        if (rep_) xcd_barrier(bar, tid);
        MOE_TABLES(8);
        const int RT = tbl[32], U1 = RT * 4; const int rta = (U1 < G ? U1 : G) >> 2;
        MOE_DN(rta * 8, RT * 8, G, bx);
        GRID_BAR(15);
    }
    if (IN(16)) for (int rep_ = 0; rep_ < NREP(16); ++rep_) {
        PHASE_IDS
        if (rep_) xcd_barrier(bar, tid);
        MOE_TABLES(1);
        const float* fg = A_->in[I_FINAL_G];
        int a0n = 0, a1n = 0; float w0n = 0.f, w1n = 0.f;
        if (gw < T) { a0n = TOKE[2 * gw]; a1n = TOKE[2 * gw + 1]; w0n = TOKW[2 * gw]; w1n = TOKW[2 * gw + 1]; }
#pragma unroll 1
        for (int t = gw; t < T; t += NGW) {
            const int a0 = a0n, a1 = a1n; const float w0 = w0n, w1 = w1n;
            { const int tn = t + NGW; if (tn < T) { a0n = TOKE[2 * tn]; a1n = TOKE[2 * tn + 1]; w0n = TOKW[2 * tn]; w1n = TOKW[2 * tn + 1]; } }
            const size_t r0 = (size_t)tbl[a0 / T] * 256 + (a0 % T), r1 = (size_t)tbl[a1 / T] * 256 + (a1 % T);
            const u32x2* xr = (const u32x2*)(X2B + (size_t)t * D) + lane; f32x4* xo = (rep_ == NREP(16) - 1) ? (f32x4*)(A_->out + (size_t)t * D) + lane : (f32x4*)((float*)(ws + WS_X1B) + (size_t)t * D) + lane; const u32x2* y0 = (const u32x2*)(Y + r0 * D) + lane; const u32x2* y1 = (const u32x2*)(Y + r1 * D) + lane;
            f32x4 v[8]; float s = 0.f;
#pragma unroll
            for (int j = 0; j < 8; ++j) { const u32x2 xq = xr[64 * j]; v[j] = (f32x4){bf2f(xq.x & 0xffffu), bf2f(xq.x >> 16), bf2f(xq.y & 0xffffu), bf2f(xq.y >> 16)}; const u32x2 p = y0[64 * j], q = y1[64 * j];
                v[j][0] += w0 * bf2f(p.x & 0xffffu) + w1 * bf2f(q.x & 0xffffu); v[j][1] += w0 * bf2f(p.x >> 16) + w1 * bf2f(q.x >> 16);
                v[j][2] += w0 * bf2f(p.y & 0xffffu) + w1 * bf2f(q.y & 0xffffu); v[j][3] += w0 * bf2f(p.y >> 16) + w1 * bf2f(q.y >> 16);
                s += (v[j][0] * v[j][0] + v[j][1] * v[j][1]) + (v[j][2] * v[j][2] + v[j][3] * v[j][3]); }
            const float r = rsqrtf(wave_sum(s) * (1.f / D) + EPS);
#pragma unroll
            for (int j = 0; j < 8; ++j) { const f32x4 g = ((const f32x4*)fg)[lane + 64 * j]; xo[64 * j] = (f32x4){v[j][0] * r * g[0], v[j][1] * r * g[1], v[j][2] * r * g[2], v[j][3] * r * g[3]}; }
        }
    }
#undef IN
#undef BOTH
#undef GRID_BAR
}

extern "C" void kernel_launch(void* const* d_in, const int* in_sizes, int n_in, void* d_out, int out_size, void* d_ws, size_t ws_size, hipStream_t stream) {
    static int grid = 0;
    if (grid == 0) {
        if (n_in != 27 || out_size != T * D || ws_size < WS_END) { fprintf(stderr, "kernel_launch: unexpected problem (n_in %d out %d ws %zu)\n", n_in, out_size, ws_size); grid = -1; return; }
        int dev = 0, cus = 0, per_cu = 0;
        if (hipGetDevice(&dev) != hipSuccess || hipDeviceGetAttribute(&cus, hipDeviceAttributeMultiprocessorCount, dev) != hipSuccess) { grid = -1; return; }
        if (hipFuncSetAttribute((const void*)mega, hipFuncAttributeMaxDynamicSharedMemorySize, LDS_BYTES) != hipSuccess) { fprintf(stderr, "kernel_launch: hipFuncSetAttribute failed\n"); grid = -1; return; }
        if (hipOccupancyMaxActiveBlocksPerMultiprocessor(&per_cu, (const void*)mega, 512, LDS_BYTES) != hipSuccess || per_cu < 1) fprintf(stderr, "kernel_launch: occupancy query reports %d\n", per_cu);
        (void)hipGetLastError();
        grid = cus;
    }
    if (grid < 0) return;
    if (hipMemsetAsync((char*)d_ws + WS_CTL, 0, CTL_ZERO_BYTES, stream) != hipSuccess) return;
    Args a{};
    for (int i = 0; i < 27; ++i) a.in[i] = (const float*)d_in[i];
    a.out = (float*)d_out; a.ws = (unsigned char*)d_ws;
    if (MK_N_LAUNCHES == 1) { a.ph_lo = 0; a.ph_hi = NPHASE; hipLaunchKernelGGL(mega, dim3(grid), dim3(512), LDS_BYTES, stream, a); }
    else { for (int p = 0; p < NPHASE; ++p) { a.ph_lo = p; a.ph_hi = p + 1; hipLaunchKernelGGL(mega, dim3(grid), dim3(512), LDS_BYTES, stream, a); } }
}
```
